# Optimizing an MI355X kernel written in HIP

```python
import math
import jax, jax.numpy as jnp
from jax import lax
import numpy as np

D_MODEL = 2048
BATCH = 4
SEQ = 4096
DEPTH = 2

CHUNK = 64
Q_BLOCK = 128
N_MIXERS = 2
NORM_EPS = 1e-6
ROPE_THETA = 500000.0

DA_HEADS = 8
DA_HEAD_DIM = D_MODEL // (2 * DA_HEADS)
DA_V_DIM = 2 * DA_HEAD_DIM
ROPE_DIM = DA_HEAD_DIM // 4
DA_IN_COLS = 3 * DA_HEADS * DA_V_DIM

ML_HEADS = 8
ML_V_DIM = D_MODEL // ML_HEADS
ML_QK_DIM = ML_V_DIM // 2
ML_CONV = 4
ML_QK_COLS = 2 * ML_HEADS * ML_QK_DIM
ML_V_COLS = ML_HEADS * ML_V_DIM
ML_IN_COLS = ML_QK_COLS + 2 * ML_V_COLS + 2 * ML_HEADS

MOE_GROUPS = 4
MOE_PER_GROUP = 8
MOE_EXPERTS = MOE_GROUPS * MOE_PER_GROUP
MOE_TOPK = 2
MOE_HIDDEN = D_MODEL // 2
MOE_BLOCK = 128

N_ATTN_LAYERS = (DEPTH + 1) // N_MIXERS
N_MLSTM_LAYERS = DEPTH // N_MIXERS

kernel_name = 'hybrid_diffattn_mlstm_hmoe'


def rms_norm(x, g):
    xf = x.astype(jnp.float32)
    y = xf * lax.rsqrt(jnp.mean(xf * xf, axis=-1, keepdims=True) + NORM_EPS)
    return (y * g.astype(jnp.float32)).astype(x.dtype)


def partial_rope(t, cos, sin):
    half = ROPE_DIM // 2
    t1 = t[..., :half]
    t2 = t[..., half:ROPE_DIM]
    rot = jnp.concatenate([t1 * cos - t2 * sin, t2 * cos + t1 * sin], axis=-1)
    return jnp.concatenate([rot, t[..., ROPE_DIM:]], axis=-1)


def diff_attention(h, positions, w_in, w_out, lq1, lk1, lq2, lk2, head_g, layer_idx):
    B, S, _ = h.shape
    q, k, v = jnp.split(h @ w_in, 3, axis=-1)
    q = q.reshape(B, S, DA_HEADS, 2, DA_HEAD_DIM)
    k = k.reshape(B, S, DA_HEADS, 2, DA_HEAD_DIM)
    v = v.reshape(B, S, DA_HEADS, DA_V_DIM)
    half = ROPE_DIM // 2
    inv_freq = ROPE_THETA ** (-jnp.arange(half, dtype=jnp.float32) * 2.0 / ROPE_DIM)
    ang = positions.astype(jnp.float32)[..., None] * inv_freq
    cos = jnp.cos(ang)[:, :, None, None, :].astype(h.dtype)
    sin = jnp.sin(ang)[:, :, None, None, :].astype(h.dtype)
    q = partial_rope(q, cos, sin) * (DA_HEAD_DIM ** -0.5)
    k = partial_rope(k, cos, sin)
    lam_init = 0.8 - 0.6 * math.exp(-0.3 * layer_idx)
    lam = (jnp.exp(jnp.sum(lq1.astype(jnp.float32) * lk1.astype(jnp.float32)))
           - jnp.exp(jnp.sum(lq2.astype(jnp.float32) * lk2.astype(jnp.float32))) + lam_init)
    outs = []
    for qb in range(S // Q_BLOCK):
        q0 = qb * Q_BLOCK
        kv_end = q0 + Q_BLOCK
        s = jnp.einsum('bqhmd,bkhmd->bhmqk', q[:, q0:kv_end], k[:, :kv_end]).astype(jnp.float32)
        q_chunk = (q0 + jnp.arange(Q_BLOCK)) // CHUNK
        k_chunk = jnp.arange(kv_end) // CHUNK
        mask = k_chunk[None, :] <= q_chunk[:, None]
        p = jax.nn.softmax(jnp.where(mask, s, -jnp.inf), axis=-1)
        a = p[:, :, 0] - lam * p[:, :, 1]
        outs.append(jnp.einsum('bhqk,bkhe->bqhe', a.astype(v.dtype), v[:, :kv_end]))
    o = jnp.concatenate(outs, axis=1)
    o = rms_norm(o, head_g) * (1.0 - lam_init)
    return o.reshape(B, S, DA_HEADS * DA_V_DIM) @ w_out


def mlstm_chunk_step(carry, xs):
    C, n, m = carry
    q, k, v, ig, lf = xs
    causal = jnp.tril(jnp.ones((CHUNK, CHUNK), dtype=bool))
    b = jnp.cumsum(lf, axis=-1)
    dmat = jnp.where(causal, b[..., :, None] - b[..., None, :] + ig[..., None, :], -jnp.inf)
    inter = b + m[..., None]
    m_t = jnp.maximum(inter, jnp.max(dmat, axis=-1))
    w = jnp.exp(dmat - m_t[..., None])
    s = jnp.einsum('bhtd,bhsd->bhts', q, k) * w
    decay = jnp.exp(inter - m_t)
    num = jnp.einsum('bhts,bhse->bhte', s, v) + decay[..., None] * jnp.einsum('bhed,bhtd->bhte', C, q)
    den = jnp.sum(s, axis=-1) + decay * jnp.einsum('bhd,bhtd->bht', n, q)
    h = num / jnp.maximum(jnp.abs(den), jnp.exp(-m_t))[..., None]
    b_last = b[..., -1]
    g = b_last[..., None] - b + ig
    m_new = jnp.maximum(b_last + m, jnp.max(g, axis=-1))
    carry_decay = jnp.exp(b_last + m - m_new)
    wg = jnp.exp(g - m_new[..., None])
    C_new = carry_decay[..., None, None] * C + jnp.einsum('bhs,bhse,bhsd->bhed', wg, v, k)
    n_new = carry_decay[..., None] * n + jnp.einsum('bhs,bhsd->bhd', wg, k)
    return (C_new, n_new, m_new), h


def mlstm_mixer(h, w_in, conv_w, conv_b, gate_b, head_g, w_out):
    B, S, _ = h.shape
    H = ML_HEADS
    proj = h @ w_in
    qk_pre = proj[..., :ML_QK_COLS]
    v = proj[..., ML_QK_COLS:ML_QK_COLS + ML_V_COLS]
    o_pre = proj[..., ML_QK_COLS + ML_V_COLS:ML_QK_COLS + 2 * ML_V_COLS]
    gates = proj[..., ML_QK_COLS + 2 * ML_V_COLS:].astype(jnp.float32) + gate_b.astype(jnp.float32)
    qk = lax.conv_general_dilated(qk_pre, conv_w[:, None, :], window_strides=(1,),
                                  padding=[(ML_CONV - 1, 0)], dimension_numbers=('NWC', 'WIO', 'NWC'),
                                  feature_group_count=ML_QK_COLS)
    qk = jax.nn.silu(qk + conv_b)
    q, k = jnp.split(qk, 2, axis=-1)
    q = q.reshape(B, S, H, ML_QK_DIM).astype(jnp.float32)
    k = k.reshape(B, S, H, ML_QK_DIM).astype(jnp.float32) * (ML_QK_DIM ** -0.5)
    vf = v.reshape(B, S, H, ML_V_DIM).astype(jnp.float32)
    ig = gates[..., :H]
    lf = jax.nn.log_sigmoid(gates[..., H:])
    nc = S // CHUNK

    def to_chunks(t):
        return t.reshape(B, nc, CHUNK, H, -1).transpose(1, 0, 3, 2, 4)

    def gate_chunks(t):
        return t.reshape(B, nc, CHUNK, H).transpose(1, 0, 3, 2)

    init = (jnp.zeros((B, H, ML_V_DIM, ML_QK_DIM), jnp.float32),
            jnp.zeros((B, H, ML_QK_DIM), jnp.float32),
            jnp.zeros((B, H), jnp.float32))
    _, hs = lax.scan(mlstm_chunk_step, init,
                     (to_chunks(q), to_chunks(k), to_chunks(vf), gate_chunks(ig), gate_chunks(lf)))
    hs = hs.transpose(1, 0, 3, 2, 4).reshape(B, S, H, ML_V_DIM)
    hn = rms_norm(hs, head_g.reshape(H, ML_V_DIM)).reshape(B, S, H * ML_V_DIM).astype(h.dtype)
    return (jax.nn.sigmoid(o_pre) * hn) @ w_out


def hier_moe(h, w_group, b_group, w_expert, b_expert, w_gu, w_down):
    B, S, D = h.shape
    xt = h.reshape(-1, D)
    N = xt.shape[0]
    gl = (xt @ w_group + b_group).astype(jnp.float32)
    grp = jnp.argmax(gl, axis=-1)
    p_group = jnp.take_along_axis(jax.nn.softmax(gl, axis=-1), grp[:, None], axis=-1)
    el = (xt @ w_expert + b_expert).astype(jnp.float32).reshape(N, MOE_GROUPS, MOE_PER_GROUP)
    el_g = jnp.take_along_axis(el, grp[:, None, None], axis=1)[:, 0]
    top_v, top_i = lax.top_k(el_g, MOE_TOPK)
    gate = jax.nn.softmax(top_v, axis=-1) * p_group
    eid = (grp[:, None] * MOE_PER_GROUP + top_i).reshape(-1).astype(jnp.int32)
    tok = jnp.repeat(jnp.arange(N, dtype=jnp.int32), MOE_TOPK)
    wts = gate.reshape(-1)
    A = N * MOE_TOPK
    order = jnp.argsort(eid)
    se, stok, sw = eid[order], tok[order], wts[order]
    counts = jnp.bincount(eid, length=MOE_EXPERTS)
    padded = ((counts + MOE_BLOCK - 1) // MOE_BLOCK) * MOE_BLOCK
    start = jnp.cumsum(counts) - counts
    pad_end = jnp.cumsum(padded)
    pad_start = pad_end - padded
    dest = pad_start[se] + jnp.arange(A, dtype=jnp.int32) - start[se]
    P = A + MOE_EXPERTS * MOE_BLOCK
    row_tok = jnp.zeros((P,), jnp.int32).at[dest].set(stok)
    row_w = jnp.zeros((P,), jnp.float32).at[dest].set(sw)
    nb = P // MOE_BLOCK
    block_e = jnp.minimum(jnp.searchsorted(pad_end, jnp.arange(nb) * MOE_BLOCK, side='right'),
                          MOE_EXPERTS - 1)
    xin = xt[row_tok].reshape(nb, MOE_BLOCK, D)

    def expert_block(args):
        xb, e = args
        gt, up = jnp.split(xb @ w_gu[e], 2, axis=-1)
        return (jax.nn.silu(gt) * up) @ w_down[e]

    y = lax.map(expert_block, (xin, block_e)).reshape(P, D)
    out = jnp.zeros_like(xt).at[row_tok].add(y * row_w[:, None].astype(y.dtype))
    return out.reshape(B, S, D)


def setup_inputs(seed: int = 0) -> dict:
    key = jax.random.key(seed)
    ks = jax.random.split(key, 32)
    f32 = jnp.float32
    D = D_MODEL

    def nrm(k, shape, scale):
        return jax.random.normal(k, shape, f32) * scale

    forget_b = jnp.broadcast_to(jnp.linspace(3.0, 6.0, ML_HEADS, dtype=f32), (N_MLSTM_LAYERS, ML_HEADS))
    gate_b = jnp.concatenate([nrm(ks[20], (N_MLSTM_LAYERS, ML_HEADS), 0.1),
                              forget_b + nrm(ks[21], (N_MLSTM_LAYERS, ML_HEADS), 0.1)], axis=-1)
    return {
        'x': nrm(ks[0], (BATCH, SEQ, D), 1.0),
        'c': nrm(ks[1], (BATCH, D), 1.0),
        'positions': (jnp.arange(SEQ, dtype=jnp.int32)[None, :]
                      + jax.random.randint(ks[2], (BATCH, 1), 0, 4096, dtype=jnp.int32)),
        'ada_w': nrm(ks[3], (DEPTH, D, 6 * D), 0.5 * D ** -0.5),
        'ada_b': nrm(ks[4], (DEPTH, 6 * D), 0.02),
        'norm_mix_g': 1.0 + nrm(ks[5], (DEPTH, D), 0.02),
        'norm_ffn_g': 1.0 + nrm(ks[6], (DEPTH, D), 0.02),
        'final_norm_g': 1.0 + nrm(ks[7], (D,), 0.02),
        'attn_w_in': nrm(ks[8], (N_ATTN_LAYERS, D, DA_IN_COLS), D ** -0.5),
        'attn_w_out': nrm(ks[9], (N_ATTN_LAYERS, DA_HEADS * DA_V_DIM, D), (DA_HEADS * DA_V_DIM) ** -0.5),
        'attn_lambda_q1': nrm(ks[10], (N_ATTN_LAYERS, DA_HEAD_DIM), 0.1),
        'attn_lambda_k1': nrm(ks[11], (N_ATTN_LAYERS, DA_HEAD_DIM), 0.1),
        'attn_lambda_q2': nrm(ks[12], (N_ATTN_LAYERS, DA_HEAD_DIM), 0.1),
        'attn_lambda_k2': nrm(ks[13], (N_ATTN_LAYERS, DA_HEAD_DIM), 0.1),
        'attn_head_norm_g': 1.0 + nrm(ks[14], (N_ATTN_LAYERS, DA_V_DIM), 0.02),
        'mlstm_w_in': nrm(ks[15], (N_MLSTM_LAYERS, D, ML_IN_COLS), D ** -0.5),
        'mlstm_conv_w': nrm(ks[16], (N_MLSTM_LAYERS, ML_CONV, ML_QK_COLS), ML_CONV ** -0.5),
        'mlstm_conv_b': nrm(ks[17], (N_MLSTM_LAYERS, ML_QK_COLS), 0.02),
        'mlstm_gate_b': gate_b,
        'mlstm_head_norm_g': 1.0 + nrm(ks[18], (N_MLSTM_LAYERS, ML_V_COLS), 0.02),
        'mlstm_w_out': nrm(ks[19], (N_MLSTM_LAYERS, ML_V_COLS, D), ML_V_COLS ** -0.5),
        'moe_w_group': nrm(ks[22], (DEPTH, D, MOE_GROUPS), D ** -0.5),
        'moe_b_group': nrm(ks[23], (DEPTH, MOE_GROUPS), 0.01),
        'moe_w_expert': nrm(ks[24], (DEPTH, D, MOE_EXPERTS), D ** -0.5),
        'moe_b_expert': nrm(ks[25], (DEPTH, MOE_EXPERTS), 0.01),
        'moe_w_gu': nrm(ks[26], (DEPTH, MOE_EXPERTS, D, 2 * MOE_HIDDEN), D ** -0.5),
        'moe_w_down': nrm(ks[27], (DEPTH, MOE_EXPERTS, MOE_HIDDEN, D), MOE_HIDDEN ** -0.5),
    }


def reference(x, c, positions, ada_w, ada_b, norm_mix_g, norm_ffn_g, final_norm_g,
              attn_w_in, attn_w_out, attn_lambda_q1, attn_lambda_k1, attn_lambda_q2, attn_lambda_k2,
              attn_head_norm_g, mlstm_w_in, mlstm_conv_w, mlstm_conv_b, mlstm_gate_b,
              mlstm_head_norm_g, mlstm_w_out, moe_w_group, moe_b_group, moe_w_expert, moe_b_expert,
              moe_w_gu, moe_w_down):
    cond = jax.nn.silu(c)
    for i in range(DEPTH):
        mod = (cond @ ada_w[i] + ada_b[i])[:, None, :]
        sh1, sc1, gt1, sh2, sc2, gt2 = jnp.split(mod, 6, axis=-1)
        hmix = rms_norm(x, norm_mix_g[i]) * (1.0 + sc1) + sh1
        j = i // N_MIXERS
        if i % N_MIXERS == 0:
            y = diff_attention(hmix, positions, attn_w_in[j], attn_w_out[j], attn_lambda_q1[j],
                               attn_lambda_k1[j], attn_lambda_q2[j], attn_lambda_k2[j],
                               attn_head_norm_g[j], i)
        else:
            y = mlstm_mixer(hmix, mlstm_w_in[j], mlstm_conv_w[j], mlstm_conv_b[j], mlstm_gate_b[j],
                            mlstm_head_norm_g[j], mlstm_w_out[j])
        x = x + gt1 * y
        hffn = rms_norm(x, norm_ffn_g[i]) * (1.0 + sc2) + sh2
        x = x + gt2 * hier_moe(hffn, moe_w_group[i], moe_b_group[i], moe_w_expert[i], moe_b_expert[i],
                               moe_w_gu[i], moe_w_down[i])
    return rms_norm(x, final_norm_g)
```

```cpp
#include <hip/hip_runtime.h>
#include <math.h>
#include <stdint.h>


namespace pg8 {
#define PG8_LAS __attribute__((address_space(3)))
typedef unsigned short bf16_t;
typedef short bf16x8 __attribute__((ext_vector_type(8)));
typedef float f32x4 __attribute__((ext_vector_type(4)));
typedef unsigned u32x4 __attribute__((ext_vector_type(4)));
constexpr int BM = 256, BK = 64, HALF = 128, KBP = 1088  , HTB = 16 * KBP  , STAGE_BYTES = 8 * HTB, NXCD = 8, WGM = 8;

__host__ __device__ __forceinline__ int lds_byte(int r, int c) { const int ch = c >> 3, p = (ch & 4) | ((ch & 3) ^ ((r >> 1) & 3)); return (r >> 3) * KBP + (r & 7) * 128 + p * 16 + (c & 7) * 2; }
__host__ __device__ __forceinline__ void stage_rc(int tid, int i, int& R, int& C) { const int g = (tid >> 6) + 8 * i, l = tid & 63, rr = l >> 3, p = l & 7, ch = (p & 4) | ((p & 3) ^ ((rr >> 1) & 3)); R = 8 * g + rr; C = ch * 8; }
__host__ __device__ __forceinline__ int perm32(int rho) { const int n = rho >> 4, i = rho & 15; return 8 * (i >> 2) + 4 * n + (i & 3); }

typedef int i32x4 __attribute__((ext_vector_type(4)));
typedef int i32x8 __attribute__((ext_vector_type(8)));
typedef int i32x2 __attribute__((ext_vector_type(2)));
__device__ __forceinline__ i32x8 cat8(i32x4 l, i32x4 h) { return __builtin_shufflevector(l, h, 0, 1, 2, 3, 4, 5, 6, 7); }
__device__ __forceinline__ void mfma_scale_f8(f32x4& acc, i32x8 b, i32x8 a, int sc) {
    asm volatile("v_mfma_scale_f32_16x16x128_f8f6f4 %0, %1, %2, %0, %3, %3 op_sel_hi:[0,0,0]" : "+v"(acc) : "v"(b), "v"(a), "v"(sc));
}
struct Unit { int pm, pn; };
struct Gemm { const bf16_t* A; const bf16_t* Bt; int M, N, K; };

struct StaticOrder {
    int nM, nN, nwg, G, c;
    __host__ __device__ void init(int M, int N, int G_, int c_) { nM = M / BM; nN = N / BM; nwg = nM * nN; G = G_; c = c_; }
    __host__ __device__ bool next(int i, Unit& u) const {
        const long L = (long)i * G + c; if (L >= nwg) return false;
        int wgid = (int)L; { const int q = nwg / NXCD, r = nwg % NXCD, xcd = wgid % NXCD, off = wgid / NXCD; wgid = (xcd < r ? xcd * (q + 1) : r * (q + 1) + (xcd - r) * q) + off; }
        const int nig = WGM * nN, gid = wgid / nig, fm = gid * WGM, gsz = (nM - fm) < WGM ? (nM - fm) : WGM;
        u.pm = fm + ((wgid % nig) % gsz); u.pn = (wgid % nig) / gsz; return true;
    }
    __device__ __forceinline__ void a_ready(const Unit&) const {}
    __device__ __forceinline__ void done(const Unit&) const {}
};

__device__ __forceinline__ unsigned cvt_pk_bf16(float lo, float hi) { unsigned r; asm volatile("v_cvt_pk_bf16_f32 %0, %1, %2" : "=v"(r) : "v"(lo), "v"(hi)); return r; }
typedef float f32x2 __attribute__((ext_vector_type(2)));
__device__ __forceinline__ f32x2 gelu_pk(f32x2 v) {
    const f32x2 av = __builtin_elementwise_abs(v), d = av * 0.2316418882f + 1.0f;
    f32x2 t; t.x = __builtin_amdgcn_rcpf(d.x); t.y = __builtin_amdgcn_rcpf(d.y);
    f32x2 q = t * 0.5307027145f + (-0.7265760135f); q = q * t + 0.7107068705f; q = q * t + (-0.142248368f); q = q * t + 0.127414796f; q = q * t;
    const f32x2 s = (v * v) * (-0.72134752044f);
    f32x2 e; e.x = __builtin_amdgcn_exp2f(s.x); e.y = __builtin_amdgcn_exp2f(s.y);
    const f32x2 m = v * (q * e), r = v - m;
    f32x2 o; o.x = v.x < 0.f ? m.x : r.x; o.y = v.y < 0.f ? m.y : r.y; return o;
}


template <class Epi, class Sched, bool ALIGN_EPI = false, bool SP2 = false, bool F8 = false, int SCA = 127, int SCB = 127>
__device__ __forceinline__ void gemm_phase(PG8_LAS unsigned char* lds, const Gemm g, const Sched& S, const Epi& E) {
    const int tid = threadIdx.x, wid = __builtin_amdgcn_readfirstlane(tid >> 6), lane = tid & 63, wr = wid >> 2, wc = wid & 3, fr = lane & 15, fq = lane >> 4;
    const int K = g.K, nt = K / BK;
    unsigned voffA[2], voffB[2];
#pragma unroll
    for (int i = 0; i < 2; ++i) { int R, C; stage_rc(tid, i, R, C); const int Rb = Epi::PERM ? ((R & ~31) + perm32(R & 31)) : R;
        voffA[i] = (unsigned)(R * K + C) * 2u; voffB[i] = (unsigned)(Rb * K + C) * 2u; }
    const size_t kstep = (size_t)(BK * 2);
    const size_t hstep = (size_t)HALF * K * 2;
    const size_t tstep = 2 * hstep;
    const unsigned ldsw = (unsigned)wid * (unsigned)KBP;
    const int aoff = lds_byte(wr * 64 + fr, fq * 8), boff = lds_byte(wc * 32 + fr, fq * 8);
#define PG8_SA(b, h) (((b) * 2 + (h)) * HTB)
#define PG8_SB(b, h) ((4 + (b) * 2 + (h)) * HTB)
#define PG8_STAGE(bufoff, gbase, voff) do { _Pragma("unroll") for (int _i = 0; _i < 2; ++_i) \
        __builtin_amdgcn_global_load_lds((const unsigned*)((const char*)(gbase) + (voff)[_i]), (PG8_LAS unsigned*)(lds + (bufoff) + ldsw + _i * (8 * KBP)), 16, 0, 0); } while (0)
#define PG8_LDA(dst, b, h) do { if constexpr (F8) { _Pragma("unroll") for (int m = 0; m < 4; ++m) dst##8[m] = cat8(*(const PG8_LAS i32x4*)(lds + PG8_SA(b, h) + aoff + m * (2 * KBP)), *(const PG8_LAS i32x4*)(lds + PG8_SA(b, h) + aoff + m * (2 * KBP) + 64)); } \
        else { _Pragma("unroll") for (int m = 0; m < 4; ++m) _Pragma("unroll") for (int k = 0; k < 2; ++k) dst[m][k] = *(const PG8_LAS bf16x8*)(lds + PG8_SA(b, h) + aoff + m * (2 * KBP) + k * 64); } } while (0)
#define PG8_LDB(dst, b, h) do { if constexpr (F8) { _Pragma("unroll") for (int n = 0; n < 2; ++n) dst##8[n] = cat8(*(const PG8_LAS i32x4*)(lds + PG8_SB(b, h) + boff + n * (2 * KBP)), *(const PG8_LAS i32x4*)(lds + PG8_SB(b, h) + boff + n * (2 * KBP) + 64)); } \
        else { _Pragma("unroll") for (int n = 0; n < 2; ++n) _Pragma("unroll") for (int k = 0; k < 2; ++k) dst[n][k] = *(const PG8_LAS bf16x8*)(lds + PG8_SB(b, h) + boff + n * (2 * KBP) + k * 64); } } while (0)
#define PG8_MMA(ai, bj, At, Bt) do { __builtin_amdgcn_s_setprio(1); _Pragma("unroll") for (int m = 0; m < 4; ++m) _Pragma("unroll") for (int n = 0; n < 2; ++n) { \
        if constexpr (F8) { mfma_scale_f8(acc[ai][bj][m][n], Bt##8[n], At##8[m], sc1); } \
        else { _Pragma("unroll") for (int k = 0; k < 2; ++k) acc[ai][bj][m][n] = __builtin_amdgcn_mfma_f32_16x16x32_bf16(Bt[n][k], At[m][k], acc[ai][bj][m][n], 0, 0, 0); } } \
        __builtin_amdgcn_s_setprio(0); } while (0)
#define PG8_WAIT_V(n) asm volatile("s_waitcnt vmcnt(" #n ")" ::: "memory")
#define PG8_WAIT_L(n) asm volatile("s_waitcnt lgkmcnt(" #n ")" ::: "memory")
#define PG8_BAR __builtin_amdgcn_s_barrier()
#define PG8_SCHED __builtin_amdgcn_sched_barrier(0)
    Unit cur, nxt; int ui = 0;
    if (!S.next(0, cur)) return;
    f32x4 acc[2][2][4][2];
#pragma unroll
    for (int a = 0; a < 2; ++a)
#pragma unroll
        for (int b = 0; b < 2; ++b)
#pragma unroll
            for (int m = 0; m < 4; ++m)
#pragma unroll
                for (int n = 0; n < 2; ++n) acc[a][b][m][n] = (f32x4){0.f, 0.f, 0.f, 0.f};
    bf16x8 At[4][2], B0[2][2], B1[2][2]; i32x8 At8[4], B08[2], B18[2]; int sc1 = 0x7f7f7f7f; asm volatile("" : "+v"(sc1));
    const char* cA = (const char*)g.A + (size_t)cur.pm * tstep; const char* cB = (const char*)g.Bt + (size_t)cur.pn * tstep;
    S.a_ready(cur);
    if constexpr (SP2) {
        PG8_STAGE(PG8_SB(0, 0), cB, voffB); PG8_STAGE(PG8_SB(0, 1), cB + hstep, voffB); PG8_STAGE(PG8_SA(0, 0), cA, voffA); PG8_STAGE(PG8_SA(0, 1), cA + hstep, voffA);
        if (wr == 1) PG8_BAR;
        PG8_WAIT_V(2); PG8_BAR;
        PG8_STAGE(PG8_SB(1, 0), cB + kstep, voffB); PG8_STAGE(PG8_SA(1, 0), cA + kstep, voffA); PG8_STAGE(PG8_SB(1, 1), cB + hstep + kstep, voffB);
        PG8_WAIT_V(6); PG8_BAR;
    } else {
        PG8_STAGE(PG8_SB(0, 0), cB, voffB); PG8_STAGE(PG8_SA(0, 0), cA, voffA); PG8_STAGE(PG8_SB(0, 1), cB + hstep, voffB); PG8_STAGE(PG8_SA(0, 1), cA + hstep, voffA);
        if (wr == 1) PG8_BAR;
        PG8_WAIT_V(4); PG8_BAR;
        PG8_STAGE(PG8_SB(1, 0), cB + kstep, voffB); PG8_STAGE(PG8_SA(1, 0), cA + kstep, voffA); PG8_STAGE(PG8_SB(1, 1), cB + hstep + kstep, voffB);
        PG8_WAIT_V(6); PG8_BAR;
    }
    for (;;) {
        const bool has_next = S.next(ui + 1, nxt);
        const char* nA = has_next ? (const char*)g.A + (size_t)nxt.pm * tstep : cA; const char* nB = has_next ? (const char*)g.Bt + (size_t)nxt.pn * tstep : cB;
#pragma nounroll
        for (int t = 0; t < nt; t += 2) {
            const bool last = (t == nt - 2);
            const char* a1 = cA + (size_t)(t + 1) * kstep;
            const char* a2 = last ? nA : cA + (size_t)(t + 2) * kstep; const char* b2 = last ? nB : cB + (size_t)(t + 2) * kstep;
            const char* a3 = a2 + kstep; const char* b3 = b2 + kstep;
            if (last && has_next) S.a_ready(nxt);
            if constexpr (SP2) {
            PG8_LDB(B0, 0, 0); PG8_LDB(B1, 0, 1); PG8_SCHED; PG8_LDA(At, 0, 0); PG8_STAGE(PG8_SA(1, 1), a1 + hstep, voffA);
            PG8_WAIT_V(8); PG8_WAIT_L(0); PG8_BAR; PG8_MMA(0, 0, At, B0); PG8_MMA(0, 1, At, B1); PG8_BAR; PG8_SCHED;
            PG8_LDA(At, 0, 1); PG8_STAGE(PG8_SB(0, 0), b2, voffB); PG8_STAGE(PG8_SB(0, 1), b2 + hstep, voffB); PG8_STAGE(PG8_SA(0, 0), a2, voffA);
            PG8_WAIT_V(8); PG8_WAIT_L(0); PG8_BAR; PG8_MMA(1, 0, At, B0); PG8_MMA(1, 1, At, B1); PG8_BAR; PG8_SCHED;
            PG8_LDB(B0, 1, 0); PG8_LDB(B1, 1, 1); PG8_SCHED; PG8_LDA(At, 1, 0); PG8_STAGE(PG8_SA(0, 1), a2 + hstep, voffA);
            PG8_WAIT_V(8); PG8_WAIT_L(0); PG8_BAR; PG8_MMA(0, 0, At, B0); PG8_MMA(0, 1, At, B1); PG8_BAR; PG8_SCHED;
            PG8_LDA(At, 1, 1); PG8_STAGE(PG8_SB(1, 0), b3, voffB); PG8_STAGE(PG8_SB(1, 1), b3 + hstep, voffB); PG8_STAGE(PG8_SA(1, 0), a3, voffA);
            PG8_WAIT_V(8); PG8_WAIT_L(0); PG8_BAR; PG8_MMA(1, 0, At, B0); PG8_MMA(1, 1, At, B1); PG8_BAR; PG8_SCHED;
            } else {
            PG8_LDB(B0, 0, 0); PG8_SCHED; PG8_LDA(At, 0, 0); PG8_STAGE(PG8_SA(1, 1), a1 + hstep, voffA);
            PG8_WAIT_L(8); PG8_BAR; PG8_WAIT_L(0); PG8_MMA(0, 0, At, B0); PG8_BAR; PG8_SCHED;
            PG8_LDB(B1, 0, 1); PG8_STAGE(PG8_SB(0, 0), b2, voffB);
            PG8_BAR; PG8_WAIT_L(0); PG8_MMA(0, 1, At, B1); PG8_BAR;
            PG8_LDA(At, 0, 1); PG8_STAGE(PG8_SA(0, 0), a2, voffA);
            PG8_BAR; PG8_WAIT_L(0); PG8_MMA(1, 0, At, B0); PG8_BAR; PG8_SCHED;
            PG8_STAGE(PG8_SB(0, 1), b2 + hstep, voffB);
            PG8_WAIT_V(6); PG8_BAR; PG8_MMA(1, 1, At, B1); PG8_BAR;
            PG8_LDB(B0, 1, 0); PG8_SCHED; PG8_LDA(At, 1, 0); PG8_STAGE(PG8_SA(0, 1), a2 + hstep, voffA);
            PG8_WAIT_L(8); PG8_BAR; PG8_WAIT_L(0); PG8_MMA(0, 0, At, B0); PG8_BAR; PG8_SCHED;
            PG8_LDB(B1, 1, 1); PG8_STAGE(PG8_SB(1, 0), b3, voffB);
            PG8_BAR; PG8_WAIT_L(0); PG8_MMA(0, 1, At, B1); PG8_BAR;
            PG8_LDA(At, 1, 1); PG8_STAGE(PG8_SA(1, 0), a3, voffA);
            PG8_BAR; PG8_WAIT_L(0); PG8_MMA(1, 0, At, B0); PG8_BAR; PG8_SCHED;
            PG8_STAGE(PG8_SB(1, 1), b3 + hstep, voffB);
            PG8_WAIT_V(6); PG8_BAR; PG8_MMA(1, 1, At, B1); PG8_BAR;
            }
        }
        if constexpr (F8) {
            asm volatile("s_nop 15\n\ts_nop 15" ::: "memory");
            _Pragma("unroll") for (int a = 0; a < 2; ++a) _Pragma("unroll") for (int b = 0; b < 2; ++b) _Pragma("unroll") for (int m = 0; m < 4; ++m) _Pragma("unroll") for (int n = 0; n < 2; ++n) asm volatile("" : "+v"(acc[a][b][m][n]));
        }
        if constexpr (ALIGN_EPI) { if (wr == 0) PG8_BAR; }
        if constexpr (!Epi::AFTER_DRAIN) { E(acc, cur, wr, wc, fr, fq); S.done(cur); }
        if (!has_next) break;
#pragma unroll
        for (int a = 0; a < 2; ++a)
#pragma unroll
            for (int b = 0; b < 2; ++b)
#pragma unroll
                for (int m = 0; m < 4; ++m)
#pragma unroll
                    for (int n = 0; n < 2; ++n) acc[a][b][m][n] = (f32x4){0.f, 0.f, 0.f, 0.f};
        cur = nxt; cA = nA; cB = nB; ++ui;
        if constexpr (ALIGN_EPI) { if (wr == 1) PG8_BAR; }
    }
    PG8_WAIT_V(0);
    if constexpr (!ALIGN_EPI) { if (wr == 0) PG8_BAR; }
    PG8_BAR;
    if constexpr (Epi::AFTER_DRAIN) { E.fused(acc, cur, wr, wc, fr, fq, lds, wid, lane); S.done(cur); }
#undef PG8_SA
#undef PG8_SB
#undef PG8_STAGE
#undef PG8_LDA
#undef PG8_LDB
#undef PG8_MMA
#undef PG8_WAIT_V
#undef PG8_WAIT_L
#undef PG8_BAR
#undef PG8_SCHED
}
template <class Epi, class Sched, bool F8 = false, int SCA = 127, int SCB = 127>
__device__ __forceinline__ void gemm_phase_gather(PG8_LAS unsigned char* lds, const Gemm g, const Sched& S, const Epi& E) {
    const int tid = threadIdx.x, wid = __builtin_amdgcn_readfirstlane(tid >> 6), lane = tid & 63, wr = wid >> 2, wc = wid & 3, fr = lane & 15, fq = lane >> 4;
    constexpr bool ALIGN_EPI = true, SP2 = true;
    const int K = g.K, nt = K / BK;
    unsigned voffA[2], voffB[2]; int rowA[2];
#pragma unroll
    for (int i = 0; i < 2; ++i) { int R, C; stage_rc(tid, i, R, C); const int Rb = Epi::PERM ? ((R & ~31) + perm32(R & 31)) : R;
        voffA[i] = (unsigned)C * 2u; rowA[i] = R; voffB[i] = (unsigned)(Rb * K + C) * 2u; }
    const size_t kstep = (size_t)(BK * 2);
    const size_t hstep = (size_t)HALF * K * 2;
    const size_t tstep = 2 * hstep;
    const unsigned ldsw = (unsigned)wid * (unsigned)KBP;
    const int aoff = lds_byte(wr * 64 + fr, fq * 8), boff = lds_byte(wc * 32 + fr, fq * 8);
#define PG8_SA(b, h) (((b) * 2 + (h)) * HTB)
#define PG8_SB(b, h) ((4 + (b) * 2 + (h)) * HTB)
#define PG8_STAGE(bufoff, gbase, voff) do { _Pragma("unroll") for (int _i = 0; _i < 2; ++_i) \
        __builtin_amdgcn_global_load_lds((const unsigned*)((const char*)(gbase) + (voff)[_i]), (PG8_LAS unsigned*)(lds + (bufoff) + ldsw + _i * (8 * KBP)), 16, 0, 0); } while (0)
#define PG8_STAGE_A(bufoff, gbase, o0, o1) do { \
        __builtin_amdgcn_global_load_lds((const unsigned*)((const char*)(gbase) + (o0)), (PG8_LAS unsigned*)(lds + (bufoff) + ldsw), 16, 0, 0); \
        __builtin_amdgcn_global_load_lds((const unsigned*)((const char*)(gbase) + (o1)), (PG8_LAS unsigned*)(lds + (bufoff) + ldsw + 8 * KBP), 16, 0, 0); } while (0)
#define PG8_GOFF(dst, u) do { _Pragma("unroll") for (int h_ = 0; h_ < 2; ++h_) _Pragma("unroll") for (int i_ = 0; i_ < 2; ++i_) dst[h_][i_] = (unsigned)S.a_row(u, 128 * h_ + rowA[i_]) * (unsigned)(K * 2) + voffA[i_]; } while (0)
#define PG8_LDA(dst, b, h) do { if constexpr (F8) { _Pragma("unroll") for (int m = 0; m < 4; ++m) dst##8[m] = cat8(*(const PG8_LAS i32x4*)(lds + PG8_SA(b, h) + aoff + m * (2 * KBP)), *(const PG8_LAS i32x4*)(lds + PG8_SA(b, h) + aoff + m * (2 * KBP) + 64)); } \
        else { _Pragma("unroll") for (int m = 0; m < 4; ++m) _Pragma("unroll") for (int k = 0; k < 2; ++k) dst[m][k] = *(const PG8_LAS bf16x8*)(lds + PG8_SA(b, h) + aoff + m * (2 * KBP) + k * 64); } } while (0)
#define PG8_LDB(dst, b, h) do { if constexpr (F8) { _Pragma("unroll") for (int n = 0; n < 2; ++n) dst##8[n] = cat8(*(const PG8_LAS i32x4*)(lds + PG8_SB(b, h) + boff + n * (2 * KBP)), *(const PG8_LAS i32x4*)(lds + PG8_SB(b, h) + boff + n * (2 * KBP) + 64)); } \
        else { _Pragma("unroll") for (int n = 0; n < 2; ++n) _Pragma("unroll") for (int k = 0; k < 2; ++k) dst[n][k] = *(const PG8_LAS bf16x8*)(lds + PG8_SB(b, h) + boff + n * (2 * KBP) + k * 64); } } while (0)
#define PG8_MMA(ai, bj, At, Bt) do { __builtin_amdgcn_s_setprio(1); _Pragma("unroll") for (int m = 0; m < 4; ++m) _Pragma("unroll") for (int n = 0; n < 2; ++n) { \
        if constexpr (F8) { mfma_scale_f8(acc[ai][bj][m][n], Bt##8[n], At##8[m], sc1); } \
        else { _Pragma("unroll") for (int k = 0; k < 2; ++k) acc[ai][bj][m][n] = __builtin_amdgcn_mfma_f32_16x16x32_bf16(Bt[n][k], At[m][k], acc[ai][bj][m][n], 0, 0, 0); } } \
        __builtin_amdgcn_s_setprio(0); } while (0)
#define PG8_WAIT_V(n) asm volatile("s_waitcnt vmcnt(" #n ")" ::: "memory")
#define PG8_WAIT_L(n) asm volatile("s_waitcnt lgkmcnt(" #n ")" ::: "memory")
#define PG8_BAR __builtin_amdgcn_s_barrier()
#define PG8_SCHED __builtin_amdgcn_sched_barrier(0)
    Unit cur, nxt; int ui = 0;
    if (!S.next(0, cur)) return;
    f32x4 acc[2][2][4][2];
#pragma unroll
    for (int a = 0; a < 2; ++a)
#pragma unroll
        for (int b = 0; b < 2; ++b)
#pragma unroll
            for (int m = 0; m < 4; ++m)
#pragma unroll
                for (int n = 0; n < 2; ++n) acc[a][b][m][n] = (f32x4){0.f, 0.f, 0.f, 0.f};
    bf16x8 At[4][2], B0[2][2], B1[2][2]; i32x8 At8[4], B08[2], B18[2]; int sc1 = 0x7f7f7f7f; asm volatile("" : "+v"(sc1));
    const char* const cA = (const char*)g.A; const char* cB = (const char*)g.Bt + (size_t)cur.pn * tstep;
    unsigned gc[2][2], gn[2][2];
    S.a_ready(cur); PG8_GOFF(gc, cur);
    if constexpr (SP2) {
        PG8_STAGE(PG8_SB(0, 0), cB, voffB); PG8_STAGE(PG8_SB(0, 1), cB + hstep, voffB); PG8_STAGE_A(PG8_SA(0, 0), cA, gc[0][0], gc[0][1]); PG8_STAGE_A(PG8_SA(0, 1), cA, gc[1][0], gc[1][1]);
        if (wr == 1) PG8_BAR;
        PG8_WAIT_V(2); PG8_BAR;
        PG8_STAGE(PG8_SB(1, 0), cB + kstep, voffB); PG8_STAGE_A(PG8_SA(1, 0), cA + kstep, gc[0][0], gc[0][1]); PG8_STAGE(PG8_SB(1, 1), cB + hstep + kstep, voffB);
        PG8_WAIT_V(6); PG8_BAR;
    }
    for (;;) {
        const bool has_next = S.next(ui + 1, nxt);
        const char* nB = has_next ? (const char*)g.Bt + (size_t)nxt.pn * tstep : cB;
        if (has_next) { PG8_GOFF(gn, nxt); } else { _Pragma("unroll") for (int h_ = 0; h_ < 2; ++h_) _Pragma("unroll") for (int i_ = 0; i_ < 2; ++i_) gn[h_][i_] = gc[h_][i_]; }
#pragma nounroll
        for (int t = 0; t < nt; t += 2) {
            const bool last = (t == nt - 2);
            const char* a1 = cA + (size_t)(t + 1) * kstep;
            const char* a2 = last ? cA : cA + (size_t)(t + 2) * kstep; const char* b2 = last ? nB : cB + (size_t)(t + 2) * kstep;
            const unsigned g200 = last ? gn[0][0] : gc[0][0], g201 = last ? gn[0][1] : gc[0][1], g210 = last ? gn[1][0] : gc[1][0], g211 = last ? gn[1][1] : gc[1][1];
            const char* a3 = a2 + kstep; const char* b3 = b2 + kstep;
            if (last && has_next) S.a_ready(nxt);
            if constexpr (SP2) {
            PG8_LDB(B0, 0, 0); PG8_LDB(B1, 0, 1); PG8_SCHED; PG8_LDA(At, 0, 0); PG8_STAGE_A(PG8_SA(1, 1), a1, gc[1][0], gc[1][1]);
            PG8_WAIT_V(8); PG8_WAIT_L(0); PG8_BAR; PG8_MMA(0, 0, At, B0); PG8_MMA(0, 1, At, B1); PG8_BAR; PG8_SCHED;
            PG8_LDA(At, 0, 1); PG8_STAGE(PG8_SB(0, 0), b2, voffB); PG8_STAGE(PG8_SB(0, 1), b2 + hstep, voffB); PG8_STAGE_A(PG8_SA(0, 0), a2, g200, g201);
            PG8_WAIT_V(8); PG8_WAIT_L(0); PG8_BAR; PG8_MMA(1, 0, At, B0); PG8_MMA(1, 1, At, B1); PG8_BAR; PG8_SCHED;
            PG8_LDB(B0, 1, 0); PG8_LDB(B1, 1, 1); PG8_SCHED; PG8_LDA(At, 1, 0); PG8_STAGE_A(PG8_SA(0, 1), a2, g210, g211);
            PG8_WAIT_V(8); PG8_WAIT_L(0); PG8_BAR; PG8_MMA(0, 0, At, B0); PG8_MMA(0, 1, At, B1); PG8_BAR; PG8_SCHED;
            PG8_LDA(At, 1, 1); PG8_STAGE(PG8_SB(1, 0), b3, voffB); PG8_STAGE(PG8_SB(1, 1), b3 + hstep, voffB); PG8_STAGE_A(PG8_SA(1, 0), a3, g200, g201);
            PG8_WAIT_V(8); PG8_WAIT_L(0); PG8_BAR; PG8_MMA(1, 0, At, B0); PG8_MMA(1, 1, At, B1); PG8_BAR; PG8_SCHED;
            }
        }
        if constexpr (F8) {
            asm volatile("s_nop 15\n\ts_nop 15" ::: "memory");
            _Pragma("unroll") for (int a = 0; a < 2; ++a) _Pragma("unroll") for (int b = 0; b < 2; ++b) _Pragma("unroll") for (int m = 0; m < 4; ++m) _Pragma("unroll") for (int n = 0; n < 2; ++n) asm volatile("" : "+v"(acc[a][b][m][n]));
        }
        if constexpr (ALIGN_EPI) { if (wr == 0) PG8_BAR; }
        if constexpr (!Epi::AFTER_DRAIN) { E(acc, cur, wr, wc, fr, fq); S.done(cur); }
        if (!has_next) break;
#pragma unroll
        for (int a = 0; a < 2; ++a)
#pragma unroll
            for (int b = 0; b < 2; ++b)
#pragma unroll
                for (int m = 0; m < 4; ++m)
#pragma unroll
                    for (int n = 0; n < 2; ++n) acc[a][b][m][n] = (f32x4){0.f, 0.f, 0.f, 0.f};
        cur = nxt; cB = nB; ++ui;
#pragma unroll
        for (int h_ = 0; h_ < 2; ++h_)
#pragma unroll
            for (int i_ = 0; i_ < 2; ++i_) gc[h_][i_] = gn[h_][i_];
        if constexpr (ALIGN_EPI) { if (wr == 1) PG8_BAR; }
    }
    PG8_WAIT_V(0);
    if constexpr (!ALIGN_EPI) { if (wr == 0) PG8_BAR; }
    PG8_BAR;
    if constexpr (Epi::AFTER_DRAIN) { E.fused(acc, cur, wr, wc, fr, fq, lds, wid, lane); S.done(cur); }
#undef PG8_SA
#undef PG8_SB
#undef PG8_STAGE
#undef PG8_STAGE_A
#undef PG8_GOFF
#undef PG8_LDA
#undef PG8_LDB
#undef PG8_MMA
#undef PG8_WAIT_V
#undef PG8_WAIT_L
#undef PG8_BAR
#undef PG8_SCHED
}
}

namespace att {
constexpr int D = 128;
constexpr float THR = 8.f;
constexpr bool WSKIP = false;
constexpr float SCALE = 0.08838834764831845f;
constexpr int NW = 8, QBLK = 32, KVBLK = 64, QB = NW * QBLK;
constexpr int SHM_V = KVBLK * D * 2, SHM_K = KVBLK * D * 2;
constexpr int ATT_LDS_BYTES = 2 * SHM_V + 2 * SHM_K + NW * 64 * 4;
typedef short bf16x8 __attribute__((ext_vector_type(8)));
typedef short s16x4 __attribute__((ext_vector_type(4)));
typedef float f32x16 __attribute__((ext_vector_type(16)));
typedef float f32x4 __attribute__((ext_vector_type(4)));
typedef unsigned u32x4 __attribute__((ext_vector_type(4)));
template <class A, class Bt> struct same_t { static constexpr bool v = false; };
template <class A> struct same_t<A, A> { static constexpr bool v = true; };

#define KSWZ(row, colB) ((row) * 256 + ((colB) ^ (((row) & 7) << 4)))
#define SBAR() __builtin_amdgcn_sched_barrier(0)
__device__ __forceinline__ int v_st(int k, int c) { const int kk = (k & ~0xC) | ((k & 4) << 1) | ((k & 8) >> 1); return ((kk >> 3) * 4 + (c >> 5)) * 512 + ((kk & 7) * 32 + (c & 31)) * 2; }
__device__ __forceinline__ int v_rd_base(int lane) { return ((lane & 3) << 3) | (((lane >> 2) & 3) << 6) | (((lane >> 4) & 1) << 5) | (((lane >> 5) & 1) << 8); }
constexpr int v_rd_off(int d0, int ks, int half) { return d0 * 512 + ks * 4096 + half * 2048; }
__device__ __forceinline__ int crow(int r, int hi) { return (r & 3) + 8 * (r >> 2) + 4 * hi; }
__device__ __forceinline__ unsigned cvtpk(float lo, float hi) {
    unsigned r; asm volatile("v_cvt_pk_bf16_f32 %0, %1, %2" : "=v"(r) : "v"(lo), "v"(hi)); return r;
}
__device__ __forceinline__ bf16x8 pack8(f32x4 a, f32x4 b) {
    u32x4 w = {cvtpk(a[0], a[1]), cvtpk(a[2], a[3]), cvtpk(b[0], b[1]), cvtpk(b[2], b[3])};
    return *reinterpret_cast<bf16x8*>(&w);
}
template <class T> __device__ __forceinline__ bf16x8 load8(const T* p) {
    if constexpr (same_t<T, float>::v) { return pack8(*(const f32x4*)p, *(const f32x4*)(p + 4)); }
    else { return *reinterpret_cast<const bf16x8*>(p); }
}
__device__ __forceinline__ void mask_tile(f32x16& p0, f32x16& p1, int dq, unsigned W) {
    const float NEG = -__builtin_inff();
#pragma unroll
    for (int r = 0; r < 16; ++r) {
        const int c = (r & 3) + 8 * (r >> 2);
        if ((unsigned)(dq - c) >= W) p0[r] = NEG;
        if ((unsigned)(dq - c - 32) >= W) p1[r] = NEG;
    }
}
__device__ __forceinline__ void partialSM(f32x16& p0, f32x16& p1, float& m_reg, float& mn, float& alpha) {
    float pmax = p0[0]; for (int r = 1; r < 16; ++r) pmax = fmaxf(pmax, p0[r]); for (int r = 0; r < 16; ++r) pmax = fmaxf(pmax, p1[r]);
    { auto rr = __builtin_amdgcn_permlane32_swap(__float_as_uint(pmax), __float_as_uint(pmax), false, false);
      pmax = fmaxf(__uint_as_float(rr[0]), __uint_as_float(rr[1])); }
    constexpr float C2 = 1.4426950408889634f * SCALE;
    if (__builtin_expect(__all((pmax - m_reg) * SCALE <= THR), 1)) { mn = m_reg; alpha = 1.f; }
    else { mn = fmaxf(m_reg, pmax); alpha = __builtin_amdgcn_exp2f((m_reg - mn) * C2); m_reg = mn; }
    const float mnL = -mn * C2;
    for (int r = 0; r < 16; ++r) p0[r] = fmaf(p0[r], C2, mnL); for (int r = 0; r < 16; ++r) p1[r] = fmaf(p1[r], C2, mnL);
    for (int r = 0; r < 16; ++r) p0[r] = __builtin_amdgcn_exp2f(p0[r]);
}
__device__ __forceinline__ void finishSM(f32x16& p0, f32x16& p1, float alpha, float& l_reg, bf16x8& pa0, bf16x8& pa1, bf16x8& pa2, bf16x8& pa3) {
    for (int r = 0; r < 16; ++r) p1[r] = __builtin_amdgcn_exp2f(p1[r]);
    float ps = 0; for (int r = 0; r < 16; ++r) ps += p0[r]; for (int r = 0; r < 16; ++r) ps += p1[r];
    { auto rr = __builtin_amdgcn_permlane32_swap(__float_as_uint(ps), __float_as_uint(ps), false, false);
      ps = __uint_as_float(rr[0]) + __uint_as_float(rr[1]); }
    l_reg = l_reg * alpha + ps;
#define PK4(P, B_, OUT) do { unsigned a0 = cvtpk(P[B_+0], P[B_+1]), a1 = cvtpk(P[B_+2], P[B_+3]);                          \
        unsigned b0 = cvtpk(P[B_+4], P[B_+5]), b1 = cvtpk(P[B_+6], P[B_+7]);                                             \
        auto r0 = __builtin_amdgcn_permlane32_swap(a0, b0, false, false); auto r1 = __builtin_amdgcn_permlane32_swap(a1, b1, false, false); \
        u32x4 w = {r0[0], r1[0], r0[1], r1[1]}; OUT = *reinterpret_cast<bf16x8*>(&w); } while (0)
    PK4(p0, 0, pa0); PK4(p0, 8, pa1); PK4(p1, 0, pa2); PK4(p1, 8, pa3);
#undef PK4
}
template <int KB, bool SK>
__device__ __forceinline__ void qkt(f32x16& p0, f32x16& p1, const char* K_lds, int r32, int hi, const bf16x8* qr, bool act) {
    if (SK && !act) { const float NEG = -__builtin_inff();
#pragma unroll
        for (int r = 0; r < 16; ++r) { p0[r] = NEG; p1[r] = NEG; } return; }
    p0 = f32x16{}; p1 = f32x16{};
    const char* kb[4];
#pragma unroll
    for (int dd = 0; dd < 4; ++dd) kb[dd] = K_lds + KB * SHM_K + KSWZ(r32, (dd * 16 + hi * 8) * 2);
#pragma unroll
    for (int d0 = 0; d0 < 8; ++d0) { const char* a = kb[d0 & 3] + (d0 >> 2) * 128;
        bf16x8 b0 = *reinterpret_cast<const bf16x8*>(a);
        bf16x8 b1 = *reinterpret_cast<const bf16x8*>(a + 32 * 256);
        p0 = __builtin_amdgcn_mfma_f32_32x32x16_bf16(b0, qr[d0], p0, 0, 0, 0);
        p1 = __builtin_amdgcn_mfma_f32_32x32x16_bf16(b1, qr[d0], p1, 0, 0, 0); }
}
template <int VB, bool SK>
__device__ __forceinline__ void pv_tile(f32x16* o, int vb0, bf16x8 pa0, bf16x8 pa1, bf16x8 pa2, bf16x8 pa3, bool act) {
    if (SK && !act) return;
#define TRRD(dst, off) asm volatile("ds_read_b64_tr_b16 %0, %1 offset:%2" : "=&v"(dst) : "v"(vb0), "i"(off) : "memory")
#define PV_D0(d0) do { s16x4 l0, l1, l2, l3, h0, h1, h2, h3; constexpr int b_ = VB * SHM_V + v_rd_off(d0, 0, 0);     \
        TRRD(l0, b_); TRRD(h0, b_ + 2048); TRRD(l1, b_ + 4096); TRRD(h1, b_ + 6144); TRRD(l2, b_ + 8192); TRRD(h2, b_ + 10240); TRRD(l3, b_ + 12288); TRRD(h3, b_ + 14336); \
        asm volatile("s_waitcnt lgkmcnt(0)" ::: "memory"); SBAR();                 \
        o[d0] = __builtin_amdgcn_mfma_f32_32x32x16_bf16(pa0, (bf16x8){l0[0], l0[1], l0[2], l0[3], h0[0], h0[1], h0[2], h0[3]}, o[d0], 0, 0, 0);   \
        o[d0] = __builtin_amdgcn_mfma_f32_32x32x16_bf16(pa1, (bf16x8){l1[0], l1[1], l1[2], l1[3], h1[0], h1[1], h1[2], h1[3]}, o[d0], 0, 0, 0);   \
        o[d0] = __builtin_amdgcn_mfma_f32_32x32x16_bf16(pa2, (bf16x8){l2[0], l2[1], l2[2], l2[3], h2[0], h2[1], h2[2], h2[3]}, o[d0], 0, 0, 0);   \
        o[d0] = __builtin_amdgcn_mfma_f32_32x32x16_bf16(pa3, (bf16x8){l3[0], l3[1], l3[2], l3[3], h3[0], h3[1], h3[2], h3[3]}, o[d0], 0, 0, 0); } while (0)
    PV_D0(0); PV_D0(1); PV_D0(2); PV_D0(3);
#undef PV_D0
#undef TRRD
}

template <class TIn, class TOut> struct BlockRef { const TIn* Q; const TIn* K; const TIn* V; TOut* O; int P0; };
template <class TIn> struct Seam {
    bf16x8 qr[8];
    bf16x8 st_v0, st_v1, st_k0, st_k1; f32x4 sf0, sf1, sf2, sf3;
    f32x4 tq[16];
};
__device__ __forceinline__ int swa_jlo(int P0, int W) { const int lowk = P0 - W + 1; return lowk > 0 ? lowk / KVBLK : 0; }
#define ROW(p, k0, rr) ((p) + (size_t)((k0) + (rr)) * D + sc)
#define VMW() asm volatile("s_waitcnt vmcnt(0)" ::: "memory")
#define VMWN(n) asm volatile("s_waitcnt vmcnt(%0)" :: "i"(n) : "memory")
#define SLOAD_H(Kp, Vp, k0) do { S.st_v0 = load8<TIn>(ROW(Vp, k0, sr)); S.st_v1 = load8<TIn>(ROW(Vp, k0, 32 + sr));              \
                         S.st_k0 = load8<TIn>(ROW(Kp, k0, sr)); S.st_k1 = load8<TIn>(ROW(Kp, k0, 32 + sr)); } while (0)
#define SWRITE_HK(bf) do { *(bf16x8*)(K_lds + (bf) * SHM_K + kws) = S.st_k0; *(bf16x8*)(K_lds + (bf) * SHM_K + kws + 32 * 256) = S.st_k1; } while (0)
#define SWRITE_HV(bf) do { *(bf16x8*)(V_lds + (bf) * SHM_V + vst0) = S.st_v0; *(bf16x8*)(V_lds + (bf) * SHM_V + vst1) = S.st_v1; } while (0)
#define SWRITE_H(bf) do { SWRITE_HV(bf); SWRITE_HK(bf); } while (0)
#define SLOAD_F(p, k0) do { S.sf0 = *(const f32x4*)ROW(p, k0, sr); S.sf1 = *(const f32x4*)(ROW(p, k0, sr) + 4);                \
                            S.sf2 = *(const f32x4*)ROW(p, k0, 32 + sr); S.sf3 = *(const f32x4*)(ROW(p, k0, 32 + sr) + 4); } while (0)
#define SWRITE_KF(bf) do { *(bf16x8*)(K_lds + (bf) * SHM_K + kws) = pack8(S.sf0, S.sf1); *(bf16x8*)(K_lds + (bf) * SHM_K + kws + 32 * 256) = pack8(S.sf2, S.sf3); } while (0)
#define SWRITE_VF(bf) do { *(bf16x8*)(V_lds + (bf) * SHM_V + vst0) = pack8(S.sf0, S.sf1); *(bf16x8*)(V_lds + (bf) * SHM_V + vst1) = pack8(S.sf2, S.sf3); } while (0)
template <class TIn, class TOut>
__device__ __forceinline__ void causal_swa_prime(const BlockRef<TIn, TOut>& cur, int W, char* lds, Seam<TIn>& S) {
    constexpr bool F32 = same_t<TIn, float>::v;
    const int tid = threadIdx.x, wid = __builtin_amdgcn_readfirstlane(tid >> 6), lane = tid & 63, r32 = lane & 31, hi = lane >> 5;
    const int sr = tid >> 4, sc = (tid & 15) * 8, kws = KSWZ(sr, sc * 2); char* K_lds = lds + 2 * SHM_V;
    const int kb0 = swa_jlo(cur.P0, W) * KVBLK;
    for (int d0 = 0; d0 < 8; ++d0) S.qr[d0] = load8<TIn>(cur.Q + (size_t)(wid * QBLK + r32) * D + d0 * 16 + hi * 8);
    if constexpr (F32) { SLOAD_F((const float*)cur.K, kb0); VMW(); SWRITE_KF(0); SBAR(); SLOAD_F((const float*)cur.V, kb0); }
    else { SLOAD_H(cur.K, cur.V, kb0); VMW(); SWRITE_HK(0); }
    __syncthreads();
}
template <class TIn, class TOut, class CV>
__device__ __forceinline__ void causal_swa_block(const BlockRef<TIn, TOut>& cur, const BlockRef<TIn, TOut>& nxt, int skv, int W, char* lds, Seam<TIn>& S, CV& cv) {
    constexpr bool F32 = same_t<TIn, float>::v;
    const int tid = threadIdx.x, wid = __builtin_amdgcn_readfirstlane(tid >> 6), lane = tid & 63, r32 = lane & 31, hi = lane >> 5;
    const int j_lo = swa_jlo(cur.P0, W);
    int j_hi = (cur.P0 + QB - 1) / KVBLK + 1; if (j_hi > skv / KVBLK) j_hi = skv / KVBLK;
    const int NT = j_hi - j_lo;
    const int kbn = swa_jlo(nxt.P0, W) * KVBLK;
    const int qlo = cur.P0 + wid * QBLK, qm = ((qlo + r32) | 63) - 4 * hi;
    char* V_lds = lds; char* K_lds = lds + 2 * SHM_V;
    float* ws = (float*)(lds + 2 * SHM_V + 2 * SHM_K) + wid * 64; float* li_l = ws, * al_l = ws + 32;
    float m_reg = -1e30f, l_reg = 0; f32x16 o[4] = {};
    const int sr = tid >> 4, sc = (tid & 15) * 8, vst0 = v_st(sr, sc), vst1 = v_st(32 + sr, sc), kws = KSWZ(sr, sc * 2);
    const int vb0 = (int)(uintptr_t)V_lds + v_rd_base(lane);
    const TIn* Kh = cur.K; const TIn* Vh = cur.V;
#define RESC(a) do { if (__any((a) < 1.f)) { if (hi == 0) al_l[r32] = (a); asm volatile("s_waitcnt lgkmcnt(0)" ::: "memory");              \
                     for (int d_ = 0; d_ < 4; ++d_) for (int r = 0; r < 16; ++r) o[d_][r] *= al_l[crow(r, hi)]; } } while (0)
#define KBASE(t) ((j_lo + (t)) * KVBLK)
#define ACT(t) (KBASE(t) <= qlo + QBLK - 1 && KBASE(t) + KVBLK - 1 >= qlo - W + 1)
#define MASKT(P0_, P1_, t) do { const int kb_ = KBASE(t); if ((!SK || ACT(t)) && (kb_ > qlo)) mask_tile(P0_, P1_, qm - kb_, (unsigned)W); } while (0)
    constexpr int NQL = F32 ? 16 : 8;
    constexpr bool SK = WSKIP && !F32;
#define SEAM_K0() do { VMWN(NQL); if constexpr (F32) { SWRITE_KF(0); SBAR(); SLOAD_F((const float*)nxt.V, kbn); } else { SWRITE_HK(0); } SBAR(); } while (0)
    f32x16 pA0, pA1, pB0, pB1; float mnA, mnB, alA, alB; bf16x8 pa0, pa1, pa2, pa3;
    if constexpr (F32) { VMW(); SWRITE_VF(0); SBAR(); } else { SWRITE_HV(0); SBAR(); }
    if (NT > 1) { if constexpr (F32) SLOAD_F((const float*)Kh, KBASE(1)); else SLOAD_H(Kh, Vh, KBASE(1)); }
    SBAR(); qkt<0, SK>(pA0, pA1, K_lds, r32, hi, S.qr, ACT(0));
    if constexpr (F32) { if (NT > 1) { VMW(); SWRITE_KF(1); SBAR(); SLOAD_F((const float*)Vh, KBASE(1)); } }
    MASKT(pA0, pA1, 0); partialSM(pA0, pA1, m_reg, mnA, alA);
    if (NT > 1) { VMW(); if constexpr (F32) { SWRITE_VF(1); SBAR(); if (NT > 2) SLOAD_F((const float*)Kh, KBASE(2)); } else SWRITE_H(1); }
    __syncthreads();
#define LBAR() do { asm volatile("s_waitcnt lgkmcnt(0)" ::: "memory"); __builtin_amdgcn_s_barrier(); asm volatile("" ::: "memory"); } while (0)
#define HALF_STEP(PX0, PX1, mnX, alX, PY0, PY1, alY, t, KB, VB, SB) do {                                                      \
        SBAR(); cv.issue(); SBAR(); qkt<KB, SK>(PX0, PX1, K_lds, r32, hi, S.qr, ACT(t));                                             \
        finishSM(PY0, PY1, alY, l_reg, pa0, pa1, pa2, pa3); SBAR();                                                           \
        if ((t) + 1 < NT) { if constexpr (F32) { VMW(); SWRITE_KF(SB); SBAR(); SLOAD_F((const float*)Vh, KBASE((t) + 1)); }  \
                            else { SLOAD_H(Kh, Vh, KBASE((t) + 1)); } SBAR(); }                                               \
        pv_tile<VB, SK>(o, vb0, pa0, pa1, pa2, pa3, ACT((t) - 1)); MASKT(PX0, PX1, (t)); partialSM(PX0, PX1, m_reg, mnX, alX);                                        \
        LBAR();                                                                                                               \
        if ((t) + 1 < NT) { VMW(); if constexpr (F32) { SWRITE_VF(SB); SBAR(); if ((t) + 2 < NT) SLOAD_F((const float*)Kh, KBASE((t) + 2)); } \
                            else { SWRITE_H(SB); } }                                                                          \
        RESC(alX); SBAR(); cv.consume(); SBAR(); LBAR(); } while (0)
    __builtin_amdgcn_s_waitcnt(0x0F70);
    for (int t = 1; t + 1 < NT; t += 2) {
        HALF_STEP(pB0, pB1, mnB, alB, pA0, pA1, alA, t, 1, 0, 0);
        HALF_STEP(pA0, pA1, mnA, alA, pB0, pB1, alB, t + 1, 0, 1, 1);
    }
    const bool even = (NT & 1) == 0;
    if (even) { SBAR(); qkt<1, SK>(pB0, pB1, K_lds, r32, hi, S.qr, ACT(NT - 1)); SBAR(); }
#define QROW(e) (nxt.Q + (size_t)(wid * QBLK + r32) * D + ((e) >> 1) * 16 + hi * 8 + ((e) & 1) * 4)
    if constexpr (F32) { SLOAD_F((const float*)nxt.K, kbn); SBAR();
#pragma unroll
        for (int e = 0; e < 8; ++e) S.tq[e] = *(const f32x4*)QROW(e); }
    else { SLOAD_H(nxt.K, nxt.V, kbn); SBAR();
#pragma unroll
        for (int d0 = 0; d0 < 8; ++d0) S.qr[d0] = load8<TIn>(nxt.Q + (size_t)(wid * QBLK + r32) * D + d0 * 16 + hi * 8); }
    SBAR();
    finishSM(pA0, pA1, alA, l_reg, pa0, pa1, pa2, pa3); SBAR();
    if constexpr (F32) {
#pragma unroll
        for (int e = 8; e < 16; ++e) S.tq[e] = *(const f32x4*)QROW(e); SBAR(); }
#undef QROW
    pv_tile<0, SK>(o, vb0, pa0, pa1, pa2, pa3, ACT(even ? NT - 2 : NT - 1));
    if (even) { MASKT(pB0, pB1, NT - 1); partialSM(pB0, pB1, m_reg, mnB, alB); __syncthreads(); RESC(alB);
        finishSM(pB0, pB1, alB, l_reg, pa0, pa1, pa2, pa3); SBAR(); pv_tile<1, SK>(o, vb0, pa0, pa1, pa2, pa3, ACT(NT - 1)); }
    SBAR(); SEAM_K0();
    if (hi == 0) li_l[r32] = l_reg; asm volatile("s_waitcnt lgkmcnt(0)" ::: "memory");
    float rli[16];
#pragma unroll
    for (int r = 0; r < 16; ++r) rli[r] = __builtin_amdgcn_rcpf(li_l[crow(r, hi)]);
    TOut* Ow = cur.O + (size_t)(wid * QBLK) * D;
#pragma unroll
    for (int r = 0; r < 16; ++r) { const int orow = crow(r, hi);
#pragma unroll
        for (int d0 = 0; d0 < 4; ++d0) { const float v = o[d0][r] * rli[r];
            if constexpr (same_t<TOut, float>::v) { Ow[(size_t)orow * D + d0 * 32 + r32] = v; }
            else { const float vn = __shfl_xor(v, 1);
                   if ((r32 & 1) == 0) *(unsigned*)(Ow + (size_t)orow * D + d0 * 32 + r32) = cvtpk(v, vn); } } }
    if constexpr (F32) {
#pragma unroll
        for (int d0 = 0; d0 < 8; ++d0) S.qr[d0] = pack8(S.tq[2 * d0], S.tq[2 * d0 + 1]); }
    __syncthreads();
#undef RESC
#undef KBASE
#undef ACT
#undef MASKT
#undef SEAM_K0
#undef HALF_STEP
#undef LBAR
}
#undef ROW
#undef VMW
#undef VMWN
#undef SLOAD_H
#undef SWRITE_HK
#undef SWRITE_HV
#undef SWRITE_H
#undef SLOAD_F
#undef SWRITE_KF
#undef SWRITE_VF
}


namespace mk {
using pg8::bf16_t; using pg8::f32x4; using pg8::u32x4; using pg8::Unit;
typedef float f32x2v __attribute__((ext_vector_type(2)));
typedef __bf16 bf16x2v __attribute__((ext_vector_type(2)));
__device__ __forceinline__ unsigned cvt_pk_bf16(float lo, float hi) { const f32x2v v = {lo, hi}; return __builtin_bit_cast(unsigned, __builtin_convertvector(v, bf16x2v)); }
#define LAS __attribute__((address_space(3)))
#define LDS_WAIT() asm volatile("s_waitcnt lgkmcnt(0)" ::: "memory")
#define VM_WAIT() asm volatile("s_waitcnt vmcnt(0)" ::: "memory")
constexpr int D = 2048, NB = 4, S = 4096, NT = NB * S, NE = 32, NA = 2 * NT, MH = 1024;
constexpr int NWAVES = 8, NTHR = 512;
constexpr int LDS_MISC = 147456, LDS_BYTES = 163840;
constexpr int MISC_BAR = 0, MISC_PE = 64, MISC_PS = 64 + 1024, MISC_HIST = 64 + 1024 + 256, MISC_BASE = MISC_HIST + 128, MISC_NP = MISC_BASE + 128, MISC_CNT = MISC_NP + 64;
constexpr int PMAX = NA + NE * 256;
constexpr float EPS = 1e-6f;
typedef unsigned u32x2 __attribute__((ext_vector_type(2)));

struct Args {
    const float *x, *c; const int* pos; const float *ada_w, *ada_b, *nmg, *nfg, *fng, *a_win, *a_wout, *lq1, *lk1, *lq2, *lk2, *a_hg,
        *m_win, *m_cw, *m_cb, *m_gb, *m_hg, *m_wout, *wg, *bg, *we, *be, *wgu, *wdn;
    float* out;
    unsigned* ctl; float* mod; float2* cs;
    bf16_t *Bt_qkv, *Bt_ao, *Bt_min, *Bt_mo, *Bt_rt, *Bt_g, *Bt_gu, *Bt_dn;
    bf16_t* xres; bf16_t* hb; bf16_t* ob; float* proj;
    float* logits; int* eid; float* wts; int* pos_in_e; int* slot; int* counts; int* inv;
    bf16_t *XG, *Hm, *Y;
    bf16_t *Qh, *Kh, *Vh, *Oa;
    unsigned char *hb8, *Hm8, *Bt_gu8, *Bt_dn8;
    unsigned char *Bt_min8, *Bt_mo8, *ob8;
    bf16_t *P3, *Qn, *Kn, *KT, *VT, *HS; float *gates, *GA, *GS;
    int ph_lo, ph_hi;
};

__device__ __forceinline__ unsigned pk4_fp8(float x0, float x1, float x2, float x3) { unsigned w = 0u; w = __builtin_amdgcn_cvt_pk_fp8_f32(x0, x1, w, false); w = __builtin_amdgcn_cvt_pk_fp8_f32(x2, x3, w, true); return w; }
__device__ __forceinline__ float wave_sum(float v) {
#pragma unroll
    for (int o = 1; o < 64; o <<= 1) v += __shfl_xor(v, o);
    return v;
}
__device__ __forceinline__ float silu_f(float v) { return v / (1.f + __expf(-v)); }
__device__ __forceinline__ f32x4 bf4_to_f32(const u32x2 p) { f32x4 r; r[0] = __uint_as_float(p.x << 16); r[1] = __uint_as_float(p.x & 0xffff0000u); r[2] = __uint_as_float(p.y << 16); r[3] = __uint_as_float(p.y & 0xffff0000u); return r; }
__device__ __forceinline__ int opq(int v) { asm volatile("" : "+v"(v)); return v; }

template <bool IN_F32>
struct EpiResid {
    static constexpr bool PERM = true, AFTER_DRAIN = false;
    const void* xin; bf16_t* xout; const float* gt; float sc;
    __device__ __forceinline__ void operator()(const f32x4 (&acc)[2][2][4][2], const Unit& u, int wr, int wc, int fr, int fq) const {
        const int row0 = u.pm * 256 + wr * 64 + fr, col0 = u.pn * 256 + wc * 32 + 8 * fq, b = (u.pm * 256) / S;
        f32x4 gv[2][2];
#pragma unroll
        for (int bj = 0; bj < 2; ++bj)
#pragma unroll
            for (int n = 0; n < 2; ++n) gv[bj][n] = *(const f32x4*)(gt + (size_t)b * 6 * D + col0 + bj * 128 + n * 4) * sc;
#pragma unroll
        for (int ai = 0; ai < 2; ++ai)
#pragma unroll
            for (int m = 0; m < 4; ++m) { const size_t off = (size_t)(row0 + ai * 128 + m * 16) * D + col0;
#pragma unroll
                for (int bj = 0; bj < 2; ++bj) { f32x4 x0, x1;
                    if (IN_F32) { x0 = *(const f32x4*)((const float*)xin + off + bj * 128); x1 = *(const f32x4*)((const float*)xin + off + bj * 128 + 4); }
                    else { const u32x4 p = *(const u32x4*)((const bf16_t*)xin + off + bj * 128); x0 = bf4_to_f32((u32x2){p.x, p.y}); x1 = bf4_to_f32((u32x2){p.z, p.w}); }
                    const f32x4 y0 = x0 + gv[bj][0] * acc[ai][bj][m][0], y1 = x1 + gv[bj][1] * acc[ai][bj][m][1];
                    u32x4 w; w.x = cvt_pk_bf16(y0[0], y0[1]); w.y = cvt_pk_bf16(y0[2], y0[3]); w.z = cvt_pk_bf16(y1[0], y1[1]); w.w = cvt_pk_bf16(y1[2], y1[3]);
                    *(u32x4*)(xout + off + bj * 128) = w; } }
    }
};
struct EpiGU {
    static constexpr bool PERM = true, AFTER_DRAIN = false;
    unsigned char* Hm8;
    __device__ __forceinline__ void operator()(const f32x4 (&acc)[2][2][4][2], const Unit& u, int wr, int wc, int fr, int fq) const {
        const int row0 = u.pm * 256 + wr * 64 + fr, col0 = (u.pn & 7) * 128 + wc * 32 + 8 * fq;
#pragma unroll
        for (int ai = 0; ai < 2; ++ai)
#pragma unroll
            for (int m = 0; m < 4; ++m) { unsigned char* rowp = Hm8 + (size_t)(row0 + ai * 128 + m * 16) * MH + col0;
                float h[8];
#pragma unroll
                for (int n = 0; n < 2; ++n)
#pragma unroll
                    for (int j = 0; j < 4; ++j) { const float g = acc[ai][0][m][n][j] * (1.f / 256.f), up = acc[ai][1][m][n][j] * (1.f / 256.f); h[n * 4 + j] = silu_f(g) * up * 4.f; }
                u32x2 w; w.x = pk4_fp8(h[0], h[1], h[2], h[3]); w.y = pk4_fp8(h[4], h[5], h[6], h[7]);
                *(u32x2*)rowp = w; }
    }
};
struct EpiBf16G {
    static constexpr bool PERM = true, AFTER_DRAIN = false;
    bf16_t* O; int ldc; float sc;
    __device__ __forceinline__ void operator()(const f32x4 (&acc)[2][2][4][2], const Unit& u, int wr, int wc, int fr, int fq) const {
        const int row0 = u.pm * 256 + wr * 64 + fr, col0 = (u.pn & 7) * 256 + wc * 32 + 8 * fq;
#pragma unroll
        for (int ai = 0; ai < 2; ++ai)
#pragma unroll
            for (int m = 0; m < 4; ++m) { bf16_t* rowp = O + (size_t)(row0 + ai * 128 + m * 16) * ldc + col0;
#pragma unroll
                for (int bj = 0; bj < 2; ++bj) { const f32x4 v0 = acc[ai][bj][m][0] * sc, v1 = acc[ai][bj][m][1] * sc;
                    u32x4 w; w.x = cvt_pk_bf16(v0[0], v0[1]); w.y = cvt_pk_bf16(v0[2], v0[3]); w.z = cvt_pk_bf16(v1[0], v1[1]); w.w = cvt_pk_bf16(v1[2], v1[3]);
                    *(u32x4*)(rowp + bj * 128) = w; } }
    }
};
struct GroupedOrder {
    int NP, total, G, c; const LAS int* pe;
    __device__ __forceinline__ bool next(int i, Unit& u) const {
        int p, j;
        if (G == 256) { const int x = c >> 5, l = c & 31, gidx = i * 8 + x; p = gidx * 4 + (l >> 3); j = l & 7; if (p >= NP) return false; }
        else { const long L = (long)i * G + c; if (L >= total) return false; p = (int)(L % NP); j = (int)(L / NP); }
        u.pm = p; u.pn = __builtin_amdgcn_readfirstlane(pe[p]) * 8 + j; return true; }
    __device__ __forceinline__ void a_ready(const Unit&) const {}
    __device__ __forceinline__ void done(const Unit&) const {}
};
struct GroupedOrderG : GroupedOrder {
    const LAS int* ps; const LAS int* cn; const int* inv;
    __device__ __forceinline__ int a_row(const Unit& u, int r) const {
        const int e = u.pn >> 3, local = u.pm * 256 + r - ps[e];
        return local < cn[e] ? inv[e * 32768 + local] : NT; }
};
struct CvItem { const float* W; bf16_t* WT; int ldw, K, n0, s0, k0; };
__device__ __forceinline__ void tr_load(const CvItem& d, int lane, f32x4 (&v)[8]) {
    const int kp = lane >> 3, c4 = lane & 7;
#pragma unroll
    for (int i = 0; i < 8; ++i) v[i] = *(const f32x4*)(d.W + (size_t)(d.k0 + 2 * kp + 16 * (i >> 1) + (i & 1)) * d.ldw + d.s0 + 4 * c4);
}
__device__ __forceinline__ void tr_finish(const CvItem& d, const f32x4 (&v)[8], LAS float* scr, int lane) {
    const int kp = lane >> 3, c4 = lane & 7; LAS unsigned* sp = (LAS unsigned*)scr;
#pragma unroll
    for (int i = 0; i < 4; ++i) { u32x4 o; o.x = cvt_pk_bf16(v[2 * i][0], v[2 * i + 1][0]); o.y = cvt_pk_bf16(v[2 * i][1], v[2 * i + 1][1]); o.z = cvt_pk_bf16(v[2 * i][2], v[2 * i + 1][2]); o.w = cvt_pk_bf16(v[2 * i][3], v[2 * i + 1][3]);
        *(LAS u32x4*)(sp + (kp + 8 * i) * 36 + 4 * c4) = o; }
    LDS_WAIT(); asm volatile("" ::: "memory");
    const int c = lane & 7;
#pragma unroll
    for (int j = 0; j < 4; ++j) { const int n = (lane >> 3) + 8 * j; const LAS unsigned* q = sp + (4 * c) * 36 + n;
        u32x4 o; o.x = q[0]; o.y = q[36]; o.z = q[72]; o.w = q[108];
        *(u32x4*)(d.WT + (size_t)(d.n0 + n) * d.K + d.k0 + 8 * c) = o; }
    LDS_WAIT(); asm volatile("" ::: "memory");
}
__device__ __forceinline__ int gu_src(int n) { const int t = n >> 8, r = n & 255; return r < 128 ? t * 128 + r : 1024 + t * 128 + (r - 128); }

constexpr int CV_I1 = 32 * 192, CV_I2 = 32 * 64, CV_ALL = CV_I1 + CV_I2;
__device__ __forceinline__ CvItem cv_decode(const Args& a, int r) {
    CvItem d;
    if (r < CV_I1) { const int kb = r / 192, nb = r % 192; d.W = a.a_win; d.ldw = 6144; d.WT = a.Bt_qkv; d.K = D; d.n0 = nb * 32; d.s0 = nb * 32; d.k0 = kb * 64; return d; } r -= CV_I1;
    { const int kb = r / 64, nb = r % 64; d.W = a.a_wout; d.ldw = D; d.WT = a.Bt_ao; d.K = D; d.n0 = nb * 32; d.s0 = nb * 32; d.k0 = kb * 64; return d; }
}
__device__ __forceinline__ void conv_items(const Args& a, LAS unsigned char* lds, int w, int nw, int lo, int hi, int wave, int lane) {
    LAS float* scr = (LAS float*)(lds + wave * 16384);
    const int it = lo + w; if (it >= hi) return;
    CvItem d0 = cv_decode(a, it), d1 = d0, d2 = d0; f32x4 v0[8], v1[8], v2[8];
    bool h1 = it + nw < hi, h2 = it + 2 * nw < hi, h0;
    tr_load(d0, lane, v0);
    if (h1) { d1 = cv_decode(a, it + nw); tr_load(d1, lane, v1); }
    if (h2) { d2 = cv_decode(a, it + 2 * nw); tr_load(d2, lane, v2); }
    int nx = it + 3 * nw;
    for (;;) {
        tr_finish(d0, v0, scr, lane); h0 = nx < hi; if (h0) { d0 = cv_decode(a, nx); tr_load(d0, lane, v0); nx += nw; }
        if (!h1) break;
        tr_finish(d1, v1, scr, lane); h1 = nx < hi; if (h1) { d1 = cv_decode(a, nx); tr_load(d1, lane, v1); nx += nw; }
        if (!h2) break;
        tr_finish(d2, v2, scr, lane); h2 = nx < hi; if (h2) { d2 = cv_decode(a, nx); tr_load(d2, lane, v2); nx += nw; }
        if (!h0) break;
    }
}
__device__ __forceinline__ void p0_prologue(const Args& a, LAS unsigned char* lds, int vcu, int G, int tid, int wave, int lane) {
    {
        LAS float* sc = (LAS float*)lds;
        LAS float* red = (LAS float*)(lds + 32768);
        for (int i = tid; i < NB * D; i += NTHR) sc[i] = silu_f(a.c[i]);
        __syncthreads();
        for (int it = vcu; it < 2 * 384; it += G) {
            const int l = it / 384, col = (it % 384) * 32 + (lane & 31), kh = lane >> 5;
            const float* w = a.ada_w + (size_t)l * D * 6 * D + (size_t)(wave * 256 + kh * 128) * 6 * D + col;
            float a0 = 0.f, a1 = 0.f, a2 = 0.f, a3 = 0.f;
#pragma unroll 8
            for (int k = 0; k < 128; ++k) { const float wv = w[(size_t)k * 6 * D]; const int kk = wave * 256 + kh * 128 + k;
                a0 += sc[kk] * wv; a1 += sc[D + kk] * wv; a2 += sc[2 * D + kk] * wv; a3 += sc[3 * D + kk] * wv; }
            a0 += __shfl_xor(a0, 32); a1 += __shfl_xor(a1, 32); a2 += __shfl_xor(a2, 32); a3 += __shfl_xor(a3, 32);
            if (lane < 32) { red[(wave * 4 + 0) * 32 + lane] = a0; red[(wave * 4 + 1) * 32 + lane] = a1; red[(wave * 4 + 2) * 32 + lane] = a2; red[(wave * 4 + 3) * 32 + lane] = a3; }
            __syncthreads();
            if (tid < 128) { const int bb = tid >> 5, cl = tid & 31; float sacc = 0.f;
#pragma unroll
                for (int w8 = 0; w8 < 8; ++w8) sacc += red[(w8 * 4 + bb) * 32 + cl];
                const int cg = (it % 384) * 32 + cl;
                a.mod[((size_t)l * NB + bb) * 6 * D + cg] = sacc + a.ada_b[l * 6 * D + cg]; }
            __syncthreads();
        }
    }
    for (int i = vcu * NTHR + tid; i < NT * 16; i += G * NTHR) {
        const int row = i >> 4, j = i & 15;
        const double ang = (double)a.pos[row] * pow(500000.0, -(double)j / 16.0);
        a.cs[i] = make_float2((float)cos(ang), (float)sin(ang));
    }
    for (int i = vcu * NTHR + tid; i < 2 * 256 * D; i += G * NTHR) {
        const int k = i % D, n = (i / D) % 256, l = i / (256 * D);
        float v = 0.f; if (n < 4) v = a.wg[((size_t)l * D + k) * 4 + n]; else if (n < 36) v = a.we[((size_t)l * D + k) * 32 + (n - 4)];
        a.Bt_rt[i] = (bf16_t)(cvt_pk_bf16(v, 0.f) & 0xffffu);
    }
    if (vcu == 0) for (int i = tid; i < D / 4; i += NTHR) ((unsigned*)(a.hb8 + (size_t)NT * D))[i] = 0u;
    for (int i = vcu * NTHR + tid; i < 16 * D; i += G * NTHR) { const int k = i % D, n = i / D; a.Bt_g[i] = (bf16_t)(cvt_pk_bf16(a.m_win[(size_t)k * 6160 + 6144 + n], 0.f) & 0xffffu); }
    __syncthreads();
    conv_items(a, lds, vcu * NWAVES + wave, G * NWAVES, 0, CV_I1 + CV_I2, wave, lane);
}
template <bool TOLDS>
__device__ __forceinline__ void norm_store(const f32x4 (&v)[8], float ss, const float* g, const float* scv, const float* shv, bf16_t* orow, int lane, LAS unsigned char* yrow) {
    const float rstd = rsqrtf(wave_sum(ss) * (1.f / D) + EPS);
#pragma unroll
    for (int j = 0; j < 8; ++j) { const int c = 4 * lane + 256 * j;
        const f32x4 gg = *(const f32x4*)(g + c), sc = *(const f32x4*)(scv + c), sh = *(const f32x4*)(shv + c);
        const f32x4 y = v[j] * rstd * gg * (sc + 1.f) + sh;
        u32x2 w; w.x = cvt_pk_bf16(y[0], y[1]); w.y = cvt_pk_bf16(y[2], y[3]);
        *(u32x2*)(orow + c) = w;
        if (TOLDS) *(LAS u32x2*)(yrow + c * 2) = w; }
}
constexpr int YT_PITCH = 4112, NR_YT = 0, NR_RED = 16 * YT_PITCH, NR_LG = NR_RED + 24576, NR_TOK = NR_LG + 3072;
typedef short bf16x8r __attribute__((ext_vector_type(8)));
template <int NTL>
__device__ __forceinline__ void rows16_logits(const bf16_t* Bt, LAS unsigned char* lds, int wave, int lane, int tid) {
    const int r16 = lane & 15, q4 = lane >> 4;
    f32x4 acc[NTL];
#pragma unroll
    for (int nt = 0; nt < NTL; ++nt) acc[nt] = (f32x4){0.f, 0.f, 0.f, 0.f};
#pragma unroll
    for (int kk = 0; kk < 8; ++kk) { const int k0 = 256 * wave + 32 * kk + 8 * q4;
        const bf16x8r yf = *(const LAS bf16x8r*)(lds + NR_YT + r16 * YT_PITCH + k0 * 2);
#pragma unroll
        for (int nt = 0; nt < NTL; ++nt) { const bf16x8r wf = *(const bf16x8r*)(Bt + (size_t)(16 * nt + r16) * D + k0);
            acc[nt] = __builtin_amdgcn_mfma_f32_16x16x32_bf16(wf, yf, acc[nt], 0, 0, 0); } }
#pragma unroll
    for (int nt = 0; nt < NTL; ++nt) *(LAS f32x4*)(lds + NR_RED + ((wave * NTL + nt) * 64 + lane) * 16) = acc[nt];
    __syncthreads();
    if (tid < NTL * 64) { const int nt = tid >> 6, ln = tid & 63; f32x4 sum = {0.f, 0.f, 0.f, 0.f};
#pragma unroll
        for (int w = 0; w < 8; ++w) sum += *(const LAS f32x4*)(lds + NR_RED + ((w * NTL + nt) * 64 + ln) * 16);
        LAS float* lg = (LAS float*)(lds + NR_LG) + (ln & 15) * 48 + 16 * nt + 4 * (ln >> 4);
        lg[0] = sum[0]; lg[1] = sum[1]; lg[2] = sum[2]; lg[3] = sum[3]; }
    __syncthreads();
}
__device__ __forceinline__ void phase_norm(const float* xin, const float* g, const float* modl, int sh_idx, int sc_idx, bf16_t* hb, int gw, int NGW, int lane) {
    const int RPW = (NT + NGW - 1) / NGW; int m = gw * RPW; const int mend = (m + RPW < NT) ? m + RPW : NT;
    if (m >= mend) return;
    f32x4 A[8], Bv[8], v[8], vn[8]; int bcur = -1;
#pragma unroll
    for (int j = 0; j < 8; ++j) v[j] = *(const f32x4*)(xin + (size_t)m * D + 4 * lane + 256 * j);
    for (;;) {
        const bool more = m + 1 < mend;
        if (more) {
#pragma unroll
            for (int j = 0; j < 8; ++j) vn[j] = *(const f32x4*)(xin + (size_t)(m + 1) * D + 4 * lane + 256 * j); }
        const int b = m / S;
        if (b != bcur) { bcur = b; const float* scv = modl + (size_t)b * 6 * D + sc_idx * D; const float* shv = modl + (size_t)b * 6 * D + sh_idx * D;
#pragma unroll
            for (int j = 0; j < 8; ++j) { const int c = 4 * lane + 256 * j; A[j] = *(const f32x4*)(g + c) * (*(const f32x4*)(scv + c) + 1.f); Bv[j] = *(const f32x4*)(shv + c); } }
        float ss = 0.f;
#pragma unroll
        for (int j = 0; j < 8; ++j) ss += (v[j][0] * v[j][0] + v[j][1] * v[j][1]) + (v[j][2] * v[j][2] + v[j][3] * v[j][3]);
        const float rstd = rsqrtf(wave_sum(ss) * (1.f / D) + EPS);
        bf16_t* orow = hb + (size_t)m * D;
#pragma unroll
        for (int j = 0; j < 8; ++j) { const f32x4 y = v[j] * rstd * A[j] + Bv[j]; u32x2 w; w.x = cvt_pk_bf16(y[0], y[1]); w.y = cvt_pk_bf16(y[2], y[3]); *(u32x2*)(orow + 4 * lane + 256 * j) = w; }
        if (!more) break;
        ++m;
#pragma unroll
        for (int j = 0; j < 8; ++j) v[j] = vn[j];
    }
}
__device__ __forceinline__ void phase_combine_final(const Args& a, const float* modl, const LAS int* ps, int gw, int NGW, int lane) {
    const int RPW = (NT + NGW - 1) / NGW; const int m0 = gw * RPW; const int mend = (m0 + RPW < NT) ? m0 + RPW : NT;
    if (m0 >= mend) return;
    int slot_l = 0; float w_l = 0.f;
    if (lane < 2 * (mend - m0) && lane < 64) { const int as = 2 * m0 + lane; slot_l = ps[a.eid[as]] + a.pos_in_e[as]; w_l = a.wts[as]; }
    f32x4 G4[8], F4[8];
    { const float* gt = modl + (size_t)(m0 / S) * 6 * D + 5 * D;
#pragma unroll
      for (int j = 0; j < 8; ++j) { G4[j] = *(const f32x4*)(gt + 4 * lane + 256 * j); F4[j] = *(const f32x4*)(a.fng + 4 * lane + 256 * j); } }
    for (int m = m0; m < mend; ++m) {
        const int r = m - m0; const int s0 = __shfl(slot_l, 2 * r), s1 = __shfl(slot_l, 2 * r + 1); const float w0 = __shfl(w_l, 2 * r), w1 = __shfl(w_l, 2 * r + 1);
        const bf16_t* xr = a.xres + (size_t)m * D; const bf16_t* y0 = a.Y + (size_t)s0 * D; const bf16_t* y1 = a.Y + (size_t)s1 * D;
        f32x4 v[8]; float ss = 0.f;
#pragma unroll
        for (int j = 0; j < 8; ++j) { const int c = 4 * lane + 256 * j;
            const f32x4 x1 = bf4_to_f32(*(const u32x2*)(xr + c)); const u32x2 p0 = *(const u32x2*)(y0 + c), p1 = *(const u32x2*)(y1 + c);
            f32x4 ya, yb;
            ya[0] = __uint_as_float(p0.x << 16); ya[1] = __uint_as_float(p0.x & 0xffff0000u); ya[2] = __uint_as_float(p0.y << 16); ya[3] = __uint_as_float(p0.y & 0xffff0000u);
            yb[0] = __uint_as_float(p1.x << 16); yb[1] = __uint_as_float(p1.x & 0xffff0000u); yb[2] = __uint_as_float(p1.y << 16); yb[3] = __uint_as_float(p1.y & 0xffff0000u);
            v[j] = x1 + G4[j] * (ya * w0 + yb * w1);
            ss += (v[j][0] * v[j][0] + v[j][1] * v[j][1]) + (v[j][2] * v[j][2] + v[j][3] * v[j][3]); }
        const float rstd = rsqrtf(wave_sum(ss) * (1.f / D) + EPS);
#pragma unroll
        for (int j = 0; j < 8; ++j) *(f32x4*)(a.out + (size_t)m * D + 4 * lane + 256 * j) = v[j] * rstd * F4[j];
    }
}
__device__ __forceinline__ void phase_combine_gates(const Args& a, const float* modl, const float* modn, const float* gnext, const LAS int* ps, LAS unsigned char* lds, int vcu, int G, int tid, int wave, int lane) {
    const int NGRP = NT / 16, GPW = (NGRP + G - 1) / G, g0 = vcu * GPW, gend = (g0 + GPW < NGRP) ? g0 + GPW : NGRP;
    if (g0 >= gend) return;
    int slot_l = 0; float w_l = 0.f;
    if (lane < 4 * (gend - g0)) { const int m = (g0 + (lane >> 2)) * 16 + 2 * wave + ((lane >> 1) & 1), as = 2 * m + (lane & 1); slot_l = ps[a.eid[as]] + a.pos_in_e[as]; w_l = a.wts[as]; }
    const int b = (g0 * 16) / S;
    const float* gt = modl + (size_t)b * 6 * D + 5 * D; const float* scv = modn + (size_t)b * 6 * D + 1 * D; const float* shv = modn + (size_t)b * 6 * D;
    u32x2 xc[8], xn[8]; u32x2 pc0[8], pc1[8], pn0[8], pn1[8];
#define CG_LOAD(s_, X, P0, P1) do { const int m_ = (g0 + ((s_) >> 1)) * 16 + 2 * wave + ((s_) & 1), li_ = 2 * (s_); \
        const bf16_t* y0_ = a.Y + (size_t)__shfl(slot_l, li_) * D; const bf16_t* y1_ = a.Y + (size_t)__shfl(slot_l, li_ + 1) * D; \
        _Pragma("unroll") for (int j_ = 0; j_ < 8; ++j_) { const int c_ = 4 * lane + 256 * j_; X[j_] = *(const u32x2*)(a.xres + (size_t)m_ * D + c_); P0[j_] = *(const u32x2*)(y0_ + c_); P1[j_] = *(const u32x2*)(y1_ + c_); } } while (0)
    const int nrow = 2 * (gend - g0);
    CG_LOAD(0, xc, pc0, pc1);
    for (int sq = 0; sq < nrow; ++sq) {
        const int grp = g0 + (sq >> 1), rr = sq & 1, m = grp * 16 + 2 * wave + rr;
        if (sq + 1 < nrow) CG_LOAD(sq + 1, xn, pn0, pn1);
        const float w0 = __shfl(w_l, 2 * sq), w1 = __shfl(w_l, 2 * sq + 1);
        f32x4 v[8]; float ss = 0.f;
#pragma unroll
        for (int j = 0; j < 8; ++j) { const u32x2 p0 = pc0[j], p1 = pc1[j]; f32x4 ya, yb;
            ya[0] = __uint_as_float(p0.x << 16); ya[1] = __uint_as_float(p0.x & 0xffff0000u); ya[2] = __uint_as_float(p0.y << 16); ya[3] = __uint_as_float(p0.y & 0xffff0000u);
            yb[0] = __uint_as_float(p1.x << 16); yb[1] = __uint_as_float(p1.x & 0xffff0000u); yb[2] = __uint_as_float(p1.y << 16); yb[3] = __uint_as_float(p1.y & 0xffff0000u);
            v[j] = bf4_to_f32(xc[j]) + *(const f32x4*)(gt + 4 * lane + 256 * j) * (ya * w0 + yb * w1);
            ss += (v[j][0] * v[j][0] + v[j][1] * v[j][1]) + (v[j][2] * v[j][2] + v[j][3] * v[j][3]); }
        const float rstd = rsqrtf(wave_sum(ss) * (1.f / D) + EPS);
        LAS unsigned char* yrow = lds + NR_YT + (2 * wave + rr) * YT_PITCH;
#pragma unroll
        for (int j = 0; j < 8; ++j) { const int c = 4 * lane + 256 * j; { u32x2 xw; xw.x = cvt_pk_bf16(v[j][0], v[j][1]); xw.y = cvt_pk_bf16(v[j][2], v[j][3]); *(u32x2*)(a.xres + (size_t)m * D + c) = xw; }
            const f32x4 y = v[j] * rstd * (*(const f32x4*)(gnext + c) * (*(const f32x4*)(scv + c) + 1.f)) + *(const f32x4*)(shv + c); u32x2 w; w.x = cvt_pk_bf16(y[0], y[1]); w.y = cvt_pk_bf16(y[2], y[3]);
            *(unsigned*)(a.hb8 + (size_t)m * D + c) = pk4_fp8(y[0] * 4.f, y[1] * 4.f, y[2] * 4.f, y[3] * 4.f); *(LAS u32x2*)(yrow + c * 2) = w; }
#pragma unroll
        for (int j = 0; j < 8; ++j) { xc[j] = xn[j]; pc0[j] = pn0[j]; pc1[j] = pn1[j]; }
        if (rr == 1) {
            __syncthreads();
            rows16_logits<1>(a.Bt_g, lds, wave, lane, tid);
            if (tid < 256) a.gates[(size_t)(grp * 16 + (tid >> 4)) * 16 + (tid & 15)] = ((const LAS float*)(lds + NR_LG))[(tid >> 4) * 48 + (tid & 15)];
        }
    }
#undef CG_LOAD
}
__device__ __forceinline__ void phase_norm_route(const Args& a, int layer, const float* modl, LAS unsigned char* lds, LAS unsigned char* misc, int vcu, int G, int tid, int wave, int lane) {
    LAS int* hist = (LAS int*)(misc + MISC_HIST); LAS int* base = (LAS int*)(misc + MISC_BASE);
    LAS int* tk = (LAS int*)(lds + NR_TOK);
    LAS float* tw = (LAS float*)(lds + NR_TOK + 2048);
    int* counts = a.counts + layer * 64;
    const float* bg = a.bg + layer * 4; const float* be = a.be + layer * 32; const float* g = a.nfg + layer * D;
    if (tid < 32) hist[tid] = 0;
    __syncthreads();
    const int NGRP = NT / 16, GPW = (NGRP + G - 1) / G, g0 = vcu * GPW, gend = (g0 + GPW < NGRP) ? g0 + GPW : NGRP;
    const int ng = gend > g0 ? gend - g0 : 0;
    if (ng > 0) {
        const int b = (g0 * 16) / S;
        f32x4 A[8]; const float* shv = modl + (size_t)b * 6 * D + 3 * D;
        { const float* scv = modl + (size_t)b * 6 * D + 4 * D;
#pragma unroll
          for (int j = 0; j < 8; ++j) { const int c = 4 * lane + 256 * j; A[j] = *(const f32x4*)(g + c) * (*(const f32x4*)(scv + c) + 1.f); } }
        u32x2 x1[2][8];
#define NR_LOAD(grp_) do { _Pragma("unroll") for (int rr_ = 0; rr_ < 2; ++rr_) { const bf16_t* xr_ = a.xres + (size_t)((grp_) * 16 + 2 * wave + rr_) * D; \
        _Pragma("unroll") for (int j_ = 0; j_ < 8; ++j_) x1[rr_][j_] = *(const u32x2*)(xr_ + 4 * lane + 256 * j_); } } while (0)
        NR_LOAD(g0);
        for (int grp = g0; grp < gend; ++grp) {
            const int gi = grp - g0;
#pragma unroll
            for (int rr = 0; rr < 2; ++rr) { const int m = grp * 16 + 2 * wave + rr; float ss = 0.f;
#pragma unroll
                for (int j = 0; j < 8; ++j) { const f32x4 v = bf4_to_f32(x1[rr][j]); ss += (v[0] * v[0] + v[1] * v[1]) + (v[2] * v[2] + v[3] * v[3]); }
                const float rstd = rsqrtf(wave_sum(ss) * (1.f / D) + EPS);
                LAS unsigned char* yrow = lds + NR_YT + (2 * wave + rr) * YT_PITCH;
#pragma unroll
                for (int j = 0; j < 8; ++j) { const int c = 4 * lane + 256 * j; const f32x4 y = bf4_to_f32(x1[rr][j]) * rstd * A[j] + *(const f32x4*)(shv + c);
                    u32x2 w; w.x = cvt_pk_bf16(y[0], y[1]); w.y = cvt_pk_bf16(y[2], y[3]); *(LAS u32x2*)(yrow + c * 2) = w;
                    *(unsigned*)(a.hb8 + (size_t)m * D + c) = pk4_fp8(y[0] * 4.f, y[1] * 4.f, y[2] * 4.f, y[3] * 4.f); } }
            if (grp + 1 < gend) NR_LOAD(grp + 1);
            __syncthreads();
            rows16_logits<3>(a.Bt_rt + (size_t)layer * 256 * D, lds, wave, lane, tid);
            if (tid < 16 && gi < 8) {
                const LAS float* lg = (const LAS float*)(lds + NR_LG) + tid * 48;
                float gmax = -INFINITY; int grpi = 0;
#pragma unroll
                for (int i = 0; i < 4; ++i) { const float v = lg[i] + bg[i]; if (v > gmax) { gmax = v; grpi = i; } }
                float gs = 0.f;
#pragma unroll
                for (int i = 0; i < 4; ++i) gs += expf(lg[i] + bg[i] - gmax);
                const float pg = 1.f / gs;
                float v1 = -INFINITY, v2 = -INFINITY; int i1 = 0, i2 = 0;
                for (int i = 0; i < 8; ++i) { const float v = lg[4 + grpi * 8 + i] + be[grpi * 8 + i];
                    if (v > v1) { v2 = v1; i2 = i1; v1 = v; i1 = i; } else if (v > v2) { v2 = v; i2 = i; } }
                const float ex = expf(v2 - v1); const int e1 = grpi * 8 + i1, e2 = grpi * 8 + i2, sl = gi * 16 + tid;
                tk[sl] = e1; tk[128 + sl] = e2; tk[256 + sl] = atomicAdd((int*)&hist[e1], 1); tk[384 + sl] = atomicAdd((int*)&hist[e2], 1);
                tw[sl] = pg / (1.f + ex); tw[128 + sl] = pg * ex / (1.f + ex);
            }
        }
#undef NR_LOAD
    }
    __syncthreads();
    if (tid < 32) { const int h = hist[tid]; base[tid] = h ? atomicAdd(&counts[tid], h) : 0; }
    __syncthreads();
    if (tid < ng * 16 && tid < 128) { const int t = (g0 + (tid >> 4)) * 16 + (tid & 15), e1 = tk[tid], e2 = tk[128 + tid];
        a.eid[2 * t] = e1; a.eid[2 * t + 1] = e2; a.wts[2 * t] = tw[tid]; a.wts[2 * t + 1] = tw[128 + tid];
        const int p1 = base[e1] + tk[256 + tid], p2 = base[e2] + tk[384 + tid];
        a.pos_in_e[2 * t] = p1; a.pos_in_e[2 * t + 1] = p2; a.inv[e1 * 32768 + p1] = t; a.inv[e2 * 32768 + p2] = t; }
    __syncthreads();
}
__device__ __forceinline__ int moe_tables(const int* counts, LAS unsigned char* misc, int tid) {
    LAS int* ps = (LAS int*)(misc + MISC_PS); LAS int* pe = (LAS int*)(misc + MISC_PE); LAS int* npw = (LAS int*)(misc + MISC_NP);
    __syncthreads();
    if (tid == 0) { LAS int* cn = (LAS int*)(misc + MISC_CNT); int s = 0; for (int e = 0; e < NE; ++e) { ps[e] = s; const int c = __hip_atomic_load(&counts[e], __ATOMIC_RELAXED, __HIP_MEMORY_SCOPE_AGENT); cn[e] = c; const int np = (c + 255) >> 8;
            for (int p = 0; p < np; ++p) pe[(s >> 8) + p] = e; s += np << 8; } ps[NE] = s; npw[0] = s >> 8; }
    __syncthreads();
    return npw[0];
}
struct EpiQKV {
    static constexpr bool PERM = true, AFTER_DRAIN = false;
    bf16_t *Qh, *Kh, *Vh; const float2* cs;
    __device__ __forceinline__ void operator()(const f32x4 (&acc)[2][2][4][2], const Unit& u, int wr, int wc, int fr, int fq) const {
        const int t = u.pn >> 3, hh = u.pn & 7;
        bf16_t* base = Qh + (size_t)t * ((size_t)NT * 2048);
        const int row0 = u.pm * 256 + wr * 64 + fr;
        const bool rope = (t < 2) && (wc == 0);
#pragma unroll
        for (int ai = 0; ai < 2; ++ai)
#pragma unroll
            for (int m = 0; m < 4; ++m) { const int row = row0 + ai * 128 + m * 16;
                f32x4 c0 = {0.f, 0.f, 0.f, 0.f}, c1 = c0, c2 = c0, c3 = c0;
                if (rope) { const f32x4* cp = (const f32x4*)(cs + (size_t)row * 16 + 8 * (fq & 1)); c0 = cp[0]; c1 = cp[1]; c2 = cp[2]; c3 = cp[3]; }
#pragma unroll
                for (int bj = 0; bj < 2; ++bj) { f32x4 v0 = acc[ai][bj][m][0], v1 = acc[ai][bj][m][1];
                    if (rope) {
                        const float sg = (fq < 2) ? -1.f : 1.f;
                        float v[8] = {v0[0], v0[1], v0[2], v0[3], v1[0], v1[1], v1[2], v1[3]};
                        const float cc[8] = {c0[0], c0[2], c1[0], c1[2], c2[0], c2[2], c3[0], c3[2]}, sn[8] = {c0[1], c0[3], c1[1], c1[3], c2[1], c2[3], c3[1], c3[3]};
#pragma unroll
                        for (int i = 0; i < 8; ++i) { const float pv = __shfl_xor(v[i], 32); v[i] = v[i] * cc[i] + sg * pv * sn[i]; }
                        v0 = (f32x4){v[0], v[1], v[2], v[3]}; v1 = (f32x4){v[4], v[5], v[6], v[7]};
                    }
                    u32x4 w; w.x = cvt_pk_bf16(v0[0], v0[1]); w.y = cvt_pk_bf16(v0[2], v0[3]); w.z = cvt_pk_bf16(v1[0], v1[1]); w.w = cvt_pk_bf16(v1[2], v1[3]);
                    *(u32x4*)(base + ((size_t)(hh * 2 + bj) * NT + row) * 128 + wc * 32 + 8 * fq) = w; } }
    }
};
typedef att::BlockRef<bf16_t, bf16_t> ARef;
__device__ __forceinline__ ARef att_ref(const Args& a, int hd, int qb) {
    const int b = hd >> 5, vh = hd & 31, h = vh >> 2, m = (vh >> 1) & 1, half = vh & 1;
    ARef r;
    r.Q = a.Qh + ((size_t)(h * 2 + m) * NT + (size_t)b * S + (size_t)qb * 256) * 128;
    r.K = a.Kh + ((size_t)(h * 2 + m) * NT + (size_t)b * S) * 128;
    r.V = a.Vh + ((size_t)(h * 2 + half) * NT + (size_t)b * S) * 128;
    r.O = a.Oa + ((size_t)((h * 2 + m) * 2 + half) * NT + (size_t)b * S + (size_t)qb * 256) * 128;
    r.P0 = qb * 256;
    return r;
}
__device__ __forceinline__ bool att_pos(int w, int N, int r, int& hd, int& qb) {
    const int p = r * N + ((r & 1) ? (N - 1 - w) : w); if (p >= 2048) return false;
    const int c = p >> 9, pl = p & 511; hd = pl >> 2; qb = 15 - 4 * c - (pl & 3); return true;
}
constexpr int CVA_MIN = 16 * 96, CVA_MO = 16 * 32, CVA_GU = 64 * 512, CVA_DN = 64 * 256, CVA_ITEMS = CVA_MIN + CVA_MO + CVA_GU + CVA_DN, CVA_BUF = 4224;
struct CvaItem { const float* W; unsigned char* WT; int ldw, K, k0, n0, s0; float sc; };
__device__ __forceinline__ CvaItem cva_decode(const Args& a, int r) {
    CvaItem d; d.ldw = 2048; d.K = D; d.sc = 64.f;
    if (r < CVA_MIN) { const int kb = r / 96, nb = r - kb * 96; d.W = a.m_win; d.ldw = 6160; d.WT = a.Bt_min8; d.k0 = kb * 128; d.n0 = nb * 64; d.s0 = d.n0; return d; } r -= CVA_MIN;
    if (r < CVA_MO) { d.W = a.m_wout; d.WT = a.Bt_mo8; d.k0 = (r >> 5) * 128; d.n0 = (r & 31) * 64; d.s0 = d.n0; return d; } r -= CVA_MO;
    if (r < CVA_GU) { const int ex = r >> 9, q = r & 511; d.W = a.wgu + (size_t)ex * D * 2048; d.WT = a.Bt_gu8 + (size_t)ex * 2048 * D; d.k0 = (q >> 5) * 128; d.n0 = (q & 31) * 64; d.s0 = gu_src(d.n0); return d; } r -= CVA_GU;
    { const int ex = r >> 8, q = r & 255; d.W = a.wdn + (size_t)ex * MH * D; d.WT = a.Bt_dn8 + (size_t)ex * D * MH; d.K = MH; d.k0 = (q >> 5) * 128; d.n0 = (q & 31) * 64; d.s0 = d.n0; d.sc = 32.f; return d; }
}
struct AttConv {
    const Args* a; LAS unsigned char* buf;
    int nxt, stride, cur, wave; unsigned bufa;
    __device__ __forceinline__ void issue() {
        if (nxt >= CVA_ITEMS) return;
        const CvaItem d = cva_decode(*a, nxt);
        const int l = opq((int)threadIdx.x) & 63, kq = wave & 3, nh = wave >> 2;
        cur = nxt; nxt += stride;
        const char* base = (const char*)(d.W + (size_t)(d.k0 + 32 * kq) * d.ldw + d.s0 + 32 * nh);
        const unsigned voff = (unsigned)(((l >> 3) * d.ldw + 4 * (l & 7)) * 4);
#pragma unroll
        for (int j = 0; j < 4; ++j) asm volatile("s_mov_b32 m0, %2\n\ts_nop 0\n\tglobal_load_lds_dwordx4 %0, %1 nt" :: "v"(voff), "s"(base + (size_t)(8 * j) * d.ldw * 4), "s"(bufa + j * 1024 + (j >= 2 ? 128 : 0)) : "memory", "m0");
    }
    __device__ __forceinline__ void consume() {
        if (cur < 0) return;
        asm volatile("s_waitcnt vmcnt(0)" ::: "memory");
        const CvaItem d = cva_decode(*a, cur);
        const int l = opq((int)threadIdx.x) & 63, n = l & 31, kh = l >> 5, kq = wave & 3, nh = wave >> 2;
        const LAS float* p = (const LAS float*)(buf + kh * (17 * 128) + n * 4);
        float v[16];
#pragma unroll
        for (int i = 0; i < 16; ++i) v[i] = p[i * 32] * d.sc;
        u32x4 o; o.x = pk4_fp8(v[0], v[1], v[2], v[3]); o.y = pk4_fp8(v[4], v[5], v[6], v[7]); o.z = pk4_fp8(v[8], v[9], v[10], v[11]); o.w = pk4_fp8(v[12], v[13], v[14], v[15]);
        *(u32x4*)(d.WT + (size_t)(d.n0 + 32 * nh + n) * d.K + d.k0 + 32 * kq + 16 * kh) = o;
        asm volatile("s_waitcnt lgkmcnt(0)" ::: "memory");
        cur = -1;
    }
    __device__ __forceinline__ void finish() {
        consume();
        while (nxt < CVA_ITEMS) { issue(); consume(); }
    }
};
__device__ __forceinline__ void phase_attn(const Args& a, char* lds, int w, int N  ) {
    AttConv cv; cv.a = &a; cv.wave = __builtin_amdgcn_readfirstlane((int)threadIdx.x >> 6); cv.buf = (LAS unsigned char*)lds + att::ATT_LDS_BYTES + cv.wave * CVA_BUF; cv.bufa = __builtin_amdgcn_readfirstlane((unsigned)(uintptr_t)lds + att::ATT_LDS_BYTES + cv.wave * CVA_BUF);
    cv.nxt = w; cv.stride = N; cv.cur = -1;
    int hd, qb, r = 0;
    if (att_pos(w, N, 0, hd, qb)) {
        ARef cur = att_ref(a, hd, qb);
        att::Seam<bf16_t> Sm;
        att::causal_swa_prime<bf16_t, bf16_t>(cur, 1 << 30, lds, Sm);
        for (;;) {
            int hn, qn; const bool more = att_pos(w, N, r + 1, hn, qn);
            const ARef nxt = more ? att_ref(a, hn, qn) : cur;
            att::causal_swa_block<bf16_t, bf16_t, AttConv>(cur, nxt, S, 1 << 30, lds, Sm, cv);
            if (!more) break;
            cur = nxt; ++r;
        }
    }
    cv.finish();
}
__device__ __forceinline__ float bf_lo(unsigned u) { return __uint_as_float(u << 16); }
__device__ __forceinline__ float bf_hi(unsigned u) { return __uint_as_float(u & 0xffff0000u); }
typedef unsigned short u16x8 __attribute__((ext_vector_type(8)));
__device__ __forceinline__ void bf8_to_f32(const u32x4 p, float (&f)[8]) {
    f[0] = bf_lo(p.x); f[1] = bf_hi(p.x); f[2] = bf_lo(p.y); f[3] = bf_hi(p.y); f[4] = bf_lo(p.z); f[5] = bf_hi(p.z); f[6] = bf_lo(p.w); f[7] = bf_hi(p.w); }
__device__ __forceinline__ void phase_attn_combine(const Args& a, int gw, int NGW, int lane) {
    float d1 = a.lq1[lane] * a.lk1[lane] + a.lq1[lane + 64] * a.lk1[lane + 64], d2 = a.lq2[lane] * a.lk2[lane] + a.lq2[lane + 64] * a.lk2[lane + 64];
    const float lam = __expf(wave_sum(d1)) - __expf(wave_sum(d2)) + 0.2f;
    const int hh = lane >> 3, e0 = (lane & 7) * 32, half = e0 >> 7, d0 = e0 & 127;
    float gv[32];
#pragma unroll
    for (int i = 0; i < 8; ++i) { const f32x4 t = *(const f32x4*)(a.a_hg + e0 + 4 * i); gv[4 * i] = t[0]; gv[4 * i + 1] = t[1]; gv[4 * i + 2] = t[2]; gv[4 * i + 3] = t[3]; }
    const bf16_t* O0 = a.Oa + ((size_t)((hh * 2 + 0) * 2 + half) * NT) * 128 + d0;
    const bf16_t* O1 = a.Oa + ((size_t)((hh * 2 + 1) * 2 + half) * NT) * 128 + d0;
    const int RPW = (NT + NGW - 1) / NGW; int m = gw * RPW; const int mend = (m + RPW < NT) ? m + RPW : NT;
    if (m >= mend) return;
    u32x4 p0[4], p1[4], n0[4], n1[4];
#pragma unroll
    for (int i = 0; i < 4; ++i) { p0[i] = *(const u32x4*)(O0 + (size_t)m * 128 + 8 * i); p1[i] = *(const u32x4*)(O1 + (size_t)m * 128 + 8 * i); }
    for (;;) {
        const bool more = m + 1 < mend;
        if (more) {
#pragma unroll
            for (int i = 0; i < 4; ++i) { n0[i] = *(const u32x4*)(O0 + (size_t)(m + 1) * 128 + 8 * i); n1[i] = *(const u32x4*)(O1 + (size_t)(m + 1) * 128 + 8 * i); } }
        float o[32]; float ss = 0.f;
#pragma unroll
        for (int i = 0; i < 4; ++i) { float f0[8], f1[8]; bf8_to_f32(p0[i], f0); bf8_to_f32(p1[i], f1);
#pragma unroll
            for (int j = 0; j < 8; ++j) { o[8 * i + j] = f0[j] - lam * f1[j]; ss += o[8 * i + j] * o[8 * i + j]; } }
        ss += __shfl_xor(ss, 1); ss += __shfl_xor(ss, 2); ss += __shfl_xor(ss, 4);
        const float r = rsqrtf(ss * (1.f / 256.f) + EPS) * 0.8f;
        bf16_t* orow = a.ob + (size_t)m * D + hh * 256 + e0;
#pragma unroll
        for (int i = 0; i < 4; ++i) { u32x4 w; w.x = cvt_pk_bf16(o[8 * i] * r * gv[8 * i], o[8 * i + 1] * r * gv[8 * i + 1]); w.y = cvt_pk_bf16(o[8 * i + 2] * r * gv[8 * i + 2], o[8 * i + 3] * r * gv[8 * i + 3]);
            w.z = cvt_pk_bf16(o[8 * i + 4] * r * gv[8 * i + 4], o[8 * i + 5] * r * gv[8 * i + 5]); w.w = cvt_pk_bf16(o[8 * i + 6] * r * gv[8 * i + 6], o[8 * i + 7] * r * gv[8 * i + 7]);
            *(u32x4*)(orow + 8 * i) = w; }
        if (!more) break;
        ++m;
#pragma unroll
        for (int i = 0; i < 4; ++i) { p0[i] = n0[i]; p1[i] = n1[i]; }
    }
}

struct EpiMin {
    static constexpr bool PERM = true, AFTER_DRAIN = false;
    bf16_t* P3;
    __device__ __forceinline__ void operator()(const f32x4 (&acc)[2][2][4][2], const Unit& u, int wr, int wc, int fr, int fq) const {
        const int t = u.pn >> 3; const int row0 = u.pm * 256 + wr * 64 + fr;
        bf16_t* base = P3 + (size_t)t * ((size_t)NT * 2048); const int col0 = (u.pn & 7) * 256 + wc * 32 + 8 * fq;
#pragma unroll
        for (int ai = 0; ai < 2; ++ai)
#pragma unroll
            for (int m = 0; m < 4; ++m) { bf16_t* rowp = base + (size_t)(row0 + ai * 128 + m * 16) * 2048 + col0;
#pragma unroll
                for (int bj = 0; bj < 2; ++bj) { f32x4 v0 = acc[ai][bj][m][0] * (1.f / 256.f), v1 = acc[ai][bj][m][1] * (1.f / 256.f);
                    if (t == 2) {
#pragma unroll
                        for (int j = 0; j < 4; ++j) { v0[j] = 1.f / (1.f + __expf(-v0[j])); v1[j] = 1.f / (1.f + __expf(-v1[j])); } }
                    u32x4 w; w.x = cvt_pk_bf16(v0[0], v0[1]); w.y = cvt_pk_bf16(v0[2], v0[3]); w.z = cvt_pk_bf16(v1[0], v1[1]); w.w = cvt_pk_bf16(v1[2], v1[3]);
                    *(u32x4*)(rowp + bj * 128) = w; } }
    }
};
constexpr int MP_XS = 0, MP_VT = 35840, MP_QS = 69632, MP_KS = 87040, MP_GT = 104448;
__device__ __forceinline__ unsigned pk_lo(unsigned a, unsigned b) { return (a & 0xffffu) | (b << 16); }
__device__ __forceinline__ unsigned pk_hi(unsigned a, unsigned b) { return (a >> 16) | (b & 0xffff0000u); }
__device__ __forceinline__ void phase_mprep(const Args& a, LAS unsigned char* lds, int vcu, int G, int tid) {
    const bf16_t* QKP = a.P3; const bf16_t* VB = a.P3 + (size_t)NT * 2048;
    for (int it = vcu; it < NB * 64; it += G) {
        const int b = it >> 6, ck = it & 63; const size_t row0 = (size_t)b * S + (size_t)ck * 64;
        __syncthreads();
        {
            const int t = tid >> 3, h = tid & 7; LAS float* gt = (LAS float*)(lds + MP_GT);
            const float gi = a.gates[(row0 + t) * 16 + h] + a.m_gb[h], z = a.gates[(row0 + t) * 16 + 8 + h] + a.m_gb[8 + h];
            gt[t * 8 + h] = gi; gt[512 + t * 8 + h] = fminf(z, 0.f) - log1pf(expf(-fabsf(z)));
        }
        __syncthreads();
        if (tid < 8) {
            const int h = tid; float bc = 0.f, cm = -INFINITY; const LAS float* gt = (const LAS float*)(lds + MP_GT);
            float* ga = a.GA + (size_t)((b * 8 + h) * 64 + ck) * 192;
            for (int t = 0; t < 64; ++t) { bc += gt[512 + t * 8 + h]; const float av = gt[t * 8 + h] - bc; cm = fmaxf(cm, av); ga[t] = av; ga[64 + t] = cm; ga[128 + t] = bc; }
            a.GS[(size_t)((b * 8 + h) * 64 + ck) * 2 + 0] = cm; a.GS[(size_t)((b * 8 + h) * 64 + ck) * 2 + 1] = bc;
        }
        for (int h = 0; h < 8; ++h) {
            for (int c = tid; c < 67 * 32; c += NTHR) { const int r = c >> 5, cc = c & 31; const int tt = r - 3;
                u32x4 v = {0u, 0u, 0u, 0u};
                if (ck * 64 + tt >= 0) v = *(const u32x4*)(QKP + (size_t)((long)row0 + tt) * 2048 + (cc < 16 ? h * 128 + cc * 8 : 1024 + h * 128 + (cc - 16) * 8));
                *(LAS u32x4*)(lds + MP_XS + r * 528 + cc * 16) = v; }
#pragma unroll
            for (int i = 0; i < 4; ++i) { const int c = tid + 512 * i, sr = c >> 5, e16 = c & 31;
                *(LAS u32x4*)(lds + MP_VT + sr * 528 + e16 * 16) = *(const u32x4*)(VB + (row0 + sr) * 2048 + h * 256 + e16 * 8); }
            __syncthreads();
            {
                const int cp = tid & 127, rq = tid >> 7; const bool isk = cp >= 64;
                const int col = isk ? 1024 + h * 128 + 2 * (cp - 64) : h * 128 + 2 * cp;
                float w0[4], w1[4];
#pragma unroll
                for (int j = 0; j < 4; ++j) { w0[j] = a.m_cw[j * 2048 + col]; w1[j] = a.m_cw[j * 2048 + col + 1]; }
                const float b0 = a.m_cb[col], b1 = a.m_cb[col + 1];
                const LAS unsigned char* xp = lds + MP_XS + (16 * rq) * 528 + cp * 4;
                float xa[4], xb[4];
#pragma unroll
                for (int j = 0; j < 3; ++j) { const unsigned v = *(const LAS unsigned*)(xp + j * 528); xa[j] = bf_lo(v); xb[j] = bf_hi(v); }
                const float sc = isk ? 0.08838834764831845f : 1.f;
                LAS unsigned char* dst = lds + (isk ? MP_KS : MP_QS) + (isk ? cp - 64 : cp) * 4;
#pragma unroll
                for (int i = 0; i < 16; ++i) { const int t = 16 * rq + i;
                    const unsigned v = *(const LAS unsigned*)(xp + (i + 3) * 528); xa[3] = bf_lo(v); xb[3] = bf_hi(v);
                    float ya = b0 + w0[0] * xa[0] + w0[1] * xa[1] + w0[2] * xa[2] + w0[3] * xa[3];
                    float yb = b1 + w1[0] * xb[0] + w1[1] * xb[1] + w1[2] * xb[2] + w1[3] * xb[3];
                    ya = ya / (1.f + __expf(-ya)) * sc; yb = yb / (1.f + __expf(-yb)) * sc;
                    *(LAS unsigned*)(dst + t * 272) = cvt_pk_bf16(ya, yb);
                    xa[0] = xa[1]; xa[1] = xa[2]; xa[2] = xa[3]; xb[0] = xb[1]; xb[1] = xb[2]; xb[2] = xb[3]; }
            }
            __syncthreads();
            {
#pragma unroll
                for (int i = 0; i < 4; ++i) { const int c = tid + 512 * i, isk = c >> 10, r = (c >> 4) & 63, cc = c & 15;
                    *(u32x4*)(a.Qn + (isk ? (size_t)NT * 1024 : (size_t)0) + (row0 + r) * 1024 + h * 128 + cc * 8) = *(const LAS u32x4*)(lds + (isk ? MP_KS : MP_QS) + r * 272 + cc * 16); }
            }
            if (tid < 256) {
                const int dp = tid & 63, sq = tid >> 6; unsigned w[16];
#pragma unroll
                for (int i = 0; i < 16; ++i) w[i] = *(const LAS unsigned*)(lds + MP_KS + (16 * sq + i) * 272 + dp * 4);
                u32x4* d0p = (u32x4*)(a.KT + ((size_t)((b * 8 + h) * 64 + ck) * 128 + 2 * dp) * 64 + 16 * sq);
                d0p[0] = (u32x4){pk_lo(w[0], w[1]), pk_lo(w[2], w[3]), pk_lo(w[4], w[5]), pk_lo(w[6], w[7])};
                d0p[1] = (u32x4){pk_lo(w[8], w[9]), pk_lo(w[10], w[11]), pk_lo(w[12], w[13]), pk_lo(w[14], w[15])};
                d0p[8] = (u32x4){pk_hi(w[0], w[1]), pk_hi(w[2], w[3]), pk_hi(w[4], w[5]), pk_hi(w[6], w[7])};
                d0p[9] = (u32x4){pk_hi(w[8], w[9]), pk_hi(w[10], w[11]), pk_hi(w[12], w[13]), pk_hi(w[14], w[15])};
            }
            {
                const int ep = tid & 127, sq = tid >> 7; unsigned w[16];
#pragma unroll
                for (int i = 0; i < 16; ++i) w[i] = *(const LAS unsigned*)(lds + MP_VT + (16 * sq + i) * 528 + ep * 4);
                u32x4* d0p = (u32x4*)(a.VT + ((size_t)((b * 8 + h) * 64 + ck) * 256 + 2 * ep) * 64 + 16 * sq);
                d0p[0] = (u32x4){pk_lo(w[0], w[1]), pk_lo(w[2], w[3]), pk_lo(w[4], w[5]), pk_lo(w[6], w[7])};
                d0p[1] = (u32x4){pk_lo(w[8], w[9]), pk_lo(w[10], w[11]), pk_lo(w[12], w[13]), pk_lo(w[14], w[15])};
                d0p[8] = (u32x4){pk_hi(w[0], w[1]), pk_hi(w[2], w[3]), pk_hi(w[4], w[5]), pk_hi(w[6], w[7])};
                d0p[9] = (u32x4){pk_hi(w[8], w[9]), pk_hi(w[10], w[11]), pk_hi(w[12], w[13]), pk_hi(w[14], w[15])};
            }
            __syncthreads();
        }
    }
}

constexpr int ML_QS = 0, ML_KS = 17408, ML_KTS = 34816, ML_VTS = 53248, ML_GL = 60160, ML_PL = 60928, ML_QD = 70144, ML_CL = 87552, ML_MP = 113664, ML_END = 113920;
typedef short bf16x8s __attribute__((ext_vector_type(8)));
__device__ __forceinline__ void phase_mlstm(const Args& a, LAS unsigned char* lds, int vcu, int G, int tid, int wave, int lane) {
    const int r16 = lane & 15, q4 = lane >> 4;
    for (int unit = vcu; unit < 256; unit += G) {
        const int bh = unit >> 3, es = unit & 7, b = bh >> 3, h = bh & 7;
        __syncthreads();
        for (int i = tid; i < 16 * 36; i += NTHR) { const int r = i / 36, c = i % 36; *(LAS unsigned*)(lds + ML_VTS + (32 + r) * 144 + c * 4) = (r == 0) ? 0x3F803F80u : 0u; }
        for (int i = tid; i < 48 * 68; i += NTHR) *(LAS unsigned*)(lds + ML_CL + i * 4) = 0u;
        if (tid < 64) { ((LAS float*)(lds + ML_END))[2 * tid] = a.GS[(size_t)(bh * 64 + tid) * 2]; ((LAS float*)(lds + ML_END))[2 * tid + 1] = a.GS[(size_t)(bh * 64 + tid) * 2 + 1]; }
        __syncthreads();
        if (tid == 0) { float m = 0.f; LAS float* mp = (LAS float*)(lds + ML_MP); const LAS float* gs = (const LAS float*)(lds + ML_END);
            for (int k = 0; k < 64; ++k) { mp[k] = m; m = gs[2 * k + 1] + fmaxf(m, gs[2 * k]); } }
        f32x4 accC[2][3];
#pragma unroll
        for (int i = 0; i < 2; ++i)
#pragma unroll
            for (int j = 0; j < 3; ++j) accC[i][j] = (f32x4){0.f, 0.f, 0.f, 0.f};
        u32x4 rq[2], rk[2], rkt[2], rv, rg, sq[2], sk[2], skt[2], sv, sg;
        rv = (u32x4){0u, 0u, 0u, 0u}; rg = rv; sv = rv; sg = rv;
#define ML_LOAD(k, Q_, K_, KT_, V_, G_) do { const int kc_ = (k) < 64 ? (k) : 63; const size_t row0_ = (size_t)b * S + (size_t)kc_ * 64; const size_t cb_ = (size_t)(bh * 64 + kc_); \
        _Pragma("unroll") for (int i_ = 0; i_ < 2; ++i_) { const int c_ = tid + 512 * i_; \
            Q_[i_] = *(const u32x4*)(a.Qn + (row0_ + (c_ >> 4)) * 1024 + h * 128 + (c_ & 15) * 8); \
            K_[i_] = *(const u32x4*)(a.Kn + (row0_ + (c_ >> 4)) * 1024 + h * 128 + (c_ & 15) * 8); \
            KT_[i_] = *(const u32x4*)(a.KT + cb_ * 8192 + (size_t)c_ * 8); } \
        V_ = *(const u32x4*)(a.VT + cb_ * 16384 + (size_t)es * 2048 + (size_t)(tid & 255) * 8); \
        G_ = *(const u32x4*)(a.GA + cb_ * 192 + (tid & 31) * 4); } while (0)
#define ML_STORE(Q_, K_, KT_, V_, G_) do { \
        _Pragma("unroll") for (int i_ = 0; i_ < 2; ++i_) { const int c_ = tid + 512 * i_; \
            *(LAS u32x4*)(lds + ML_QS + (c_ >> 4) * 272 + (c_ & 15) * 16) = Q_[i_]; \
            *(LAS u32x4*)(lds + ML_KS + (c_ >> 4) * 272 + (c_ & 15) * 16) = K_[i_]; \
            *(LAS u32x4*)(lds + ML_KTS + (c_ >> 3) * 144 + (c_ & 7) * 16) = KT_[i_]; } \
        if (tid < 256) *(LAS u32x4*)(lds + ML_VTS + (tid >> 3) * 144 + (tid & 7) * 16) = V_; \
        if (tid < 48) *(LAS u32x4*)(lds + ML_GL + tid * 16) = G_; } while (0)
        ML_LOAD(0, rq, rk, rkt, rv, rg);
        ML_STORE(rq, rk, rkt, rv, rg);
        __syncthreads();
        ML_LOAD(1, rq, rk, rkt, rv, rg); ML_LOAD(2, sq, sk, skt, sv, sg);
        auto chunk = [&](const int k) __attribute__((always_inline)) {
            const LAS float* ga = (const LAS float*)(lds + ML_GL);
            const float m = ((const LAS float*)(lds + ML_MP))[k];
            const int cur = k & 1;
            if (wave < 4) {
                const int tr = wave, t = 16 * tr + r16;
                const float Mt = fmaxf(m, ga[64 + t]);
                bf16x8s qf[4];
#pragma unroll
                for (int kk = 0; kk < 4; ++kk) qf[kk] = *(const LAS bf16x8s*)(lds + ML_QS + t * 272 + kk * 64 + q4 * 16);
#pragma unroll
                for (int sc = 0; sc < 4; ++sc) {
                    u32x2 w0 = {0u, 0u};
                    if (sc <= tr) {
                        f32x4 s0 = {0.f, 0.f, 0.f, 0.f};
#pragma unroll
                        for (int kk = 0; kk < 4; ++kk) { const bf16x8s kf = *(const LAS bf16x8s*)(lds + ML_KS + (16 * sc + r16) * 272 + kk * 64 + q4 * 16);
                            s0 = __builtin_amdgcn_mfma_f32_16x16x32_bf16(kf, qf[kk], s0, 0, 0, 0); }
                        const f32x4 a0 = *(const LAS f32x4*)(lds + ML_GL + (16 * sc + 4 * q4) * 4);
                        float p[4];
#pragma unroll
                        for (int j = 0; j < 4; ++j) { const int sA = 16 * sc + 4 * q4 + j; p[j] = (sA <= t) ? s0[j] * __expf(a0[j] - Mt) : 0.f; }
                        w0.x = cvt_pk_bf16(p[0], p[1]); w0.y = cvt_pk_bf16(p[2], p[3]);
                    }
                    *(LAS u32x2*)(lds + ML_PL + t * 144 + (16 * sc + 4 * q4) * 2) = w0;
                }
                {
                    const int tq = 16 * tr + (lane >> 2), c0 = (lane & 3) * 32;
                    const float dec = __expf(m - fmaxf(m, ga[64 + tq]));
#pragma unroll
                    for (int i = 0; i < 4; ++i) { const u32x4 v = *(const LAS u32x4*)(lds + ML_QS + tq * 272 + (c0 + 8 * i) * 2); u32x4 o;
                        o.x = cvt_pk_bf16(bf_lo(v.x) * dec, bf_hi(v.x) * dec); o.y = cvt_pk_bf16(bf_lo(v.y) * dec, bf_hi(v.y) * dec);
                        o.z = cvt_pk_bf16(bf_lo(v.z) * dec, bf_hi(v.z) * dec); o.w = cvt_pk_bf16(bf_lo(v.w) * dec, bf_hi(v.w) * dec);
                        *(LAS u32x4*)(lds + ML_QD + tq * 272 + (c0 + 8 * i) * 2) = o; }
                }
                asm volatile("s_waitcnt lgkmcnt(0)" ::: "memory");
                f32x4 o0 = {0.f, 0.f, 0.f, 0.f}, o1 = o0, o2 = o0;
#pragma unroll
                for (int kk = 0; kk < 2; ++kk) {
                    if (kk * 2 <= tr) {
                    const bf16x8s pf = *(const LAS bf16x8s*)(lds + ML_PL + t * 144 + kk * 64 + q4 * 16);
                    const bf16x8s v0 = *(const LAS bf16x8s*)(lds + ML_VTS + (r16) * 144 + kk * 64 + q4 * 16);
                    const bf16x8s v1 = *(const LAS bf16x8s*)(lds + ML_VTS + (16 + r16) * 144 + kk * 64 + q4 * 16);
                    const bf16x8s v2 = *(const LAS bf16x8s*)(lds + ML_VTS + (32 + r16) * 144 + kk * 64 + q4 * 16);
                    o0 = __builtin_amdgcn_mfma_f32_16x16x32_bf16(v0, pf, o0, 0, 0, 0);
                    o1 = __builtin_amdgcn_mfma_f32_16x16x32_bf16(v1, pf, o1, 0, 0, 0);
                    o2 = __builtin_amdgcn_mfma_f32_16x16x32_bf16(v2, pf, o2, 0, 0, 0); }
                }
#pragma unroll
                for (int kk = 0; kk < 4; ++kk) {
                    const bf16x8s qd = *(const LAS bf16x8s*)(lds + ML_QD + t * 272 + kk * 64 + q4 * 16);
                    const bf16x8s c0 = *(const LAS bf16x8s*)(lds + ML_CL + cur * 13056 + (r16) * 272 + kk * 64 + q4 * 16);
                    const bf16x8s c1 = *(const LAS bf16x8s*)(lds + ML_CL + cur * 13056 + (16 + r16) * 272 + kk * 64 + q4 * 16);
                    const bf16x8s c2 = *(const LAS bf16x8s*)(lds + ML_CL + cur * 13056 + (32 + r16) * 272 + kk * 64 + q4 * 16);
                    o0 = __builtin_amdgcn_mfma_f32_16x16x32_bf16(c0, qd, o0, 0, 0, 0);
                    o1 = __builtin_amdgcn_mfma_f32_16x16x32_bf16(c1, qd, o1, 0, 0, 0);
                    o2 = __builtin_amdgcn_mfma_f32_16x16x32_bf16(c2, qd, o2, 0, 0, 0);
                }
                const float den = __shfl(o2[0], r16);
                const float mt = ga[128 + t] + Mt;
                const float inv = 1.f / fmaxf(fabsf(den), __expf(-mt));
                bf16_t* hp = a.HS + ((size_t)b * S + (size_t)k * 64 + t) * 2048 + h * 256 + es * 32 + 4 * q4;
                u32x2 w0, w1; w0.x = cvt_pk_bf16(o0[0] * inv, o0[1] * inv); w0.y = cvt_pk_bf16(o0[2] * inv, o0[3] * inv);
                w1.x = cvt_pk_bf16(o1[0] * inv, o1[1] * inv); w1.y = cvt_pk_bf16(o1[2] * inv, o1[3] * inv);
                *(u32x2*)hp = w0; *(u32x2*)(hp + 16) = w1;
            } else {
                const int dj = wave - 4;
                const float Ml = fmaxf(m, ga[64 + 63]), cd = __expf(m - Ml);
#pragma unroll
                for (int i = 0; i < 2; ++i)
#pragma unroll
                    for (int et = 0; et < 3; ++et) accC[i][et] = accC[i][et] * cd;
#pragma unroll
                for (int kk = 0; kk < 2; ++kk) {
                    const f32x4 aA = *(const LAS f32x4*)(lds + ML_GL + (32 * kk + 8 * q4) * 4), aB = *(const LAS f32x4*)(lds + ML_GL + (32 * kk + 8 * q4 + 4) * 4);
                    float wg[8];
#pragma unroll
                    for (int j = 0; j < 4; ++j) { wg[j] = __expf(aA[j] - Ml); wg[4 + j] = __expf(aB[j] - Ml); }
                    bf16x8s vw[3];
#pragma unroll
                    for (int et = 0; et < 3; ++et) { const u32x4 v = *(const LAS u32x4*)(lds + ML_VTS + (16 * et + r16) * 144 + kk * 64 + q4 * 16); u32x4 o;
                        o.x = cvt_pk_bf16(bf_lo(v.x) * wg[0], bf_hi(v.x) * wg[1]); o.y = cvt_pk_bf16(bf_lo(v.y) * wg[2], bf_hi(v.y) * wg[3]);
                        o.z = cvt_pk_bf16(bf_lo(v.z) * wg[4], bf_hi(v.z) * wg[5]); o.w = cvt_pk_bf16(bf_lo(v.w) * wg[6], bf_hi(v.w) * wg[7]);
                        vw[et] = __builtin_bit_cast(bf16x8s, o); }
#pragma unroll
                    for (int i = 0; i < 2; ++i) { const bf16x8s kf = *(const LAS bf16x8s*)(lds + ML_KTS + (16 * (2 * dj + i) + r16) * 144 + kk * 64 + q4 * 16);
#pragma unroll
                        for (int et = 0; et < 3; ++et) accC[i][et] = __builtin_amdgcn_mfma_f32_16x16x32_bf16(kf, vw[et], accC[i][et], 0, 0, 0); }
                }
#pragma unroll
                for (int i = 0; i < 2; ++i)
#pragma unroll
                    for (int et = 0; et < 3; ++et) { u32x2 w; w.x = cvt_pk_bf16(accC[i][et][0], accC[i][et][1]); w.y = cvt_pk_bf16(accC[i][et][2], accC[i][et][3]);
                        *(LAS u32x2*)(lds + ML_CL + (cur ^ 1) * 13056 + (16 * et + r16) * 272 + (16 * (2 * dj + i) + 4 * q4) * 2) = w; }
            }
        };
        for (int k = 0; k < 64; k += 2) {
            chunk(k);
            __syncthreads();
            ML_STORE(rq, rk, rkt, rv, rg);
            __syncthreads();
            ML_LOAD(k + 3, rq, rk, rkt, rv, rg);
            chunk(k + 1);
            __syncthreads();
            ML_STORE(sq, sk, skt, sv, sg);
            __syncthreads();
            ML_LOAD(k + 4, sq, sk, skt, sv, sg);
        }
#undef ML_LOAD
#undef ML_STORE
    }
}
__device__ __forceinline__ void phase_mnorm(const Args& a, int gw, int NGW, int lane) {
    const bf16_t* SG = a.P3 + (size_t)2 * NT * 2048;
    float gv[32];
#pragma unroll
    for (int i = 0; i < 8; ++i) { const f32x4 t = *(const f32x4*)(a.m_hg + 32 * lane + 4 * i); gv[4 * i] = t[0]; gv[4 * i + 1] = t[1]; gv[4 * i + 2] = t[2]; gv[4 * i + 3] = t[3]; }
    const int RPW = (NT + NGW - 1) / NGW; int m = gw * RPW; const int mend = (m + RPW < NT) ? m + RPW : NT;
    if (m >= mend) return;
    u32x4 p0[4], p1[4], n0[4], n1[4];
#pragma unroll
    for (int i = 0; i < 4; ++i) { p0[i] = *(const u32x4*)(a.HS + (size_t)m * D + 32 * lane + 8 * i); p1[i] = *(const u32x4*)(SG + (size_t)m * D + 32 * lane + 8 * i); }
    for (;;) {
        const bool more = m + 1 < mend;
        if (more) {
#pragma unroll
            for (int i = 0; i < 4; ++i) { n0[i] = *(const u32x4*)(a.HS + (size_t)(m + 1) * D + 32 * lane + 8 * i); n1[i] = *(const u32x4*)(SG + (size_t)(m + 1) * D + 32 * lane + 8 * i); } }
        float o[32], sg[32]; float ss = 0.f;
#pragma unroll
        for (int i = 0; i < 4; ++i) { float f0[8], f1[8]; bf8_to_f32(p0[i], f0); bf8_to_f32(p1[i], f1);
#pragma unroll
            for (int j = 0; j < 8; ++j) { o[8 * i + j] = f0[j]; sg[8 * i + j] = f1[j]; ss += f0[j] * f0[j]; } }
        ss += __shfl_xor(ss, 1); ss += __shfl_xor(ss, 2); ss += __shfl_xor(ss, 4);
        const float r = rsqrtf(ss * (1.f / 256.f) + EPS);
        unsigned char* orow = a.ob8 + (size_t)m * D + 32 * lane;
#pragma unroll
        for (int i = 0; i < 4; ++i) { float y[8];
#pragma unroll
            for (int j = 0; j < 8; ++j) y[j] = o[8 * i + j] * r * gv[8 * i + j] * sg[8 * i + j];
            u32x2 w; w.x = pk4_fp8(y[0] * 8.f, y[1] * 8.f, y[2] * 8.f, y[3] * 8.f); w.y = pk4_fp8(y[4] * 8.f, y[5] * 8.f, y[6] * 8.f, y[7] * 8.f);
            *(u32x2*)(orow + 8 * i) = w; }
        if (!more) break;
        ++m;
#pragma unroll
        for (int i = 0; i < 4; ++i) { p0[i] = n0[i]; p1[i] = n1[i]; }
    }
}

#define XB_TMO      128
#define XB_XCNT(j)  (256  + 64 * (j))
#define XB_XSUB(j)  (1280 + 64 * (j))
#define XB_XGEN(j)  (2304 + 64 * (j))
#define XB_TOP      3328
#define XB_TOPGEN   3392
#define XCD_BAR_WORDS 3456
#define XB_SPIN_CAP (1u << 18)

__device__ __forceinline__ unsigned xb_ld(unsigned* p)              { return __hip_atomic_load(p, __ATOMIC_RELAXED, __HIP_MEMORY_SCOPE_AGENT); }
__device__ __forceinline__ unsigned xb_add(unsigned* p, unsigned v) { return __hip_atomic_fetch_add(p, v, __ATOMIC_RELAXED, __HIP_MEMORY_SCOPE_AGENT); }
__device__ __forceinline__ unsigned xb_xcc_id() { return (unsigned)__builtin_amdgcn_s_getreg((3 << 11) | 20) & 0xFu; }
#define XB_SPIN(cond, bar) do { unsigned _sp = 0; while (cond) { __builtin_amdgcn_s_sleep(1); \
    if ((++_sp & 255u) == 0u) { if (xb_ld(&(bar)[XB_TMO])) break; if (_sp > XB_SPIN_CAP) { atomicAdd(&(bar)[XB_TMO], 1u); break; } } } } while (0)

struct XcdBarrier {
    unsigned* bar; unsigned x;
    volatile LAS unsigned* st;
};

__device__ __forceinline__ XcdBarrier xcd_barrier_post(unsigned* bar, volatile LAS unsigned* st) {
    XcdBarrier b; b.bar = bar; b.x = xb_xcc_id(); b.st = st;
    if (threadIdx.x == 0) (void)xb_add(&bar[XB_XCNT(b.x)], 1u);
    return b;
}
__device__ __forceinline__ void xcd_barrier_complete(unsigned* bar, unsigned x, unsigned& nloc, unsigned& nx) {
    const unsigned G = gridDim.x * gridDim.y * gridDim.z;
    unsigned sum, cnt, mine, sp = 0u;
    for (;;) {
        sum = 0u; cnt = 0u; mine = 0u;
#pragma unroll
        for (unsigned j = 0; j < 16; ++j) { const unsigned c = xb_ld(&bar[XB_XCNT(j)]); sum += c; cnt += (c > 0u) ? 1u : 0u; mine = (j == x) ? c : mine; }
        if (sum == G) break;
        __builtin_amdgcn_s_sleep(1);
        if ((++sp & 255u) == 0u) { if (xb_ld(&bar[XB_TMO])) break; if (sp > XB_SPIN_CAP) { atomicAdd(&bar[XB_TMO], 1u); break; } }
    }
    nloc = mine > 0u ? mine : 1u; nx = cnt > 0u ? cnt : 1u;
}

__device__ __forceinline__ void xcd_barrier(const XcdBarrier& b) {
    asm volatile("s_waitcnt vmcnt(0)" ::: "memory");
    __syncthreads();
    if (threadIdx.x == 0) {
        unsigned* bar = b.bar;
        __builtin_amdgcn_s_waitcnt(0);
        unsigned nloc = b.st[0], nx = b.st[1];
        if (nloc == 0u) { xcd_barrier_complete(bar, b.x, nloc, nx); b.st[0] = nloc; b.st[1] = nx; }
        const unsigned old = xb_add(&bar[XB_XSUB(b.x)], 1u);
        const unsigned gen = old / nloc;
        if (old + 1u == (gen + 1u) * nloc) {
            __builtin_amdgcn_fence(__ATOMIC_RELEASE, "agent");
            asm volatile("s_waitcnt vmcnt(0)" ::: "memory");
            const unsigned og = xb_add(&bar[XB_TOP], 1u);
            const unsigned tg = og / nx;
            if (og + 1u == (tg + 1u) * nx) xb_add(&bar[XB_TOPGEN], 1u);
            else XB_SPIN(xb_ld(&bar[XB_TOPGEN]) == tg, bar);
            __builtin_amdgcn_fence(__ATOMIC_ACQUIRE, "agent");
            xb_add(&bar[XB_XGEN(b.x)], 1u);
            asm volatile("s_waitcnt vmcnt(0)" ::: "memory");
        } else {
            XB_SPIN(xb_ld(&bar[XB_XGEN(b.x)]) == gen, bar);
            __builtin_amdgcn_fence(__ATOMIC_ACQUIRE, "agent");
            asm volatile("s_waitcnt vmcnt(0)" ::: "memory");
        }
    }
    __syncthreads();
}


#ifndef MK_REP_MASK
#define MK_REP_MASK 0u
#endif
__device__ __forceinline__ constexpr int REPS(int k) { return ((MK_REP_MASK >> k) & 1u) ? 2 : 1; }
__global__ void __launch_bounds__(NTHR, 2) mk_fwd(Args a) {
    extern __shared__ __attribute__((aligned(16))) unsigned char lds_raw[];
    LAS unsigned char* lds = (LAS unsigned char*)lds_raw;
    LAS unsigned char* misc = lds + LDS_MISC;
    const int tid = threadIdx.x, lane = tid & 63, wave = __builtin_amdgcn_readfirstlane(tid >> 6);
    const int G = gridDim.x; const int bx = blockIdx.x; const int vcu = (G % 8 == 0) ? (bx % 8) * (G / 8) + bx / 8 : bx;
    const int gw = vcu * NWAVES + wave, NGW = G * NWAVES;
    if (tid < 16) ((LAS unsigned*)(misc + MISC_BAR))[tid] = 0u;
    __syncthreads();
    const int lo = a.ph_lo, hi = a.ph_hi;
    XcdBarrier bar; bar.bar = a.ctl + 4096; bar.x = 0; bar.st = nullptr;
    if (hi - lo > 1) bar = xcd_barrier_post(a.ctl + 4096, (volatile LAS unsigned*)(misc + MISC_BAR));
#define IN(k) (lo <= (k) && (k) < hi)
#define SEAM(k) do { if (IN(k) && IN((k) + 1)) xcd_barrier(bar); } while (0)
    const float* mod0 = a.mod; const float* mod1 = a.mod + (size_t)NB * 6 * D;

#define PH(k) if (IN(k)) _Pragma("unroll") for (int rep_ = 0; rep_ < REPS(k); (REPS(k) > 1 ? __syncthreads() : (void)0, ++rep_))
    PH(0) { p0_prologue(a, lds, vcu, G, opq(tid), wave, opq(lane)); } SEAM(0);
    PH(1) { phase_norm(a.x, a.nmg, mod0, 0, 1, a.hb, gw, NGW, opq(lane)); } SEAM(1);
    PH(2) {
        pg8::Gemm g{a.hb, a.Bt_qkv, NT, 6144, D}; pg8::StaticOrder So; So.init(NT, 6144, G, bx);
        EpiQKV E{a.Qh, a.Kh, a.Vh, a.cs};
        pg8::gemm_phase<EpiQKV, pg8::StaticOrder, true, true>(lds, g, So, E);
    } SEAM(2);
    PH(3) { phase_attn(a, (char*)lds_raw, vcu, G); } SEAM(3);
    PH(4) { phase_attn_combine(a, gw, NGW, opq(lane)); } SEAM(4);
    PH(5) {
        pg8::Gemm g{a.ob, a.Bt_ao, NT, D, D}; pg8::StaticOrder So; So.init(NT, D, G, bx);
        EpiResid<true> E{a.x, a.xres, mod0 + 2 * D, 1.f};
        pg8::gemm_phase<EpiResid<true>, pg8::StaticOrder, true, true>(lds, g, So, E);
    } SEAM(5);
#define MOE_PHASES(P, layer, modl)                                                                                                   \
    PH(P) { phase_norm_route(a, layer, modl, lds, misc, vcu, G, opq(tid), wave, opq(lane)); } SEAM(P);                            \
    PH(P + 1) { const int NP = moe_tables(a.counts + (layer) * 64, misc, tid);                                                    \
        pg8::Gemm g{(const bf16_t*)a.hb8, (const bf16_t*)(a.Bt_gu8 + (size_t)(layer) * NE * 2048 * D), NP * 256, NE * 2048, D / 2};     \
        GroupedOrderG So; So.NP = NP; So.total = NP * 8; So.G = G; So.c = vcu; So.pe = (const LAS int*)(misc + MISC_PE);          \
        So.ps = (const LAS int*)(misc + MISC_PS); So.cn = (const LAS int*)(misc + MISC_CNT); So.inv = a.inv; EpiGU E{a.Hm8};      \
        pg8::gemm_phase_gather<EpiGU, GroupedOrderG, true, 125, 121>(lds, g, So, E); } SEAM(P + 1);                                               \
    PH(P + 2) { const int NP = moe_tables(a.counts + (layer) * 64, misc, tid);                                                    \
        pg8::Gemm g{(const bf16_t*)a.Hm8, (const bf16_t*)(a.Bt_dn8 + (size_t)(layer) * NE * D * MH), NP * 256, NE * 2048, MH / 2};   \
        GroupedOrder So{NP, NP * 8, G, vcu, (const LAS int*)(misc + MISC_PE)}; EpiBf16G E{a.Y, D, 1.f / 128.f};                                \
        pg8::gemm_phase<EpiBf16G, GroupedOrder, true, true, true, 125, 122>(lds, g, So, E); } SEAM(P + 2);
    MOE_PHASES(6, 0, mod0)
    PH(9) { moe_tables(a.counts, misc, tid); phase_combine_gates(a, mod0, mod1, a.nmg + D, (const LAS int*)(misc + MISC_PS), lds, vcu, G, opq(tid), wave, opq(lane)); } SEAM(9);
    PH(10) {
        pg8::Gemm g{(const bf16_t*)a.hb8, (const bf16_t*)a.Bt_min8, NT, 6144, D / 2}; pg8::StaticOrder So; So.init(NT, 6144, G, bx);
        EpiMin E{a.P3};
        pg8::gemm_phase<EpiMin, pg8::StaticOrder, true, true, true>(lds, g, So, E);
    } SEAM(10);
    PH(11) { phase_mprep(a, lds, vcu, G, opq(tid)); } SEAM(11);
    PH(12) { phase_mlstm(a, lds, vcu, G, opq(tid), wave, opq(lane)); } SEAM(12);
    PH(13) { phase_mnorm(a, gw, NGW, opq(lane)); } SEAM(13);
    PH(14) {
        pg8::Gemm g{(const bf16_t*)a.ob8, (const bf16_t*)a.Bt_mo8, NT, D, D / 2}; pg8::StaticOrder So; So.init(NT, D, G, bx);
        EpiResid<false> E{a.xres, a.xres, mod1 + 2 * D, 1.f / 512.f};
        pg8::gemm_phase<EpiResid<false>, pg8::StaticOrder, true, true, true>(lds, g, So, E);
    } SEAM(14);
    MOE_PHASES(15, 1, mod1)
    PH(18) { moe_tables(a.counts + 64, misc, tid); phase_combine_final(a, mod1, (const LAS int*)(misc + MISC_PS), gw, NGW, opq(lane)); }
#undef PH
#undef IN
#undef SEAM
}
}

extern "C" void kernel_launch(void* const* d_in, const int* in_sizes, int n_in, void* d_out, int out_size, void* d_ws, size_t ws_size, hipStream_t st) {
    using namespace mk;
    static int grid = 0;
    if (grid == 0) {
        int dev = 0, cus = 0;
        if (hipGetDevice(&dev) != hipSuccess || hipDeviceGetAttribute(&cus, hipDeviceAttributeMultiprocessorCount, dev) != hipSuccess || cus <= 0) cus = 256;
        (void)hipFuncSetAttribute((const void*)mk_fwd, hipFuncAttributeMaxDynamicSharedMemorySize, LDS_BYTES);
        int per_cu = 0; (void)hipOccupancyMaxActiveBlocksPerMultiprocessor(&per_cu, (const void*)mk_fwd, NTHR, LDS_BYTES);
        (void)hipGetLastError();
        grid = cus;
    }
    Args a{};
    a.x = (const float*)d_in[0]; a.c = (const float*)d_in[1]; a.pos = (const int*)d_in[2];
    a.ada_w = (const float*)d_in[3]; a.ada_b = (const float*)d_in[4]; a.nmg = (const float*)d_in[5]; a.nfg = (const float*)d_in[6]; a.fng = (const float*)d_in[7];
    a.a_win = (const float*)d_in[8]; a.a_wout = (const float*)d_in[9];
    a.lq1 = (const float*)d_in[10]; a.lk1 = (const float*)d_in[11]; a.lq2 = (const float*)d_in[12]; a.lk2 = (const float*)d_in[13]; a.a_hg = (const float*)d_in[14];
    a.m_win = (const float*)d_in[15]; a.m_cw = (const float*)d_in[16]; a.m_cb = (const float*)d_in[17]; a.m_gb = (const float*)d_in[18]; a.m_hg = (const float*)d_in[19]; a.m_wout = (const float*)d_in[20];
    a.wg = (const float*)d_in[21]; a.bg = (const float*)d_in[22]; a.we = (const float*)d_in[23]; a.be = (const float*)d_in[24]; a.wgu = (const float*)d_in[25]; a.wdn = (const float*)d_in[26];
    a.out = (float*)d_out;
    char* w = (char*)d_ws; size_t off = 0;
    auto alloc = [&](size_t bytes) { void* p = w + off; off += (bytes + 4095) & ~(size_t)4095; return p; };
    a.ctl = (unsigned*)alloc(1 << 20);
    a.counts = (int*)(a.ctl + 65536);
    a.mod = (float*)alloc((size_t)2 * NB * 6 * D * 4);
    a.cs = (float2*)alloc((size_t)NT * 16 * 8);
    a.Bt_qkv = (bf16_t*)alloc((size_t)6144 * D * 2); a.Bt_ao = (bf16_t*)alloc((size_t)D * D * 2); a.Bt_min = nullptr; a.Bt_mo = nullptr; a.Bt_min8 = (unsigned char*)alloc((size_t)6144 * D); a.Bt_mo8 = (unsigned char*)alloc((size_t)D * D);
    a.Bt_rt = (bf16_t*)alloc((size_t)2 * 256 * D * 2); a.Bt_g = (bf16_t*)alloc((size_t)16 * D * 2); a.Bt_gu = nullptr; a.Bt_dn = nullptr;
    a.Bt_gu8 = (unsigned char*)alloc((size_t)2 * NE * 2048 * D); a.Bt_dn8 = (unsigned char*)alloc((size_t)2 * NE * D * MH); a.hb8 = (unsigned char*)alloc((size_t)(NT + 1) * D);
    a.xres = (bf16_t*)alloc((size_t)NT * D * 2); a.hb = (bf16_t*)alloc((size_t)(NT + 1) * D * 2); a.ob = (bf16_t*)alloc((size_t)NT * D * 2); a.ob8 = (unsigned char*)a.ob;

    a.logits = nullptr; a.eid = (int*)alloc((size_t)NA * 4); a.wts = (float*)alloc((size_t)NA * 4); a.pos_in_e = (int*)alloc((size_t)NA * 4); a.slot = nullptr; a.inv = (int*)alloc((size_t)NE * 32768 * 4);
    a.Qh = (bf16_t*)alloc((size_t)3 * NT * 2048 * 2); a.Kh = a.Qh + (size_t)NT * 2048; a.Vh = a.Kh + (size_t)NT * 2048; a.Oa = (bf16_t*)alloc((size_t)NT * 4096 * 2);
    a.P3 = (bf16_t*)alloc((size_t)3 * NT * 2048 * 2); a.Qn = (bf16_t*)alloc((size_t)2 * NT * 1024 * 2); a.Kn = a.Qn + (size_t)NT * 1024;
    a.KT = (bf16_t*)alloc((size_t)NT * 1024 * 2); a.VT = (bf16_t*)alloc((size_t)NT * 2048 * 2); a.HS = (bf16_t*)alloc((size_t)NT * 2048 * 2);
    a.gates = (float*)alloc((size_t)NT * 16 * 4); a.GA = (float*)alloc((size_t)32 * 64 * 192 * 4); a.GS = (float*)alloc((size_t)32 * 64 * 2 * 4);
    a.XG = nullptr; a.Hm = nullptr; a.Hm8 = (unsigned char*)alloc((size_t)PMAX * MH); a.Y = (bf16_t*)alloc((size_t)PMAX * D * 2);
    if (off > ws_size) return;

    (void)hipMemsetAsync(a.ctl, 0, 1 << 20, st);
    auto run = [&](int lo, int hi) { a.ph_lo = lo; a.ph_hi = hi; hipLaunchKernelGGL(mk_fwd, dim3(grid), dim3(NTHR), LDS_BYTES, st, a); };
#ifndef MK_N_LAUNCHES
#define MK_N_LAUNCHES 1
#endif
#if MK_N_LAUNCHES == 1
    run(0, 19);
#else
    for (int p = 0; p <= 18; ++p) run(p, p + 1);
#endif
}
```

```cpp
#include <hip/hip_runtime.h>
#include <math.h>
#include <stdint.h>


namespace pg8 {
#define PG8_LAS __attribute__((address_space(3)))
typedef unsigned short bf16_t;
typedef short bf16x8 __attribute__((ext_vector_type(8)));
typedef float f32x4 __attribute__((ext_vector_type(4)));
typedef unsigned u32x4 __attribute__((ext_vector_type(4)));
constexpr int BM = 256, BK = 64, HALF = 128, KBP = 1088  , HTB = 16 * KBP  , STAGE_BYTES = 8 * HTB, NXCD = 8, WGM = 8;

__host__ __device__ __forceinline__ int lds_byte(int r, int c) { const int ch = c >> 3, p = (ch & 4) | ((ch & 3) ^ ((r >> 1) & 3)); return (r >> 3) * KBP + (r & 7) * 128 + p * 16 + (c & 7) * 2; }
__host__ __device__ __forceinline__ void stage_rc(int tid, int i, int& R, int& C) { const int g = (tid >> 6) + 8 * i, l = tid & 63, rr = l >> 3, p = l & 7, ch = (p & 4) | ((p & 3) ^ ((rr >> 1) & 3)); R = 8 * g + rr; C = ch * 8; }
__host__ __device__ __forceinline__ int perm32(int rho) { const int n = rho >> 4, i = rho & 15; return 8 * (i >> 2) + 4 * n + (i & 3); }

typedef int i32x4 __attribute__((ext_vector_type(4)));
typedef int i32x8 __attribute__((ext_vector_type(8)));
typedef int i32x2 __attribute__((ext_vector_type(2)));
__device__ __forceinline__ i32x8 cat8(i32x4 l, i32x4 h) { return __builtin_shufflevector(l, h, 0, 1, 2, 3, 4, 5, 6, 7); }
__device__ __forceinline__ void mfma_scale_f8(f32x4& acc, i32x8 b, i32x8 a, int sc) {
    asm volatile("v_mfma_scale_f32_16x16x128_f8f6f4 %0, %1, %2, %0, %3, %3 op_sel_hi:[0,0,0]" : "+v"(acc) : "v"(b), "v"(a), "v"(sc));
}
struct Unit { int pm, pn; };
struct Gemm { const bf16_t* A; const bf16_t* Bt; int M, N, K; };

struct StaticOrder {
    int nM, nN, nwg, G, c;
    __host__ __device__ void init(int M, int N, int G_, int c_) { nM = M / BM; nN = N / BM; nwg = nM * nN; G = G_; c = c_; }
    __host__ __device__ bool next(int i, Unit& u) const {
        const long L = (long)i * G + c; if (L >= nwg) return false;
        int wgid = (int)L; { const int q = nwg / NXCD, r = nwg % NXCD, xcd = wgid % NXCD, off = wgid / NXCD; wgid = (xcd < r ? xcd * (q + 1) : r * (q + 1) + (xcd - r) * q) + off; }
        const int nig = WGM * nN, gid = wgid / nig, fm = gid * WGM, gsz = (nM - fm) < WGM ? (nM - fm) : WGM;
        u.pm = fm + ((wgid % nig) % gsz); u.pn = (wgid % nig) / gsz; return true;
    }
    __device__ __forceinline__ void a_ready(const Unit&) const {}
    __device__ __forceinline__ void done(const Unit&) const {}
};

__device__ __forceinline__ unsigned cvt_pk_bf16(float lo, float hi) { unsigned r; asm volatile("v_cvt_pk_bf16_f32 %0, %1, %2" : "=v"(r) : "v"(lo), "v"(hi)); return r; }
typedef float f32x2 __attribute__((ext_vector_type(2)));
__device__ __forceinline__ f32x2 gelu_pk(f32x2 v) {
    const f32x2 av = __builtin_elementwise_abs(v), d = av * 0.2316418882f + 1.0f;
    f32x2 t; t.x = __builtin_amdgcn_rcpf(d.x); t.y = __builtin_amdgcn_rcpf(d.y);
    f32x2 q = t * 0.5307027145f + (-0.7265760135f); q = q * t + 0.7107068705f; q = q * t + (-0.142248368f); q = q * t + 0.127414796f; q = q * t;
    const f32x2 s = (v * v) * (-0.72134752044f);
    f32x2 e; e.x = __builtin_amdgcn_exp2f(s.x); e.y = __builtin_amdgcn_exp2f(s.y);
    const f32x2 m = v * (q * e), r = v - m;
    f32x2 o; o.x = v.x < 0.f ? m.x : r.x; o.y = v.y < 0.f ? m.y : r.y; return o;
}


template <class Epi, class Sched, bool ALIGN_EPI = false, bool SP2 = false, bool F8 = false, int SCA = 127, int SCB = 127>
__device__ __forceinline__ void gemm_phase(PG8_LAS unsigned char* lds, const Gemm g, const Sched& S, const Epi& E) {
    const int tid = threadIdx.x, wid = __builtin_amdgcn_readfirstlane(tid >> 6), lane = tid & 63, wr = wid >> 2, wc = wid & 3, fr = lane & 15, fq = lane >> 4;
    const int K = g.K, nt = K / BK;
    unsigned voffA[2], voffB[2];
#pragma unroll
    for (int i = 0; i < 2; ++i) { int R, C; stage_rc(tid, i, R, C); const int Rb = Epi::PERM ? ((R & ~31) + perm32(R & 31)) : R;
        voffA[i] = (unsigned)(R * K + C) * 2u; voffB[i] = (unsigned)(Rb * K + C) * 2u; }
    const size_t kstep = (size_t)(BK * 2);
    const size_t hstep = (size_t)HALF * K * 2;
    const size_t tstep = 2 * hstep;
    const unsigned ldsw = (unsigned)wid * (unsigned)KBP;
    const int aoff = lds_byte(wr * 64 + fr, fq * 8), boff = lds_byte(wc * 32 + fr, fq * 8);
#define PG8_SA(b, h) (((b) * 2 + (h)) * HTB)
#define PG8_SB(b, h) ((4 + (b) * 2 + (h)) * HTB)
#define PG8_STAGE(bufoff, gbase, voff) do { _Pragma("unroll") for (int _i = 0; _i < 2; ++_i) \
        __builtin_amdgcn_global_load_lds((const unsigned*)((const char*)(gbase) + (voff)[_i]), (PG8_LAS unsigned*)(lds + (bufoff) + ldsw + _i * (8 * KBP)), 16, 0, 0); } while (0)
#define PG8_LDA(dst, b, h) do { if constexpr (F8) { _Pragma("unroll") for (int m = 0; m < 4; ++m) dst##8[m] = cat8(*(const PG8_LAS i32x4*)(lds + PG8_SA(b, h) + aoff + m * (2 * KBP)), *(const PG8_LAS i32x4*)(lds + PG8_SA(b, h) + aoff + m * (2 * KBP) + 64)); } \
        else { _Pragma("unroll") for (int m = 0; m < 4; ++m) _Pragma("unroll") for (int k = 0; k < 2; ++k) dst[m][k] = *(const PG8_LAS bf16x8*)(lds + PG8_SA(b, h) + aoff + m * (2 * KBP) + k * 64); } } while (0)
#define PG8_LDB(dst, b, h) do { if constexpr (F8) { _Pragma("unroll") for (int n = 0; n < 2; ++n) dst##8[n] = cat8(*(const PG8_LAS i32x4*)(lds + PG8_SB(b, h) + boff + n * (2 * KBP)), *(const PG8_LAS i32x4*)(lds + PG8_SB(b, h) + boff + n * (2 * KBP) + 64)); } \
        else { _Pragma("unroll") for (int n = 0; n < 2; ++n) _Pragma("unroll") for (int k = 0; k < 2; ++k) dst[n][k] = *(const PG8_LAS bf16x8*)(lds + PG8_SB(b, h) + boff + n * (2 * KBP) + k * 64); } } while (0)
#define PG8_MMA(ai, bj, At, Bt) do { __builtin_amdgcn_s_setprio(1); _Pragma("unroll") for (int m = 0; m < 4; ++m) _Pragma("unroll") for (int n = 0; n < 2; ++n) { \
        if constexpr (F8) { mfma_scale_f8(acc[ai][bj][m][n], Bt##8[n], At##8[m], sc1); } \
        else { _Pragma("unroll") for (int k = 0; k < 2; ++k) acc[ai][bj][m][n] = __builtin_amdgcn_mfma_f32_16x16x32_bf16(Bt[n][k], At[m][k], acc[ai][bj][m][n], 0, 0, 0); } } \
        __builtin_amdgcn_s_setprio(0); } while (0)
#define PG8_WAIT_V(n) asm volatile("s_waitcnt vmcnt(" #n ")" ::: "memory")
#define PG8_WAIT_L(n) asm volatile("s_waitcnt lgkmcnt(" #n ")" ::: "memory")
#define PG8_BAR __builtin_amdgcn_s_barrier()
#define PG8_SCHED __builtin_amdgcn_sched_barrier(0)
    Unit cur, nxt; int ui = 0;
    if (!S.next(0, cur)) return;
    f32x4 acc[2][2][4][2];
#pragma unroll
    for (int a = 0; a < 2; ++a)
#pragma unroll
        for (int b = 0; b < 2; ++b)
#pragma unroll
            for (int m = 0; m < 4; ++m)
#pragma unroll
                for (int n = 0; n < 2; ++n) acc[a][b][m][n] = (f32x4){0.f, 0.f, 0.f, 0.f};
    bf16x8 At[4][2], B0[2][2], B1[2][2]; i32x8 At8[4], B08[2], B18[2]; int sc1 = 0x7f7f7f7f; asm volatile("" : "+v"(sc1));
    const char* cA = (const char*)g.A + (size_t)cur.pm * tstep; const char* cB = (const char*)g.Bt + (size_t)cur.pn * tstep;
    S.a_ready(cur);
    if constexpr (SP2) {
        PG8_STAGE(PG8_SB(0, 0), cB, voffB); PG8_STAGE(PG8_SB(0, 1), cB + hstep, voffB); PG8_STAGE(PG8_SA(0, 0), cA, voffA); PG8_STAGE(PG8_SA(0, 1), cA + hstep, voffA);
        if (wr == 1) PG8_BAR;
        PG8_WAIT_V(2); PG8_BAR;
        PG8_STAGE(PG8_SB(1, 0), cB + kstep, voffB); PG8_STAGE(PG8_SA(1, 0), cA + kstep, voffA); PG8_STAGE(PG8_SB(1, 1), cB + hstep + kstep, voffB);
        PG8_WAIT_V(6); PG8_BAR;
    } else {
        PG8_STAGE(PG8_SB(0, 0), cB, voffB); PG8_STAGE(PG8_SA(0, 0), cA, voffA); PG8_STAGE(PG8_SB(0, 1), cB + hstep, voffB); PG8_STAGE(PG8_SA(0, 1), cA + hstep, voffA);
        if (wr == 1) PG8_BAR;
        PG8_WAIT_V(4); PG8_BAR;
        PG8_STAGE(PG8_SB(1, 0), cB + kstep, voffB); PG8_STAGE(PG8_SA(1, 0), cA + kstep, voffA); PG8_STAGE(PG8_SB(1, 1), cB + hstep + kstep, voffB);
        PG8_WAIT_V(6); PG8_BAR;
    }
    for (;;) {
        const bool has_next = S.next(ui + 1, nxt);
        const char* nA = has_next ? (const char*)g.A + (size_t)nxt.pm * tstep : cA; const char* nB = has_next ? (const char*)g.Bt + (size_t)nxt.pn * tstep : cB;
#pragma nounroll
        for (int t = 0; t < nt; t += 2) {
            const bool last = (t == nt - 2);
            const char* a1 = cA + (size_t)(t + 1) * kstep;
            const char* a2 = last ? nA : cA + (size_t)(t + 2) * kstep; const char* b2 = last ? nB : cB + (size_t)(t + 2) * kstep;
            const char* a3 = a2 + kstep; const char* b3 = b2 + kstep;
            if (last && has_next) S.a_ready(nxt);
            if constexpr (SP2) {
            PG8_LDB(B0, 0, 0); PG8_LDB(B1, 0, 1); PG8_SCHED; PG8_LDA(At, 0, 0); PG8_STAGE(PG8_SA(1, 1), a1 + hstep, voffA);
            PG8_WAIT_V(8); PG8_WAIT_L(0); PG8_BAR; PG8_MMA(0, 0, At, B0); PG8_MMA(0, 1, At, B1); PG8_BAR; PG8_SCHED;
            PG8_LDA(At, 0, 1); PG8_STAGE(PG8_SB(0, 0), b2, voffB); PG8_STAGE(PG8_SB(0, 1), b2 + hstep, voffB); PG8_STAGE(PG8_SA(0, 0), a2, voffA);
            PG8_WAIT_V(8); PG8_WAIT_L(0); PG8_BAR; PG8_MMA(1, 0, At, B0); PG8_MMA(1, 1, At, B1); PG8_BAR; PG8_SCHED;
            PG8_LDB(B0, 1, 0); PG8_LDB(B1, 1, 1); PG8_SCHED; PG8_LDA(At, 1, 0); PG8_STAGE(PG8_SA(0, 1), a2 + hstep, voffA);
            PG8_WAIT_V(8); PG8_WAIT_L(0); PG8_BAR; PG8_MMA(0, 0, At, B0); PG8_MMA(0, 1, At, B1); PG8_BAR; PG8_SCHED;
            PG8_LDA(At, 1, 1); PG8_STAGE(PG8_SB(1, 0), b3, voffB); PG8_STAGE(PG8_SB(1, 1), b3 + hstep, voffB); PG8_STAGE(PG8_SA(1, 0), a3, voffA);
            PG8_WAIT_V(8); PG8_WAIT_L(0); PG8_BAR; PG8_MMA(1, 0, At, B0); PG8_MMA(1, 1, At, B1); PG8_BAR; PG8_SCHED;
            } else {
            PG8_LDB(B0, 0, 0); PG8_SCHED; PG8_LDA(At, 0, 0); PG8_STAGE(PG8_SA(1, 1), a1 + hstep, voffA);
            PG8_WAIT_L(8); PG8_BAR; PG8_WAIT_L(0); PG8_MMA(0, 0, At, B0); PG8_BAR; PG8_SCHED;
            PG8_LDB(B1, 0, 1); PG8_STAGE(PG8_SB(0, 0), b2, voffB);
            PG8_BAR; PG8_WAIT_L(0); PG8_MMA(0, 1, At, B1); PG8_BAR;
            PG8_LDA(At, 0, 1); PG8_STAGE(PG8_SA(0, 0), a2, voffA);
            PG8_BAR; PG8_WAIT_L(0); PG8_MMA(1, 0, At, B0); PG8_BAR; PG8_SCHED;
            PG8_STAGE(PG8_SB(0, 1), b2 + hstep, voffB);
            PG8_WAIT_V(6); PG8_BAR; PG8_MMA(1, 1, At, B1); PG8_BAR;
            PG8_LDB(B0, 1, 0); PG8_SCHED; PG8_LDA(At, 1, 0); PG8_STAGE(PG8_SA(0, 1), a2 + hstep, voffA);
            PG8_WAIT_L(8); PG8_BAR; PG8_WAIT_L(0); PG8_MMA(0, 0, At, B0); PG8_BAR; PG8_SCHED;
            PG8_LDB(B1, 1, 1); PG8_STAGE(PG8_SB(1, 0), b3, voffB);
            PG8_BAR; PG8_WAIT_L(0); PG8_MMA(0, 1, At, B1); PG8_BAR;
            PG8_LDA(At, 1, 1); PG8_STAGE(PG8_SA(1, 0), a3, voffA);
            PG8_BAR; PG8_WAIT_L(0); PG8_MMA(1, 0, At, B0); PG8_BAR; PG8_SCHED;
            PG8_STAGE(PG8_SB(1, 1), b3 + hstep, voffB);
            PG8_WAIT_V(6); PG8_BAR; PG8_MMA(1, 1, At, B1); PG8_BAR;
            }
        }
        if constexpr (F8) {
            asm volatile("s_nop 15\n\ts_nop 15" ::: "memory");
            _Pragma("unroll") for (int a = 0; a < 2; ++a) _Pragma("unroll") for (int b = 0; b < 2; ++b) _Pragma("unroll") for (int m = 0; m < 4; ++m) _Pragma("unroll") for (int n = 0; n < 2; ++n) asm volatile("" : "+v"(acc[a][b][m][n]));
        }
        if constexpr (ALIGN_EPI) { if (wr == 0) PG8_BAR; }
        if constexpr (!Epi::AFTER_DRAIN) { E(acc, cur, wr, wc, fr, fq); S.done(cur); }
        if (!has_next) break;
#pragma unroll
        for (int a = 0; a < 2; ++a)
#pragma unroll
            for (int b = 0; b < 2; ++b)
#pragma unroll
                for (int m = 0; m < 4; ++m)
#pragma unroll
                    for (int n = 0; n < 2; ++n) acc[a][b][m][n] = (f32x4){0.f, 0.f, 0.f, 0.f};
        cur = nxt; cA = nA; cB = nB; ++ui;
        if constexpr (ALIGN_EPI) { if (wr == 1) PG8_BAR; }
    }
    PG8_WAIT_V(0);
    if constexpr (!ALIGN_EPI) { if (wr == 0) PG8_BAR; }
    PG8_BAR;
    if constexpr (Epi::AFTER_DRAIN) { E.fused(acc, cur, wr, wc, fr, fq, lds, wid, lane); S.done(cur); }
#undef PG8_SA
#undef PG8_SB
#undef PG8_STAGE
#undef PG8_LDA
#undef PG8_LDB
#undef PG8_MMA
#undef PG8_WAIT_V
#undef PG8_WAIT_L
#undef PG8_BAR
#undef PG8_SCHED
}
template <class Epi, class Sched, bool F8 = false, int SCA = 127, int SCB = 127>
__device__ __forceinline__ void gemm_phase_gather(PG8_LAS unsigned char* lds, const Gemm g, const Sched& S, const Epi& E) {
    const int tid = threadIdx.x, wid = __builtin_amdgcn_readfirstlane(tid >> 6), lane = tid & 63, wr = wid >> 2, wc = wid & 3, fr = lane & 15, fq = lane >> 4;
    constexpr bool ALIGN_EPI = true, SP2 = true;
    const int K = g.K, nt = K / BK;
    unsigned voffA[2], voffB[2]; int rowA[2];
#pragma unroll
    for (int i = 0; i < 2; ++i) { int R, C; stage_rc(tid, i, R, C); const int Rb = Epi::PERM ? ((R & ~31) + perm32(R & 31)) : R;
        voffA[i] = (unsigned)C * 2u; rowA[i] = R; voffB[i] = (unsigned)(Rb * K + C) * 2u; }
    const size_t kstep = (size_t)(BK * 2);
    const size_t hstep = (size_t)HALF * K * 2;
    const size_t tstep = 2 * hstep;
    const unsigned ldsw = (unsigned)wid * (unsigned)KBP;
    const int aoff = lds_byte(wr * 64 + fr, fq * 8), boff = lds_byte(wc * 32 + fr, fq * 8);
#define PG8_SA(b, h) (((b) * 2 + (h)) * HTB)
#define PG8_SB(b, h) ((4 + (b) * 2 + (h)) * HTB)
#define PG8_STAGE(bufoff, gbase, voff) do { _Pragma("unroll") for (int _i = 0; _i < 2; ++_i) \
        __builtin_amdgcn_global_load_lds((const unsigned*)((const char*)(gbase) + (voff)[_i]), (PG8_LAS unsigned*)(lds + (bufoff) + ldsw + _i * (8 * KBP)), 16, 0, 0); } while (0)
#define PG8_STAGE_A(bufoff, gbase, o0, o1) do { \
        __builtin_amdgcn_global_load_lds((const unsigned*)((const char*)(gbase) + (o0)), (PG8_LAS unsigned*)(lds + (bufoff) + ldsw), 16, 0, 0); \
        __builtin_amdgcn_global_load_lds((const unsigned*)((const char*)(gbase) + (o1)), (PG8_LAS unsigned*)(lds + (bufoff) + ldsw + 8 * KBP), 16, 0, 0); } while (0)
#define PG8_GOFF(dst, u) do { _Pragma("unroll") for (int h_ = 0; h_ < 2; ++h_) _Pragma("unroll") for (int i_ = 0; i_ < 2; ++i_) dst[h_][i_] = (unsigned)S.a_row(u, 128 * h_ + rowA[i_]) * (unsigned)(K * 2) + voffA[i_]; } while (0)
#define PG8_LDA(dst, b, h) do { if constexpr (F8) { _Pragma("unroll") for (int m = 0; m < 4; ++m) dst##8[m] = cat8(*(const PG8_LAS i32x4*)(lds + PG8_SA(b, h) + aoff + m * (2 * KBP)), *(const PG8_LAS i32x4*)(lds + PG8_SA(b, h) + aoff + m * (2 * KBP) + 64)); } \
        else { _Pragma("unroll") for (int m = 0; m < 4; ++m) _Pragma("unroll") for (int k = 0; k < 2; ++k) dst[m][k] = *(const PG8_LAS bf16x8*)(lds + PG8_SA(b, h) + aoff + m * (2 * KBP) + k * 64); } } while (0)
#define PG8_LDB(dst, b, h) do { if constexpr (F8) { _Pragma("unroll") for (int n = 0; n < 2; ++n) dst##8[n] = cat8(*(const PG8_LAS i32x4*)(lds + PG8_SB(b, h) + boff + n * (2 * KBP)), *(const PG8_LAS i32x4*)(lds + PG8_SB(b, h) + boff + n * (2 * KBP) + 64)); } \
        else { _Pragma("unroll") for (int n = 0; n < 2; ++n) _Pragma("unroll") for (int k = 0; k < 2; ++k) dst[n][k] = *(const PG8_LAS bf16x8*)(lds + PG8_SB(b, h) + boff + n * (2 * KBP) + k * 64); } } while (0)
#define PG8_MMA(ai, bj, At, Bt) do { __builtin_amdgcn_s_setprio(1); _Pragma("unroll") for (int m = 0; m < 4; ++m) _Pragma("unroll") for (int n = 0; n < 2; ++n) { \
        if constexpr (F8) { mfma_scale_f8(acc[ai][bj][m][n], Bt##8[n], At##8[m], sc1); } \
        else { _Pragma("unroll") for (int k = 0; k < 2; ++k) acc[ai][bj][m][n] = __builtin_amdgcn_mfma_f32_16x16x32_bf16(Bt[n][k], At[m][k], acc[ai][bj][m][n], 0, 0, 0); } } \
        __builtin_amdgcn_s_setprio(0); } while (0)
#define PG8_WAIT_V(n) asm volatile("s_waitcnt vmcnt(" #n ")" ::: "memory")
#define PG8_WAIT_L(n) asm volatile("s_waitcnt lgkmcnt(" #n ")" ::: "memory")
#define PG8_BAR __builtin_amdgcn_s_barrier()
#define PG8_SCHED __builtin_amdgcn_sched_barrier(0)
    Unit cur, nxt; int ui = 0;
    if (!S.next(0, cur)) return;
    f32x4 acc[2][2][4][2];
#pragma unroll
    for (int a = 0; a < 2; ++a)
#pragma unroll
        for (int b = 0; b < 2; ++b)
#pragma unroll
            for (int m = 0; m < 4; ++m)
#pragma unroll
                for (int n = 0; n < 2; ++n) acc[a][b][m][n] = (f32x4){0.f, 0.f, 0.f, 0.f};
    bf16x8 At[4][2], B0[2][2], B1[2][2]; i32x8 At8[4], B08[2], B18[2]; int sc1 = 0x7f7f7f7f; asm volatile("" : "+v"(sc1));
    const char* const cA = (const char*)g.A; const char* cB = (const char*)g.Bt + (size_t)cur.pn * tstep;
    unsigned gc[2][2], gn[2][2];
    S.a_ready(cur); PG8_GOFF(gc, cur);
    if constexpr (SP2) {
        PG8_STAGE(PG8_SB(0, 0), cB, voffB); PG8_STAGE(PG8_SB(0, 1), cB + hstep, voffB); PG8_STAGE_A(PG8_SA(0, 0), cA, gc[0][0], gc[0][1]); PG8_STAGE_A(PG8_SA(0, 1), cA, gc[1][0], gc[1][1]);
        if (wr == 1) PG8_BAR;
        PG8_WAIT_V(2); PG8_BAR;
        PG8_STAGE(PG8_SB(1, 0), cB + kstep, voffB); PG8_STAGE_A(PG8_SA(1, 0), cA + kstep, gc[0][0], gc[0][1]); PG8_STAGE(PG8_SB(1, 1), cB + hstep + kstep, voffB);
        PG8_WAIT_V(6); PG8_BAR;
    }
    for (;;) {
        const bool has_next = S.next(ui + 1, nxt);
        const char* nB = has_next ? (const char*)g.Bt + (size_t)nxt.pn * tstep : cB;
        if (has_next) { PG8_GOFF(gn, nxt); } else { _Pragma("unroll") for (int h_ = 0; h_ < 2; ++h_) _Pragma("unroll") for (int i_ = 0; i_ < 2; ++i_) gn[h_][i_] = gc[h_][i_]; }
#pragma nounroll
        for (int t = 0; t < nt; t += 2) {
            const bool last = (t == nt - 2);
            const char* a1 = cA + (size_t)(t + 1) * kstep;
            const char* a2 = last ? cA : cA + (size_t)(t + 2) * kstep; const char* b2 = last ? nB : cB + (size_t)(t + 2) * kstep;
            const unsigned g200 = last ? gn[0][0] : gc[0][0], g201 = last ? gn[0][1] : gc[0][1], g210 = last ? gn[1][0] : gc[1][0], g211 = last ? gn[1][1] : gc[1][1];
            const char* a3 = a2 + kstep; const char* b3 = b2 + kstep;
            if (last && has_next) S.a_ready(nxt);
            if constexpr (SP2) {
            PG8_LDB(B0, 0, 0); PG8_LDB(B1, 0, 1); PG8_SCHED; PG8_LDA(At, 0, 0); PG8_STAGE_A(PG8_SA(1, 1), a1, gc[1][0], gc[1][1]);
            PG8_WAIT_V(8); PG8_WAIT_L(0); PG8_BAR; PG8_MMA(0, 0, At, B0); PG8_MMA(0, 1, At, B1); PG8_BAR; PG8_SCHED;
            PG8_LDA(At, 0, 1); PG8_STAGE(PG8_SB(0, 0), b2, voffB); PG8_STAGE(PG8_SB(0, 1), b2 + hstep, voffB); PG8_STAGE_A(PG8_SA(0, 0), a2, g200, g201);
            PG8_WAIT_V(8); PG8_WAIT_L(0); PG8_BAR; PG8_MMA(1, 0, At, B0); PG8_MMA(1, 1, At, B1); PG8_BAR; PG8_SCHED;
            PG8_LDB(B0, 1, 0); PG8_LDB(B1, 1, 1); PG8_SCHED; PG8_LDA(At, 1, 0); PG8_STAGE_A(PG8_SA(0, 1), a2, g210, g211);
            PG8_WAIT_V(8); PG8_WAIT_L(0); PG8_BAR; PG8_MMA(0, 0, At, B0); PG8_MMA(0, 1, At, B1); PG8_BAR; PG8_SCHED;
            PG8_LDA(At, 1, 1); PG8_STAGE(PG8_SB(1, 0), b3, voffB); PG8_STAGE(PG8_SB(1, 1), b3 + hstep, voffB); PG8_STAGE_A(PG8_SA(1, 0), a3, g200, g201);
            PG8_WAIT_V(8); PG8_WAIT_L(0); PG8_BAR; PG8_MMA(1, 0, At, B0); PG8_MMA(1, 1, At, B1); PG8_BAR; PG8_SCHED;
            }
        }
        if constexpr (F8) {
            asm volatile("s_nop 15\n\ts_nop 15" ::: "memory");
            _Pragma("unroll") for (int a = 0; a < 2; ++a) _Pragma("unroll") for (int b = 0; b < 2; ++b) _Pragma("unroll") for (int m = 0; m < 4; ++m) _Pragma("unroll") for (int n = 0; n < 2; ++n) asm volatile("" : "+v"(acc[a][b][m][n]));
        }
        if constexpr (ALIGN_EPI) { if (wr == 0) PG8_BAR; }
        if constexpr (!Epi::AFTER_DRAIN) { E(acc, cur, wr, wc, fr, fq); S.done(cur); }
        if (!has_next) break;
#pragma unroll
        for (int a = 0; a < 2; ++a)
#pragma unroll
            for (int b = 0; b < 2; ++b)
#pragma unroll
                for (int m = 0; m < 4; ++m)
#pragma unroll
                    for (int n = 0; n < 2; ++n) acc[a][b][m][n] = (f32x4){0.f, 0.f, 0.f, 0.f};
        cur = nxt; cB = nB; ++ui;
#pragma unroll
        for (int h_ = 0; h_ < 2; ++h_)
#pragma unroll
            for (int i_ = 0; i_ < 2; ++i_) gc[h_][i_] = gn[h_][i_];
        if constexpr (ALIGN_EPI) { if (wr == 1) PG8_BAR; }
    }
    PG8_WAIT_V(0);
    if constexpr (!ALIGN_EPI) { if (wr == 0) PG8_BAR; }
    PG8_BAR;
    if constexpr (Epi::AFTER_DRAIN) { E.fused(acc, cur, wr, wc, fr, fq, lds, wid, lane); S.done(cur); }
#undef PG8_SA
#undef PG8_SB
#undef PG8_STAGE
#undef PG8_STAGE_A
#undef PG8_GOFF
#undef PG8_LDA
#undef PG8_LDB
#undef PG8_MMA
#undef PG8_WAIT_V
#undef PG8_WAIT_L
#undef PG8_BAR
#undef PG8_SCHED
}
}

namespace att {
constexpr int D = 128;
constexpr float THR = 8.f;
constexpr bool WSKIP = false;
constexpr float SCALE = 0.08838834764831845f;
constexpr int NW = 8, QBLK = 32, KVBLK = 64, QB = NW * QBLK;
constexpr int SHM_V = KVBLK * D * 2, SHM_K = KVBLK * D * 2;
constexpr int ATT_LDS_BYTES = 2 * SHM_V + 2 * SHM_K + NW * 64 * 4;
typedef short bf16x8 __attribute__((ext_vector_type(8)));
typedef short s16x4 __attribute__((ext_vector_type(4)));
typedef float f32x16 __attribute__((ext_vector_type(16)));
typedef float f32x4 __attribute__((ext_vector_type(4)));
typedef unsigned u32x4 __attribute__((ext_vector_type(4)));
template <class A, class Bt> struct same_t { static constexpr bool v = false; };
template <class A> struct same_t<A, A> { static constexpr bool v = true; };

#define KSWZ(row, colB) ((row) * 256 + ((colB) ^ (((row) & 7) << 4)))
#define SBAR() __builtin_amdgcn_sched_barrier(0)
__device__ __forceinline__ int v_st(int k, int c) { const int kk = (k & ~0xC) | ((k & 4) << 1) | ((k & 8) >> 1); return ((kk >> 3) * 4 + (c >> 5)) * 512 + ((kk & 7) * 32 + (c & 31)) * 2; }
__device__ __forceinline__ int v_rd_base(int lane) { return ((lane & 3) << 3) | (((lane >> 2) & 3) << 6) | (((lane >> 4) & 1) << 5) | (((lane >> 5) & 1) << 8); }
constexpr int v_rd_off(int d0, int ks, int half) { return d0 * 512 + ks * 4096 + half * 2048; }
__device__ __forceinline__ int crow(int r, int hi) { return (r & 3) + 8 * (r >> 2) + 4 * hi; }
__device__ __forceinline__ unsigned cvtpk(float lo, float hi) {
    unsigned r; asm volatile("v_cvt_pk_bf16_f32 %0, %1, %2" : "=v"(r) : "v"(lo), "v"(hi)); return r;
}
__device__ __forceinline__ bf16x8 pack8(f32x4 a, f32x4 b) {
    u32x4 w = {cvtpk(a[0], a[1]), cvtpk(a[2], a[3]), cvtpk(b[0], b[1]), cvtpk(b[2], b[3])};
    return *reinterpret_cast<bf16x8*>(&w);
}
template <class T> __device__ __forceinline__ bf16x8 load8(const T* p) {
    if constexpr (same_t<T, float>::v) { return pack8(*(const f32x4*)p, *(const f32x4*)(p + 4)); }
    else { return *reinterpret_cast<const bf16x8*>(p); }
}
__device__ __forceinline__ void mask_tile(f32x16& p0, f32x16& p1, int dq, unsigned W) {
    const float NEG = -__builtin_inff();
#pragma unroll
    for (int r = 0; r < 16; ++r) {
        const int c = (r & 3) + 8 * (r >> 2);
        if ((unsigned)(dq - c) >= W) p0[r] = NEG;
        if ((unsigned)(dq - c - 32) >= W) p1[r] = NEG;
    }
}
__device__ __forceinline__ void partialSM(f32x16& p0, f32x16& p1, float& m_reg, float& mn, float& alpha) {
    float pmax = p0[0]; for (int r = 1; r < 16; ++r) pmax = fmaxf(pmax, p0[r]); for (int r = 0; r < 16; ++r) pmax = fmaxf(pmax, p1[r]);
    { auto rr = __builtin_amdgcn_permlane32_swap(__float_as_uint(pmax), __float_as_uint(pmax), false, false);
      pmax = fmaxf(__uint_as_float(rr[0]), __uint_as_float(rr[1])); }
    constexpr float C2 = 1.4426950408889634f * SCALE;
    if (__builtin_expect(__all((pmax - m_reg) * SCALE <= THR), 1)) { mn = m_reg; alpha = 1.f; }
    else { mn = fmaxf(m_reg, pmax); alpha = __builtin_amdgcn_exp2f((m_reg - mn) * C2); m_reg = mn; }
    const float mnL = -mn * C2;
    for (int r = 0; r < 16; ++r) p0[r] = fmaf(p0[r], C2, mnL); for (int r = 0; r < 16; ++r) p1[r] = fmaf(p1[r], C2, mnL);
    for (int r = 0; r < 16; ++r) p0[r] = __builtin_amdgcn_exp2f(p0[r]);
}
__device__ __forceinline__ void finishSM(f32x16& p0, f32x16& p1, float alpha, float& l_reg, bf16x8& pa0, bf16x8& pa1, bf16x8& pa2, bf16x8& pa3) {
    for (int r = 0; r < 16; ++r) p1[r] = __builtin_amdgcn_exp2f(p1[r]);
    float ps = 0; for (int r = 0; r < 16; ++r) ps += p0[r]; for (int r = 0; r < 16; ++r) ps += p1[r];
    { auto rr = __builtin_amdgcn_permlane32_swap(__float_as_uint(ps), __float_as_uint(ps), false, false);
      ps = __uint_as_float(rr[0]) + __uint_as_float(rr[1]); }
    l_reg = l_reg * alpha + ps;
#define PK4(P, B_, OUT) do { unsigned a0 = cvtpk(P[B_+0], P[B_+1]), a1 = cvtpk(P[B_+2], P[B_+3]);                          \
        unsigned b0 = cvtpk(P[B_+4], P[B_+5]), b1 = cvtpk(P[B_+6], P[B_+7]);                                             \
        auto r0 = __builtin_amdgcn_permlane32_swap(a0, b0, false, false); auto r1 = __builtin_amdgcn_permlane32_swap(a1, b1, false, false); \
        u32x4 w = {r0[0], r1[0], r0[1], r1[1]}; OUT = *reinterpret_cast<bf16x8*>(&w); } while (0)
    PK4(p0, 0, pa0); PK4(p0, 8, pa1); PK4(p1, 0, pa2); PK4(p1, 8, pa3);
#undef PK4
}
template <int KB, bool SK>
__device__ __forceinline__ void qkt(f32x16& p0, f32x16& p1, const char* K_lds, int r32, int hi, const bf16x8* qr, bool act) {
    if (SK && !act) { const float NEG = -__builtin_inff();
#pragma unroll
        for (int r = 0; r < 16; ++r) { p0[r] = NEG; p1[r] = NEG; } return; }
    p0 = f32x16{}; p1 = f32x16{};
    const char* kb[4];
#pragma unroll
    for (int dd = 0; dd < 4; ++dd) kb[dd] = K_lds + KB * SHM_K + KSWZ(r32, (dd * 16 + hi * 8) * 2);
#pragma unroll
    for (int d0 = 0; d0 < 8; ++d0) { const char* a = kb[d0 & 3] + (d0 >> 2) * 128;
        bf16x8 b0 = *reinterpret_cast<const bf16x8*>(a);
        bf16x8 b1 = *reinterpret_cast<const bf16x8*>(a + 32 * 256);
        p0 = __builtin_amdgcn_mfma_f32_32x32x16_bf16(b0, qr[d0], p0, 0, 0, 0);
        p1 = __builtin_amdgcn_mfma_f32_32x32x16_bf16(b1, qr[d0], p1, 0, 0, 0); }
}
template <int VB, bool SK>
__device__ __forceinline__ void pv_tile(f32x16* o, int vb0, bf16x8 pa0, bf16x8 pa1, bf16x8 pa2, bf16x8 pa3, bool act) {
    if (SK && !act) return;
#define TRRD(dst, off) asm volatile("ds_read_b64_tr_b16 %0, %1 offset:%2" : "=&v"(dst) : "v"(vb0), "i"(off) : "memory")
#define PV_D0(d0) do { s16x4 l0, l1, l2, l3, h0, h1, h2, h3; constexpr int b_ = VB * SHM_V + v_rd_off(d0, 0, 0);     \
        TRRD(l0, b_); TRRD(h0, b_ + 2048); TRRD(l1, b_ + 4096); TRRD(h1, b_ + 6144); TRRD(l2, b_ + 8192); TRRD(h2, b_ + 10240); TRRD(l3, b_ + 12288); TRRD(h3, b_ + 14336); \
        asm volatile("s_waitcnt lgkmcnt(0)" ::: "memory"); SBAR();                 \
        o[d0] = __builtin_amdgcn_mfma_f32_32x32x16_bf16(pa0, (bf16x8){l0[0], l0[1], l0[2], l0[3], h0[0], h0[1], h0[2], h0[3]}, o[d0], 0, 0, 0);   \
        o[d0] = __builtin_amdgcn_mfma_f32_32x32x16_bf16(pa1, (bf16x8){l1[0], l1[1], l1[2], l1[3], h1[0], h1[1], h1[2], h1[3]}, o[d0], 0, 0, 0);   \
        o[d0] = __builtin_amdgcn_mfma_f32_32x32x16_bf16(pa2, (bf16x8){l2[0], l2[1], l2[2], l2[3], h2[0], h2[1], h2[2], h2[3]}, o[d0], 0, 0, 0);   \
        o[d0] = __builtin_amdgcn_mfma_f32_32x32x16_bf16(pa3, (bf16x8){l3[0], l3[1], l3[2], l3[3], h3[0], h3[1], h3[2], h3[3]}, o[d0], 0, 0, 0); } while (0)
    PV_D0(0); PV_D0(1); PV_D0(2); PV_D0(3);
#undef PV_D0
#undef TRRD
}

template <class TIn, class TOut> struct BlockRef { const TIn* Q; const TIn* K; const TIn* V; TOut* O; int P0; };
template <class TIn> struct Seam {
    bf16x8 qr[8];
    bf16x8 st_v0, st_v1, st_k0, st_k1; f32x4 sf0, sf1, sf2, sf3;
    f32x4 tq[16];
};
__device__ __forceinline__ int swa_jlo(int P0, int W) { const int lowk = P0 - W + 1; return lowk > 0 ? lowk / KVBLK : 0; }
#define ROW(p, k0, rr) ((p) + (size_t)((k0) + (rr)) * D + sc)
#define VMW() asm volatile("s_waitcnt vmcnt(0)" ::: "memory")
#define VMWN(n) asm volatile("s_waitcnt vmcnt(%0)" :: "i"(n) : "memory")
#define SLOAD_H(Kp, Vp, k0) do { S.st_v0 = load8<TIn>(ROW(Vp, k0, sr)); S.st_v1 = load8<TIn>(ROW(Vp, k0, 32 + sr));              \
                         S.st_k0 = load8<TIn>(ROW(Kp, k0, sr)); S.st_k1 = load8<TIn>(ROW(Kp, k0, 32 + sr)); } while (0)
#define SWRITE_HK(bf) do { *(bf16x8*)(K_lds + (bf) * SHM_K + kws) = S.st_k0; *(bf16x8*)(K_lds + (bf) * SHM_K + kws + 32 * 256) = S.st_k1; } while (0)
#define SWRITE_HV(bf) do { *(bf16x8*)(V_lds + (bf) * SHM_V + vst0) = S.st_v0; *(bf16x8*)(V_lds + (bf) * SHM_V + vst1) = S.st_v1; } while (0)
#define SWRITE_H(bf) do { SWRITE_HV(bf); SWRITE_HK(bf); } while (0)
#define SLOAD_F(p, k0) do { S.sf0 = *(const f32x4*)ROW(p, k0, sr); S.sf1 = *(const f32x4*)(ROW(p, k0, sr) + 4);                \
                            S.sf2 = *(const f32x4*)ROW(p, k0, 32 + sr); S.sf3 = *(const f32x4*)(ROW(p, k0, 32 + sr) + 4); } while (0)
#define SWRITE_KF(bf) do { *(bf16x8*)(K_lds + (bf) * SHM_K + kws) = pack8(S.sf0, S.sf1); *(bf16x8*)(K_lds + (bf) * SHM_K + kws + 32 * 256) = pack8(S.sf2, S.sf3); } while (0)
#define SWRITE_VF(bf) do { *(bf16x8*)(V_lds + (bf) * SHM_V + vst0) = pack8(S.sf0, S.sf1); *(bf16x8*)(V_lds + (bf) * SHM_V + vst1) = pack8(S.sf2, S.sf3); } while (0)
template <class TIn, class TOut>
__device__ __forceinline__ void causal_swa_prime(const BlockRef<TIn, TOut>& cur, int W, char* lds, Seam<TIn>& S) {
    constexpr bool F32 = same_t<TIn, float>::v;
    const int tid = threadIdx.x, wid = __builtin_amdgcn_readfirstlane(tid >> 6), lane = tid & 63, r32 = lane & 31, hi = lane >> 5;
    const int sr = tid >> 4, sc = (tid & 15) * 8, kws = KSWZ(sr, sc * 2); char* K_lds = lds + 2 * SHM_V;
    const int kb0 = swa_jlo(cur.P0, W) * KVBLK;
    for (int d0 = 0; d0 < 8; ++d0) S.qr[d0] = load8<TIn>(cur.Q + (size_t)(wid * QBLK + r32) * D + d0 * 16 + hi * 8);
    if constexpr (F32) { SLOAD_F((const float*)cur.K, kb0); VMW(); SWRITE_KF(0); SBAR(); SLOAD_F((const float*)cur.V, kb0); }
    else { SLOAD_H(cur.K, cur.V, kb0); VMW(); SWRITE_HK(0); }
    __syncthreads();
}
template <class TIn, class TOut, class CV>
__device__ __forceinline__ void causal_swa_block(const BlockRef<TIn, TOut>& cur, const BlockRef<TIn, TOut>& nxt, int skv, int W, char* lds, Seam<TIn>& S, CV& cv) {
    constexpr bool F32 = same_t<TIn, float>::v;
    const int tid = threadIdx.x, wid = __builtin_amdgcn_readfirstlane(tid >> 6), lane = tid & 63, r32 = lane & 31, hi = lane >> 5;
    const int j_lo = swa_jlo(cur.P0, W);
    int j_hi = (cur.P0 + QB - 1) / KVBLK + 1; if (j_hi > skv / KVBLK) j_hi = skv / KVBLK;
    const int NT = j_hi - j_lo;
    const int kbn = swa_jlo(nxt.P0, W) * KVBLK;
    const int qlo = cur.P0 + wid * QBLK, qm = ((qlo + r32) | 63) - 4 * hi;
    char* V_lds = lds; char* K_lds = lds + 2 * SHM_V;
    float* ws = (float*)(lds + 2 * SHM_V + 2 * SHM_K) + wid * 64; float* li_l = ws, * al_l = ws + 32;
    float m_reg = -1e30f, l_reg = 0; f32x16 o[4] = {};
    const int sr = tid >> 4, sc = (tid & 15) * 8, vst0 = v_st(sr, sc), vst1 = v_st(32 + sr, sc), kws = KSWZ(sr, sc * 2);
    const int vb0 = (int)(uintptr_t)V_lds + v_rd_base(lane);
    const TIn* Kh = cur.K; const TIn* Vh = cur.V;
#define RESC(a) do { if (__any((a) < 1.f)) { if (hi == 0) al_l[r32] = (a); asm volatile("s_waitcnt lgkmcnt(0)" ::: "memory");              \
                     for (int d_ = 0; d_ < 4; ++d_) for (int r = 0; r < 16; ++r) o[d_][r] *= al_l[crow(r, hi)]; } } while (0)
#define KBASE(t) ((j_lo + (t)) * KVBLK)
#define ACT(t) (KBASE(t) <= qlo + QBLK - 1 && KBASE(t) + KVBLK - 1 >= qlo - W + 1)
#define MASKT(P0_, P1_, t) do { const int kb_ = KBASE(t); if ((!SK || ACT(t)) && (kb_ > qlo)) mask_tile(P0_, P1_, qm - kb_, (unsigned)W); } while (0)
    constexpr int NQL = F32 ? 16 : 8;
    constexpr bool SK = WSKIP && !F32;
#define SEAM_K0() do { VMWN(NQL); if constexpr (F32) { SWRITE_KF(0); SBAR(); SLOAD_F((const float*)nxt.V, kbn); } else { SWRITE_HK(0); } SBAR(); } while (0)
    f32x16 pA0, pA1, pB0, pB1; float mnA, mnB, alA, alB; bf16x8 pa0, pa1, pa2, pa3;
    if constexpr (F32) { VMW(); SWRITE_VF(0); SBAR(); } else { SWRITE_HV(0); SBAR(); }
    if (NT > 1) { if constexpr (F32) SLOAD_F((const float*)Kh, KBASE(1)); else SLOAD_H(Kh, Vh, KBASE(1)); }
    SBAR(); qkt<0, SK>(pA0, pA1, K_lds, r32, hi, S.qr, ACT(0));
    if constexpr (F32) { if (NT > 1) { VMW(); SWRITE_KF(1); SBAR(); SLOAD_F((const float*)Vh, KBASE(1)); } }
    MASKT(pA0, pA1, 0); partialSM(pA0, pA1, m_reg, mnA, alA);
    if (NT > 1) { VMW(); if constexpr (F32) { SWRITE_VF(1); SBAR(); if (NT > 2) SLOAD_F((const float*)Kh, KBASE(2)); } else SWRITE_H(1); }
    __syncthreads();
#define LBAR() do { asm volatile("s_waitcnt lgkmcnt(0)" ::: "memory"); __builtin_amdgcn_s_barrier(); asm volatile("" ::: "memory"); } while (0)
#define HALF_STEP(PX0, PX1, mnX, alX, PY0, PY1, alY, t, KB, VB, SB) do {                                                      \
        SBAR(); cv.issue(); SBAR(); qkt<KB, SK>(PX0, PX1, K_lds, r32, hi, S.qr, ACT(t));                                             \
        finishSM(PY0, PY1, alY, l_reg, pa0, pa1, pa2, pa3); SBAR();                                                           \
        if ((t) + 1 < NT) { if constexpr (F32) { VMW(); SWRITE_KF(SB); SBAR(); SLOAD_F((const float*)Vh, KBASE((t) + 1)); }  \
                            else { SLOAD_H(Kh, Vh, KBASE((t) + 1)); } SBAR(); }                                               \
        pv_tile<VB, SK>(o, vb0, pa0, pa1, pa2, pa3, ACT((t) - 1)); MASKT(PX0, PX1, (t)); partialSM(PX0, PX1, m_reg, mnX, alX);                                        \
        LBAR();                                                                                                               \
        if ((t) + 1 < NT) { VMW(); if constexpr (F32) { SWRITE_VF(SB); SBAR(); if ((t) + 2 < NT) SLOAD_F((const float*)Kh, KBASE((t) + 2)); } \
                            else { SWRITE_H(SB); } }                                                                          \
        RESC(alX); SBAR(); cv.consume(); SBAR(); LBAR(); } while (0)
    __builtin_amdgcn_s_waitcnt(0x0F70);
    for (int t = 1; t + 1 < NT; t += 2) {
        HALF_STEP(pB0, pB1, mnB, alB, pA0, pA1, alA, t, 1, 0, 0);
        HALF_STEP(pA0, pA1, mnA, alA, pB0, pB1, alB, t + 1, 0, 1, 1);
    }
    const bool even = (NT & 1) == 0;
    if (even) { SBAR(); qkt<1, SK>(pB0, pB1, K_lds, r32, hi, S.qr, ACT(NT - 1)); SBAR(); }
#define QROW(e) (nxt.Q + (size_t)(wid * QBLK + r32) * D + ((e) >> 1) * 16 + hi * 8 + ((e) & 1) * 4)
    if constexpr (F32) { SLOAD_F((const float*)nxt.K, kbn); SBAR();
#pragma unroll
        for (int e = 0; e < 8; ++e) S.tq[e] = *(const f32x4*)QROW(e); }
    else { SLOAD_H(nxt.K, nxt.V, kbn); SBAR();
#pragma unroll
        for (int d0 = 0; d0 < 8; ++d0) S.qr[d0] = load8<TIn>(nxt.Q + (size_t)(wid * QBLK + r32) * D + d0 * 16 + hi * 8); }
    SBAR();
    finishSM(pA0, pA1, alA, l_reg, pa0, pa1, pa2, pa3); SBAR();
    if constexpr (F32) {
#pragma unroll
        for (int e = 8; e < 16; ++e) S.tq[e] = *(const f32x4*)QROW(e); SBAR(); }
#undef QROW
    pv_tile<0, SK>(o, vb0, pa0, pa1, pa2, pa3, ACT(even ? NT - 2 : NT - 1));
    if (even) { MASKT(pB0, pB1, NT - 1); partialSM(pB0, pB1, m_reg, mnB, alB); __syncthreads(); RESC(alB);
        finishSM(pB0, pB1, alB, l_reg, pa0, pa1, pa2, pa3); SBAR(); pv_tile<1, SK>(o, vb0, pa0, pa1, pa2, pa3, ACT(NT - 1)); }
    SBAR(); SEAM_K0();
    if (hi == 0) li_l[r32] = l_reg; asm volatile("s_waitcnt lgkmcnt(0)" ::: "memory");
    float rli[16];
#pragma unroll
    for (int r = 0; r < 16; ++r) rli[r] = __builtin_amdgcn_rcpf(li_l[crow(r, hi)]);
    TOut* Ow = cur.O + (size_t)(wid * QBLK) * D;
#pragma unroll
    for (int r = 0; r < 16; ++r) { const int orow = crow(r, hi);
#pragma unroll
        for (int d0 = 0; d0 < 4; ++d0) { const float v = o[d0][r] * rli[r];
            if constexpr (same_t<TOut, float>::v) { Ow[(size_t)orow * D + d0 * 32 + r32] = v; }
            else { const float vn = __shfl_xor(v, 1);
                   if ((r32 & 1) == 0) *(unsigned*)(Ow + (size_t)orow * D + d0 * 32 + r32) = cvtpk(v, vn); } } }
    if constexpr (F32) {
#pragma unroll
        for (int d0 = 0; d0 < 8; ++d0) S.qr[d0] = pack8(S.tq[2 * d0], S.tq[2 * d0 + 1]); }
    __syncthreads();
#undef RESC
#undef KBASE
#undef ACT
#undef MASKT
#undef SEAM_K0
#undef HALF_STEP
#undef LBAR
}
#undef ROW
#undef VMW
#undef VMWN
#undef SLOAD_H
#undef SWRITE_HK
#undef SWRITE_HV
#undef SWRITE_H
#undef SLOAD_F
#undef SWRITE_KF
#undef SWRITE_VF
}


namespace mk {
using pg8::bf16_t; using pg8::f32x4; using pg8::u32x4; using pg8::Unit;
typedef float f32x2v __attribute__((ext_vector_type(2)));
typedef __bf16 bf16x2v __attribute__((ext_vector_type(2)));
__device__ __forceinline__ unsigned cvt_pk_bf16(float lo, float hi) { const f32x2v v = {lo, hi}; return __builtin_bit_cast(unsigned, __builtin_convertvector(v, bf16x2v)); }
#define LAS __attribute__((address_space(3)))
#define LDS_WAIT() asm volatile("s_waitcnt lgkmcnt(0)" ::: "memory")
#define VM_WAIT() asm volatile("s_waitcnt vmcnt(0)" ::: "memory")
constexpr int D = 2048, NB = 4, S = 4096, NT = NB * S, NE = 32, NA = 2 * NT, MH = 1024;
constexpr int NWAVES = 8, NTHR = 512;
constexpr int LDS_MISC = 147456, LDS_BYTES = 163840;
constexpr int MISC_BAR = 0, MISC_PE = 64, MISC_PS = 64 + 1024, MISC_HIST = 64 + 1024 + 256, MISC_BASE = MISC_HIST + 128, MISC_NP = MISC_BASE + 128, MISC_CNT = MISC_NP + 64;
constexpr int PMAX = NA + NE * 256;
constexpr float EPS = 1e-6f;
typedef unsigned u32x2 __attribute__((ext_vector_type(2)));

struct Args {
    const float *x, *c; const int* pos; const float *ada_w, *ada_b, *nmg, *nfg, *fng, *a_win, *a_wout, *lq1, *lk1, *lq2, *lk2, *a_hg,
        *m_win, *m_cw, *m_cb, *m_gb, *m_hg, *m_wout, *wg, *bg, *we, *be, *wgu, *wdn;
    float* out;
    unsigned* ctl; float* mod; float2* cs;
    bf16_t *Bt_qkv, *Bt_ao, *Bt_min, *Bt_mo, *Bt_rt, *Bt_g, *Bt_gu, *Bt_dn;
    bf16_t* xres; bf16_t* hb; bf16_t* ob; float* proj;
    float* logits; int* eid; float* wts; int* pos_in_e; int* slot; int* counts; int* inv;
    bf16_t *XG, *Hm, *Y;
    bf16_t *Qh, *Kh, *Vh, *Oa;
    unsigned char *hb8, *Hm8, *Bt_gu8, *Bt_dn8;
    unsigned char *Bt_min8, *Bt_mo8, *ob8;
    bf16_t *P3, *Qn, *Kn, *KT, *VT, *HS; float *gates, *GA, *GS;
    int ph_lo, ph_hi;
};

__device__ __forceinline__ unsigned pk4_fp8(float x0, float x1, float x2, float x3) { unsigned w = 0u; w = __builtin_amdgcn_cvt_pk_fp8_f32(x0, x1, w, false); w = __builtin_amdgcn_cvt_pk_fp8_f32(x2, x3, w, true); return w; }
__device__ __forceinline__ float wave_sum(float v) {
#pragma unroll
    for (int o = 1; o < 64; o <<= 1) v += __shfl_xor(v, o);
    return v;
}
__device__ __forceinline__ float silu_f(float v) { return v / (1.f + __expf(-v)); }
__device__ __forceinline__ f32x4 bf4_to_f32(const u32x2 p) { f32x4 r; r[0] = __uint_as_float(p.x << 16); r[1] = __uint_as_float(p.x & 0xffff0000u); r[2] = __uint_as_float(p.y << 16); r[3] = __uint_as_float(p.y & 0xffff0000u); return r; }
__device__ __forceinline__ int opq(int v) { asm volatile("" : "+v"(v)); return v; }

template <bool IN_F32>
struct EpiResid {
    static constexpr bool PERM = true, AFTER_DRAIN = false;
    const void* xin; bf16_t* xout; const float* gt; float sc;
    __device__ __forceinline__ void operator()(const f32x4 (&acc)[2][2][4][2], const Unit& u, int wr, int wc, int fr, int fq) const {
        const int row0 = u.pm * 256 + wr * 64 + fr, col0 = u.pn * 256 + wc * 32 + 8 * fq, b = (u.pm * 256) / S;
        f32x4 gv[2][2];
#pragma unroll
        for (int bj = 0; bj < 2; ++bj)
#pragma unroll
            for (int n = 0; n < 2; ++n) gv[bj][n] = *(const f32x4*)(gt + (size_t)b * 6 * D + col0 + bj * 128 + n * 4) * sc;
#pragma unroll
        for (int ai = 0; ai < 2; ++ai)
#pragma unroll
            for (int m = 0; m < 4; ++m) { const size_t off = (size_t)(row0 + ai * 128 + m * 16) * D + col0;
#pragma unroll
                for (int bj = 0; bj < 2; ++bj) { f32x4 x0, x1;
                    if (IN_F32) { x0 = *(const f32x4*)((const float*)xin + off + bj * 128); x1 = *(const f32x4*)((const float*)xin + off + bj * 128 + 4); }
                    else { const u32x4 p = *(const u32x4*)((const bf16_t*)xin + off + bj * 128); x0 = bf4_to_f32((u32x2){p.x, p.y}); x1 = bf4_to_f32((u32x2){p.z, p.w}); }
                    const f32x4 y0 = x0 + gv[bj][0] * acc[ai][bj][m][0], y1 = x1 + gv[bj][1] * acc[ai][bj][m][1];
                    u32x4 w; w.x = cvt_pk_bf16(y0[0], y0[1]); w.y = cvt_pk_bf16(y0[2], y0[3]); w.z = cvt_pk_bf16(y1[0], y1[1]); w.w = cvt_pk_bf16(y1[2], y1[3]);
                    *(u32x4*)(xout + off + bj * 128) = w; } }
    }
};
struct EpiGU {
    static constexpr bool PERM = true, AFTER_DRAIN = false;
    unsigned char* Hm8;
    __device__ __forceinline__ void operator()(const f32x4 (&acc)[2][2][4][2], const Unit& u, int wr, int wc, int fr, int fq) const {
        const int row0 = u.pm * 256 + wr * 64 + fr, col0 = (u.pn & 7) * 128 + wc * 32 + 8 * fq;
#pragma unroll
        for (int ai = 0; ai < 2; ++ai)
#pragma unroll
            for (int m = 0; m < 4; ++m) { unsigned char* rowp = Hm8 + (size_t)(row0 + ai * 128 + m * 16) * MH + col0;
                float h[8];
#pragma unroll
                for (int n = 0; n < 2; ++n)
#pragma unroll
                    for (int j = 0; j < 4; ++j) { const float g = acc[ai][0][m][n][j] * (1.f / 256.f), up = acc[ai][1][m][n][j] * (1.f / 256.f); h[n * 4 + j] = silu_f(g) * up * 4.f; }
                u32x2 w; w.x = pk4_fp8(h[0], h[1], h[2], h[3]); w.y = pk4_fp8(h[4], h[5], h[6], h[7]);
                *(u32x2*)rowp = w; }
    }
};
struct EpiBf16G {
    static constexpr bool PERM = true, AFTER_DRAIN = false;
    bf16_t* O; int ldc; float sc;
    __device__ __forceinline__ void operator()(const f32x4 (&acc)[2][2][4][2], const Unit& u, int wr, int wc, int fr, int fq) const {
        const int row0 = u.pm * 256 + wr * 64 + fr, col0 = (u.pn & 7) * 256 + wc * 32 + 8 * fq;
#pragma unroll
        for (int ai = 0; ai < 2; ++ai)
#pragma unroll
            for (int m = 0; m < 4; ++m) { bf16_t* rowp = O + (size_t)(row0 + ai * 128 + m * 16) * ldc + col0;
#pragma unroll
                for (int bj = 0; bj < 2; ++bj) { const f32x4 v0 = acc[ai][bj][m][0] * sc, v1 = acc[ai][bj][m][1] * sc;
                    u32x4 w; w.x = cvt_pk_bf16(v0[0], v0[1]); w.y = cvt_pk_bf16(v0[2], v0[3]); w.z = cvt_pk_bf16(v1[0], v1[1]); w.w = cvt_pk_bf16(v1[2], v1[3]);
                    *(u32x4*)(rowp + bj * 128) = w; } }
    }
};
struct GroupedOrder {
    int NP, total, G, c; const LAS int* pe;
    __device__ __forceinline__ bool next(int i, Unit& u) const {
        int p, j;
        if (G == 256) { const int x = c >> 5, l = c & 31, gidx = i * 8 + x; p = gidx * 4 + (l >> 3); j = l & 7; if (p >= NP) return false; }
        else { const long L = (long)i * G + c; if (L >= total) return false; p = (int)(L % NP); j = (int)(L / NP); }
        u.pm = p; u.pn = __builtin_amdgcn_readfirstlane(pe[p]) * 8 + j; return true; }
    __device__ __forceinline__ void a_ready(const Unit&) const {}
    __device__ __forceinline__ void done(const Unit&) const {}
};
struct GroupedOrderG : GroupedOrder {
    const LAS int* ps; const LAS int* cn; const int* inv;
    __device__ __forceinline__ int a_row(const Unit& u, int r) const {
        const int e = u.pn >> 3, local = u.pm * 256 + r - ps[e];
        return local < cn[e] ? inv[e * 32768 + local] : NT; }
};
struct CvItem { const float* W; bf16_t* WT; int ldw, K, n0, s0, k0; };
__device__ __forceinline__ void tr_load(const CvItem& d, int lane, f32x4 (&v)[8]) {
    const int kp = lane >> 3, c4 = lane & 7;
#pragma unroll
    for (int i = 0; i < 8; ++i) v[i] = *(const f32x4*)(d.W + (size_t)(d.k0 + 2 * kp + 16 * (i >> 1) + (i & 1)) * d.ldw + d.s0 + 4 * c4);
}
__device__ __forceinline__ void tr_finish(const CvItem& d, const f32x4 (&v)[8], LAS float* scr, int lane) {
    const int kp = lane >> 3, c4 = lane & 7; LAS unsigned* sp = (LAS unsigned*)scr;
#pragma unroll
    for (int i = 0; i < 4; ++i) { u32x4 o; o.x = cvt_pk_bf16(v[2 * i][0], v[2 * i + 1][0]); o.y = cvt_pk_bf16(v[2 * i][1], v[2 * i + 1][1]); o.z = cvt_pk_bf16(v[2 * i][2], v[2 * i + 1][2]); o.w = cvt_pk_bf16(v[2 * i][3], v[2 * i + 1][3]);
        *(LAS u32x4*)(sp + (kp + 8 * i) * 36 + 4 * c4) = o; }
    LDS_WAIT(); asm volatile("" ::: "memory");
    const int c = lane & 7;
#pragma unroll
    for (int j = 0; j < 4; ++j) { const int n = (lane >> 3) + 8 * j; const LAS unsigned* q = sp + (4 * c) * 36 + n;
        u32x4 o; o.x = q[0]; o.y = q[36]; o.z = q[72]; o.w = q[108];
        *(u32x4*)(d.WT + (size_t)(d.n0 + n) * d.K + d.k0 + 8 * c) = o; }
    LDS_WAIT(); asm volatile("" ::: "memory");
}
__device__ __forceinline__ int gu_src(int n) { const int t = n >> 8, r = n & 255; return r < 128 ? t * 128 + r : 1024 + t * 128 + (r - 128); }

constexpr int CV_I1 = 32 * 192, CV_I2 = 32 * 64, CV_ALL = CV_I1 + CV_I2;
__device__ __forceinline__ CvItem cv_decode(const Args& a, int r) {
    CvItem d;
    if (r < CV_I1) { const int kb = r / 192, nb = r % 192; d.W = a.a_win; d.ldw = 6144; d.WT = a.Bt_qkv; d.K = D; d.n0 = nb * 32; d.s0 = nb * 32; d.k0 = kb * 64; return d; } r -= CV_I1;
    { const int kb = r / 64, nb = r % 64; d.W = a.a_wout; d.ldw = D; d.WT = a.Bt_ao; d.K = D; d.n0 = nb * 32; d.s0 = nb * 32; d.k0 = kb * 64; return d; }
}
__device__ __forceinline__ void conv_items(const Args& a, LAS unsigned char* lds, int w, int nw, int lo, int hi, int wave, int lane) {
    LAS float* scr = (LAS float*)(lds + wave * 16384);
    const int it = lo + w; if (it >= hi) return;
    CvItem d0 = cv_decode(a, it), d1 = d0, d2 = d0; f32x4 v0[8], v1[8], v2[8];
    bool h1 = it + nw < hi, h2 = it + 2 * nw < hi, h0;
    tr_load(d0, lane, v0);
    if (h1) { d1 = cv_decode(a, it + nw); tr_load(d1, lane, v1); }
    if (h2) { d2 = cv_decode(a, it + 2 * nw); tr_load(d2, lane, v2); }
    int nx = it + 3 * nw;
    for (;;) {
        tr_finish(d0, v0, scr, lane); h0 = nx < hi; if (h0) { d0 = cv_decode(a, nx); tr_load(d0, lane, v0); nx += nw; }
        if (!h1) break;
        tr_finish(d1, v1, scr, lane); h1 = nx < hi; if (h1) { d1 = cv_decode(a, nx); tr_load(d1, lane, v1); nx += nw; }
        if (!h2) break;
        tr_finish(d2, v2, scr, lane); h2 = nx < hi; if (h2) { d2 = cv_decode(a, nx); tr_load(d2, lane, v2); nx += nw; }
        if (!h0) break;
    }
}
__device__ __forceinline__ void p0_prologue(const Args& a, LAS unsigned char* lds, int vcu, int G, int tid, int wave, int lane) {
    {
        LAS float* sc = (LAS float*)lds;
        LAS float* red = (LAS float*)(lds + 32768);
        for (int i = tid; i < NB * D; i += NTHR) sc[i] = silu_f(a.c[i]);
        __syncthreads();
        for (int it = vcu; it < 2 * 384; it += G) {
            const int l = it / 384, col = (it % 384) * 32 + (lane & 31), kh = lane >> 5;
            const float* w = a.ada_w + (size_t)l * D * 6 * D + (size_t)(wave * 256 + kh * 128) * 6 * D + col;
            float a0 = 0.f, a1 = 0.f, a2 = 0.f, a3 = 0.f;
#pragma unroll 8
            for (int k = 0; k < 128; ++k) { const float wv = w[(size_t)k * 6 * D]; const int kk = wave * 256 + kh * 128 + k;
                a0 += sc[kk] * wv; a1 += sc[D + kk] * wv; a2 += sc[2 * D + kk] * wv; a3 += sc[3 * D + kk] * wv; }
            a0 += __shfl_xor(a0, 32); a1 += __shfl_xor(a1, 32); a2 += __shfl_xor(a2, 32); a3 += __shfl_xor(a3, 32);
            if (lane < 32) { red[(wave * 4 + 0) * 32 + lane] = a0; red[(wave * 4 + 1) * 32 + lane] = a1; red[(wave * 4 + 2) * 32 + lane] = a2; red[(wave * 4 + 3) * 32 + lane] = a3; }
            __syncthreads();
            if (tid < 128) { const int bb = tid >> 5, cl = tid & 31; float sacc = 0.f;
#pragma unroll
                for (int w8 = 0; w8 < 8; ++w8) sacc += red[(w8 * 4 + bb) * 32 + cl];
                const int cg = (it % 384) * 32 + cl;
                a.mod[((size_t)l * NB + bb) * 6 * D + cg] = sacc + a.ada_b[l * 6 * D + cg]; }
            __syncthreads();
        }
    }
    for (int i = vcu * NTHR + tid; i < NT * 16; i += G * NTHR) {
        const int row = i >> 4, j = i & 15;
        const double ang = (double)a.pos[row] * pow(500000.0, -(double)j / 16.0);
        a.cs[i] = make_float2((float)cos(ang), (float)sin(ang));
    }
    for (int i = vcu * NTHR + tid; i < 2 * 256 * D; i += G * NTHR) {
        const int k = i % D, n = (i / D) % 256, l = i / (256 * D);
        float v = 0.f; if (n < 4) v = a.wg[((size_t)l * D + k) * 4 + n]; else if (n < 36) v = a.we[((size_t)l * D + k) * 32 + (n - 4)];
        a.Bt_rt[i] = (bf16_t)(cvt_pk_bf16(v, 0.f) & 0xffffu);
    }
    if (vcu == 0) for (int i = tid; i < D / 4; i += NTHR) ((unsigned*)(a.hb8 + (size_t)NT * D))[i] = 0u;
    for (int i = vcu * NTHR + tid; i < 16 * D; i += G * NTHR) { const int k = i % D, n = i / D; a.Bt_g[i] = (bf16_t)(cvt_pk_bf16(a.m_win[(size_t)k * 6160 + 6144 + n], 0.f) & 0xffffu); }
    __syncthreads();
    conv_items(a, lds, vcu * NWAVES + wave, G * NWAVES, 0, CV_I1 + CV_I2, wave, lane);
}
template <bool TOLDS>
__device__ __forceinline__ void norm_store(const f32x4 (&v)[8], float ss, const float* g, const float* scv, const float* shv, bf16_t* orow, int lane, LAS unsigned char* yrow) {
    const float rstd = rsqrtf(wave_sum(ss) * (1.f / D) + EPS);
#pragma unroll
    for (int j = 0; j < 8; ++j) { const int c = 4 * lane + 256 * j;
        const f32x4 gg = *(const f32x4*)(g + c), sc = *(const f32x4*)(scv + c), sh = *(const f32x4*)(shv + c);
        const f32x4 y = v[j] * rstd * gg * (sc + 1.f) + sh;
        u32x2 w; w.x = cvt_pk_bf16(y[0], y[1]); w.y = cvt_pk_bf16(y[2], y[3]);
        *(u32x2*)(orow + c) = w;
        if (TOLDS) *(LAS u32x2*)(yrow + c * 2) = w; }
}
constexpr int YT_PITCH = 4112, NR_YT = 0, NR_RED = 16 * YT_PITCH, NR_LG = NR_RED + 24576, NR_TOK = NR_LG + 3072;
typedef short bf16x8r __attribute__((ext_vector_type(8)));
template <int NTL>
__device__ __forceinline__ void rows16_logits(const bf16_t* Bt, LAS unsigned char* lds, int wave, int lane, int tid) {
    const int r16 = lane & 15, q4 = lane >> 4;
    f32x4 acc[NTL];
#pragma unroll
    for (int nt = 0; nt < NTL; ++nt) acc[nt] = (f32x4){0.f, 0.f, 0.f, 0.f};
#pragma unroll
    for (int kk = 0; kk < 8; ++kk) { const int k0 = 256 * wave + 32 * kk + 8 * q4;
        const bf16x8r yf = *(const LAS bf16x8r*)(lds + NR_YT + r16 * YT_PITCH + k0 * 2);
#pragma unroll
        for (int nt = 0; nt < NTL; ++nt) { const bf16x8r wf = *(const bf16x8r*)(Bt + (size_t)(16 * nt + r16) * D + k0);
            acc[nt] = __builtin_amdgcn_mfma_f32_16x16x32_bf16(wf, yf, acc[nt], 0, 0, 0); } }
#pragma unroll
    for (int nt = 0; nt < NTL; ++nt) *(LAS f32x4*)(lds + NR_RED + ((wave * NTL + nt) * 64 + lane) * 16) = acc[nt];
    __syncthreads();
    if (tid < NTL * 64) { const int nt = tid >> 6, ln = tid & 63; f32x4 sum = {0.f, 0.f, 0.f, 0.f};
#pragma unroll
        for (int w = 0; w < 8; ++w) sum += *(const LAS f32x4*)(lds + NR_RED + ((w * NTL + nt) * 64 + ln) * 16);
        LAS float* lg = (LAS float*)(lds + NR_LG) + (ln & 15) * 48 + 16 * nt + 4 * (ln >> 4);
        lg[0] = sum[0]; lg[1] = sum[1]; lg[2] = sum[2]; lg[3] = sum[3]; }
    __syncthreads();
}
__device__ __forceinline__ void phase_norm(const float* xin, const float* g, const float* modl, int sh_idx, int sc_idx, bf16_t* hb, int gw, int NGW, int lane) {
    const int RPW = (NT + NGW - 1) / NGW; int m = gw * RPW; const int mend = (m + RPW < NT) ? m + RPW : NT;
    if (m >= mend) return;
    f32x4 A[8], Bv[8], v[8], vn[8]; int bcur = -1;
#pragma unroll
    for (int j = 0; j < 8; ++j) v[j] = *(const f32x4*)(xin + (size_t)m * D + 4 * lane + 256 * j);
    for (;;) {
        const bool more = m + 1 < mend;
        if (more) {
#pragma unroll
            for (int j = 0; j < 8; ++j) vn[j] = *(const f32x4*)(xin + (size_t)(m + 1) * D + 4 * lane + 256 * j); }
        const int b = m / S;
        if (b != bcur) { bcur = b; const float* scv = modl + (size_t)b * 6 * D + sc_idx * D; const float* shv = modl + (size_t)b * 6 * D + sh_idx * D;
#pragma unroll
            for (int j = 0; j < 8; ++j) { const int c = 4 * lane + 256 * j; A[j] = *(const f32x4*)(g + c) * (*(const f32x4*)(scv + c) + 1.f); Bv[j] = *(const f32x4*)(shv + c); } }
        float ss = 0.f;
#pragma unroll
        for (int j = 0; j < 8; ++j) ss += (v[j][0] * v[j][0] + v[j][1] * v[j][1]) + (v[j][2] * v[j][2] + v[j][3] * v[j][3]);
        const float rstd = rsqrtf(wave_sum(ss) * (1.f / D) + EPS);
        bf16_t* orow = hb + (size_t)m * D;
#pragma unroll
        for (int j = 0; j < 8; ++j) { const f32x4 y = v[j] * rstd * A[j] + Bv[j]; u32x2 w; w.x = cvt_pk_bf16(y[0], y[1]); w.y = cvt_pk_bf16(y[2], y[3]); *(u32x2*)(orow + 4 * lane + 256 * j) = w; }
        if (!more) break;
        ++m;
#pragma unroll
        for (int j = 0; j < 8; ++j) v[j] = vn[j];
    }
}
__device__ __forceinline__ void phase_combine_final(const Args& a, const float* modl, const LAS int* ps, int gw, int NGW, int lane) {
    const int RPW = (NT + NGW - 1) / NGW; const int m0 = gw * RPW; const int mend = (m0 + RPW < NT) ? m0 + RPW : NT;
    if (m0 >= mend) return;
    int slot_l = 0; float w_l = 0.f;
    if (lane < 2 * (mend - m0) && lane < 64) { const int as = 2 * m0 + lane; slot_l = ps[a.eid[as]] + a.pos_in_e[as]; w_l = a.wts[as]; }
    f32x4 G4[8], F4[8];
    { const float* gt = modl + (size_t)(m0 / S) * 6 * D + 5 * D;
#pragma unroll
      for (int j = 0; j < 8; ++j) { G4[j] = *(const f32x4*)(gt + 4 * lane + 256 * j); F4[j] = *(const f32x4*)(a.fng + 4 * lane + 256 * j); } }
    for (int m = m0; m < mend; ++m) {
        const int r = m - m0; const int s0 = __shfl(slot_l, 2 * r), s1 = __shfl(slot_l, 2 * r + 1); const float w0 = __shfl(w_l, 2 * r), w1 = __shfl(w_l, 2 * r + 1);
        const bf16_t* xr = a.xres + (size_t)m * D; const bf16_t* y0 = a.Y + (size_t)s0 * D; const bf16_t* y1 = a.Y + (size_t)s1 * D;
        f32x4 v[8]; float ss = 0.f;
#pragma unroll
        for (int j = 0; j < 8; ++j) { const int c = 4 * lane + 256 * j;
            const f32x4 x1 = bf4_to_f32(*(const u32x2*)(xr + c)); const u32x2 p0 = *(const u32x2*)(y0 + c), p1 = *(const u32x2*)(y1 + c);
            f32x4 ya, yb;
            ya[0] = __uint_as_float(p0.x << 16); ya[1] = __uint_as_float(p0.x & 0xffff0000u); ya[2] = __uint_as_float(p0.y << 16); ya[3] = __uint_as_float(p0.y & 0xffff0000u);
            yb[0] = __uint_as_float(p1.x << 16); yb[1] = __uint_as_float(p1.x & 0xffff0000u); yb[2] = __uint_as_float(p1.y << 16); yb[3] = __uint_as_float(p1.y & 0xffff0000u);
            v[j] = x1 + G4[j] * (ya * w0 + yb * w1);
            ss += (v[j][0] * v[j][0] + v[j][1] * v[j][1]) + (v[j][2] * v[j][2] + v[j][3] * v[j][3]); }
        const float rstd = rsqrtf(wave_sum(ss) * (1.f / D) + EPS);
#pragma unroll
        for (int j = 0; j < 8; ++j) *(f32x4*)(a.out + (size_t)m * D + 4 * lane + 256 * j) = v[j] * rstd * F4[j];
    }
}
__device__ __forceinline__ void phase_combine_gates(const Args& a, const float* modl, const float* modn, const float* gnext, const LAS int* ps, LAS unsigned char* lds, int vcu, int G, int tid, int wave, int lane) {
    const int NGRP = NT / 16, GPW = (NGRP + G - 1) / G, g0 = vcu * GPW, gend = (g0 + GPW < NGRP) ? g0 + GPW : NGRP;
    if (g0 >= gend) return;
    int slot_l = 0; float w_l = 0.f;
    if (lane < 4 * (gend - g0)) { const int m = (g0 + (lane >> 2)) * 16 + 2 * wave + ((lane >> 1) & 1), as = 2 * m + (lane & 1); slot_l = ps[a.eid[as]] + a.pos_in_e[as]; w_l = a.wts[as]; }
    const int b = (g0 * 16) / S;
    const float* gt = modl + (size_t)b * 6 * D + 5 * D; const float* scv = modn + (size_t)b * 6 * D + 1 * D; const float* shv = modn + (size_t)b * 6 * D;
    u32x2 xc[8], xn[8]; u32x2 pc0[8], pc1[8], pn0[8], pn1[8];
#define CG_LOAD(s_, X, P0, P1) do { const int m_ = (g0 + ((s_) >> 1)) * 16 + 2 * wave + ((s_) & 1), li_ = 2 * (s_); \
        const bf16_t* y0_ = a.Y + (size_t)__shfl(slot_l, li_) * D; const bf16_t* y1_ = a.Y + (size_t)__shfl(slot_l, li_ + 1) * D; \
        _Pragma("unroll") for (int j_ = 0; j_ < 8; ++j_) { const int c_ = 4 * lane + 256 * j_; X[j_] = *(const u32x2*)(a.xres + (size_t)m_ * D + c_); P0[j_] = *(const u32x2*)(y0_ + c_); P1[j_] = *(const u32x2*)(y1_ + c_); } } while (0)
    const int nrow = 2 * (gend - g0);
    CG_LOAD(0, xc, pc0, pc1);
    for (int sq = 0; sq < nrow; ++sq) {
        const int grp = g0 + (sq >> 1), rr = sq & 1, m = grp * 16 + 2 * wave + rr;
        if (sq + 1 < nrow) CG_LOAD(sq + 1, xn, pn0, pn1);
        const float w0 = __shfl(w_l, 2 * sq), w1 = __shfl(w_l, 2 * sq + 1);
        f32x4 v[8]; float ss = 0.f;
#pragma unroll
        for (int j = 0; j < 8; ++j) { const u32x2 p0 = pc0[j], p1 = pc1[j]; f32x4 ya, yb;
            ya[0] = __uint_as_float(p0.x << 16); ya[1] = __uint_as_float(p0.x & 0xffff0000u); ya[2] = __uint_as_float(p0.y << 16); ya[3] = __uint_as_float(p0.y & 0xffff0000u);
            yb[0] = __uint_as_float(p1.x << 16); yb[1] = __uint_as_float(p1.x & 0xffff0000u); yb[2] = __uint_as_float(p1.y << 16); yb[3] = __uint_as_float(p1.y & 0xffff0000u);
            v[j] = bf4_to_f32(xc[j]) + *(const f32x4*)(gt + 4 * lane + 256 * j) * (ya * w0 + yb * w1);
            ss += (v[j][0] * v[j][0] + v[j][1] * v[j][1]) + (v[j][2] * v[j][2] + v[j][3] * v[j][3]); }
        const float rstd = rsqrtf(wave_sum(ss) * (1.f / D) + EPS);
        LAS unsigned char* yrow = lds + NR_YT + (2 * wave + rr) * YT_PITCH;
#pragma unroll
        for (int j = 0; j < 8; ++j) { const int c = 4 * lane + 256 * j; { u32x2 xw; xw.x = cvt_pk_bf16(v[j][0], v[j][1]); xw.y = cvt_pk_bf16(v[j][2], v[j][3]); *(u32x2*)(a.xres + (size_t)m * D + c) = xw; }
            const f32x4 y = v[j] * rstd * (*(const f32x4*)(gnext + c) * (*(const f32x4*)(scv + c) + 1.f)) + *(const f32x4*)(shv + c); u32x2 w; w.x = cvt_pk_bf16(y[0], y[1]); w.y = cvt_pk_bf16(y[2], y[3]);
            *(unsigned*)(a.hb8 + (size_t)m * D + c) = pk4_fp8(y[0] * 4.f, y[1] * 4.f, y[2] * 4.f, y[3] * 4.f); *(LAS u32x2*)(yrow + c * 2) = w; }
#pragma unroll
        for (int j = 0; j < 8; ++j) { xc[j] = xn[j]; pc0[j] = pn0[j]; pc1[j] = pn1[j]; }
        if (rr == 1) {
            __syncthreads();
            rows16_logits<1>(a.Bt_g, lds, wave, lane, tid);
            if (tid < 256) a.gates[(size_t)(grp * 16 + (tid >> 4)) * 16 + (tid & 15)] = ((const LAS float*)(lds + NR_LG))[(tid >> 4) * 48 + (tid & 15)];
        }
    }
#undef CG_LOAD
}
__device__ __forceinline__ void phase_norm_route(const Args& a, int layer, const float* modl, LAS unsigned char* lds, LAS unsigned char* misc, int vcu, int G, int tid, int wave, int lane) {
    LAS int* hist = (LAS int*)(misc + MISC_HIST); LAS int* base = (LAS int*)(misc + MISC_BASE);
    LAS int* tk = (LAS int*)(lds + NR_TOK);
    LAS float* tw = (LAS float*)(lds + NR_TOK + 2048);
    int* counts = a.counts + layer * 64;
    const float* bg = a.bg + layer * 4; const float* be = a.be + layer * 32; const float* g = a.nfg + layer * D;
    if (tid < 32) hist[tid] = 0;
    __syncthreads();
    const int NGRP = NT / 16, GPW = (NGRP + G - 1) / G, g0 = vcu * GPW, gend = (g0 + GPW < NGRP) ? g0 + GPW : NGRP;
    const int ng = gend > g0 ? gend - g0 : 0;
    if (ng > 0) {
        const int b = (g0 * 16) / S;
        f32x4 A[8]; const float* shv = modl + (size_t)b * 6 * D + 3 * D;
        { const float* scv = modl + (size_t)b * 6 * D + 4 * D;
#pragma unroll
          for (int j = 0; j < 8; ++j) { const int c = 4 * lane + 256 * j; A[j] = *(const f32x4*)(g + c) * (*(const f32x4*)(scv + c) + 1.f); } }
        u32x2 x1[2][8];
#define NR_LOAD(grp_) do { _Pragma("unroll") for (int rr_ = 0; rr_ < 2; ++rr_) { const bf16_t* xr_ = a.xres + (size_t)((grp_) * 16 + 2 * wave + rr_) * D; \
        _Pragma("unroll") for (int j_ = 0; j_ < 8; ++j_) x1[rr_][j_] = *(const u32x2*)(xr_ + 4 * lane + 256 * j_); } } while (0)
        NR_LOAD(g0);
        for (int grp = g0; grp < gend; ++grp) {
            const int gi = grp - g0;
#pragma unroll
            for (int rr = 0; rr < 2; ++rr) { const int m = grp * 16 + 2 * wave + rr; float ss = 0.f;
#pragma unroll
                for (int j = 0; j < 8; ++j) { const f32x4 v = bf4_to_f32(x1[rr][j]); ss += (v[0] * v[0] + v[1] * v[1]) + (v[2] * v[2] + v[3] * v[3]); }
                const float rstd = rsqrtf(wave_sum(ss) * (1.f / D) + EPS);
                LAS unsigned char* yrow = lds + NR_YT + (2 * wave + rr) * YT_PITCH;
#pragma unroll
                for (int j = 0; j < 8; ++j) { const int c = 4 * lane + 256 * j; const f32x4 y = bf4_to_f32(x1[rr][j]) * rstd * A[j] + *(const f32x4*)(shv + c);
                    u32x2 w; w.x = cvt_pk_bf16(y[0], y[1]); w.y = cvt_pk_bf16(y[2], y[3]); *(LAS u32x2*)(yrow + c * 2) = w;
                    *(unsigned*)(a.hb8 + (size_t)m * D + c) = pk4_fp8(y[0] * 4.f, y[1] * 4.f, y[2] * 4.f, y[3] * 4.f); } }
            if (grp + 1 < gend) NR_LOAD(grp + 1);
            __syncthreads();
            rows16_logits<3>(a.Bt_rt + (size_t)layer * 256 * D, lds, wave, lane, tid);
            if (tid < 16 && gi < 8) {
                const LAS float* lg = (const LAS float*)(lds + NR_LG) + tid * 48;
                float gmax = -INFINITY; int grpi = 0;
#pragma unroll
                for (int i = 0; i < 4; ++i) { const float v = lg[i] + bg[i]; if (v > gmax) { gmax = v; grpi = i; } }
                float gs = 0.f;
#pragma unroll
                for (int i = 0; i < 4; ++i) gs += expf(lg[i] + bg[i] - gmax);
                const float pg = 1.f / gs;
                float v1 = -INFINITY, v2 = -INFINITY; int i1 = 0, i2 = 0;
                for (int i = 0; i < 8; ++i) { const float v = lg[4 + grpi * 8 + i] + be[grpi * 8 + i];
                    if (v > v1) { v2 = v1; i2 = i1; v1 = v; i1 = i; } else if (v > v2) { v2 = v; i2 = i; } }
                const float ex = expf(v2 - v1); const int e1 = grpi * 8 + i1, e2 = grpi * 8 + i2, sl = gi * 16 + tid;
                tk[sl] = e1; tk[128 + sl] = e2; tk[256 + sl] = atomicAdd((int*)&hist[e1], 1); tk[384 + sl] = atomicAdd((int*)&hist[e2], 1);
                tw[sl] = pg / (1.f + ex); tw[128 + sl] = pg * ex / (1.f + ex);
            }
        }
#undef NR_LOAD
    }
    __syncthreads();
    if (tid < 32) { const int h = hist[tid]; base[tid] = h ? atomicAdd(&counts[tid], h) : 0; }
    __syncthreads();
    if (tid < ng * 16 && tid < 128) { const int t = (g0 + (tid >> 4)) * 16 + (tid & 15), e1 = tk[tid], e2 = tk[128 + tid];
        a.eid[2 * t] = e1; a.eid[2 * t + 1] = e2; a.wts[2 * t] = tw[tid]; a.wts[2 * t + 1] = tw[128 + tid];
        const int p1 = base[e1] + tk[256 + tid], p2 = base[e2] + tk[384 + tid];
        a.pos_in_e[2 * t] = p1; a.pos_in_e[2 * t + 1] = p2; a.inv[e1 * 32768 + p1] = t; a.inv[e2 * 32768 + p2] = t; }
    __syncthreads();
}
__device__ __forceinline__ int moe_tables(const int* counts, LAS unsigned char* misc, int tid) {
    LAS int* ps = (LAS int*)(misc + MISC_PS); LAS int* pe = (LAS int*)(misc + MISC_PE); LAS int* npw = (LAS int*)(misc + MISC_NP);
    __syncthreads();
    if (tid < 64) {
        LAS int* cn = (LAS int*)(misc + MISC_CNT); const int e = tid & 31;
        const int c = __hip_atomic_load(&counts[e], __ATOMIC_RELAXED, __HIP_MEMORY_SCOPE_AGENT), np = (c + 255) >> 8;
        int incl = np;
#pragma unroll
        for (int d = 1; d < 32; d <<= 1) { const int t = __shfl_up(incl, d); if (tid >= d) incl += t; }
        if (tid < 32) { const int start = incl - np; ps[e] = start << 8; cn[e] = c;
            for (int p = 0; p < np; ++p) pe[start + p] = e;
            if (e == NE - 1) { ps[NE] = incl << 8; npw[0] = incl; } }
    }
    __syncthreads();
    return npw[0];
}
struct EpiQKV {
    static constexpr bool PERM = true, AFTER_DRAIN = false;
    bf16_t *Qh, *Kh, *Vh; const float2* cs;
    __device__ __forceinline__ void operator()(const f32x4 (&acc)[2][2][4][2], const Unit& u, int wr, int wc, int fr, int fq) const {
        const int t = u.pn >> 3, hh = u.pn & 7;
        bf16_t* base = Qh + (size_t)t * ((size_t)NT * 2048);
        const int row0 = u.pm * 256 + wr * 64 + fr;
        const bool rope = (t < 2) && (wc == 0);
#pragma unroll
        for (int ai = 0; ai < 2; ++ai)
#pragma unroll
            for (int m = 0; m < 4; ++m) { const int row = row0 + ai * 128 + m * 16;
                f32x4 c0 = {0.f, 0.f, 0.f, 0.f}, c1 = c0, c2 = c0, c3 = c0;
                if (rope) { const f32x4* cp = (const f32x4*)(cs + (size_t)row * 16 + 8 * (fq & 1)); c0 = cp[0]; c1 = cp[1]; c2 = cp[2]; c3 = cp[3]; }
#pragma unroll
                for (int bj = 0; bj < 2; ++bj) { f32x4 v0 = acc[ai][bj][m][0], v1 = acc[ai][bj][m][1];
                    if (rope) {
                        const float sg = (fq < 2) ? -1.f : 1.f;
                        float v[8] = {v0[0], v0[1], v0[2], v0[3], v1[0], v1[1], v1[2], v1[3]};
                        const float cc[8] = {c0[0], c0[2], c1[0], c1[2], c2[0], c2[2], c3[0], c3[2]}, sn[8] = {c0[1], c0[3], c1[1], c1[3], c2[1], c2[3], c3[1], c3[3]};
#pragma unroll
                        for (int i = 0; i < 8; ++i) { const float pv = __shfl_xor(v[i], 32); v[i] = v[i] * cc[i] + sg * pv * sn[i]; }
                        v0 = (f32x4){v[0], v[1], v[2], v[3]}; v1 = (f32x4){v[4], v[5], v[6], v[7]};
                    }
                    u32x4 w; w.x = cvt_pk_bf16(v0[0], v0[1]); w.y = cvt_pk_bf16(v0[2], v0[3]); w.z = cvt_pk_bf16(v1[0], v1[1]); w.w = cvt_pk_bf16(v1[2], v1[3]);
                    *(u32x4*)(base + ((size_t)(hh * 2 + bj) * NT + row) * 128 + wc * 32 + 8 * fq) = w; } }
    }
};
typedef att::BlockRef<bf16_t, bf16_t> ARef;
__device__ __forceinline__ ARef att_ref(const Args& a, int hd, int qb) {
    const int b = hd >> 5, vh = hd & 31, h = vh >> 2, m = (vh >> 1) & 1, half = vh & 1;
    ARef r;
    r.Q = a.Qh + ((size_t)(h * 2 + m) * NT + (size_t)b * S + (size_t)qb * 256) * 128;
    r.K = a.Kh + ((size_t)(h * 2 + m) * NT + (size_t)b * S) * 128;
    r.V = a.Vh + ((size_t)(h * 2 + half) * NT + (size_t)b * S) * 128;
    r.O = a.Oa + ((size_t)((h * 2 + m) * 2 + half) * NT + (size_t)b * S + (size_t)qb * 256) * 128;
    r.P0 = qb * 256;
    return r;
}
__device__ __forceinline__ bool att_pos(int w, int N, int r, int& hd, int& qb) {
    const int p = r * N + ((r & 1) ? (N - 1 - w) : w); if (p >= 2048) return false;
    const int c = p >> 9, pl = p & 511; hd = pl >> 2; qb = 15 - 4 * c - (pl & 3); return true;
}
constexpr int CVA_MIN = 16 * 96, CVA_MO = 16 * 32, CVA_GU = 64 * 512, CVA_DN = 64 * 256, CVA_ITEMS = CVA_MIN + CVA_MO + CVA_GU + CVA_DN, CVA_BUF = 4224;
struct CvaItem { const float* W; unsigned char* WT; int ldw, K, k0, n0, s0; float sc; };
__device__ __forceinline__ CvaItem cva_decode(const Args& a, int r) {
    CvaItem d; d.ldw = 2048; d.K = D; d.sc = 64.f;
    if (r < CVA_MIN) { const int kb = r / 96, nb = r - kb * 96; d.W = a.m_win; d.ldw = 6160; d.WT = a.Bt_min8; d.k0 = kb * 128; d.n0 = nb * 64; d.s0 = d.n0; return d; } r -= CVA_MIN;
    if (r < CVA_MO) { d.W = a.m_wout; d.WT = a.Bt_mo8; d.k0 = (r >> 5) * 128; d.n0 = (r & 31) * 64; d.s0 = d.n0; return d; } r -= CVA_MO;
    if (r < CVA_GU) { const int ex = r >> 9, q = r & 511; d.W = a.wgu + (size_t)ex * D * 2048; d.WT = a.Bt_gu8 + (size_t)ex * 2048 * D; d.k0 = (q >> 5) * 128; d.n0 = (q & 31) * 64; d.s0 = gu_src(d.n0); return d; } r -= CVA_GU;
    { const int ex = r >> 8, q = r & 255; d.W = a.wdn + (size_t)ex * MH * D; d.WT = a.Bt_dn8 + (size_t)ex * D * MH; d.K = MH; d.k0 = (q >> 5) * 128; d.n0 = (q & 31) * 64; d.s0 = d.n0; d.sc = 32.f; return d; }
}
struct AttConv {
    const Args* a; LAS unsigned char* buf;
    int nxt, stride, cur, wave; unsigned bufa;
    __device__ __forceinline__ void issue() {
        if (nxt >= CVA_ITEMS) return;
        const CvaItem d = cva_decode(*a, nxt);
        const int l = opq((int)threadIdx.x) & 63, kq = wave & 3, nh = wave >> 2;
        cur = nxt; nxt += stride;
        const char* base = (const char*)(d.W + (size_t)(d.k0 + 32 * kq) * d.ldw + d.s0 + 32 * nh);
        const unsigned voff = (unsigned)(((l >> 3) * d.ldw + 4 * (l & 7)) * 4);
#pragma unroll
        for (int j = 0; j < 4; ++j) asm volatile("s_mov_b32 m0, %2\n\ts_nop 0\n\tglobal_load_lds_dwordx4 %0, %1" :: "v"(voff), "s"(base + (size_t)(8 * j) * d.ldw * 4), "s"(bufa + j * 1024 + (j >= 2 ? 128 : 0)) : "memory", "m0");
    }
    __device__ __forceinline__ void consume() {
        if (cur < 0) return;
        asm volatile("s_waitcnt vmcnt(0)" ::: "memory");
        const CvaItem d = cva_decode(*a, cur);
        const int l = opq((int)threadIdx.x) & 63, n = l & 31, kh = l >> 5, kq = wave & 3, nh = wave >> 2;
        const LAS float* p = (const LAS float*)(buf + kh * (17 * 128) + n * 4);
        float v[16];
#pragma unroll
        for (int i = 0; i < 16; ++i) v[i] = p[i * 32] * d.sc;
        u32x4 o; o.x = pk4_fp8(v[0], v[1], v[2], v[3]); o.y = pk4_fp8(v[4], v[5], v[6], v[7]); o.z = pk4_fp8(v[8], v[9], v[10], v[11]); o.w = pk4_fp8(v[12], v[13], v[14], v[15]);
        *(u32x4*)(d.WT + (size_t)(d.n0 + 32 * nh + n) * d.K + d.k0 + 32 * kq + 16 * kh) = o;
        asm volatile("s_waitcnt lgkmcnt(0)" ::: "memory");
        cur = -1;
    }
    __device__ __forceinline__ void finish() {
        consume();
        while (nxt < CVA_ITEMS) { issue(); consume(); }
    }
};
__device__ __forceinline__ void phase_attn(const Args& a, char* lds, int w, int N  ) {
    AttConv cv; cv.a = &a; cv.wave = __builtin_amdgcn_readfirstlane((int)threadIdx.x >> 6); cv.buf = (LAS unsigned char*)lds + att::ATT_LDS_BYTES + cv.wave * CVA_BUF; cv.bufa = __builtin_amdgcn_readfirstlane((unsigned)(uintptr_t)lds + att::ATT_LDS_BYTES + cv.wave * CVA_BUF);
    cv.nxt = w; cv.stride = N; cv.cur = -1;
    int hd, qb, r = 0;
    if (att_pos(w, N, 0, hd, qb)) {
        ARef cur = att_ref(a, hd, qb);
        att::Seam<bf16_t> Sm;
        att::causal_swa_prime<bf16_t, bf16_t>(cur, 1 << 30, lds, Sm);
        for (;;) {
            int hn, qn; const bool more = att_pos(w, N, r + 1, hn, qn);
            const ARef nxt = more ? att_ref(a, hn, qn) : cur;
            att::causal_swa_block<bf16_t, bf16_t, AttConv>(cur, nxt, S, 1 << 30, lds, Sm, cv);
            if (!more) break;
            cur = nxt; ++r;
        }
    }
    cv.finish();
}
__device__ __forceinline__ float bf_lo(unsigned u) { return __uint_as_float(u << 16); }
__device__ __forceinline__ float bf_hi(unsigned u) { return __uint_as_float(u & 0xffff0000u); }
typedef unsigned short u16x8 __attribute__((ext_vector_type(8)));
__device__ __forceinline__ void bf8_to_f32(const u32x4 p, float (&f)[8]) {
    f[0] = bf_lo(p.x); f[1] = bf_hi(p.x); f[2] = bf_lo(p.y); f[3] = bf_hi(p.y); f[4] = bf_lo(p.z); f[5] = bf_hi(p.z); f[6] = bf_lo(p.w); f[7] = bf_hi(p.w); }
__device__ __forceinline__ void phase_attn_combine(const Args& a, int gw, int NGW, int lane) {
    float d1 = a.lq1[lane] * a.lk1[lane] + a.lq1[lane + 64] * a.lk1[lane + 64], d2 = a.lq2[lane] * a.lk2[lane] + a.lq2[lane + 64] * a.lk2[lane + 64];
    const float lam = __expf(wave_sum(d1)) - __expf(wave_sum(d2)) + 0.2f;
    const int hh = lane >> 3, e0 = (lane & 7) * 32, half = e0 >> 7, d0 = e0 & 127;
    float gv[32];
#pragma unroll
    for (int i = 0; i < 8; ++i) { const f32x4 t = *(const f32x4*)(a.a_hg + e0 + 4 * i); gv[4 * i] = t[0]; gv[4 * i + 1] = t[1]; gv[4 * i + 2] = t[2]; gv[4 * i + 3] = t[3]; }
    const bf16_t* O0 = a.Oa + ((size_t)((hh * 2 + 0) * 2 + half) * NT) * 128 + d0;
    const bf16_t* O1 = a.Oa + ((size_t)((hh * 2 + 1) * 2 + half) * NT) * 128 + d0;
    const int RPW = (NT + NGW - 1) / NGW; int m = gw * RPW; const int mend = (m + RPW < NT) ? m + RPW : NT;
    if (m >= mend) return;
    u32x4 p0[4], p1[4], n0[4], n1[4];
#pragma unroll
    for (int i = 0; i < 4; ++i) { p0[i] = *(const u32x4*)(O0 + (size_t)m * 128 + 8 * i); p1[i] = *(const u32x4*)(O1 + (size_t)m * 128 + 8 * i); }
    for (;;) {
        const bool more = m + 1 < mend;
        if (more) {
#pragma unroll
            for (int i = 0; i < 4; ++i) { n0[i] = *(const u32x4*)(O0 + (size_t)(m + 1) * 128 + 8 * i); n1[i] = *(const u32x4*)(O1 + (size_t)(m + 1) * 128 + 8 * i); } }
        float o[32]; float ss = 0.f;
#pragma unroll
        for (int i = 0; i < 4; ++i) { float f0[8], f1[8]; bf8_to_f32(p0[i], f0); bf8_to_f32(p1[i], f1);
#pragma unroll
            for (int j = 0; j < 8; ++j) { o[8 * i + j] = f0[j] - lam * f1[j]; ss += o[8 * i + j] * o[8 * i + j]; } }
        ss += __shfl_xor(ss, 1); ss += __shfl_xor(ss, 2); ss += __shfl_xor(ss, 4);
        const float r = rsqrtf(ss * (1.f / 256.f) + EPS) * 0.8f;
        bf16_t* orow = a.ob + (size_t)m * D + hh * 256 + e0;
#pragma unroll
        for (int i = 0; i < 4; ++i) { u32x4 w; w.x = cvt_pk_bf16(o[8 * i] * r * gv[8 * i], o[8 * i + 1] * r * gv[8 * i + 1]); w.y = cvt_pk_bf16(o[8 * i + 2] * r * gv[8 * i + 2], o[8 * i + 3] * r * gv[8 * i + 3]);
            w.z = cvt_pk_bf16(o[8 * i + 4] * r * gv[8 * i + 4], o[8 * i + 5] * r * gv[8 * i + 5]); w.w = cvt_pk_bf16(o[8 * i + 6] * r * gv[8 * i + 6], o[8 * i + 7] * r * gv[8 * i + 7]);
            *(u32x4*)(orow + 8 * i) = w; }
        if (!more) break;
        ++m;
#pragma unroll
        for (int i = 0; i < 4; ++i) { p0[i] = n0[i]; p1[i] = n1[i]; }
    }
}

struct EpiMin {
    static constexpr bool PERM = true, AFTER_DRAIN = false;
    bf16_t* P3;
    __device__ __forceinline__ void operator()(const f32x4 (&acc)[2][2][4][2], const Unit& u, int wr, int wc, int fr, int fq) const {
        const int t = u.pn >> 3; const int row0 = u.pm * 256 + wr * 64 + fr;
        bf16_t* base = P3 + (size_t)t * ((size_t)NT * 2048); const int col0 = (u.pn & 7) * 256 + wc * 32 + 8 * fq;
#pragma unroll
        for (int ai = 0; ai < 2; ++ai)
#pragma unroll
            for (int m = 0; m < 4; ++m) { bf16_t* rowp = base + (size_t)(row0 + ai * 128 + m * 16) * 2048 + col0;
#pragma unroll
                for (int bj = 0; bj < 2; ++bj) { f32x4 v0 = acc[ai][bj][m][0] * (1.f / 256.f), v1 = acc[ai][bj][m][1] * (1.f / 256.f);
                    if (t == 2) {
#pragma unroll
                        for (int j = 0; j < 4; ++j) { v0[j] = 1.f / (1.f + __expf(-v0[j])); v1[j] = 1.f / (1.f + __expf(-v1[j])); } }
                    u32x4 w; w.x = cvt_pk_bf16(v0[0], v0[1]); w.y = cvt_pk_bf16(v0[2], v0[3]); w.z = cvt_pk_bf16(v1[0], v1[1]); w.w = cvt_pk_bf16(v1[2], v1[3]);
                    *(u32x4*)(rowp + bj * 128) = w; } }
    }
};
constexpr int MP_XS = 0, MP_VT = 35840, MP_QS = 69632, MP_KS = 87040, MP_GT = 104448;
__device__ __forceinline__ unsigned pk_lo(unsigned a, unsigned b) { return (a & 0xffffu) | (b << 16); }
__device__ __forceinline__ unsigned pk_hi(unsigned a, unsigned b) { return (a >> 16) | (b & 0xffff0000u); }
__device__ __forceinline__ void phase_mprep(const Args& a, LAS unsigned char* lds, int vcu, int G, int tid) {
    const bf16_t* QKP = a.P3; const bf16_t* VB = a.P3 + (size_t)NT * 2048;
    for (int it = vcu; it < NB * 64; it += G) {
        const int b = it >> 6, ck = it & 63; const size_t row0 = (size_t)b * S + (size_t)ck * 64;
        __syncthreads();
        {
            const int t = tid >> 3, h = tid & 7; LAS float* gt = (LAS float*)(lds + MP_GT);
            const float gi = a.gates[(row0 + t) * 16 + h] + a.m_gb[h], z = a.gates[(row0 + t) * 16 + 8 + h] + a.m_gb[8 + h];
            gt[t * 8 + h] = gi; gt[512 + t * 8 + h] = fminf(z, 0.f) - log1pf(expf(-fabsf(z)));
        }
        __syncthreads();
        if (tid < 8) {
            const int h = tid; float bc = 0.f, cm = -INFINITY; const LAS float* gt = (const LAS float*)(lds + MP_GT);
            float* ga = a.GA + (size_t)((b * 8 + h) * 64 + ck) * 192;
            for (int t = 0; t < 64; ++t) { bc += gt[512 + t * 8 + h]; const float av = gt[t * 8 + h] - bc; cm = fmaxf(cm, av); ga[t] = av; ga[64 + t] = cm; ga[128 + t] = bc; }
            a.GS[(size_t)((b * 8 + h) * 64 + ck) * 2 + 0] = cm; a.GS[(size_t)((b * 8 + h) * 64 + ck) * 2 + 1] = bc;
        }
        for (int h = 0; h < 8; ++h) {
            for (int c = tid; c < 67 * 32; c += NTHR) { const int r = c >> 5, cc = c & 31; const int tt = r - 3;
                u32x4 v = {0u, 0u, 0u, 0u};
                if (ck * 64 + tt >= 0) v = *(const u32x4*)(QKP + (size_t)((long)row0 + tt) * 2048 + (cc < 16 ? h * 128 + cc * 8 : 1024 + h * 128 + (cc - 16) * 8));
                *(LAS u32x4*)(lds + MP_XS + r * 528 + cc * 16) = v; }
#pragma unroll
            for (int i = 0; i < 4; ++i) { const int c = tid + 512 * i, sr = c >> 5, e16 = c & 31;
                *(LAS u32x4*)(lds + MP_VT + sr * 528 + e16 * 16) = *(const u32x4*)(VB + (row0 + sr) * 2048 + h * 256 + e16 * 8); }
            __syncthreads();
            {
                const int cp = tid & 127, rq = tid >> 7; const bool isk = cp >= 64;
                const int col = isk ? 1024 + h * 128 + 2 * (cp - 64) : h * 128 + 2 * cp;
                float w0[4], w1[4];
#pragma unroll
                for (int j = 0; j < 4; ++j) { w0[j] = a.m_cw[j * 2048 + col]; w1[j] = a.m_cw[j * 2048 + col + 1]; }
                const float b0 = a.m_cb[col], b1 = a.m_cb[col + 1];
                const LAS unsigned char* xp = lds + MP_XS + (16 * rq) * 528 + cp * 4;
                float xa[4], xb[4];
#pragma unroll
                for (int j = 0; j < 3; ++j) { const unsigned v = *(const LAS unsigned*)(xp + j * 528); xa[j] = bf_lo(v); xb[j] = bf_hi(v); }
                const float sc = isk ? 0.08838834764831845f : 1.f;
                LAS unsigned char* dst = lds + (isk ? MP_KS : MP_QS) + (isk ? cp - 64 : cp) * 4;
#pragma unroll
                for (int i = 0; i < 16; ++i) { const int t = 16 * rq + i;
                    const unsigned v = *(const LAS unsigned*)(xp + (i + 3) * 528); xa[3] = bf_lo(v); xb[3] = bf_hi(v);
                    float ya = b0 + w0[0] * xa[0] + w0[1] * xa[1] + w0[2] * xa[2] + w0[3] * xa[3];
                    float yb = b1 + w1[0] * xb[0] + w1[1] * xb[1] + w1[2] * xb[2] + w1[3] * xb[3];
                    ya = ya / (1.f + __expf(-ya)) * sc; yb = yb / (1.f + __expf(-yb)) * sc;
                    *(LAS unsigned*)(dst + t * 272) = cvt_pk_bf16(ya, yb);
                    xa[0] = xa[1]; xa[1] = xa[2]; xa[2] = xa[3]; xb[0] = xb[1]; xb[1] = xb[2]; xb[2] = xb[3]; }
            }
            __syncthreads();
            {
#pragma unroll
                for (int i = 0; i < 4; ++i) { const int c = tid + 512 * i, isk = c >> 10, r = (c >> 4) & 63, cc = c & 15;
                    *(u32x4*)(a.Qn + (isk ? (size_t)NT * 1024 : (size_t)0) + (row0 + r) * 1024 + h * 128 + cc * 8) = *(const LAS u32x4*)(lds + (isk ? MP_KS : MP_QS) + r * 272 + cc * 16); }
            }
            if (tid < 256) {
                const int dp = tid & 63, sq = tid >> 6; unsigned w[16];
#pragma unroll
                for (int i = 0; i < 16; ++i) w[i] = *(const LAS unsigned*)(lds + MP_KS + (16 * sq + i) * 272 + dp * 4);
                u32x4* d0p = (u32x4*)(a.KT + ((size_t)((b * 8 + h) * 64 + ck) * 128 + 2 * dp) * 64 + 16 * sq);
                d0p[0] = (u32x4){pk_lo(w[0], w[1]), pk_lo(w[2], w[3]), pk_lo(w[4], w[5]), pk_lo(w[6], w[7])};
                d0p[1] = (u32x4){pk_lo(w[8], w[9]), pk_lo(w[10], w[11]), pk_lo(w[12], w[13]), pk_lo(w[14], w[15])};
                d0p[8] = (u32x4){pk_hi(w[0], w[1]), pk_hi(w[2], w[3]), pk_hi(w[4], w[5]), pk_hi(w[6], w[7])};
                d0p[9] = (u32x4){pk_hi(w[8], w[9]), pk_hi(w[10], w[11]), pk_hi(w[12], w[13]), pk_hi(w[14], w[15])};
            }
            {
                const int ep = tid & 127, sq = tid >> 7; unsigned w[16];
#pragma unroll
                for (int i = 0; i < 16; ++i) w[i] = *(const LAS unsigned*)(lds + MP_VT + (16 * sq + i) * 528 + ep * 4);
                u32x4* d0p = (u32x4*)(a.VT + ((size_t)((b * 8 + h) * 64 + ck) * 256 + 2 * ep) * 64 + 16 * sq);
                d0p[0] = (u32x4){pk_lo(w[0], w[1]), pk_lo(w[2], w[3]), pk_lo(w[4], w[5]), pk_lo(w[6], w[7])};
                d0p[1] = (u32x4){pk_lo(w[8], w[9]), pk_lo(w[10], w[11]), pk_lo(w[12], w[13]), pk_lo(w[14], w[15])};
                d0p[8] = (u32x4){pk_hi(w[0], w[1]), pk_hi(w[2], w[3]), pk_hi(w[4], w[5]), pk_hi(w[6], w[7])};
                d0p[9] = (u32x4){pk_hi(w[8], w[9]), pk_hi(w[10], w[11]), pk_hi(w[12], w[13]), pk_hi(w[14], w[15])};
            }
            __syncthreads();
        }
    }
}

constexpr int ML_QS = 0, ML_KS = 17408, ML_KTS = 34816, ML_VTS = 53248, ML_GL = 60160, ML_PL = 60928, ML_QD = 70144, ML_CL = 87552, ML_MP = 113664, ML_END = 113920;
typedef short bf16x8s __attribute__((ext_vector_type(8)));
__device__ __forceinline__ void phase_mlstm(const Args& a, LAS unsigned char* lds, int vcu, int G, int tid, int wave, int lane) {
    const int r16 = lane & 15, q4 = lane >> 4;
    for (int unit = vcu; unit < 256; unit += G) {
        const int bh = unit >> 3, es = unit & 7, b = bh >> 3, h = bh & 7;
        __syncthreads();
        for (int i = tid; i < 16 * 36; i += NTHR) { const int r = i / 36, c = i % 36; *(LAS unsigned*)(lds + ML_VTS + (32 + r) * 144 + c * 4) = (r == 0) ? 0x3F803F80u : 0u; }
        for (int i = tid; i < 48 * 68; i += NTHR) *(LAS unsigned*)(lds + ML_CL + i * 4) = 0u;
        if (tid < 64) { ((LAS float*)(lds + ML_END))[2 * tid] = a.GS[(size_t)(bh * 64 + tid) * 2]; ((LAS float*)(lds + ML_END))[2 * tid + 1] = a.GS[(size_t)(bh * 64 + tid) * 2 + 1]; }
        __syncthreads();
        if (tid == 0) { float m = 0.f; LAS float* mp = (LAS float*)(lds + ML_MP); const LAS float* gs = (const LAS float*)(lds + ML_END);
            for (int k = 0; k < 64; ++k) { mp[k] = m; m = gs[2 * k + 1] + fmaxf(m, gs[2 * k]); } }
        f32x4 accC[2][3];
#pragma unroll
        for (int i = 0; i < 2; ++i)
#pragma unroll
            for (int j = 0; j < 3; ++j) accC[i][j] = (f32x4){0.f, 0.f, 0.f, 0.f};
        u32x4 rq[2], rk[2], rkt[2], rv, rg, sq[2], sk[2], skt[2], sv, sg;
        rv = (u32x4){0u, 0u, 0u, 0u}; rg = rv; sv = rv; sg = rv;
#define ML_LOAD(k, Q_, K_, KT_, V_, G_) do { const int kc_ = (k) < 64 ? (k) : 63; const size_t row0_ = (size_t)b * S + (size_t)kc_ * 64; const size_t cb_ = (size_t)(bh * 64 + kc_); \
        _Pragma("unroll") for (int i_ = 0; i_ < 2; ++i_) { const int c_ = tid + 512 * i_; \
            Q_[i_] = *(const u32x4*)(a.Qn + (row0_ + (c_ >> 4)) * 1024 + h * 128 + (c_ & 15) * 8); \
            K_[i_] = *(const u32x4*)(a.Kn + (row0_ + (c_ >> 4)) * 1024 + h * 128 + (c_ & 15) * 8); \
            KT_[i_] = *(const u32x4*)(a.KT + cb_ * 8192 + (size_t)c_ * 8); } \
        V_ = *(const u32x4*)(a.VT + cb_ * 16384 + (size_t)es * 2048 + (size_t)(tid & 255) * 8); \
        G_ = *(const u32x4*)(a.GA + cb_ * 192 + (tid & 31) * 4); } while (0)
#define ML_STORE(Q_, K_, KT_, V_, G_) do { \
        _Pragma("unroll") for (int i_ = 0; i_ < 2; ++i_) { const int c_ = tid + 512 * i_; \
            *(LAS u32x4*)(lds + ML_QS + (c_ >> 4) * 272 + (c_ & 15) * 16) = Q_[i_]; \
            *(LAS u32x4*)(lds + ML_KS + (c_ >> 4) * 272 + (c_ & 15) * 16) = K_[i_]; \
            *(LAS u32x4*)(lds + ML_KTS + (c_ >> 3) * 144 + (c_ & 7) * 16) = KT_[i_]; } \
        if (tid < 256) *(LAS u32x4*)(lds + ML_VTS + (tid >> 3) * 144 + (tid & 7) * 16) = V_; \
        if (tid < 48) *(LAS u32x4*)(lds + ML_GL + tid * 16) = G_; } while (0)
        ML_LOAD(0, rq, rk, rkt, rv, rg);
        ML_STORE(rq, rk, rkt, rv, rg);
        __syncthreads();
        ML_LOAD(1, rq, rk, rkt, rv, rg); ML_LOAD(2, sq, sk, skt, sv, sg);
        auto chunk = [&](const int k) __attribute__((always_inline)) {
            const LAS float* ga = (const LAS float*)(lds + ML_GL);
            const float m = ((const LAS float*)(lds + ML_MP))[k];
            const int cur = k & 1;
            if (wave < 4) {
                const int tr = wave, t = 16 * tr + r16;
                const float Mt = fmaxf(m, ga[64 + t]);
                bf16x8s qf[4];
#pragma unroll
                for (int kk = 0; kk < 4; ++kk) qf[kk] = *(const LAS bf16x8s*)(lds + ML_QS + t * 272 + kk * 64 + q4 * 16);
#pragma unroll
                for (int sc = 0; sc < 4; ++sc) {
                    u32x2 w0 = {0u, 0u};
                    if (sc <= tr) {
                        f32x4 s0 = {0.f, 0.f, 0.f, 0.f};
#pragma unroll
                        for (int kk = 0; kk < 4; ++kk) { const bf16x8s kf = *(const LAS bf16x8s*)(lds + ML_KS + (16 * sc + r16) * 272 + kk * 64 + q4 * 16);
                            s0 = __builtin_amdgcn_mfma_f32_16x16x32_bf16(kf, qf[kk], s0, 0, 0, 0); }
                        const f32x4 a0 = *(const LAS f32x4*)(lds + ML_GL + (16 * sc + 4 * q4) * 4);
                        float p[4];
#pragma unroll
                        for (int j = 0; j < 4; ++j) { const int sA = 16 * sc + 4 * q4 + j; p[j] = (sA <= t) ? s0[j] * __expf(a0[j] - Mt) : 0.f; }
                        w0.x = cvt_pk_bf16(p[0], p[1]); w0.y = cvt_pk_bf16(p[2], p[3]);
                    }
                    *(LAS u32x2*)(lds + ML_PL + t * 144 + (16 * sc + 4 * q4) * 2) = w0;
                }
                {
                    const int tq = 16 * tr + (lane >> 2), c0 = (lane & 3) * 32;
                    const float dec = __expf(m - fmaxf(m, ga[64 + tq]));
#pragma unroll
                    for (int i = 0; i < 4; ++i) { const u32x4 v = *(const LAS u32x4*)(lds + ML_QS + tq * 272 + (c0 + 8 * i) * 2); u32x4 o;
                        o.x = cvt_pk_bf16(bf_lo(v.x) * dec, bf_hi(v.x) * dec); o.y = cvt_pk_bf16(bf_lo(v.y) * dec, bf_hi(v.y) * dec);
                        o.z = cvt_pk_bf16(bf_lo(v.z) * dec, bf_hi(v.z) * dec); o.w = cvt_pk_bf16(bf_lo(v.w) * dec, bf_hi(v.w) * dec);
                        *(LAS u32x4*)(lds + ML_QD + tq * 272 + (c0 + 8 * i) * 2) = o; }
                }
                asm volatile("s_waitcnt lgkmcnt(0)" ::: "memory");
                f32x4 o0 = {0.f, 0.f, 0.f, 0.f}, o1 = o0, o2 = o0;
#pragma unroll
                for (int kk = 0; kk < 2; ++kk) {
                    if (kk * 2 <= tr) {
                    const bf16x8s pf = *(const LAS bf16x8s*)(lds + ML_PL + t * 144 + kk * 64 + q4 * 16);
                    const bf16x8s v0 = *(const LAS bf16x8s*)(lds + ML_VTS + (r16) * 144 + kk * 64 + q4 * 16);
                    const bf16x8s v1 = *(const LAS bf16x8s*)(lds + ML_VTS + (16 + r16) * 144 + kk * 64 + q4 * 16);
                    const bf16x8s v2 = *(const LAS bf16x8s*)(lds + ML_VTS + (32 + r16) * 144 + kk * 64 + q4 * 16);
                    o0 = __builtin_amdgcn_mfma_f32_16x16x32_bf16(v0, pf, o0, 0, 0, 0);
                    o1 = __builtin_amdgcn_mfma_f32_16x16x32_bf16(v1, pf, o1, 0, 0, 0);
                    o2 = __builtin_amdgcn_mfma_f32_16x16x32_bf16(v2, pf, o2, 0, 0, 0); }
                }
#pragma unroll
                for (int kk = 0; kk < 4; ++kk) {
                    const bf16x8s qd = *(const LAS bf16x8s*)(lds + ML_QD + t * 272 + kk * 64 + q4 * 16);
                    const bf16x8s c0 = *(const LAS bf16x8s*)(lds + ML_CL + cur * 13056 + (r16) * 272 + kk * 64 + q4 * 16);
                    const bf16x8s c1 = *(const LAS bf16x8s*)(lds + ML_CL + cur * 13056 + (16 + r16) * 272 + kk * 64 + q4 * 16);
                    const bf16x8s c2 = *(const LAS bf16x8s*)(lds + ML_CL + cur * 13056 + (32 + r16) * 272 + kk * 64 + q4 * 16);
                    o0 = __builtin_amdgcn_mfma_f32_16x16x32_bf16(c0, qd, o0, 0, 0, 0);
                    o1 = __builtin_amdgcn_mfma_f32_16x16x32_bf16(c1, qd, o1, 0, 0, 0);
                    o2 = __builtin_amdgcn_mfma_f32_16x16x32_bf16(c2, qd, o2, 0, 0, 0);
                }
                const float den = __shfl(o2[0], r16);
                const float mt = ga[128 + t] + Mt;
                const float inv = 1.f / fmaxf(fabsf(den), __expf(-mt));
                bf16_t* hp = a.HS + ((size_t)b * S + (size_t)k * 64 + t) * 2048 + h * 256 + es * 32 + 4 * q4;
                u32x2 w0, w1; w0.x = cvt_pk_bf16(o0[0] * inv, o0[1] * inv); w0.y = cvt_pk_bf16(o0[2] * inv, o0[3] * inv);
                w1.x = cvt_pk_bf16(o1[0] * inv, o1[1] * inv); w1.y = cvt_pk_bf16(o1[2] * inv, o1[3] * inv);
                *(u32x2*)hp = w0; *(u32x2*)(hp + 16) = w1;
            } else {
                const int dj = wave - 4;
                const float Ml = fmaxf(m, ga[64 + 63]), cd = __expf(m - Ml);
#pragma unroll
                for (int i = 0; i < 2; ++i)
#pragma unroll
                    for (int et = 0; et < 3; ++et) accC[i][et] = accC[i][et] * cd;
#pragma unroll
                for (int kk = 0; kk < 2; ++kk) {
                    const f32x4 aA = *(const LAS f32x4*)(lds + ML_GL + (32 * kk + 8 * q4) * 4), aB = *(const LAS f32x4*)(lds + ML_GL + (32 * kk + 8 * q4 + 4) * 4);
                    float wg[8];
#pragma unroll
                    for (int j = 0; j < 4; ++j) { wg[j] = __expf(aA[j] - Ml); wg[4 + j] = __expf(aB[j] - Ml); }
                    bf16x8s vw[3];
#pragma unroll
                    for (int et = 0; et < 3; ++et) { const u32x4 v = *(const LAS u32x4*)(lds + ML_VTS + (16 * et + r16) * 144 + kk * 64 + q4 * 16); u32x4 o;
                        o.x = cvt_pk_bf16(bf_lo(v.x) * wg[0], bf_hi(v.x) * wg[1]); o.y = cvt_pk_bf16(bf_lo(v.y) * wg[2], bf_hi(v.y) * wg[3]);
                        o.z = cvt_pk_bf16(bf_lo(v.z) * wg[4], bf_hi(v.z) * wg[5]); o.w = cvt_pk_bf16(bf_lo(v.w) * wg[6], bf_hi(v.w) * wg[7]);
                        vw[et] = __builtin_bit_cast(bf16x8s, o); }
#pragma unroll
                    for (int i = 0; i < 2; ++i) { const bf16x8s kf = *(const LAS bf16x8s*)(lds + ML_KTS + (16 * (2 * dj + i) + r16) * 144 + kk * 64 + q4 * 16);
#pragma unroll
                        for (int et = 0; et < 3; ++et) accC[i][et] = __builtin_amdgcn_mfma_f32_16x16x32_bf16(kf, vw[et], accC[i][et], 0, 0, 0); }
                }
#pragma unroll
                for (int i = 0; i < 2; ++i)
#pragma unroll
                    for (int et = 0; et < 3; ++et) { u32x2 w; w.x = cvt_pk_bf16(accC[i][et][0], accC[i][et][1]); w.y = cvt_pk_bf16(accC[i][et][2], accC[i][et][3]);
                        *(LAS u32x2*)(lds + ML_CL + (cur ^ 1) * 13056 + (16 * et + r16) * 272 + (16 * (2 * dj + i) + 4 * q4) * 2) = w; }
            }
        };
        for (int k = 0; k < 64; k += 2) {
            chunk(k);
            __syncthreads();
            ML_STORE(rq, rk, rkt, rv, rg);
            __syncthreads();
            ML_LOAD(k + 3, rq, rk, rkt, rv, rg);
            chunk(k + 1);
            __syncthreads();
            ML_STORE(sq, sk, skt, sv, sg);
            __syncthreads();
            ML_LOAD(k + 4, sq, sk, skt, sv, sg);
        }
#undef ML_LOAD
#undef ML_STORE
    }
}
__device__ __forceinline__ void phase_mnorm(const Args& a, int gw, int NGW, int lane) {
    const bf16_t* SG = a.P3 + (size_t)2 * NT * 2048;
    float gv[32];
#pragma unroll
    for (int i = 0; i < 8; ++i) { const f32x4 t = *(const f32x4*)(a.m_hg + 32 * lane + 4 * i); gv[4 * i] = t[0]; gv[4 * i + 1] = t[1]; gv[4 * i + 2] = t[2]; gv[4 * i + 3] = t[3]; }
    const int RPW = (NT + NGW - 1) / NGW; int m = gw * RPW; const int mend = (m + RPW < NT) ? m + RPW : NT;
    if (m >= mend) return;
    u32x4 p0[4], p1[4], n0[4], n1[4];
#pragma unroll
    for (int i = 0; i < 4; ++i) { p0[i] = *(const u32x4*)(a.HS + (size_t)m * D + 32 * lane + 8 * i); p1[i] = *(const u32x4*)(SG + (size_t)m * D + 32 * lane + 8 * i); }
    for (;;) {
        const bool more = m + 1 < mend;
        if (more) {
#pragma unroll
            for (int i = 0; i < 4; ++i) { n0[i] = *(const u32x4*)(a.HS + (size_t)(m + 1) * D + 32 * lane + 8 * i); n1[i] = *(const u32x4*)(SG + (size_t)(m + 1) * D + 32 * lane + 8 * i); } }
        float o[32], sg[32]; float ss = 0.f;
#pragma unroll
        for (int i = 0; i < 4; ++i) { float f0[8], f1[8]; bf8_to_f32(p0[i], f0); bf8_to_f32(p1[i], f1);
#pragma unroll
            for (int j = 0; j < 8; ++j) { o[8 * i + j] = f0[j]; sg[8 * i + j] = f1[j]; ss += f0[j] * f0[j]; } }
        ss += __shfl_xor(ss, 1); ss += __shfl_xor(ss, 2); ss += __shfl_xor(ss, 4);
        const float r = rsqrtf(ss * (1.f / 256.f) + EPS);
        unsigned char* orow = a.ob8 + (size_t)m * D + 32 * lane;
#pragma unroll
        for (int i = 0; i < 4; ++i) { float y[8];
#pragma unroll
            for (int j = 0; j < 8; ++j) y[j] = o[8 * i + j] * r * gv[8 * i + j] * sg[8 * i + j];
            u32x2 w; w.x = pk4_fp8(y[0] * 8.f, y[1] * 8.f, y[2] * 8.f, y[3] * 8.f); w.y = pk4_fp8(y[4] * 8.f, y[5] * 8.f, y[6] * 8.f, y[7] * 8.f);
            *(u32x2*)(orow + 8 * i) = w; }
        if (!more) break;
        ++m;
#pragma unroll
        for (int i = 0; i < 4; ++i) { p0[i] = n0[i]; p1[i] = n1[i]; }
    }
}

#define XB_TMO      128
#define XB_XCNT(j)  (256  + 64 * (j))
#define XB_XSUB(j)  (1280 + 64 * (j))
#define XB_XGEN(j)  (2304 + 64 * (j))
#define XB_TOP      3328
#define XB_TOPGEN   3392
#define XCD_BAR_WORDS 3456
#define XB_SPIN_CAP (1u << 18)

__device__ __forceinline__ unsigned xb_ld(unsigned* p)              { return __hip_atomic_load(p, __ATOMIC_RELAXED, __HIP_MEMORY_SCOPE_AGENT); }
__device__ __forceinline__ unsigned xb_add(unsigned* p, unsigned v) { return __hip_atomic_fetch_add(p, v, __ATOMIC_RELAXED, __HIP_MEMORY_SCOPE_AGENT); }
__device__ __forceinline__ unsigned xb_xcc_id() { return (unsigned)__builtin_amdgcn_s_getreg((3 << 11) | 20) & 0xFu; }
#define XB_SPIN(cond, bar) do { unsigned _sp = 0; while (cond) { __builtin_amdgcn_s_sleep(1); \
    if ((++_sp & 255u) == 0u) { if (xb_ld(&(bar)[XB_TMO])) break; if (_sp > XB_SPIN_CAP) { atomicAdd(&(bar)[XB_TMO], 1u); break; } } } } while (0)

struct XcdBarrier {
    unsigned* bar; unsigned x;
    volatile LAS unsigned* st;
};

__device__ __forceinline__ XcdBarrier xcd_barrier_post(unsigned* bar, volatile LAS unsigned* st) {
    XcdBarrier b; b.bar = bar; b.x = xb_xcc_id(); b.st = st;
    if (threadIdx.x == 0) (void)xb_add(&bar[XB_XCNT(b.x)], 1u);
    return b;
}
__device__ __forceinline__ void xcd_barrier_complete(unsigned* bar, unsigned x, unsigned& nloc, unsigned& nx) {
    const unsigned G = gridDim.x * gridDim.y * gridDim.z;
    unsigned sum, cnt, mine, sp = 0u;
    for (;;) {
        sum = 0u; cnt = 0u; mine = 0u;
#pragma unroll
        for (unsigned j = 0; j < 16; ++j) { const unsigned c = xb_ld(&bar[XB_XCNT(j)]); sum += c; cnt += (c > 0u) ? 1u : 0u; mine = (j == x) ? c : mine; }
        if (sum == G) break;
        __builtin_amdgcn_s_sleep(1);
        if ((++sp & 255u) == 0u) { if (xb_ld(&bar[XB_TMO])) break; if (sp > XB_SPIN_CAP) { atomicAdd(&bar[XB_TMO], 1u); break; } }
    }
    nloc = mine > 0u ? mine : 1u; nx = cnt > 0u ? cnt : 1u;
}

__device__ __forceinline__ void xcd_barrier(const XcdBarrier& b) {
    asm volatile("s_waitcnt vmcnt(0)" ::: "memory");
    __syncthreads();
    if (threadIdx.x == 0) {
        unsigned* bar = b.bar;
        __builtin_amdgcn_s_waitcnt(0);
        unsigned nloc = b.st[0], nx = b.st[1];
        if (nloc == 0u) { xcd_barrier_complete(bar, b.x, nloc, nx); b.st[0] = nloc; b.st[1] = nx; }
        const unsigned old = xb_add(&bar[XB_XSUB(b.x)], 1u);
        const unsigned gen = old / nloc;
        if (old + 1u == (gen + 1u) * nloc) {
            __builtin_amdgcn_fence(__ATOMIC_RELEASE, "agent");
            asm volatile("s_waitcnt vmcnt(0)" ::: "memory");
            const unsigned og = xb_add(&bar[XB_TOP], 1u);
            const unsigned tg = og / nx;
            if (og + 1u == (tg + 1u) * nx) xb_add(&bar[XB_TOPGEN], 1u);
            else XB_SPIN(xb_ld(&bar[XB_TOPGEN]) == tg, bar);
            __builtin_amdgcn_fence(__ATOMIC_ACQUIRE, "agent");
            xb_add(&bar[XB_XGEN(b.x)], 1u);
            asm volatile("s_waitcnt vmcnt(0)" ::: "memory");
        } else {
            XB_SPIN(xb_ld(&bar[XB_XGEN(b.x)]) == gen, bar);
            __builtin_amdgcn_fence(__ATOMIC_ACQUIRE, "agent");
            asm volatile("s_waitcnt vmcnt(0)" ::: "memory");
        }
    }
    __syncthreads();
}


#ifndef MK_REP_MASK
#define MK_REP_MASK 0u
#endif
__device__ __forceinline__ constexpr int REPS(int k) { return ((MK_REP_MASK >> k) & 1u) ? 2 : 1; }
__global__ void __launch_bounds__(NTHR, 2) mk_fwd(Args a) {
    extern __shared__ __attribute__((aligned(16))) unsigned char lds_raw[];
    LAS unsigned char* lds = (LAS unsigned char*)lds_raw;
    LAS unsigned char* misc = lds + LDS_MISC;
    const int tid = threadIdx.x, lane = tid & 63, wave = __builtin_amdgcn_readfirstlane(tid >> 6);
    const int G = gridDim.x; const int bx = blockIdx.x; const int vcu = (G % 8 == 0) ? (bx % 8) * (G / 8) + bx / 8 : bx;
    const int gw = vcu * NWAVES + wave, NGW = G * NWAVES;
    if (tid < 16) ((LAS unsigned*)(misc + MISC_BAR))[tid] = 0u;
    __syncthreads();
    const int lo = a.ph_lo, hi = a.ph_hi;
    XcdBarrier bar; bar.bar = a.ctl + 4096; bar.x = 0; bar.st = nullptr;
    if (hi - lo > 1) bar = xcd_barrier_post(a.ctl + 4096, (volatile LAS unsigned*)(misc + MISC_BAR));
#define IN(k) (lo <= (k) && (k) < hi)
#define SEAM(k) do { if (IN(k) && IN((k) + 1)) xcd_barrier(bar); } while (0)
    const float* mod0 = a.mod; const float* mod1 = a.mod + (size_t)NB * 6 * D;

#define PH(k) if (IN(k)) _Pragma("unroll") for (int rep_ = 0; rep_ < REPS(k); (REPS(k) > 1 ? __syncthreads() : (void)0, ++rep_))
    PH(0) { p0_prologue(a, lds, vcu, G, opq(tid), wave, opq(lane)); } SEAM(0);
    PH(1) { phase_norm(a.x, a.nmg, mod0, 0, 1, a.hb, gw, NGW, opq(lane)); } SEAM(1);
    PH(2) {
        pg8::Gemm g{a.hb, a.Bt_qkv, NT, 6144, D}; pg8::StaticOrder So; So.init(NT, 6144, G, bx);
        EpiQKV E{a.Qh, a.Kh, a.Vh, a.cs};
        pg8::gemm_phase<EpiQKV, pg8::StaticOrder, true, true>(lds, g, So, E);
    } SEAM(2);
    PH(3) { phase_attn(a, (char*)lds_raw, vcu, G); } SEAM(3);
    PH(4) { phase_attn_combine(a, gw, NGW, opq(lane)); } SEAM(4);
    PH(5) {
        pg8::Gemm g{a.ob, a.Bt_ao, NT, D, D}; pg8::StaticOrder So; So.init(NT, D, G, bx);
        EpiResid<true> E{a.x, a.xres, mod0 + 2 * D, 1.f};
        pg8::gemm_phase<EpiResid<true>, pg8::StaticOrder, true, true>(lds, g, So, E);
    } SEAM(5);
#define MOE_PHASES(P, layer, modl)                                                                                                   \
    PH(P) { phase_norm_route(a, layer, modl, lds, misc, vcu, G, opq(tid), wave, opq(lane)); } SEAM(P);                            \
    PH(P + 1) { const int NP = moe_tables(a.counts + (layer) * 64, misc, tid);                                                    \
        pg8::Gemm g{(const bf16_t*)a.hb8, (const bf16_t*)(a.Bt_gu8 + (size_t)(layer) * NE * 2048 * D), NP * 256, NE * 2048, D / 2};     \
        GroupedOrderG So; So.NP = NP; So.total = NP * 8; So.G = G; So.c = vcu; So.pe = (const LAS int*)(misc + MISC_PE);          \
        So.ps = (const LAS int*)(misc + MISC_PS); So.cn = (const LAS int*)(misc + MISC_CNT); So.inv = a.inv; EpiGU E{a.Hm8};      \
        pg8::gemm_phase_gather<EpiGU, GroupedOrderG, true, 125, 121>(lds, g, So, E); } SEAM(P + 1);                                               \
    PH(P + 2) { const int NP = moe_tables(a.counts + (layer) * 64, misc, tid);                                                    \
        pg8::Gemm g{(const bf16_t*)a.Hm8, (const bf16_t*)(a.Bt_dn8 + (size_t)(layer) * NE * D * MH), NP * 256, NE * 2048, MH / 2};   \
        GroupedOrder So{NP, NP * 8, G, vcu, (const LAS int*)(misc + MISC_PE)}; EpiBf16G E{a.Y, D, 1.f / 128.f};                                \
        pg8::gemm_phase<EpiBf16G, GroupedOrder, true, true, true, 125, 122>(lds, g, So, E); } SEAM(P + 2);
    MOE_PHASES(6, 0, mod0)
    PH(9) { moe_tables(a.counts, misc, tid); phase_combine_gates(a, mod0, mod1, a.nmg + D, (const LAS int*)(misc + MISC_PS), lds, vcu, G, opq(tid), wave, opq(lane)); } SEAM(9);
    PH(10) {
        pg8::Gemm g{(const bf16_t*)a.hb8, (const bf16_t*)a.Bt_min8, NT, 6144, D / 2}; pg8::StaticOrder So; So.init(NT, 6144, G, bx);
        EpiMin E{a.P3};
        pg8::gemm_phase<EpiMin, pg8::StaticOrder, true, true, true>(lds, g, So, E);
    } SEAM(10);
    PH(11) { phase_mprep(a, lds, vcu, G, opq(tid)); } SEAM(11);
    PH(12) { phase_mlstm(a, lds, vcu, G, opq(tid), wave, opq(lane)); } SEAM(12);
    PH(13) { phase_mnorm(a, gw, NGW, opq(lane)); } SEAM(13);
    PH(14) {
        pg8::Gemm g{(const bf16_t*)a.ob8, (const bf16_t*)a.Bt_mo8, NT, D, D / 2}; pg8::StaticOrder So; So.init(NT, D, G, bx);
        EpiResid<false> E{a.xres, a.xres, mod1 + 2 * D, 1.f / 512.f};
        pg8::gemm_phase<EpiResid<false>, pg8::StaticOrder, true, true, true>(lds, g, So, E);
    } SEAM(14);
    MOE_PHASES(15, 1, mod1)
    PH(18) { moe_tables(a.counts + 64, misc, tid); phase_combine_final(a, mod1, (const LAS int*)(misc + MISC_PS), gw, NGW, opq(lane)); }
#undef PH
#undef IN
#undef SEAM
}
}

extern "C" void kernel_launch(void* const* d_in, const int* in_sizes, int n_in, void* d_out, int out_size, void* d_ws, size_t ws_size, hipStream_t st) {
    using namespace mk;
    static int grid = 0;
    if (grid == 0) {
        int dev = 0, cus = 0;
        if (hipGetDevice(&dev) != hipSuccess || hipDeviceGetAttribute(&cus, hipDeviceAttributeMultiprocessorCount, dev) != hipSuccess || cus <= 0) cus = 256;
        (void)hipFuncSetAttribute((const void*)mk_fwd, hipFuncAttributeMaxDynamicSharedMemorySize, LDS_BYTES);
        int per_cu = 0; (void)hipOccupancyMaxActiveBlocksPerMultiprocessor(&per_cu, (const void*)mk_fwd, NTHR, LDS_BYTES);
        (void)hipGetLastError();
        grid = cus;
    }
    Args a{};
    a.x = (const float*)d_in[0]; a.c = (const float*)d_in[1]; a.pos = (const int*)d_in[2];
    a.ada_w = (const float*)d_in[3]; a.ada_b = (const float*)d_in[4]; a.nmg = (const float*)d_in[5]; a.nfg = (const float*)d_in[6]; a.fng = (const float*)d_in[7];
    a.a_win = (const float*)d_in[8]; a.a_wout = (const float*)d_in[9];
    a.lq1 = (const float*)d_in[10]; a.lk1 = (const float*)d_in[11]; a.lq2 = (const float*)d_in[12]; a.lk2 = (const float*)d_in[13]; a.a_hg = (const float*)d_in[14];
    a.m_win = (const float*)d_in[15]; a.m_cw = (const float*)d_in[16]; a.m_cb = (const float*)d_in[17]; a.m_gb = (const float*)d_in[18]; a.m_hg = (const float*)d_in[19]; a.m_wout = (const float*)d_in[20];
    a.wg = (const float*)d_in[21]; a.bg = (const float*)d_in[22]; a.we = (const float*)d_in[23]; a.be = (const float*)d_in[24]; a.wgu = (const float*)d_in[25]; a.wdn = (const float*)d_in[26];
    a.out = (float*)d_out;
    char* w = (char*)d_ws; size_t off = 0;
    auto alloc = [&](size_t bytes) { void* p = w + off; off += (bytes + 4095) & ~(size_t)4095; return p; };
    a.ctl = (unsigned*)alloc(1 << 20);
    a.counts = (int*)(a.ctl + 65536);
    a.mod = (float*)alloc((size_t)2 * NB * 6 * D * 4);
    a.cs = (float2*)alloc((size_t)NT * 16 * 8);
    a.Bt_qkv = (bf16_t*)alloc((size_t)6144 * D * 2); a.Bt_ao = (bf16_t*)alloc((size_t)D * D * 2); a.Bt_min = nullptr; a.Bt_mo = nullptr; a.Bt_min8 = (unsigned char*)alloc((size_t)6144 * D); a.Bt_mo8 = (unsigned char*)alloc((size_t)D * D);
    a.Bt_rt = (bf16_t*)alloc((size_t)2 * 256 * D * 2); a.Bt_g = (bf16_t*)alloc((size_t)16 * D * 2); a.Bt_gu = nullptr; a.Bt_dn = nullptr;
    a.Bt_gu8 = (unsigned char*)alloc((size_t)2 * NE * 2048 * D); a.Bt_dn8 = (unsigned char*)alloc((size_t)2 * NE * D * MH); a.hb8 = (unsigned char*)alloc((size_t)(NT + 1) * D);
    a.xres = (bf16_t*)alloc((size_t)NT * D * 2); a.hb = (bf16_t*)alloc((size_t)(NT + 1) * D * 2); a.ob = (bf16_t*)alloc((size_t)NT * D * 2); a.ob8 = (unsigned char*)a.ob;

    a.logits = nullptr; a.eid = (int*)alloc((size_t)NA * 4); a.wts = (float*)alloc((size_t)NA * 4); a.pos_in_e = (int*)alloc((size_t)NA * 4); a.slot = nullptr; a.inv = (int*)alloc((size_t)NE * 32768 * 4);
    a.Qh = (bf16_t*)alloc((size_t)3 * NT * 2048 * 2); a.Kh = a.Qh + (size_t)NT * 2048; a.Vh = a.Kh + (size_t)NT * 2048; a.Oa = (bf16_t*)alloc((size_t)NT * 4096 * 2);
    a.P3 = (bf16_t*)alloc((size_t)3 * NT * 2048 * 2); a.Qn = (bf16_t*)alloc((size_t)2 * NT * 1024 * 2); a.Kn = a.Qn + (size_t)NT * 1024;
    a.KT = (bf16_t*)alloc((size_t)NT * 1024 * 2); a.VT = (bf16_t*)alloc((size_t)NT * 2048 * 2); a.HS = (bf16_t*)alloc((size_t)NT * 2048 * 2);
    a.gates = (float*)alloc((size_t)NT * 16 * 4); a.GA = (float*)alloc((size_t)32 * 64 * 192 * 4); a.GS = (float*)alloc((size_t)32 * 64 * 2 * 4);
    a.XG = nullptr; a.Hm = nullptr; a.Hm8 = (unsigned char*)alloc((size_t)PMAX * MH); a.Y = (bf16_t*)alloc((size_t)PMAX * D * 2);
    if (off > ws_size) return;

    (void)hipMemsetAsync(a.ctl, 0, 1 << 20, st);
    auto run = [&](int lo, int hi) { a.ph_lo = lo; a.ph_hi = hi; hipLaunchKernelGGL(mk_fwd, dim3(grid), dim3(NTHR), LDS_BYTES, st, a); };
#ifndef MK_N_LAUNCHES
#define MK_N_LAUNCHES 1
#endif
#if MK_N_LAUNCHES == 1
    run(0, 19);
#else
    for (int p = 0; p <= 18; ++p) run(p, p + 1);
#endif
}
```

```cpp
#include <hip/hip_runtime.h>
#include <math.h>
#include <stdint.h>


namespace pg8 {
#define PG8_LAS __attribute__((address_space(3)))
typedef unsigned short bf16_t;
typedef short bf16x8 __attribute__((ext_vector_type(8)));
typedef float f32x4 __attribute__((ext_vector_type(4)));
typedef unsigned u32x4 __attribute__((ext_vector_type(4)));
constexpr int BM = 256, BK = 64, HALF = 128, KBP = 1088  , HTB = 16 * KBP  , STAGE_BYTES = 8 * HTB, NXCD = 8, WGM = 8;

__host__ __device__ __forceinline__ int lds_byte(int r, int c) { const int ch = c >> 3, p = (ch & 4) | ((ch & 3) ^ ((r >> 1) & 3)); return (r >> 3) * KBP + (r & 7) * 128 + p * 16 + (c & 7) * 2; }
__host__ __device__ __forceinline__ void stage_rc(int tid, int i, int& R, int& C) { const int g = (tid >> 6) + 8 * i, l = tid & 63, rr = l >> 3, p = l & 7, ch = (p & 4) | ((p & 3) ^ ((rr >> 1) & 3)); R = 8 * g + rr; C = ch * 8; }
__host__ __device__ __forceinline__ int perm32(int rho) { const int n = rho >> 4, i = rho & 15; return 8 * (i >> 2) + 4 * n + (i & 3); }

typedef int i32x4 __attribute__((ext_vector_type(4)));
typedef int i32x8 __attribute__((ext_vector_type(8)));
typedef int i32x2 __attribute__((ext_vector_type(2)));
__device__ __forceinline__ i32x8 cat8(i32x4 l, i32x4 h) { return __builtin_shufflevector(l, h, 0, 1, 2, 3, 4, 5, 6, 7); }
__device__ __forceinline__ void mfma_scale_f8(f32x4& acc, i32x8 b, i32x8 a, int sc) {
    asm volatile("v_mfma_scale_f32_16x16x128_f8f6f4 %0, %1, %2, %0, %3, %3 op_sel_hi:[0,0,0]" : "+v"(acc) : "v"(b), "v"(a), "v"(sc));
}
struct Unit { int pm, pn; };
struct Gemm { const bf16_t* A; const bf16_t* Bt; int M, N, K; };

struct StaticOrder {
    int nM, nN, nwg, G, c;
    __host__ __device__ void init(int M, int N, int G_, int c_) { nM = M / BM; nN = N / BM; nwg = nM * nN; G = G_; c = c_; }
    __host__ __device__ bool next(int i, Unit& u) const {
        const long L = (long)i * G + c; if (L >= nwg) return false;
        int wgid = (int)L; { const int q = nwg / NXCD, r = nwg % NXCD, xcd = wgid % NXCD, off = wgid / NXCD; wgid = (xcd < r ? xcd * (q + 1) : r * (q + 1) + (xcd - r) * q) + off; }
        const int nig = WGM * nN, gid = wgid / nig, fm = gid * WGM, gsz = (nM - fm) < WGM ? (nM - fm) : WGM;
        u.pm = fm + ((wgid % nig) % gsz); u.pn = (wgid % nig) / gsz; return true;
    }
    __device__ __forceinline__ void a_ready(const Unit&) const {}
    __device__ __forceinline__ void done(const Unit&) const {}
};

__device__ __forceinline__ unsigned cvt_pk_bf16(float lo, float hi) { unsigned r; asm volatile("v_cvt_pk_bf16_f32 %0, %1, %2" : "=v"(r) : "v"(lo), "v"(hi)); return r; }
typedef float f32x2 __attribute__((ext_vector_type(2)));
__device__ __forceinline__ f32x2 gelu_pk(f32x2 v) {
    const f32x2 av = __builtin_elementwise_abs(v), d = av * 0.2316418882f + 1.0f;
    f32x2 t; t.x = __builtin_amdgcn_rcpf(d.x); t.y = __builtin_amdgcn_rcpf(d.y);
    f32x2 q = t * 0.5307027145f + (-0.7265760135f); q = q * t + 0.7107068705f; q = q * t + (-0.142248368f); q = q * t + 0.127414796f; q = q * t;
    const f32x2 s = (v * v) * (-0.72134752044f);
    f32x2 e; e.x = __builtin_amdgcn_exp2f(s.x); e.y = __builtin_amdgcn_exp2f(s.y);
    const f32x2 m = v * (q * e), r = v - m;
    f32x2 o; o.x = v.x < 0.f ? m.x : r.x; o.y = v.y < 0.f ? m.y : r.y; return o;
}


template <class Epi, class Sched, bool ALIGN_EPI = false, bool SP2 = false, bool F8 = false, int SCA = 127, int SCB = 127>
__device__ __forceinline__ void gemm_phase(PG8_LAS unsigned char* lds, const Gemm g, const Sched& S, const Epi& E) {
    const int tid = threadIdx.x, wid = __builtin_amdgcn_readfirstlane(tid >> 6), lane = tid & 63, wr = wid >> 2, wc = wid & 3, fr = lane & 15, fq = lane >> 4;
    const int K = g.K, nt = K / BK;
    unsigned voffA[2], voffB[2];
#pragma unroll
    for (int i = 0; i < 2; ++i) { int R, C; stage_rc(tid, i, R, C); const int Rb = Epi::PERM ? ((R & ~31) + perm32(R & 31)) : R;
        voffA[i] = (unsigned)(R * K + C) * 2u; voffB[i] = (unsigned)(Rb * K + C) * 2u; }
    const size_t kstep = (size_t)(BK * 2);
    const size_t hstep = (size_t)HALF * K * 2;
    const size_t tstep = 2 * hstep;
    const unsigned ldsw = (unsigned)wid * (unsigned)KBP;
    const int aoff = lds_byte(wr * 64 + fr, fq * 8), boff = lds_byte(wc * 32 + fr, fq * 8);
#define PG8_SA(b, h) (((b) * 2 + (h)) * HTB)
#define PG8_SB(b, h) ((4 + (b) * 2 + (h)) * HTB)
#define PG8_STAGE(bufoff, gbase, voff) do { _Pragma("unroll") for (int _i = 0; _i < 2; ++_i) \
        __builtin_amdgcn_global_load_lds((const unsigned*)((const char*)(gbase) + (voff)[_i]), (PG8_LAS unsigned*)(lds + (bufoff) + ldsw + _i * (8 * KBP)), 16, 0, 0); } while (0)
#define PG8_LDA(dst, b, h) do { if constexpr (F8) { _Pragma("unroll") for (int m = 0; m < 4; ++m) dst##8[m] = cat8(*(const PG8_LAS i32x4*)(lds + PG8_SA(b, h) + aoff + m * (2 * KBP)), *(const PG8_LAS i32x4*)(lds + PG8_SA(b, h) + aoff + m * (2 * KBP) + 64)); } \
        else { _Pragma("unroll") for (int m = 0; m < 4; ++m) _Pragma("unroll") for (int k = 0; k < 2; ++k) dst[m][k] = *(const PG8_LAS bf16x8*)(lds + PG8_SA(b, h) + aoff + m * (2 * KBP) + k * 64); } } while (0)
#define PG8_LDB(dst, b, h) do { if constexpr (F8) { _Pragma("unroll") for (int n = 0; n < 2; ++n) dst##8[n] = cat8(*(const PG8_LAS i32x4*)(lds + PG8_SB(b, h) + boff + n * (2 * KBP)), *(const PG8_LAS i32x4*)(lds + PG8_SB(b, h) + boff + n * (2 * KBP) + 64)); } \
        else { _Pragma("unroll") for (int n = 0; n < 2; ++n) _Pragma("unroll") for (int k = 0; k < 2; ++k) dst[n][k] = *(const PG8_LAS bf16x8*)(lds + PG8_SB(b, h) + boff + n * (2 * KBP) + k * 64); } } while (0)
#define PG8_MMA(ai, bj, At, Bt) do { __builtin_amdgcn_s_setprio(1); _Pragma("unroll") for (int m = 0; m < 4; ++m) _Pragma("unroll") for (int n = 0; n < 2; ++n) { \
        if constexpr (F8) { mfma_scale_f8(acc[ai][bj][m][n], Bt##8[n], At##8[m], sc1); } \
        else { _Pragma("unroll") for (int k = 0; k < 2; ++k) acc[ai][bj][m][n] = __builtin_amdgcn_mfma_f32_16x16x32_bf16(Bt[n][k], At[m][k], acc[ai][bj][m][n], 0, 0, 0); } } \
        __builtin_amdgcn_s_setprio(0); } while (0)
#define PG8_WAIT_V(n) asm volatile("s_waitcnt vmcnt(" #n ")" ::: "memory")
#define PG8_WAIT_L(n) asm volatile("s_waitcnt lgkmcnt(" #n ")" ::: "memory")
#define PG8_BAR __builtin_amdgcn_s_barrier()
#define PG8_SCHED __builtin_amdgcn_sched_barrier(0)
    Unit cur, nxt; int ui = 0;
    if (!S.next(0, cur)) return;
    f32x4 acc[2][2][4][2];
#pragma unroll
    for (int a = 0; a < 2; ++a)
#pragma unroll
        for (int b = 0; b < 2; ++b)
#pragma unroll
            for (int m = 0; m < 4; ++m)
#pragma unroll
                for (int n = 0; n < 2; ++n) acc[a][b][m][n] = (f32x4){0.f, 0.f, 0.f, 0.f};
    bf16x8 At[4][2], B0[2][2], B1[2][2]; i32x8 At8[4], B08[2], B18[2]; int sc1 = 0x7f7f7f7f; asm volatile("" : "+v"(sc1));
    const char* cA = (const char*)g.A + (size_t)cur.pm * tstep; const char* cB = (const char*)g.Bt + (size_t)cur.pn * tstep;
    S.a_ready(cur);
    if constexpr (SP2) {
        PG8_STAGE(PG8_SB(0, 0), cB, voffB); PG8_STAGE(PG8_SB(0, 1), cB + hstep, voffB); PG8_STAGE(PG8_SA(0, 0), cA, voffA); PG8_STAGE(PG8_SA(0, 1), cA + hstep, voffA);
        if (wr == 1) PG8_BAR;
        PG8_WAIT_V(2); PG8_BAR;
        PG8_STAGE(PG8_SB(1, 0), cB + kstep, voffB); PG8_STAGE(PG8_SA(1, 0), cA + kstep, voffA); PG8_STAGE(PG8_SB(1, 1), cB + hstep + kstep, voffB);
        PG8_WAIT_V(6); PG8_BAR;
    } else {
        PG8_STAGE(PG8_SB(0, 0), cB, voffB); PG8_STAGE(PG8_SA(0, 0), cA, voffA); PG8_STAGE(PG8_SB(0, 1), cB + hstep, voffB); PG8_STAGE(PG8_SA(0, 1), cA + hstep, voffA);
        if (wr == 1) PG8_BAR;
        PG8_WAIT_V(4); PG8_BAR;
        PG8_STAGE(PG8_SB(1, 0), cB + kstep, voffB); PG8_STAGE(PG8_SA(1, 0), cA + kstep, voffA); PG8_STAGE(PG8_SB(1, 1), cB + hstep + kstep, voffB);
        PG8_WAIT_V(6); PG8_BAR;
    }
    for (;;) {
        const bool has_next = S.next(ui + 1, nxt);
        const char* nA = has_next ? (const char*)g.A + (size_t)nxt.pm * tstep : cA; const char* nB = has_next ? (const char*)g.Bt + (size_t)nxt.pn * tstep : cB;
#pragma nounroll
        for (int t = 0; t < nt; t += 2) {
            const bool last = (t == nt - 2);
            const char* a1 = cA + (size_t)(t + 1) * kstep;
            const char* a2 = last ? nA : cA + (size_t)(t + 2) * kstep; const char* b2 = last ? nB : cB + (size_t)(t + 2) * kstep;
            const char* a3 = a2 + kstep; const char* b3 = b2 + kstep;
            if (last && has_next) S.a_ready(nxt);
            if constexpr (SP2) {
            PG8_LDB(B0, 0, 0); PG8_LDB(B1, 0, 1); PG8_SCHED; PG8_LDA(At, 0, 0); PG8_STAGE(PG8_SA(1, 1), a1 + hstep, voffA);
            PG8_WAIT_V(8); PG8_WAIT_L(0); PG8_BAR; PG8_MMA(0, 0, At, B0); PG8_MMA(0, 1, At, B1); PG8_BAR; PG8_SCHED;
            PG8_LDA(At, 0, 1); PG8_STAGE(PG8_SB(0, 0), b2, voffB); PG8_STAGE(PG8_SB(0, 1), b2 + hstep, voffB); PG8_STAGE(PG8_SA(0, 0), a2, voffA);
            PG8_WAIT_V(8); PG8_WAIT_L(0); PG8_BAR; PG8_MMA(1, 0, At, B0); PG8_MMA(1, 1, At, B1); PG8_BAR; PG8_SCHED;
            PG8_LDB(B0, 1, 0); PG8_LDB(B1, 1, 1); PG8_SCHED; PG8_LDA(At, 1, 0); PG8_STAGE(PG8_SA(0, 1), a2 + hstep, voffA);
            PG8_WAIT_V(8); PG8_WAIT_L(0); PG8_BAR; PG8_MMA(0, 0, At, B0); PG8_MMA(0, 1, At, B1); PG8_BAR; PG8_SCHED;
            PG8_LDA(At, 1, 1); PG8_STAGE(PG8_SB(1, 0), b3, voffB); PG8_STAGE(PG8_SB(1, 1), b3 + hstep, voffB); PG8_STAGE(PG8_SA(1, 0), a3, voffA);
            PG8_WAIT_V(8); PG8_WAIT_L(0); PG8_BAR; PG8_MMA(1, 0, At, B0); PG8_MMA(1, 1, At, B1); PG8_BAR; PG8_SCHED;
            } else {
            PG8_LDB(B0, 0, 0); PG8_SCHED; PG8_LDA(At, 0, 0); PG8_STAGE(PG8_SA(1, 1), a1 + hstep, voffA);
            PG8_WAIT_L(8); PG8_BAR; PG8_WAIT_L(0); PG8_MMA(0, 0, At, B0); PG8_BAR; PG8_SCHED;
            PG8_LDB(B1, 0, 1); PG8_STAGE(PG8_SB(0, 0), b2, voffB);
            PG8_BAR; PG8_WAIT_L(0); PG8_MMA(0, 1, At, B1); PG8_BAR;
            PG8_LDA(At, 0, 1); PG8_STAGE(PG8_SA(0, 0), a2, voffA);
            PG8_BAR; PG8_WAIT_L(0); PG8_MMA(1, 0, At, B0); PG8_BAR; PG8_SCHED;
            PG8_STAGE(PG8_SB(0, 1), b2 + hstep, voffB);
            PG8_WAIT_V(6); PG8_BAR; PG8_MMA(1, 1, At, B1); PG8_BAR;
            PG8_LDB(B0, 1, 0); PG8_SCHED; PG8_LDA(At, 1, 0); PG8_STAGE(PG8_SA(0, 1), a2 + hstep, voffA);
            PG8_WAIT_L(8); PG8_BAR; PG8_WAIT_L(0); PG8_MMA(0, 0, At, B0); PG8_BAR; PG8_SCHED;
            PG8_LDB(B1, 1, 1); PG8_STAGE(PG8_SB(1, 0), b3, voffB);
            PG8_BAR; PG8_WAIT_L(0); PG8_MMA(0, 1, At, B1); PG8_BAR;
            PG8_LDA(At, 1, 1); PG8_STAGE(PG8_SA(1, 0), a3, voffA);
            PG8_BAR; PG8_WAIT_L(0); PG8_MMA(1, 0, At, B0); PG8_BAR; PG8_SCHED;
            PG8_STAGE(PG8_SB(1, 1), b3 + hstep, voffB);
            PG8_WAIT_V(6); PG8_BAR; PG8_MMA(1, 1, At, B1); PG8_BAR;
            }
        }
        if constexpr (F8) {
            asm volatile("s_nop 15\n\ts_nop 15" ::: "memory");
            _Pragma("unroll") for (int a = 0; a < 2; ++a) _Pragma("unroll") for (int b = 0; b < 2; ++b) _Pragma("unroll") for (int m = 0; m < 4; ++m) _Pragma("unroll") for (int n = 0; n < 2; ++n) asm volatile("" : "+v"(acc[a][b][m][n]));
        }
        if constexpr (ALIGN_EPI) { if (wr == 0) PG8_BAR; }
        if constexpr (!Epi::AFTER_DRAIN) { E(acc, cur, wr, wc, fr, fq); S.done(cur); }
        if (!has_next) break;
#pragma unroll
        for (int a = 0; a < 2; ++a)
#pragma unroll
            for (int b = 0; b < 2; ++b)
#pragma unroll
                for (int m = 0; m < 4; ++m)
#pragma unroll
                    for (int n = 0; n < 2; ++n) acc[a][b][m][n] = (f32x4){0.f, 0.f, 0.f, 0.f};
        cur = nxt; cA = nA; cB = nB; ++ui;
        if constexpr (ALIGN_EPI) { if (wr == 1) PG8_BAR; }
    }
    PG8_WAIT_V(0);
    if constexpr (!ALIGN_EPI) { if (wr == 0) PG8_BAR; }
    PG8_BAR;
    if constexpr (Epi::AFTER_DRAIN) { E.fused(acc, cur, wr, wc, fr, fq, lds, wid, lane); S.done(cur); }
#undef PG8_SA
#undef PG8_SB
#undef PG8_STAGE
#undef PG8_LDA
#undef PG8_LDB
#undef PG8_MMA
#undef PG8_WAIT_V
#undef PG8_WAIT_L
#undef PG8_BAR
#undef PG8_SCHED
}
template <class Epi, class Sched, bool F8 = false, int SCA = 127, int SCB = 127>
__device__ __forceinline__ void gemm_phase_gather(PG8_LAS unsigned char* lds, const Gemm g, const Sched& S, const Epi& E) {
    const int tid = threadIdx.x, wid = __builtin_amdgcn_readfirstlane(tid >> 6), lane = tid & 63, wr = wid >> 2, wc = wid & 3, fr = lane & 15, fq = lane >> 4;
    constexpr bool ALIGN_EPI = true, SP2 = true;
    const int K = g.K, nt = K / BK;
    unsigned voffA[2], voffB[2]; int rowA[2];
#pragma unroll
    for (int i = 0; i < 2; ++i) { int R, C; stage_rc(tid, i, R, C); const int Rb = Epi::PERM ? ((R & ~31) + perm32(R & 31)) : R;
        voffA[i] = (unsigned)C * 2u; rowA[i] = R; voffB[i] = (unsigned)(Rb * K + C) * 2u; }
    const size_t kstep = (size_t)(BK * 2);
    const size_t hstep = (size_t)HALF * K * 2;
    const size_t tstep = 2 * hstep;
    const unsigned ldsw = (unsigned)wid * (unsigned)KBP;
    const int aoff = lds_byte(wr * 64 + fr, fq * 8), boff = lds_byte(wc * 32 + fr, fq * 8);
#define PG8_SA(b, h) (((b) * 2 + (h)) * HTB)
#define PG8_SB(b, h) ((4 + (b) * 2 + (h)) * HTB)
#define PG8_STAGE(bufoff, gbase, voff) do { _Pragma("unroll") for (int _i = 0; _i < 2; ++_i) \
        __builtin_amdgcn_global_load_lds((const unsigned*)((const char*)(gbase) + (voff)[_i]), (PG8_LAS unsigned*)(lds + (bufoff) + ldsw + _i * (8 * KBP)), 16, 0, 0); } while (0)
#define PG8_STAGE_A(bufoff, gbase, o0, o1) do { \
        __builtin_amdgcn_global_load_lds((const unsigned*)((const char*)(gbase) + (o0)), (PG8_LAS unsigned*)(lds + (bufoff) + ldsw), 16, 0, 0); \
        __builtin_amdgcn_global_load_lds((const unsigned*)((const char*)(gbase) + (o1)), (PG8_LAS unsigned*)(lds + (bufoff) + ldsw + 8 * KBP), 16, 0, 0); } while (0)
#define PG8_GOFF(dst, u) do { _Pragma("unroll") for (int h_ = 0; h_ < 2; ++h_) _Pragma("unroll") for (int i_ = 0; i_ < 2; ++i_) dst[h_][i_] = (unsigned)S.a_row(u, 128 * h_ + rowA[i_]) * (unsigned)(K * 2) + voffA[i_]; } while (0)
#define PG8_LDA(dst, b, h) do { if constexpr (F8) { _Pragma("unroll") for (int m = 0; m < 4; ++m) dst##8[m] = cat8(*(const PG8_LAS i32x4*)(lds + PG8_SA(b, h) + aoff + m * (2 * KBP)), *(const PG8_LAS i32x4*)(lds + PG8_SA(b, h) + aoff + m * (2 * KBP) + 64)); } \
        else { _Pragma("unroll") for (int m = 0; m < 4; ++m) _Pragma("unroll") for (int k = 0; k < 2; ++k) dst[m][k] = *(const PG8_LAS bf16x8*)(lds + PG8_SA(b, h) + aoff + m * (2 * KBP) + k * 64); } } while (0)
#define PG8_LDB(dst, b, h) do { if constexpr (F8) { _Pragma("unroll") for (int n = 0; n < 2; ++n) dst##8[n] = cat8(*(const PG8_LAS i32x4*)(lds + PG8_SB(b, h) + boff + n * (2 * KBP)), *(const PG8_LAS i32x4*)(lds + PG8_SB(b, h) + boff + n * (2 * KBP) + 64)); } \
        else { _Pragma("unroll") for (int n = 0; n < 2; ++n) _Pragma("unroll") for (int k = 0; k < 2; ++k) dst[n][k] = *(const PG8_LAS bf16x8*)(lds + PG8_SB(b, h) + boff + n * (2 * KBP) + k * 64); } } while (0)
#define PG8_MMA(ai, bj, At, Bt) do { __builtin_amdgcn_s_setprio(1); _Pragma("unroll") for (int m = 0; m < 4; ++m) _Pragma("unroll") for (int n = 0; n < 2; ++n) { \
        if constexpr (F8) { mfma_scale_f8(acc[ai][bj][m][n], Bt##8[n], At##8[m], sc1); } \
        else { _Pragma("unroll") for (int k = 0; k < 2; ++k) acc[ai][bj][m][n] = __builtin_amdgcn_mfma_f32_16x16x32_bf16(Bt[n][k], At[m][k], acc[ai][bj][m][n], 0, 0, 0); } } \
        __builtin_amdgcn_s_setprio(0); } while (0)
#define PG8_WAIT_V(n) asm volatile("s_waitcnt vmcnt(" #n ")" ::: "memory")
#define PG8_WAIT_L(n) asm volatile("s_waitcnt lgkmcnt(" #n ")" ::: "memory")
#define PG8_BAR __builtin_amdgcn_s_barrier()
#define PG8_SCHED __builtin_amdgcn_sched_barrier(0)
    Unit cur, nxt; int ui = 0;
    if (!S.next(0, cur)) return;
    f32x4 acc[2][2][4][2];
#pragma unroll
    for (int a = 0; a < 2; ++a)
#pragma unroll
        for (int b = 0; b < 2; ++b)
#pragma unroll
            for (int m = 0; m < 4; ++m)
#pragma unroll
                for (int n = 0; n < 2; ++n) acc[a][b][m][n] = (f32x4){0.f, 0.f, 0.f, 0.f};
    bf16x8 At[4][2], B0[2][2], B1[2][2]; i32x8 At8[4], B08[2], B18[2]; int sc1 = 0x7f7f7f7f; asm volatile("" : "+v"(sc1));
    const char* const cA = (const char*)g.A; const char* cB = (const char*)g.Bt + (size_t)cur.pn * tstep;
    unsigned gc[2][2], gn[2][2];
    S.a_ready(cur); PG8_GOFF(gc, cur);
    if constexpr (SP2) {
        PG8_STAGE(PG8_SB(0, 0), cB, voffB); PG8_STAGE(PG8_SB(0, 1), cB + hstep, voffB); PG8_STAGE_A(PG8_SA(0, 0), cA, gc[0][0], gc[0][1]); PG8_STAGE_A(PG8_SA(0, 1), cA, gc[1][0], gc[1][1]);
        if (wr == 1) PG8_BAR;
        PG8_WAIT_V(2); PG8_BAR;
        PG8_STAGE(PG8_SB(1, 0), cB + kstep, voffB); PG8_STAGE_A(PG8_SA(1, 0), cA + kstep, gc[0][0], gc[0][1]); PG8_STAGE(PG8_SB(1, 1), cB + hstep + kstep, voffB);
        PG8_WAIT_V(6); PG8_BAR;
    }
    for (;;) {
        const bool has_next = S.next(ui + 1, nxt);
        const char* nB = has_next ? (const char*)g.Bt + (size_t)nxt.pn * tstep : cB;
        if (has_next) { PG8_GOFF(gn, nxt); } else { _Pragma("unroll") for (int h_ = 0; h_ < 2; ++h_) _Pragma("unroll") for (int i_ = 0; i_ < 2; ++i_) gn[h_][i_] = gc[h_][i_]; }
#pragma nounroll
        for (int t = 0; t < nt; t += 2) {
            const bool last = (t == nt - 2);
            const char* a1 = cA + (size_t)(t + 1) * kstep;
            const char* a2 = last ? cA : cA + (size_t)(t + 2) * kstep; const char* b2 = last ? nB : cB + (size_t)(t + 2) * kstep;
            const unsigned g200 = last ? gn[0][0] : gc[0][0], g201 = last ? gn[0][1] : gc[0][1], g210 = last ? gn[1][0] : gc[1][0], g211 = last ? gn[1][1] : gc[1][1];
            const char* a3 = a2 + kstep; const char* b3 = b2 + kstep;
            if (last && has_next) S.a_ready(nxt);
            if constexpr (SP2) {
            PG8_LDB(B0, 0, 0); PG8_LDB(B1, 0, 1); PG8_SCHED; PG8_LDA(At, 0, 0); PG8_STAGE_A(PG8_SA(1, 1), a1, gc[1][0], gc[1][1]);
            PG8_WAIT_V(8); PG8_WAIT_L(0); PG8_BAR; PG8_MMA(0, 0, At, B0); PG8_MMA(0, 1, At, B1); PG8_BAR; PG8_SCHED;
            PG8_LDA(At, 0, 1); PG8_STAGE(PG8_SB(0, 0), b2, voffB); PG8_STAGE(PG8_SB(0, 1), b2 + hstep, voffB); PG8_STAGE_A(PG8_SA(0, 0), a2, g200, g201);
            PG8_WAIT_V(8); PG8_WAIT_L(0); PG8_BAR; PG8_MMA(1, 0, At, B0); PG8_MMA(1, 1, At, B1); PG8_BAR; PG8_SCHED;
            PG8_LDB(B0, 1, 0); PG8_LDB(B1, 1, 1); PG8_SCHED; PG8_LDA(At, 1, 0); PG8_STAGE_A(PG8_SA(0, 1), a2, g210, g211);
            PG8_WAIT_V(8); PG8_WAIT_L(0); PG8_BAR; PG8_MMA(0, 0, At, B0); PG8_MMA(0, 1, At, B1); PG8_BAR; PG8_SCHED;
            PG8_LDA(At, 1, 1); PG8_STAGE(PG8_SB(1, 0), b3, voffB); PG8_STAGE(PG8_SB(1, 1), b3 + hstep, voffB); PG8_STAGE_A(PG8_SA(1, 0), a3, g200, g201);
            PG8_WAIT_V(8); PG8_WAIT_L(0); PG8_BAR; PG8_MMA(1, 0, At, B0); PG8_MMA(1, 1, At, B1); PG8_BAR; PG8_SCHED;
            }
        }
        if constexpr (F8) {
            asm volatile("s_nop 15\n\ts_nop 15" ::: "memory");
            _Pragma("unroll") for (int a = 0; a < 2; ++a) _Pragma("unroll") for (int b = 0; b < 2; ++b) _Pragma("unroll") for (int m = 0; m < 4; ++m) _Pragma("unroll") for (int n = 0; n < 2; ++n) asm volatile("" : "+v"(acc[a][b][m][n]));
        }
        if constexpr (ALIGN_EPI) { if (wr == 0) PG8_BAR; }
        if constexpr (!Epi::AFTER_DRAIN) { E(acc, cur, wr, wc, fr, fq); S.done(cur); }
        if (!has_next) break;
#pragma unroll
        for (int a = 0; a < 2; ++a)
#pragma unroll
            for (int b = 0; b < 2; ++b)
#pragma unroll
                for (int m = 0; m < 4; ++m)
#pragma unroll
                    for (int n = 0; n < 2; ++n) acc[a][b][m][n] = (f32x4){0.f, 0.f, 0.f, 0.f};
        cur = nxt; cB = nB; ++ui;
#pragma unroll
        for (int h_ = 0; h_ < 2; ++h_)
#pragma unroll
            for (int i_ = 0; i_ < 2; ++i_) gc[h_][i_] = gn[h_][i_];
        if constexpr (ALIGN_EPI) { if (wr == 1) PG8_BAR; }
    }
    PG8_WAIT_V(0);
    if constexpr (!ALIGN_EPI) { if (wr == 0) PG8_BAR; }
    PG8_BAR;
    if constexpr (Epi::AFTER_DRAIN) { E.fused(acc, cur, wr, wc, fr, fq, lds, wid, lane); S.done(cur); }
#undef PG8_SA
#undef PG8_SB
#undef PG8_STAGE
#undef PG8_STAGE_A
#undef PG8_GOFF
#undef PG8_LDA
#undef PG8_LDB
#undef PG8_MMA
#undef PG8_WAIT_V
#undef PG8_WAIT_L
#undef PG8_BAR
#undef PG8_SCHED
}
}

namespace att {
constexpr int D = 128;
constexpr float THR = 8.f;
constexpr bool WSKIP = false;
constexpr float SCALE = 0.08838834764831845f;
constexpr int NW = 8, QBLK = 32, KVBLK = 64, QB = NW * QBLK;
constexpr int SHM_V = KVBLK * D * 2, SHM_K = KVBLK * D * 2;
constexpr int ATT_LDS_BYTES = 2 * SHM_V + 2 * SHM_K + NW * 64 * 4;
typedef short bf16x8 __attribute__((ext_vector_type(8)));
typedef short s16x4 __attribute__((ext_vector_type(4)));
typedef float f32x16 __attribute__((ext_vector_type(16)));
typedef float f32x4 __attribute__((ext_vector_type(4)));
typedef unsigned u32x4 __attribute__((ext_vector_type(4)));
template <class A, class Bt> struct same_t { static constexpr bool v = false; };
template <class A> struct same_t<A, A> { static constexpr bool v = true; };

#define KSWZ(row, colB) ((row) * 256 + ((colB) ^ (((row) & 7) << 4)))
#define SBAR() __builtin_amdgcn_sched_barrier(0)
__device__ __forceinline__ int v_st(int k, int c) { const int kk = (k & ~0xC) | ((k & 4) << 1) | ((k & 8) >> 1); return ((kk >> 3) * 4 + (c >> 5)) * 512 + ((kk & 7) * 32 + (c & 31)) * 2; }
__device__ __forceinline__ int v_rd_base(int lane) { return ((lane & 3) << 3) | (((lane >> 2) & 3) << 6) | (((lane >> 4) & 1) << 5) | (((lane >> 5) & 1) << 8); }
constexpr int v_rd_off(int d0, int ks, int half) { return d0 * 512 + ks * 4096 + half * 2048; }
__device__ __forceinline__ int crow(int r, int hi) { return (r & 3) + 8 * (r >> 2) + 4 * hi; }
__device__ __forceinline__ unsigned cvtpk(float lo, float hi) {
    unsigned r; asm volatile("v_cvt_pk_bf16_f32 %0, %1, %2" : "=v"(r) : "v"(lo), "v"(hi)); return r;
}
__device__ __forceinline__ bf16x8 pack8(f32x4 a, f32x4 b) {
    u32x4 w = {cvtpk(a[0], a[1]), cvtpk(a[2], a[3]), cvtpk(b[0], b[1]), cvtpk(b[2], b[3])};
    return *reinterpret_cast<bf16x8*>(&w);
}
template <class T> __device__ __forceinline__ bf16x8 load8(const T* p) {
    if constexpr (same_t<T, float>::v) { return pack8(*(const f32x4*)p, *(const f32x4*)(p + 4)); }
    else { return *reinterpret_cast<const bf16x8*>(p); }
}
__device__ __forceinline__ void mask_tile(f32x16& p0, f32x16& p1, int dq, unsigned W) {
    const float NEG = -__builtin_inff();
#pragma unroll
    for (int r = 0; r < 16; ++r) {
        const int c = (r & 3) + 8 * (r >> 2);
        if ((unsigned)(dq - c) >= W) p0[r] = NEG;
        if ((unsigned)(dq - c - 32) >= W) p1[r] = NEG;
    }
}
__device__ __forceinline__ void partialSM(f32x16& p0, f32x16& p1, float& m_reg, float& mn, float& alpha) {
    float pmax = p0[0]; for (int r = 1; r < 16; ++r) pmax = fmaxf(pmax, p0[r]); for (int r = 0; r < 16; ++r) pmax = fmaxf(pmax, p1[r]);
    { auto rr = __builtin_amdgcn_permlane32_swap(__float_as_uint(pmax), __float_as_uint(pmax), false, false);
      pmax = fmaxf(__uint_as_float(rr[0]), __uint_as_float(rr[1])); }
    constexpr float C2 = 1.4426950408889634f * SCALE;
    if (__builtin_expect(__all((pmax - m_reg) * SCALE <= THR), 1)) { mn = m_reg; alpha = 1.f; }
    else { mn = fmaxf(m_reg, pmax); alpha = __builtin_amdgcn_exp2f((m_reg - mn) * C2); m_reg = mn; }
    const float mnL = -mn * C2;
    for (int r = 0; r < 16; ++r) p0[r] = fmaf(p0[r], C2, mnL); for (int r = 0; r < 16; ++r) p1[r] = fmaf(p1[r], C2, mnL);
    for (int r = 0; r < 16; ++r) p0[r] = __builtin_amdgcn_exp2f(p0[r]);
}
__device__ __forceinline__ void finishSM(f32x16& p0, f32x16& p1, float alpha, float& l_reg, bf16x8& pa0, bf16x8& pa1, bf16x8& pa2, bf16x8& pa3) {
    for (int r = 0; r < 16; ++r) p1[r] = __builtin_amdgcn_exp2f(p1[r]);
    float ps = 0; for (int r = 0; r < 16; ++r) ps += p0[r]; for (int r = 0; r < 16; ++r) ps += p1[r];
    { auto rr = __builtin_amdgcn_permlane32_swap(__float_as_uint(ps), __float_as_uint(ps), false, false);
      ps = __uint_as_float(rr[0]) + __uint_as_float(rr[1]); }
    l_reg = l_reg * alpha + ps;
#define PK4(P, B_, OUT) do { unsigned a0 = cvtpk(P[B_+0], P[B_+1]), a1 = cvtpk(P[B_+2], P[B_+3]);                          \
        unsigned b0 = cvtpk(P[B_+4], P[B_+5]), b1 = cvtpk(P[B_+6], P[B_+7]);                                             \
        auto r0 = __builtin_amdgcn_permlane32_swap(a0, b0, false, false); auto r1 = __builtin_amdgcn_permlane32_swap(a1, b1, false, false); \
        u32x4 w = {r0[0], r1[0], r0[1], r1[1]}; OUT = *reinterpret_cast<bf16x8*>(&w); } while (0)
    PK4(p0, 0, pa0); PK4(p0, 8, pa1); PK4(p1, 0, pa2); PK4(p1, 8, pa3);
#undef PK4
}
template <int KB, bool SK>
__device__ __forceinline__ void qkt(f32x16& p0, f32x16& p1, const char* K_lds, int r32, int hi, const bf16x8* qr, bool act) {
    if (SK && !act) { const float NEG = -__builtin_inff();
#pragma unroll
        for (int r = 0; r < 16; ++r) { p0[r] = NEG; p1[r] = NEG; } return; }
    p0 = f32x16{}; p1 = f32x16{};
    const char* kb[4];
#pragma unroll
    for (int dd = 0; dd < 4; ++dd) kb[dd] = K_lds + KB * SHM_K + KSWZ(r32, (dd * 16 + hi * 8) * 2);
#pragma unroll
    for (int d0 = 0; d0 < 8; ++d0) { const char* a = kb[d0 & 3] + (d0 >> 2) * 128;
        bf16x8 b0 = *reinterpret_cast<const bf16x8*>(a);
        bf16x8 b1 = *reinterpret_cast<const bf16x8*>(a + 32 * 256);
        p0 = __builtin_amdgcn_mfma_f32_32x32x16_bf16(b0, qr[d0], p0, 0, 0, 0);
        p1 = __builtin_amdgcn_mfma_f32_32x32x16_bf16(b1, qr[d0], p1, 0, 0, 0); }
}
template <int VB, bool SK>
__device__ __forceinline__ void pv_tile(f32x16* o, int vb0, bf16x8 pa0, bf16x8 pa1, bf16x8 pa2, bf16x8 pa3, bool act) {
    if (SK && !act) return;
#define TRRD(dst, off) asm volatile("ds_read_b64_tr_b16 %0, %1 offset:%2" : "=&v"(dst) : "v"(vb0), "i"(off) : "memory")
#define PV_D0(d0) do { s16x4 l0, l1, l2, l3, h0, h1, h2, h3; constexpr int b_ = VB * SHM_V + v_rd_off(d0, 0, 0);     \
        TRRD(l0, b_); TRRD(h0, b_ + 2048); TRRD(l1, b_ + 4096); TRRD(h1, b_ + 6144); TRRD(l2, b_ + 8192); TRRD(h2, b_ + 10240); TRRD(l3, b_ + 12288); TRRD(h3, b_ + 14336); \
        asm volatile("s_waitcnt lgkmcnt(0)" ::: "memory"); SBAR();                 \
        o[d0] = __builtin_amdgcn_mfma_f32_32x32x16_bf16(pa0, (bf16x8){l0[0], l0[1], l0[2], l0[3], h0[0], h0[1], h0[2], h0[3]}, o[d0], 0, 0, 0);   \
        o[d0] = __builtin_amdgcn_mfma_f32_32x32x16_bf16(pa1, (bf16x8){l1[0], l1[1], l1[2], l1[3], h1[0], h1[1], h1[2], h1[3]}, o[d0], 0, 0, 0);   \
        o[d0] = __builtin_amdgcn_mfma_f32_32x32x16_bf16(pa2, (bf16x8){l2[0], l2[1], l2[2], l2[3], h2[0], h2[1], h2[2], h2[3]}, o[d0], 0, 0, 0);   \
        o[d0] = __builtin_amdgcn_mfma_f32_32x32x16_bf16(pa3, (bf16x8){l3[0], l3[1], l3[2], l3[3], h3[0], h3[1], h3[2], h3[3]}, o[d0], 0, 0, 0); } while (0)
    PV_D0(0); PV_D0(1); PV_D0(2); PV_D0(3);
#undef PV_D0
#undef TRRD
}

template <class TIn, class TOut> struct BlockRef { const TIn* Q; const TIn* K; const TIn* V; TOut* O; int P0; };
template <class TIn> struct Seam {
    bf16x8 qr[8];
    bf16x8 st_v0, st_v1, st_k0, st_k1; f32x4 sf0, sf1, sf2, sf3;
    f32x4 tq[16];
};
__device__ __forceinline__ int swa_jlo(int P0, int W) { const int lowk = P0 - W + 1; return lowk > 0 ? lowk / KVBLK : 0; }
#define ROW(p, k0, rr) ((p) + (size_t)((k0) + (rr)) * D + sc)
#define VMW() asm volatile("s_waitcnt vmcnt(0)" ::: "memory")
#define VMWN(n) asm volatile("s_waitcnt vmcnt(%0)" :: "i"(n) : "memory")
#define SLOAD_H(Kp, Vp, k0) do { S.st_v0 = load8<TIn>(ROW(Vp, k0, sr)); S.st_v1 = load8<TIn>(ROW(Vp, k0, 32 + sr));              \
                         S.st_k0 = load8<TIn>(ROW(Kp, k0, sr)); S.st_k1 = load8<TIn>(ROW(Kp, k0, 32 + sr)); } while (0)
#define SWRITE_HK(bf) do { *(bf16x8*)(K_lds + (bf) * SHM_K + kws) = S.st_k0; *(bf16x8*)(K_lds + (bf) * SHM_K + kws + 32 * 256) = S.st_k1; } while (0)
#define SWRITE_HV(bf) do { *(bf16x8*)(V_lds + (bf) * SHM_V + vst0) = S.st_v0; *(bf16x8*)(V_lds + (bf) * SHM_V + vst1) = S.st_v1; } while (0)
#define SWRITE_H(bf) do { SWRITE_HV(bf); SWRITE_HK(bf); } while (0)
#define SLOAD_F(p, k0) do { S.sf0 = *(const f32x4*)ROW(p, k0, sr); S.sf1 = *(const f32x4*)(ROW(p, k0, sr) + 4);                \
                            S.sf2 = *(const f32x4*)ROW(p, k0, 32 + sr); S.sf3 = *(const f32x4*)(ROW(p, k0, 32 + sr) + 4); } while (0)
#define SWRITE_KF(bf) do { *(bf16x8*)(K_lds + (bf) * SHM_K + kws) = pack8(S.sf0, S.sf1); *(bf16x8*)(K_lds + (bf) * SHM_K + kws + 32 * 256) = pack8(S.sf2, S.sf3); } while (0)
#define SWRITE_VF(bf) do { *(bf16x8*)(V_lds + (bf) * SHM_V + vst0) = pack8(S.sf0, S.sf1); *(bf16x8*)(V_lds + (bf) * SHM_V + vst1) = pack8(S.sf2, S.sf3); } while (0)
template <class TIn, class TOut>
__device__ __forceinline__ void causal_swa_prime(const BlockRef<TIn, TOut>& cur, int W, char* lds, Seam<TIn>& S) {
    constexpr bool F32 = same_t<TIn, float>::v;
    const int tid = threadIdx.x, wid = __builtin_amdgcn_readfirstlane(tid >> 6), lane = tid & 63, r32 = lane & 31, hi = lane >> 5;
    const int sr = tid >> 4, sc = (tid & 15) * 8, kws = KSWZ(sr, sc * 2); char* K_lds = lds + 2 * SHM_V;
    const int kb0 = swa_jlo(cur.P0, W) * KVBLK;
    for (int d0 = 0; d0 < 8; ++d0) S.qr[d0] = load8<TIn>(cur.Q + (size_t)(wid * QBLK + r32) * D + d0 * 16 + hi * 8);
    if constexpr (F32) { SLOAD_F((const float*)cur.K, kb0); VMW(); SWRITE_KF(0); SBAR(); SLOAD_F((const float*)cur.V, kb0); }
    else { SLOAD_H(cur.K, cur.V, kb0); VMW(); SWRITE_HK(0); }
    __syncthreads();
}
template <class TIn, class TOut, class CV>
__device__ __forceinline__ void causal_swa_block(const BlockRef<TIn, TOut>& cur, const BlockRef<TIn, TOut>& nxt, int skv, int W, char* lds, Seam<TIn>& S, CV& cv) {
    constexpr bool F32 = same_t<TIn, float>::v;
    const int tid = threadIdx.x, wid = __builtin_amdgcn_readfirstlane(tid >> 6), lane = tid & 63, r32 = lane & 31, hi = lane >> 5;
    const int j_lo = swa_jlo(cur.P0, W);
    int j_hi = (cur.P0 + QB - 1) / KVBLK + 1; if (j_hi > skv / KVBLK) j_hi = skv / KVBLK;
    const int NT = j_hi - j_lo;
    const int kbn = swa_jlo(nxt.P0, W) * KVBLK;
    const int qlo = cur.P0 + wid * QBLK, qm = ((qlo + r32) | 63) - 4 * hi;
    char* V_lds = lds; char* K_lds = lds + 2 * SHM_V;
    float* ws = (float*)(lds + 2 * SHM_V + 2 * SHM_K) + wid * 64; float* li_l = ws, * al_l = ws + 32;
    float m_reg = -1e30f, l_reg = 0; f32x16 o[4] = {};
    const int sr = tid >> 4, sc = (tid & 15) * 8, vst0 = v_st(sr, sc), vst1 = v_st(32 + sr, sc), kws = KSWZ(sr, sc * 2);
    const int vb0 = (int)(uintptr_t)V_lds + v_rd_base(lane);
    const TIn* Kh = cur.K; const TIn* Vh = cur.V;
#define RESC(a) do { if (__any((a) < 1.f)) { if (hi == 0) al_l[r32] = (a); asm volatile("s_waitcnt lgkmcnt(0)" ::: "memory");              \
                     for (int d_ = 0; d_ < 4; ++d_) for (int r = 0; r < 16; ++r) o[d_][r] *= al_l[crow(r, hi)]; } } while (0)
#define KBASE(t) ((j_lo + (t)) * KVBLK)
#define ACT(t) (KBASE(t) <= qlo + QBLK - 1 && KBASE(t) + KVBLK - 1 >= qlo - W + 1)
#define MASKT(P0_, P1_, t) do { const int kb_ = KBASE(t); if ((!SK || ACT(t)) && (kb_ > qlo)) mask_tile(P0_, P1_, qm - kb_, (unsigned)W); } while (0)
    constexpr int NQL = F32 ? 16 : 8;
    constexpr bool SK = WSKIP && !F32;
#define SEAM_K0() do { VMWN(NQL); if constexpr (F32) { SWRITE_KF(0); SBAR(); SLOAD_F((const float*)nxt.V, kbn); } else { SWRITE_HK(0); } SBAR(); } while (0)
    f32x16 pA0, pA1, pB0, pB1; float mnA, mnB, alA, alB; bf16x8 pa0, pa1, pa2, pa3;
    if constexpr (F32) { VMW(); SWRITE_VF(0); SBAR(); } else { SWRITE_HV(0); SBAR(); }
    if (NT > 1) { if constexpr (F32) SLOAD_F((const float*)Kh, KBASE(1)); else SLOAD_H(Kh, Vh, KBASE(1)); }
    SBAR(); qkt<0, SK>(pA0, pA1, K_lds, r32, hi, S.qr, ACT(0));
    if constexpr (F32) { if (NT > 1) { VMW(); SWRITE_KF(1); SBAR(); SLOAD_F((const float*)Vh, KBASE(1)); } }
    MASKT(pA0, pA1, 0); partialSM(pA0, pA1, m_reg, mnA, alA);
    if (NT > 1) { VMW(); if constexpr (F32) { SWRITE_VF(1); SBAR(); if (NT > 2) SLOAD_F((const float*)Kh, KBASE(2)); } else SWRITE_H(1); }
    __syncthreads();
#define LBAR() do { asm volatile("s_waitcnt lgkmcnt(0)" ::: "memory"); __builtin_amdgcn_s_barrier(); asm volatile("" ::: "memory"); } while (0)
#define HALF_STEP(PX0, PX1, mnX, alX, PY0, PY1, alY, t, KB, VB, SB) do {                                                      \
        SBAR(); cv.issue(); SBAR(); qkt<KB, SK>(PX0, PX1, K_lds, r32, hi, S.qr, ACT(t));                                             \
        finishSM(PY0, PY1, alY, l_reg, pa0, pa1, pa2, pa3); SBAR();                                                           \
        if ((t) + 1 < NT) { if constexpr (F32) { VMW(); SWRITE_KF(SB); SBAR(); SLOAD_F((const float*)Vh, KBASE((t) + 1)); }  \
                            else { SLOAD_H(Kh, Vh, KBASE((t) + 1)); } SBAR(); }                                               \
        pv_tile<VB, SK>(o, vb0, pa0, pa1, pa2, pa3, ACT((t) - 1)); MASKT(PX0, PX1, (t)); partialSM(PX0, PX1, m_reg, mnX, alX);                                        \
        LBAR();                                                                                                               \
        if ((t) + 1 < NT) { VMW(); if constexpr (F32) { SWRITE_VF(SB); SBAR(); if ((t) + 2 < NT) SLOAD_F((const float*)Kh, KBASE((t) + 2)); } \
                            else { SWRITE_H(SB); } }                                                                          \
        RESC(alX); SBAR(); cv.consume(); SBAR(); LBAR(); } while (0)
    __builtin_amdgcn_s_waitcnt(0x0F70);
    for (int t = 1; t + 1 < NT; t += 2) {
        HALF_STEP(pB0, pB1, mnB, alB, pA0, pA1, alA, t, 1, 0, 0);
        HALF_STEP(pA0, pA1, mnA, alA, pB0, pB1, alB, t + 1, 0, 1, 1);
    }
    const bool even = (NT & 1) == 0;
    if (even) { SBAR(); qkt<1, SK>(pB0, pB1, K_lds, r32, hi, S.qr, ACT(NT - 1)); SBAR(); }
#define QROW(e) (nxt.Q + (size_t)(wid * QBLK + r32) * D + ((e) >> 1) * 16 + hi * 8 + ((e) & 1) * 4)
    if constexpr (F32) { SLOAD_F((const float*)nxt.K, kbn); SBAR();
#pragma unroll
        for (int e = 0; e < 8; ++e) S.tq[e] = *(const f32x4*)QROW(e); }
    else { SLOAD_H(nxt.K, nxt.V, kbn); SBAR();
#pragma unroll
        for (int d0 = 0; d0 < 8; ++d0) S.qr[d0] = load8<TIn>(nxt.Q + (size_t)(wid * QBLK + r32) * D + d0 * 16 + hi * 8); }
    SBAR();
    finishSM(pA0, pA1, alA, l_reg, pa0, pa1, pa2, pa3); SBAR();
    if constexpr (F32) {
#pragma unroll
        for (int e = 8; e < 16; ++e) S.tq[e] = *(const f32x4*)QROW(e); SBAR(); }
#undef QROW
    pv_tile<0, SK>(o, vb0, pa0, pa1, pa2, pa3, ACT(even ? NT - 2 : NT - 1));
    if (even) { MASKT(pB0, pB1, NT - 1); partialSM(pB0, pB1, m_reg, mnB, alB); __syncthreads(); RESC(alB);
        finishSM(pB0, pB1, alB, l_reg, pa0, pa1, pa2, pa3); SBAR(); pv_tile<1, SK>(o, vb0, pa0, pa1, pa2, pa3, ACT(NT - 1)); }
    SBAR(); SEAM_K0();
    if (hi == 0) li_l[r32] = l_reg; asm volatile("s_waitcnt lgkmcnt(0)" ::: "memory");
    float rli[16];
#pragma unroll
    for (int r = 0; r < 16; ++r) rli[r] = __builtin_amdgcn_rcpf(li_l[crow(r, hi)]);
    TOut* Ow = cur.O + (size_t)(wid * QBLK) * D;
#pragma unroll
    for (int r = 0; r < 16; ++r) { const int orow = crow(r, hi);
#pragma unroll
        for (int d0 = 0; d0 < 4; ++d0) { const float v = o[d0][r] * rli[r];
            if constexpr (same_t<TOut, float>::v) { Ow[(size_t)orow * D + d0 * 32 + r32] = v; }
            else { const float vn = __shfl_xor(v, 1);
                   if ((r32 & 1) == 0) *(unsigned*)(Ow + (size_t)orow * D + d0 * 32 + r32) = cvtpk(v, vn); } } }
    if constexpr (F32) {
#pragma unroll
        for (int d0 = 0; d0 < 8; ++d0) S.qr[d0] = pack8(S.tq[2 * d0], S.tq[2 * d0 + 1]); }
    __syncthreads();
#undef RESC
#undef KBASE
#undef ACT
#undef MASKT
#undef SEAM_K0
#undef HALF_STEP
#undef LBAR
}
#undef ROW
#undef VMW
#undef VMWN
#undef SLOAD_H
#undef SWRITE_HK
#undef SWRITE_HV
#undef SWRITE_H
#undef SLOAD_F
#undef SWRITE_KF
#undef SWRITE_VF
}


namespace mk {
using pg8::bf16_t; using pg8::f32x4; using pg8::u32x4; using pg8::Unit;
typedef float f32x2v __attribute__((ext_vector_type(2)));
typedef __bf16 bf16x2v __attribute__((ext_vector_type(2)));
__device__ __forceinline__ unsigned cvt_pk_bf16(float lo, float hi) { const f32x2v v = {lo, hi}; return __builtin_bit_cast(unsigned, __builtin_convertvector(v, bf16x2v)); }
#define LAS __attribute__((address_space(3)))
#define LDS_WAIT() asm volatile("s_waitcnt lgkmcnt(0)" ::: "memory")
#define VM_WAIT() asm volatile("s_waitcnt vmcnt(0)" ::: "memory")
constexpr int D = 2048, NB = 4, S = 4096, NT = NB * S, NE = 32, NA = 2 * NT, MH = 1024;
constexpr int NWAVES = 8, NTHR = 512;
constexpr int LDS_MISC = 147456, LDS_BYTES = 163840;
constexpr int MISC_BAR = 0, MISC_PE = 64, MISC_PS = 64 + 1024, MISC_HIST = 64 + 1024 + 256, MISC_BASE = MISC_HIST + 128, MISC_NP = MISC_BASE + 128, MISC_CNT = MISC_NP + 64;
constexpr int PMAX = NA + NE * 256;
constexpr float EPS = 1e-6f;
typedef unsigned u32x2 __attribute__((ext_vector_type(2)));

struct Args {
    const float *x, *c; const int* pos; const float *ada_w, *ada_b, *nmg, *nfg, *fng, *a_win, *a_wout, *lq1, *lk1, *lq2, *lk2, *a_hg,
        *m_win, *m_cw, *m_cb, *m_gb, *m_hg, *m_wout, *wg, *bg, *we, *be, *wgu, *wdn;
    float* out;
    unsigned* ctl; float* mod; float2* cs;
    bf16_t *Bt_qkv, *Bt_ao, *Bt_min, *Bt_mo, *Bt_rt, *Bt_g, *Bt_gu, *Bt_dn;
    bf16_t* xres; bf16_t* hb; bf16_t* ob; float* proj;
    float* logits; int* eid; float* wts; int* pos_in_e; int* slot; int* counts; int* inv;
    bf16_t *XG, *Hm, *Y;
    bf16_t *Qh, *Kh, *Vh, *Oa;
    unsigned char *hb8, *Hm8, *Bt_gu8, *Bt_dn8;
    unsigned char *Bt_min8, *Bt_mo8, *ob8;
    bf16_t *P3, *Qn, *Kn, *KT, *VT, *HS; float *gates, *GA, *GS;
    int ph_lo, ph_hi;
};

__device__ __forceinline__ unsigned pk4_fp8(float x0, float x1, float x2, float x3) { unsigned w = 0u; w = __builtin_amdgcn_cvt_pk_fp8_f32(x0, x1, w, false); w = __builtin_amdgcn_cvt_pk_fp8_f32(x2, x3, w, true); return w; }
__device__ __forceinline__ float wave_sum(float v) {
#pragma unroll
    for (int o = 1; o < 64; o <<= 1) v += __shfl_xor(v, o);
    return v;
}
__device__ __forceinline__ float silu_f(float v) { return v / (1.f + __expf(-v)); }
__device__ __forceinline__ f32x4 bf4_to_f32(const u32x2 p) { f32x4 r; r[0] = __uint_as_float(p.x << 16); r[1] = __uint_as_float(p.x & 0xffff0000u); r[2] = __uint_as_float(p.y << 16); r[3] = __uint_as_float(p.y & 0xffff0000u); return r; }
__device__ __forceinline__ int opq(int v) { asm volatile("" : "+v"(v)); return v; }

template <bool IN_F32>
struct EpiResid {
    static constexpr bool PERM = true, AFTER_DRAIN = false;
    const void* xin; bf16_t* xout; const float* gt; float sc;
    __device__ __forceinline__ void operator()(const f32x4 (&acc)[2][2][4][2], const Unit& u, int wr, int wc, int fr, int fq) const {
        const int row0 = u.pm * 256 + wr * 64 + fr, col0 = u.pn * 256 + wc * 32 + 8 * fq, b = (u.pm * 256) / S;
        f32x4 gv[2][2];
#pragma unroll
        for (int bj = 0; bj < 2; ++bj)
#pragma unroll
            for (int n = 0; n < 2; ++n) gv[bj][n] = *(const f32x4*)(gt + (size_t)b * 6 * D + col0 + bj * 128 + n * 4) * sc;
#pragma unroll
        for (int ai = 0; ai < 2; ++ai) {
            f32x4 X0[4][2], X1[4][2];
#pragma unroll
            for (int m = 0; m < 4; ++m) { const size_t off = (size_t)(row0 + ai * 128 + m * 16) * D + col0;
#pragma unroll
                for (int bj = 0; bj < 2; ++bj) {
                    if (IN_F32) { X0[m][bj] = *(const f32x4*)((const float*)xin + off + bj * 128); X1[m][bj] = *(const f32x4*)((const float*)xin + off + bj * 128 + 4); }
                    else { const u32x4 p = *(const u32x4*)((const bf16_t*)xin + off + bj * 128); X0[m][bj] = __builtin_bit_cast(f32x4, p); } } }
            __builtin_amdgcn_sched_barrier(0);
#pragma unroll
            for (int m = 0; m < 4; ++m) { const size_t off = (size_t)(row0 + ai * 128 + m * 16) * D + col0;
#pragma unroll
                for (int bj = 0; bj < 2; ++bj) { f32x4 x0, x1;
                    if (IN_F32) { x0 = X0[m][bj]; x1 = X1[m][bj]; }
                    else { const u32x4 p = __builtin_bit_cast(u32x4, X0[m][bj]); x0 = bf4_to_f32((u32x2){p.x, p.y}); x1 = bf4_to_f32((u32x2){p.z, p.w}); }
                    const f32x4 y0 = x0 + gv[bj][0] * acc[ai][bj][m][0], y1 = x1 + gv[bj][1] * acc[ai][bj][m][1];
                    u32x4 w; w.x = cvt_pk_bf16(y0[0], y0[1]); w.y = cvt_pk_bf16(y0[2], y0[3]); w.z = cvt_pk_bf16(y1[0], y1[1]); w.w = cvt_pk_bf16(y1[2], y1[3]);
                    *(u32x4*)(xout + off + bj * 128) = w; } }
            __builtin_amdgcn_sched_barrier(0);
        }
    }
};
struct EpiGU {
    static constexpr bool PERM = true, AFTER_DRAIN = false;
    unsigned char* Hm8;
    __device__ __forceinline__ void operator()(const f32x4 (&acc)[2][2][4][2], const Unit& u, int wr, int wc, int fr, int fq) const {
        const int row0 = u.pm * 256 + wr * 64 + fr, col0 = (u.pn & 7) * 128 + wc * 32 + 8 * fq;
#pragma unroll
        for (int ai = 0; ai < 2; ++ai)
#pragma unroll
            for (int m = 0; m < 4; ++m) { unsigned char* rowp = Hm8 + (size_t)(row0 + ai * 128 + m * 16) * MH + col0;
                float h[8];
#pragma unroll
                for (int n = 0; n < 2; ++n)
#pragma unroll
                    for (int j = 0; j < 4; ++j) { const float g = acc[ai][0][m][n][j] * (1.f / 256.f), up = acc[ai][1][m][n][j] * (1.f / 256.f); h[n * 4 + j] = silu_f(g) * up * 4.f; }
                u32x2 w; w.x = pk4_fp8(h[0], h[1], h[2], h[3]); w.y = pk4_fp8(h[4], h[5], h[6], h[7]);
                *(u32x2*)rowp = w; }
    }
};
struct EpiBf16G {
    static constexpr bool PERM = true, AFTER_DRAIN = false;
    bf16_t* O; int ldc; float sc;
    __device__ __forceinline__ void operator()(const f32x4 (&acc)[2][2][4][2], const Unit& u, int wr, int wc, int fr, int fq) const {
        const int row0 = u.pm * 256 + wr * 64 + fr, col0 = (u.pn & 7) * 256 + wc * 32 + 8 * fq;
#pragma unroll
        for (int ai = 0; ai < 2; ++ai)
#pragma unroll
            for (int m = 0; m < 4; ++m) { bf16_t* rowp = O + (size_t)(row0 + ai * 128 + m * 16) * ldc + col0;
#pragma unroll
                for (int bj = 0; bj < 2; ++bj) { const f32x4 v0 = acc[ai][bj][m][0] * sc, v1 = acc[ai][bj][m][1] * sc;
                    u32x4 w; w.x = cvt_pk_bf16(v0[0], v0[1]); w.y = cvt_pk_bf16(v0[2], v0[3]); w.z = cvt_pk_bf16(v1[0], v1[1]); w.w = cvt_pk_bf16(v1[2], v1[3]);
                    *(u32x4*)(rowp + bj * 128) = w; } }
    }
};
struct GroupedOrder {
    int NP, total, G, c; const LAS int* pe;
    __device__ __forceinline__ bool next(int i, Unit& u) const {
        int p, j;
        if (G == 256) { const int x = c >> 5, l = c & 31, gidx = i * 8 + x; p = gidx * 4 + (l >> 3); j = l & 7; if (p >= NP) return false; }
        else { const long L = (long)i * G + c; if (L >= total) return false; p = (int)(L % NP); j = (int)(L / NP); }
        u.pm = p; u.pn = __builtin_amdgcn_readfirstlane(pe[p]) * 8 + j; return true; }
    __device__ __forceinline__ void a_ready(const Unit&) const {}
    __device__ __forceinline__ void done(const Unit&) const {}
};
struct GroupedOrderG : GroupedOrder {
    const LAS int* ps; const LAS int* cn; const int* inv;
    __device__ __forceinline__ int a_row(const Unit& u, int r) const {
        const int e = u.pn >> 3, local = u.pm * 256 + r - ps[e];
        return local < cn[e] ? inv[e * 32768 + local] : NT; }
};
struct CvItem { const float* W; bf16_t* WT; int ldw, K, n0, s0, k0; };
__device__ __forceinline__ void tr_load(const CvItem& d, int lane, f32x4 (&v)[8]) {
    const int kp = lane >> 3, c4 = lane & 7;
#pragma unroll
    for (int i = 0; i < 8; ++i) v[i] = *(const f32x4*)(d.W + (size_t)(d.k0 + 2 * kp + 16 * (i >> 1) + (i & 1)) * d.ldw + d.s0 + 4 * c4);
}
__device__ __forceinline__ void tr_finish(const CvItem& d, const f32x4 (&v)[8], LAS float* scr, int lane) {
    const int kp = lane >> 3, c4 = lane & 7; LAS unsigned* sp = (LAS unsigned*)scr;
#pragma unroll
    for (int i = 0; i < 4; ++i) { u32x4 o; o.x = cvt_pk_bf16(v[2 * i][0], v[2 * i + 1][0]); o.y = cvt_pk_bf16(v[2 * i][1], v[2 * i + 1][1]); o.z = cvt_pk_bf16(v[2 * i][2], v[2 * i + 1][2]); o.w = cvt_pk_bf16(v[2 * i][3], v[2 * i + 1][3]);
        *(LAS u32x4*)(sp + (kp + 8 * i) * 36 + 4 * c4) = o; }
    LDS_WAIT(); asm volatile("" ::: "memory");
    const int c = lane & 7;
#pragma unroll
    for (int j = 0; j < 4; ++j) { const int n = (lane >> 3) + 8 * j; const LAS unsigned* q = sp + (4 * c) * 36 + n;
        u32x4 o; o.x = q[0]; o.y = q[36]; o.z = q[72]; o.w = q[108];
        *(u32x4*)(d.WT + (size_t)(d.n0 + n) * d.K + d.k0 + 8 * c) = o; }
    LDS_WAIT(); asm volatile("" ::: "memory");
}
__device__ __forceinline__ int gu_src(int n) { const int t = n >> 8, r = n & 255; return r < 128 ? t * 128 + r : 1024 + t * 128 + (r - 128); }

constexpr int CV_I1 = 32 * 192, CV_I2 = 32 * 64, CV_ALL = CV_I1 + CV_I2;
__device__ __forceinline__ CvItem cv_decode(const Args& a, int r) {
    CvItem d;
    if (r < CV_I1) { const int kb = r / 192, nb = r % 192; d.W = a.a_win; d.ldw = 6144; d.WT = a.Bt_qkv; d.K = D; d.n0 = nb * 32; d.s0 = nb * 32; d.k0 = kb * 64; return d; } r -= CV_I1;
    { const int kb = r / 64, nb = r % 64; d.W = a.a_wout; d.ldw = D; d.WT = a.Bt_ao; d.K = D; d.n0 = nb * 32; d.s0 = nb * 32; d.k0 = kb * 64; return d; }
}
__device__ __forceinline__ void conv_items(const Args& a, LAS unsigned char* lds, int w, int nw, int lo, int hi, int wave, int lane) {
    LAS float* scr = (LAS float*)(lds + wave * 16384);
    const int it = lo + w; if (it >= hi) return;
    CvItem d0 = cv_decode(a, it), d1 = d0, d2 = d0; f32x4 v0[8], v1[8], v2[8];
    bool h1 = it + nw < hi, h2 = it + 2 * nw < hi, h0;
    tr_load(d0, lane, v0);
    if (h1) { d1 = cv_decode(a, it + nw); tr_load(d1, lane, v1); }
    if (h2) { d2 = cv_decode(a, it + 2 * nw); tr_load(d2, lane, v2); }
    int nx = it + 3 * nw;
    for (;;) {
        tr_finish(d0, v0, scr, lane); h0 = nx < hi; if (h0) { d0 = cv_decode(a, nx); tr_load(d0, lane, v0); nx += nw; }
        if (!h1) break;
        tr_finish(d1, v1, scr, lane); h1 = nx < hi; if (h1) { d1 = cv_decode(a, nx); tr_load(d1, lane, v1); nx += nw; }
        if (!h2) break;
        tr_finish(d2, v2, scr, lane); h2 = nx < hi; if (h2) { d2 = cv_decode(a, nx); tr_load(d2, lane, v2); nx += nw; }
        if (!h0) break;
    }
}
__device__ __forceinline__ void p0_prologue(const Args& a, LAS unsigned char* lds, int vcu, int G, int tid, int wave, int lane) {
    {
        LAS float* sc = (LAS float*)lds;
        LAS float* red = (LAS float*)(lds + 32768);
        for (int i = tid; i < NB * D; i += NTHR) sc[i] = silu_f(a.c[i]);
        __syncthreads();
        for (int it = vcu; it < 2 * 384; it += G) {
            const int l = it / 384, col = (it % 384) * 32 + (lane & 31), kh = lane >> 5;
            const float* w = a.ada_w + (size_t)l * D * 6 * D + (size_t)(wave * 256 + kh * 128) * 6 * D + col;
            float a0 = 0.f, a1 = 0.f, a2 = 0.f, a3 = 0.f;
#pragma unroll 8
            for (int k = 0; k < 128; ++k) { const float wv = w[(size_t)k * 6 * D]; const int kk = wave * 256 + kh * 128 + k;
                a0 += sc[kk] * wv; a1 += sc[D + kk] * wv; a2 += sc[2 * D + kk] * wv; a3 += sc[3 * D + kk] * wv; }
            a0 += __shfl_xor(a0, 32); a1 += __shfl_xor(a1, 32); a2 += __shfl_xor(a2, 32); a3 += __shfl_xor(a3, 32);
            if (lane < 32) { red[(wave * 4 + 0) * 32 + lane] = a0; red[(wave * 4 + 1) * 32 + lane] = a1; red[(wave * 4 + 2) * 32 + lane] = a2; red[(wave * 4 + 3) * 32 + lane] = a3; }
            __syncthreads();
            if (tid < 128) { const int bb = tid >> 5, cl = tid & 31; float sacc = 0.f;
#pragma unroll
                for (int w8 = 0; w8 < 8; ++w8) sacc += red[(w8 * 4 + bb) * 32 + cl];
                const int cg = (it % 384) * 32 + cl;
                a.mod[((size_t)l * NB + bb) * 6 * D + cg] = sacc + a.ada_b[l * 6 * D + cg]; }
            __syncthreads();
        }
    }
    for (int i = vcu * NTHR + tid; i < NT * 16; i += G * NTHR) {
        const int row = i >> 4, j = i & 15;
        const double ang = (double)a.pos[row] * pow(500000.0, -(double)j / 16.0);
        a.cs[i] = make_float2((float)cos(ang), (float)sin(ang));
    }
    for (int i = vcu * NTHR + tid; i < 2 * 256 * D; i += G * NTHR) {
        const int k = i % D, n = (i / D) % 256, l = i / (256 * D);
        float v = 0.f; if (n < 4) v = a.wg[((size_t)l * D + k) * 4 + n]; else if (n < 36) v = a.we[((size_t)l * D + k) * 32 + (n - 4)];
        a.Bt_rt[i] = (bf16_t)(cvt_pk_bf16(v, 0.f) & 0xffffu);
    }
    if (vcu == 0) for (int i = tid; i < D / 4; i += NTHR) ((unsigned*)(a.hb8 + (size_t)NT * D))[i] = 0u;
    for (int i = vcu * NTHR + tid; i < 16 * D; i += G * NTHR) { const int k = i % D, n = i / D; a.Bt_g[i] = (bf16_t)(cvt_pk_bf16(a.m_win[(size_t)k * 6160 + 6144 + n], 0.f) & 0xffffu); }
    __syncthreads();
    conv_items(a, lds, vcu * NWAVES + wave, G * NWAVES, 0, CV_I1 + CV_I2, wave, lane);
}
template <bool TOLDS>
__device__ __forceinline__ void norm_store(const f32x4 (&v)[8], float ss, const float* g, const float* scv, const float* shv, bf16_t* orow, int lane, LAS unsigned char* yrow) {
    const float rstd = rsqrtf(wave_sum(ss) * (1.f / D) + EPS);
#pragma unroll
    for (int j = 0; j < 8; ++j) { const int c = 4 * lane + 256 * j;
        const f32x4 gg = *(const f32x4*)(g + c), sc = *(const f32x4*)(scv + c), sh = *(const f32x4*)(shv + c);
        const f32x4 y = v[j] * rstd * gg * (sc + 1.f) + sh;
        u32x2 w; w.x = cvt_pk_bf16(y[0], y[1]); w.y = cvt_pk_bf16(y[2], y[3]);
        *(u32x2*)(orow + c) = w;
        if (TOLDS) *(LAS u32x2*)(yrow + c * 2) = w; }
}
constexpr int YT_PITCH = 4112, NR_YT = 0, NR_RED = 16 * YT_PITCH, NR_LG = NR_RED + 24576, NR_TOK = NR_LG + 3072;
typedef short bf16x8r __attribute__((ext_vector_type(8)));
template <int NTL>
__device__ __forceinline__ void rows16_logits(const bf16_t* Bt, LAS unsigned char* lds, int wave, int lane, int tid) {
    const int r16 = lane & 15, q4 = lane >> 4;
    f32x4 acc[NTL];
#pragma unroll
    for (int nt = 0; nt < NTL; ++nt) acc[nt] = (f32x4){0.f, 0.f, 0.f, 0.f};
#pragma unroll
    for (int h = 0; h < 2; ++h) { bf16x8r wf[4][NTL];
#pragma unroll
        for (int kk = 0; kk < 4; ++kk)
#pragma unroll
            for (int nt = 0; nt < NTL; ++nt) wf[kk][nt] = *(const bf16x8r*)(Bt + (size_t)(16 * nt + r16) * D + 256 * wave + 32 * (4 * h + kk) + 8 * q4);
        __builtin_amdgcn_sched_barrier(0);
#pragma unroll
        for (int kk = 0; kk < 4; ++kk) { const int k0 = 256 * wave + 32 * (4 * h + kk) + 8 * q4;
            const bf16x8r yf = *(const LAS bf16x8r*)(lds + NR_YT + r16 * YT_PITCH + k0 * 2);
#pragma unroll
            for (int nt = 0; nt < NTL; ++nt) acc[nt] = __builtin_amdgcn_mfma_f32_16x16x32_bf16(wf[kk][nt], yf, acc[nt], 0, 0, 0); }
        __builtin_amdgcn_sched_barrier(0); }
#pragma unroll
    for (int nt = 0; nt < NTL; ++nt) *(LAS f32x4*)(lds + NR_RED + ((wave * NTL + nt) * 64 + lane) * 16) = acc[nt];
    __syncthreads();
    if (tid < NTL * 64) { const int nt = tid >> 6, ln = tid & 63; f32x4 sum = {0.f, 0.f, 0.f, 0.f};
#pragma unroll
        for (int w = 0; w < 8; ++w) sum += *(const LAS f32x4*)(lds + NR_RED + ((w * NTL + nt) * 64 + ln) * 16);
        LAS float* lg = (LAS float*)(lds + NR_LG) + (ln & 15) * 48 + 16 * nt + 4 * (ln >> 4);
        lg[0] = sum[0]; lg[1] = sum[1]; lg[2] = sum[2]; lg[3] = sum[3]; }
    __syncthreads();
}
__device__ __forceinline__ void phase_norm(const float* xin, const float* g, const float* modl, int sh_idx, int sc_idx, bf16_t* hb, int gw, int NGW, int lane) {
    const int RPW = (NT + NGW - 1) / NGW; int m = gw * RPW; const int mend = (m + RPW < NT) ? m + RPW : NT;
    if (m >= mend) return;
    f32x4 A[8], Bv[8], v[8], vn[8]; int bcur = -1;
#pragma unroll
    for (int j = 0; j < 8; ++j) v[j] = *(const f32x4*)(xin + (size_t)m * D + 4 * lane + 256 * j);
    for (;;) {
        const bool more = m + 1 < mend;
        if (more) {
#pragma unroll
            for (int j = 0; j < 8; ++j) vn[j] = *(const f32x4*)(xin + (size_t)(m + 1) * D + 4 * lane + 256 * j); }
        const int b = m / S;
        if (b != bcur) { bcur = b; const float* scv = modl + (size_t)b * 6 * D + sc_idx * D; const float* shv = modl + (size_t)b * 6 * D + sh_idx * D;
#pragma unroll
            for (int j = 0; j < 8; ++j) { const int c = 4 * lane + 256 * j; A[j] = *(const f32x4*)(g + c) * (*(const f32x4*)(scv + c) + 1.f); Bv[j] = *(const f32x4*)(shv + c); } }
        float ss = 0.f;
#pragma unroll
        for (int j = 0; j < 8; ++j) ss += (v[j][0] * v[j][0] + v[j][1] * v[j][1]) + (v[j][2] * v[j][2] + v[j][3] * v[j][3]);
        const float rstd = rsqrtf(wave_sum(ss) * (1.f / D) + EPS);
        bf16_t* orow = hb + (size_t)m * D;
#pragma unroll
        for (int j = 0; j < 8; ++j) { const f32x4 y = v[j] * rstd * A[j] + Bv[j]; u32x2 w; w.x = cvt_pk_bf16(y[0], y[1]); w.y = cvt_pk_bf16(y[2], y[3]); *(u32x2*)(orow + 4 * lane + 256 * j) = w; }
        if (!more) break;
        ++m;
#pragma unroll
        for (int j = 0; j < 8; ++j) v[j] = vn[j];
    }
}
__device__ __forceinline__ void phase_combine_final(const Args& a, const float* modl, const LAS int* ps, int gw, int NGW, int lane) {
    const int RPW = (NT + NGW - 1) / NGW; const int m0 = gw * RPW; const int mend = (m0 + RPW < NT) ? m0 + RPW : NT;
    if (m0 >= mend) return;
    int slot_l = 0; float w_l = 0.f;
    if (lane < 2 * (mend - m0) && lane < 64) { const int as = 2 * m0 + lane; slot_l = ps[a.eid[as]] + a.pos_in_e[as]; w_l = a.wts[as]; }
    f32x4 G4[8], F4[8];
    { const float* gt = modl + (size_t)(m0 / S) * 6 * D + 5 * D;
#pragma unroll
      for (int j = 0; j < 8; ++j) { G4[j] = *(const f32x4*)(gt + 4 * lane + 256 * j); F4[j] = *(const f32x4*)(a.fng + 4 * lane + 256 * j); } }
    for (int m = m0; m < mend; ++m) {
        const int r = m - m0; const int s0 = __shfl(slot_l, 2 * r), s1 = __shfl(slot_l, 2 * r + 1); const float w0 = __shfl(w_l, 2 * r), w1 = __shfl(w_l, 2 * r + 1);
        const bf16_t* xr = a.xres + (size_t)m * D; const bf16_t* y0 = a.Y + (size_t)s0 * D; const bf16_t* y1 = a.Y + (size_t)s1 * D;
        f32x4 v[8]; float ss = 0.f;
#pragma unroll
        for (int j = 0; j < 8; ++j) { const int c = 4 * lane + 256 * j;
            const f32x4 x1 = bf4_to_f32(*(const u32x2*)(xr + c)); const u32x2 p0 = *(const u32x2*)(y0 + c), p1 = *(const u32x2*)(y1 + c);
            f32x4 ya, yb;
            ya[0] = __uint_as_float(p0.x << 16); ya[1] = __uint_as_float(p0.x & 0xffff0000u); ya[2] = __uint_as_float(p0.y << 16); ya[3] = __uint_as_float(p0.y & 0xffff0000u);
            yb[0] = __uint_as_float(p1.x << 16); yb[1] = __uint_as_float(p1.x & 0xffff0000u); yb[2] = __uint_as_float(p1.y << 16); yb[3] = __uint_as_float(p1.y & 0xffff0000u);
            v[j] = x1 + G4[j] * (ya * w0 + yb * w1);
            ss += (v[j][0] * v[j][0] + v[j][1] * v[j][1]) + (v[j][2] * v[j][2] + v[j][3] * v[j][3]); }
        const float rstd = rsqrtf(wave_sum(ss) * (1.f / D) + EPS);
#pragma unroll
        for (int j = 0; j < 8; ++j) *(f32x4*)(a.out + (size_t)m * D + 4 * lane + 256 * j) = v[j] * rstd * F4[j];
    }
}
__device__ __forceinline__ void phase_combine_gates(const Args& a, const float* modl, const float* modn, const float* gnext, const LAS int* ps, LAS unsigned char* lds, int vcu, int G, int tid, int wave, int lane) {
    const int NGRP = NT / 16, GPW = (NGRP + G - 1) / G, g0 = vcu * GPW, gend = (g0 + GPW < NGRP) ? g0 + GPW : NGRP;
    if (g0 >= gend) return;
    int slot_l = 0; float w_l = 0.f;
    if (lane < 4 * (gend - g0)) { const int m = (g0 + (lane >> 2)) * 16 + 2 * wave + ((lane >> 1) & 1), as = 2 * m + (lane & 1); slot_l = ps[a.eid[as]] + a.pos_in_e[as]; w_l = a.wts[as]; }
    const int b = (g0 * 16) / S;
    const float* gt = modl + (size_t)b * 6 * D + 5 * D; const float* scv = modn + (size_t)b * 6 * D + 1 * D; const float* shv = modn + (size_t)b * 6 * D;
    u32x2 xc[8], xn[8]; u32x2 pc0[8], pc1[8], pn0[8], pn1[8];
#define CG_LOAD(s_, X, P0, P1) do { const int m_ = (g0 + ((s_) >> 1)) * 16 + 2 * wave + ((s_) & 1), li_ = 2 * (s_); \
        const bf16_t* y0_ = a.Y + (size_t)__shfl(slot_l, li_) * D; const bf16_t* y1_ = a.Y + (size_t)__shfl(slot_l, li_ + 1) * D; \
        _Pragma("unroll") for (int j_ = 0; j_ < 8; ++j_) { const int c_ = 4 * lane + 256 * j_; X[j_] = *(const u32x2*)(a.xres + (size_t)m_ * D + c_); P0[j_] = *(const u32x2*)(y0_ + c_); P1[j_] = *(const u32x2*)(y1_ + c_); } } while (0)
    const int nrow = 2 * (gend - g0);
    CG_LOAD(0, xc, pc0, pc1);
    for (int sq = 0; sq < nrow; ++sq) {
        const int grp = g0 + (sq >> 1), rr = sq & 1, m = grp * 16 + 2 * wave + rr;
        if (sq + 1 < nrow) CG_LOAD(sq + 1, xn, pn0, pn1);
        const float w0 = __shfl(w_l, 2 * sq), w1 = __shfl(w_l, 2 * sq + 1);
        f32x4 v[8]; float ss = 0.f;
#pragma unroll
        for (int j = 0; j < 8; ++j) { const u32x2 p0 = pc0[j], p1 = pc1[j]; f32x4 ya, yb;
            ya[0] = __uint_as_float(p0.x << 16); ya[1] = __uint_as_float(p0.x & 0xffff0000u); ya[2] = __uint_as_float(p0.y << 16); ya[3] = __uint_as_float(p0.y & 0xffff0000u);
            yb[0] = __uint_as_float(p1.x << 16); yb[1] = __uint_as_float(p1.x & 0xffff0000u); yb[2] = __uint_as_float(p1.y << 16); yb[3] = __uint_as_float(p1.y & 0xffff0000u);
            v[j] = bf4_to_f32(xc[j]) + *(const f32x4*)(gt + 4 * lane + 256 * j) * (ya * w0 + yb * w1);
            ss += (v[j][0] * v[j][0] + v[j][1] * v[j][1]) + (v[j][2] * v[j][2] + v[j][3] * v[j][3]); }
        const float rstd = rsqrtf(wave_sum(ss) * (1.f / D) + EPS);
        LAS unsigned char* yrow = lds + NR_YT + (2 * wave + rr) * YT_PITCH;
#pragma unroll
        for (int j = 0; j < 8; ++j) { const int c = 4 * lane + 256 * j; { u32x2 xw; xw.x = cvt_pk_bf16(v[j][0], v[j][1]); xw.y = cvt_pk_bf16(v[j][2], v[j][3]); *(u32x2*)(a.xres + (size_t)m * D + c) = xw; }
            const f32x4 y = v[j] * rstd * (*(const f32x4*)(gnext + c) * (*(const f32x4*)(scv + c) + 1.f)) + *(const f32x4*)(shv + c); u32x2 w; w.x = cvt_pk_bf16(y[0], y[1]); w.y = cvt_pk_bf16(y[2], y[3]);
            *(unsigned*)(a.hb8 + (size_t)m * D + c) = pk4_fp8(y[0] * 4.f, y[1] * 4.f, y[2] * 4.f, y[3] * 4.f); *(LAS u32x2*)(yrow + c * 2) = w; }
#pragma unroll
        for (int j = 0; j < 8; ++j) { xc[j] = xn[j]; pc0[j] = pn0[j]; pc1[j] = pn1[j]; }
        if (rr == 1) {
            __syncthreads();
            rows16_logits<1>(a.Bt_g, lds, wave, lane, tid);
            if (tid < 256) a.gates[(size_t)(grp * 16 + (tid >> 4)) * 16 + (tid & 15)] = ((const LAS float*)(lds + NR_LG))[(tid >> 4) * 48 + (tid & 15)];
        }
    }
#undef CG_LOAD
}
__device__ __forceinline__ void phase_norm_route(const Args& a, int layer, const float* modl, LAS unsigned char* lds, LAS unsigned char* misc, int vcu, int G, int tid, int wave, int lane) {
    LAS int* hist = (LAS int*)(misc + MISC_HIST); LAS int* base = (LAS int*)(misc + MISC_BASE);
    LAS int* tk = (LAS int*)(lds + NR_TOK);
    LAS float* tw = (LAS float*)(lds + NR_TOK + 2048);
    int* counts = a.counts + layer * 64;
    const float* bg = a.bg + layer * 4; const float* be = a.be + layer * 32; const float* g = a.nfg + layer * D;
    if (tid < 32) hist[tid] = 0;
    __syncthreads();
    const int NGRP = NT / 16, GPW = (NGRP + G - 1) / G, g0 = vcu * GPW, gend = (g0 + GPW < NGRP) ? g0 + GPW : NGRP;
    const int ng = gend > g0 ? gend - g0 : 0;
    if (ng > 0) {
        const int b = (g0 * 16) / S;
        f32x4 A[8]; const float* shv = modl + (size_t)b * 6 * D + 3 * D;
        { const float* scv = modl + (size_t)b * 6 * D + 4 * D;
#pragma unroll
          for (int j = 0; j < 8; ++j) { const int c = 4 * lane + 256 * j; A[j] = *(const f32x4*)(g + c) * (*(const f32x4*)(scv + c) + 1.f); } }
        u32x2 x1[2][8];
#define NR_LOAD(grp_) do { _Pragma("unroll") for (int rr_ = 0; rr_ < 2; ++rr_) { const bf16_t* xr_ = a.xres + (size_t)((grp_) * 16 + 2 * wave + rr_) * D; \
        _Pragma("unroll") for (int j_ = 0; j_ < 8; ++j_) x1[rr_][j_] = *(const u32x2*)(xr_ + 4 * lane + 256 * j_); } } while (0)
        NR_LOAD(g0);
        for (int grp = g0; grp < gend; ++grp) {
            const int gi = grp - g0;
#pragma unroll
            for (int rr = 0; rr < 2; ++rr) { const int m = grp * 16 + 2 * wave + rr; float ss = 0.f;
#pragma unroll
                for (int j = 0; j < 8; ++j) { const f32x4 v = bf4_to_f32(x1[rr][j]); ss += (v[0] * v[0] + v[1] * v[1]) + (v[2] * v[2] + v[3] * v[3]); }
                const float rstd = rsqrtf(wave_sum(ss) * (1.f / D) + EPS);
                LAS unsigned char* yrow = lds + NR_YT + (2 * wave + rr) * YT_PITCH;
                f32x4 Bs[8];
#pragma unroll
                for (int j = 0; j < 8; ++j) Bs[j] = *(const f32x4*)(shv + 4 * lane + 256 * j);
                __builtin_amdgcn_sched_barrier(0);
#pragma unroll
                for (int j = 0; j < 8; ++j) { const int c = 4 * lane + 256 * j; const f32x4 y = bf4_to_f32(x1[rr][j]) * rstd * A[j] + Bs[j];
                    u32x2 w; w.x = cvt_pk_bf16(y[0], y[1]); w.y = cvt_pk_bf16(y[2], y[3]); *(LAS u32x2*)(yrow + c * 2) = w;
                    *(unsigned*)(a.hb8 + (size_t)m * D + c) = pk4_fp8(y[0] * 4.f, y[1] * 4.f, y[2] * 4.f, y[3] * 4.f); } }
            if (grp + 1 < gend) NR_LOAD(grp + 1);
            __syncthreads();
            rows16_logits<3>(a.Bt_rt + (size_t)layer * 256 * D, lds, wave, lane, tid);
            if (tid < 16 && gi < 8) {
                const LAS float* lg = (const LAS float*)(lds + NR_LG) + tid * 48;
                float gmax = -INFINITY; int grpi = 0;
#pragma unroll
                for (int i = 0; i < 4; ++i) { const float v = lg[i] + bg[i]; if (v > gmax) { gmax = v; grpi = i; } }
                float gs = 0.f;
#pragma unroll
                for (int i = 0; i < 4; ++i) gs += expf(lg[i] + bg[i] - gmax);
                const float pg = 1.f / gs;
                float v1 = -INFINITY, v2 = -INFINITY; int i1 = 0, i2 = 0;
                for (int i = 0; i < 8; ++i) { const float v = lg[4 + grpi * 8 + i] + be[grpi * 8 + i];
                    if (v > v1) { v2 = v1; i2 = i1; v1 = v; i1 = i; } else if (v > v2) { v2 = v; i2 = i; } }
                const float ex = expf(v2 - v1); const int e1 = grpi * 8 + i1, e2 = grpi * 8 + i2, sl = gi * 16 + tid;
                tk[sl] = e1; tk[128 + sl] = e2; tk[256 + sl] = atomicAdd((int*)&hist[e1], 1); tk[384 + sl] = atomicAdd((int*)&hist[e2], 1);
                tw[sl] = pg / (1.f + ex); tw[128 + sl] = pg * ex / (1.f + ex);
            }
        }
#undef NR_LOAD
    }
    __syncthreads();
    if (tid < 32) { const int h = hist[tid]; base[tid] = h ? atomicAdd(&counts[tid], h) : 0; }
    __syncthreads();
    if (tid < ng * 16 && tid < 128) { const int t = (g0 + (tid >> 4)) * 16 + (tid & 15), e1 = tk[tid], e2 = tk[128 + tid];
        a.eid[2 * t] = e1; a.eid[2 * t + 1] = e2; a.wts[2 * t] = tw[tid]; a.wts[2 * t + 1] = tw[128 + tid];
        const int p1 = base[e1] + tk[256 + tid], p2 = base[e2] + tk[384 + tid];
        a.pos_in_e[2 * t] = p1; a.pos_in_e[2 * t + 1] = p2; a.inv[e1 * 32768 + p1] = t; a.inv[e2 * 32768 + p2] = t; }
    __syncthreads();
}
__device__ __forceinline__ int moe_tables(const int* counts, LAS unsigned char* misc, int tid) {
    LAS int* ps = (LAS int*)(misc + MISC_PS); LAS int* pe = (LAS int*)(misc + MISC_PE); LAS int* npw = (LAS int*)(misc + MISC_NP);
    __syncthreads();
    if (tid < 64) {
        LAS int* cn = (LAS int*)(misc + MISC_CNT); const int e = tid & 31;
        const int c = __hip_atomic_load(&counts[e], __ATOMIC_RELAXED, __HIP_MEMORY_SCOPE_AGENT), np = (c + 255) >> 8;
        int incl = np;
#pragma unroll
        for (int d = 1; d < 32; d <<= 1) { const int t = __shfl_up(incl, d); if (tid >= d) incl += t; }
        if (tid < 32) { const int start = incl - np; ps[e] = start << 8; cn[e] = c;
            for (int p = 0; p < np; ++p) pe[start + p] = e;
            if (e == NE - 1) { ps[NE] = incl << 8; npw[0] = incl; } }
    }
    __syncthreads();
    return npw[0];
}
struct EpiQKV {
    static constexpr bool PERM = true, AFTER_DRAIN = false;
    bf16_t *Qh, *Kh, *Vh; const float2* cs;
    __device__ __forceinline__ void operator()(const f32x4 (&acc)[2][2][4][2], const Unit& u, int wr, int wc, int fr, int fq) const {
        const int t = u.pn >> 3, hh = u.pn & 7;
        bf16_t* base = Qh + (size_t)t * ((size_t)NT * 2048);
        const int row0 = u.pm * 256 + wr * 64 + fr;
        const bool rope = (t < 2) && (wc == 0);
#pragma unroll
        for (int ai = 0; ai < 2; ++ai)
#pragma unroll
            for (int m = 0; m < 4; ++m) { const int row = row0 + ai * 128 + m * 16;
                f32x4 c0 = {0.f, 0.f, 0.f, 0.f}, c1 = c0, c2 = c0, c3 = c0;
                if (rope) { const f32x4* cp = (const f32x4*)(cs + (size_t)row * 16 + 8 * (fq & 1)); c0 = cp[0]; c1 = cp[1]; c2 = cp[2]; c3 = cp[3]; }
#pragma unroll
                for (int bj = 0; bj < 2; ++bj) { f32x4 v0 = acc[ai][bj][m][0], v1 = acc[ai][bj][m][1];
                    if (rope) {
                        const float sg = (fq < 2) ? -1.f : 1.f;
                        float v[8] = {v0[0], v0[1], v0[2], v0[3], v1[0], v1[1], v1[2], v1[3]};
                        const float cc[8] = {c0[0], c0[2], c1[0], c1[2], c2[0], c2[2], c3[0], c3[2]}, sn[8] = {c0[1], c0[3], c1[1], c1[3], c2[1], c2[3], c3[1], c3[3]};
#pragma unroll
                        for (int i = 0; i < 8; ++i) { const float pv = __shfl_xor(v[i], 32); v[i] = v[i] * cc[i] + sg * pv * sn[i]; }
                        v0 = (f32x4){v[0], v[1], v[2], v[3]}; v1 = (f32x4){v[4], v[5], v[6], v[7]};
                    }
                    u32x4 w; w.x = cvt_pk_bf16(v0[0], v0[1]); w.y = cvt_pk_bf16(v0[2], v0[3]); w.z = cvt_pk_bf16(v1[0], v1[1]); w.w = cvt_pk_bf16(v1[2], v1[3]);
                    *(u32x4*)(base + ((size_t)(hh * 2 + bj) * NT + row) * 128 + wc * 32 + 8 * fq) = w; } }
    }
};
typedef att::BlockRef<bf16_t, bf16_t> ARef;
__device__ __forceinline__ ARef att_ref(const Args& a, int hd, int qb) {
    const int b = hd >> 5, vh = hd & 31, h = vh >> 2, m = (vh >> 1) & 1, half = vh & 1;
    ARef r;
    r.Q = a.Qh + ((size_t)(h * 2 + m) * NT + (size_t)b * S + (size_t)qb * 256) * 128;
    r.K = a.Kh + ((size_t)(h * 2 + m) * NT + (size_t)b * S) * 128;
    r.V = a.Vh + ((size_t)(h * 2 + half) * NT + (size_t)b * S) * 128;
    r.O = a.Oa + ((size_t)((h * 2 + m) * 2 + half) * NT + (size_t)b * S + (size_t)qb * 256) * 128;
    r.P0 = qb * 256;
    return r;
}
__device__ __forceinline__ bool att_pos(int w, int N, int r, int& hd, int& qb) {
    const int p = r * N + ((r & 1) ? (N - 1 - w) : w); if (p >= 2048) return false;
    const int c = p >> 9, pl = p & 511; hd = pl >> 2; qb = 15 - 4 * c - (pl & 3); return true;
}
constexpr int CVA_MIN = 16 * 96, CVA_MO = 16 * 32, CVA_GU = 64 * 512, CVA_DN = 64 * 256, CVA_ITEMS = CVA_MIN + CVA_MO + CVA_GU + CVA_DN, CVA_BUF = 4224;
struct CvaItem { const float* W; unsigned char* WT; int ldw, K, k0, n0, s0; float sc; };
__device__ __forceinline__ CvaItem cva_decode(const Args& a, int r) {
    CvaItem d; d.ldw = 2048; d.K = D; d.sc = 64.f;
    if (r < CVA_MIN) { const int kb = r / 96, nb = r - kb * 96; d.W = a.m_win; d.ldw = 6160; d.WT = a.Bt_min8; d.k0 = kb * 128; d.n0 = nb * 64; d.s0 = d.n0; return d; } r -= CVA_MIN;
    if (r < CVA_MO) { d.W = a.m_wout; d.WT = a.Bt_mo8; d.k0 = (r >> 5) * 128; d.n0 = (r & 31) * 64; d.s0 = d.n0; return d; } r -= CVA_MO;
    if (r < CVA_GU) { const int ex = r >> 9, q = r & 511; d.W = a.wgu + (size_t)ex * D * 2048; d.WT = a.Bt_gu8 + (size_t)ex * 2048 * D; d.k0 = (q >> 5) * 128; d.n0 = (q & 31) * 64; d.s0 = gu_src(d.n0); return d; } r -= CVA_GU;
    { const int ex = r >> 8, q = r & 255; d.W = a.wdn + (size_t)ex * MH * D; d.WT = a.Bt_dn8 + (size_t)ex * D * MH; d.K = MH; d.k0 = (q >> 5) * 128; d.n0 = (q & 31) * 64; d.s0 = d.n0; d.sc = 32.f; return d; }
}
struct AttConv {
    const Args* a; LAS unsigned char* buf;
    int nxt, stride, cur, wave; unsigned bufa;
    __device__ __forceinline__ void issue() {
        if (nxt >= CVA_ITEMS) return;
        const CvaItem d = cva_decode(*a, nxt);
        const int l = opq((int)threadIdx.x) & 63, kq = wave & 3, nh = wave >> 2;
        cur = nxt; nxt += stride;
        const char* base = (const char*)(d.W + (size_t)(d.k0 + 32 * kq) * d.ldw + d.s0 + 32 * nh);
        const unsigned voff = (unsigned)(((l >> 3) * d.ldw + 4 * (l & 7)) * 4);
#pragma unroll
        for (int j = 0; j < 4; ++j) asm volatile("s_mov_b32 m0, %2\n\ts_nop 0\n\tglobal_load_lds_dwordx4 %0, %1" :: "v"(voff), "s"(base + (size_t)(8 * j) * d.ldw * 4), "s"(bufa + j * 1024 + (j >= 2 ? 128 : 0)) : "memory", "m0");
    }
    __device__ __forceinline__ void consume() {
        if (cur < 0) return;
        asm volatile("s_waitcnt vmcnt(0)" ::: "memory");
        const CvaItem d = cva_decode(*a, cur);
        const int l = opq((int)threadIdx.x) & 63, n = l & 31, kh = l >> 5, kq = wave & 3, nh = wave >> 2;
        const LAS float* p = (const LAS float*)(buf + kh * (17 * 128) + n * 4);
        float v[16];
#pragma unroll
        for (int i = 0; i < 16; ++i) v[i] = p[i * 32] * d.sc;
        u32x4 o; o.x = pk4_fp8(v[0], v[1], v[2], v[3]); o.y = pk4_fp8(v[4], v[5], v[6], v[7]); o.z = pk4_fp8(v[8], v[9], v[10], v[11]); o.w = pk4_fp8(v[12], v[13], v[14], v[15]);
        *(u32x4*)(d.WT + (size_t)(d.n0 + 32 * nh + n) * d.K + d.k0 + 32 * kq + 16 * kh) = o;
        asm volatile("s_waitcnt lgkmcnt(0)" ::: "memory");
        cur = -1;
    }
    __device__ __forceinline__ void finish() {
        consume();
        while (nxt < CVA_ITEMS) { issue(); consume(); }
    }
};
__device__ __forceinline__ void phase_attn(const Args& a, char* lds, int w, int N  ) {
    AttConv cv; cv.a = &a; cv.wave = __builtin_amdgcn_readfirstlane((int)threadIdx.x >> 6); cv.buf = (LAS unsigned char*)lds + att::ATT_LDS_BYTES + cv.wave * CVA_BUF; cv.bufa = __builtin_amdgcn_readfirstlane((unsigned)(uintptr_t)lds + att::ATT_LDS_BYTES + cv.wave * CVA_BUF);
    cv.nxt = w; cv.stride = N; cv.cur = -1;
    int hd, qb, r = 0;
    if (att_pos(w, N, 0, hd, qb)) {
        ARef cur = att_ref(a, hd, qb);
        att::Seam<bf16_t> Sm;
        att::causal_swa_prime<bf16_t, bf16_t>(cur, 1 << 30, lds, Sm);
        for (;;) {
            int hn, qn; const bool more = att_pos(w, N, r + 1, hn, qn);
            const ARef nxt = more ? att_ref(a, hn, qn) : cur;
            att::causal_swa_block<bf16_t, bf16_t, AttConv>(cur, nxt, S, 1 << 30, lds, Sm, cv);
            if (!more) break;
            cur = nxt; ++r;
        }
    }
    cv.finish();
}
__device__ __forceinline__ float bf_lo(unsigned u) { return __uint_as_float(u << 16); }
__device__ __forceinline__ float bf_hi(unsigned u) { return __uint_as_float(u & 0xffff0000u); }
typedef unsigned short u16x8 __attribute__((ext_vector_type(8)));
__device__ __forceinline__ void bf8_to_f32(const u32x4 p, float (&f)[8]) {
    f[0] = bf_lo(p.x); f[1] = bf_hi(p.x); f[2] = bf_lo(p.y); f[3] = bf_hi(p.y); f[4] = bf_lo(p.z); f[5] = bf_hi(p.z); f[6] = bf_lo(p.w); f[7] = bf_hi(p.w); }
__device__ __forceinline__ void phase_attn_combine(const Args& a, int gw, int NGW, int lane) {
    float d1 = a.lq1[lane] * a.lk1[lane] + a.lq1[lane + 64] * a.lk1[lane + 64], d2 = a.lq2[lane] * a.lk2[lane] + a.lq2[lane + 64] * a.lk2[lane + 64];
    const float lam = __expf(wave_sum(d1)) - __expf(wave_sum(d2)) + 0.2f;
    const int hh = lane >> 3, e0 = (lane & 7) * 32, half = e0 >> 7, d0 = e0 & 127;
    float gv[32];
#pragma unroll
    for (int i = 0; i < 8; ++i) { const f32x4 t = *(const f32x4*)(a.a_hg + e0 + 4 * i); gv[4 * i] = t[0]; gv[4 * i + 1] = t[1]; gv[4 * i + 2] = t[2]; gv[4 * i + 3] = t[3]; }
    const bf16_t* O0 = a.Oa + ((size_t)((hh * 2 + 0) * 2 + half) * NT) * 128 + d0;
    const bf16_t* O1 = a.Oa + ((size_t)((hh * 2 + 1) * 2 + half) * NT) * 128 + d0;
    const int RPW = (NT + NGW - 1) / NGW; int m = gw * RPW; const int mend = (m + RPW < NT) ? m + RPW : NT;
    if (m >= mend) return;
    u32x4 p0[4], p1[4], n0[4], n1[4];
#pragma unroll
    for (int i = 0; i < 4; ++i) { p0[i] = *(const u32x4*)(O0 + (size_t)m * 128 + 8 * i); p1[i] = *(const u32x4*)(O1 + (size_t)m * 128 + 8 * i); }
    for (;;) {
        const bool more = m + 1 < mend;
        if (more) {
#pragma unroll
            for (int i = 0; i < 4; ++i) { n0[i] = *(const u32x4*)(O0 + (size_t)(m + 1) * 128 + 8 * i); n1[i] = *(const u32x4*)(O1 + (size_t)(m + 1) * 128 + 8 * i); } }
        float o[32]; float ss = 0.f;
#pragma unroll
        for (int i = 0; i < 4; ++i) { float f0[8], f1[8]; bf8_to_f32(p0[i], f0); bf8_to_f32(p1[i], f1);
#pragma unroll
            for (int j = 0; j < 8; ++j) { o[8 * i + j] = f0[j] - lam * f1[j]; ss += o[8 * i + j] * o[8 * i + j]; } }
        ss += __shfl_xor(ss, 1); ss += __shfl_xor(ss, 2); ss += __shfl_xor(ss, 4);
        const float r = rsqrtf(ss * (1.f / 256.f) + EPS) * 0.8f;
        bf16_t* orow = a.ob + (size_t)m * D + hh * 256 + e0;
#pragma unroll
        for (int i = 0; i < 4; ++i) { u32x4 w; w.x = cvt_pk_bf16(o[8 * i] * r * gv[8 * i], o[8 * i + 1] * r * gv[8 * i + 1]); w.y = cvt_pk_bf16(o[8 * i + 2] * r * gv[8 * i + 2], o[8 * i + 3] * r * gv[8 * i + 3]);
            w.z = cvt_pk_bf16(o[8 * i + 4] * r * gv[8 * i + 4], o[8 * i + 5] * r * gv[8 * i + 5]); w.w = cvt_pk_bf16(o[8 * i + 6] * r * gv[8 * i + 6], o[8 * i + 7] * r * gv[8 * i + 7]);
            *(u32x4*)(orow + 8 * i) = w; }
        if (!more) break;
        ++m;
#pragma unroll
        for (int i = 0; i < 4; ++i) { p0[i] = n0[i]; p1[i] = n1[i]; }
    }
}

struct EpiMin {
    static constexpr bool PERM = true, AFTER_DRAIN = false;
    bf16_t* P3;
    __device__ __forceinline__ void operator()(const f32x4 (&acc)[2][2][4][2], const Unit& u, int wr, int wc, int fr, int fq) const {
        const int t = u.pn >> 3; const int row0 = u.pm * 256 + wr * 64 + fr;
        bf16_t* base = P3 + (size_t)t * ((size_t)NT * 2048); const int col0 = (u.pn & 7) * 256 + wc * 32 + 8 * fq;
#pragma unroll
        for (int ai = 0; ai < 2; ++ai)
#pragma unroll
            for (int m = 0; m < 4; ++m) { bf16_t* rowp = base + (size_t)(row0 + ai * 128 + m * 16) * 2048 + col0;
#pragma unroll
                for (int bj = 0; bj < 2; ++bj) { f32x4 v0 = acc[ai][bj][m][0] * (1.f / 256.f), v1 = acc[ai][bj][m][1] * (1.f / 256.f);
                    if (t == 2) {
#pragma unroll
                        for (int j = 0; j < 4; ++j) { v0[j] = 1.f / (1.f + __expf(-v0[j])); v1[j] = 1.f / (1.f + __expf(-v1[j])); } }
                    u32x4 w; w.x = cvt_pk_bf16(v0[0], v0[1]); w.y = cvt_pk_bf16(v0[2], v0[3]); w.z = cvt_pk_bf16(v1[0], v1[1]); w.w = cvt_pk_bf16(v1[2], v1[3]);
                    *(u32x4*)(rowp + bj * 128) = w; } }
    }
};
constexpr int MP_XS = 0, MP_VT = 35840, MP_QS = 69632, MP_KS = 87040, MP_GT = 104448;
__device__ __forceinline__ unsigned pk_lo(unsigned a, unsigned b) { return (a & 0xffffu) | (b << 16); }
__device__ __forceinline__ unsigned pk_hi(unsigned a, unsigned b) { return (a >> 16) | (b & 0xffff0000u); }
__device__ __forceinline__ void phase_mprep(const Args& a, LAS unsigned char* lds, int vcu, int G, int tid) {
    const bf16_t* QKP = a.P3; const bf16_t* VB = a.P3 + (size_t)NT * 2048;
    for (int it = vcu; it < NB * 64; it += G) {
        const int b = it >> 6, ck = it & 63; const size_t row0 = (size_t)b * S + (size_t)ck * 64;
        __syncthreads();
        {
            const int t = tid >> 3, h = tid & 7; LAS float* gt = (LAS float*)(lds + MP_GT);
            const float gi = a.gates[(row0 + t) * 16 + h] + a.m_gb[h], z = a.gates[(row0 + t) * 16 + 8 + h] + a.m_gb[8 + h];
            gt[t * 8 + h] = gi; gt[512 + t * 8 + h] = fminf(z, 0.f) - log1pf(expf(-fabsf(z)));
        }
        __syncthreads();
        if (tid < 8) {
            const int h = tid; float bc = 0.f, cm = -INFINITY; const LAS float* gt = (const LAS float*)(lds + MP_GT);
            float* ga = a.GA + (size_t)((b * 8 + h) * 64 + ck) * 192;
            for (int t = 0; t < 64; ++t) { bc += gt[512 + t * 8 + h]; const float av = gt[t * 8 + h] - bc; cm = fmaxf(cm, av); ga[t] = av; ga[64 + t] = cm; ga[128 + t] = bc; }
            a.GS[(size_t)((b * 8 + h) * 64 + ck) * 2 + 0] = cm; a.GS[(size_t)((b * 8 + h) * 64 + ck) * 2 + 1] = bc;
        }
        for (int h = 0; h < 8; ++h) {
            for (int c = tid; c < 67 * 32; c += NTHR) { const int r = c >> 5, cc = c & 31; const int tt = r - 3;
                u32x4 v = {0u, 0u, 0u, 0u};
                if (ck * 64 + tt >= 0) v = *(const u32x4*)(QKP + (size_t)((long)row0 + tt) * 2048 + (cc < 16 ? h * 128 + cc * 8 : 1024 + h * 128 + (cc - 16) * 8));
                *(LAS u32x4*)(lds + MP_XS + r * 528 + cc * 16) = v; }
#pragma unroll
            for (int i = 0; i < 4; ++i) { const int c = tid + 512 * i, sr = c >> 5, e16 = c & 31;
                *(LAS u32x4*)(lds + MP_VT + sr * 528 + e16 * 16) = *(const u32x4*)(VB + (row0 + sr) * 2048 + h * 256 + e16 * 8); }
            __syncthreads();
            {
                const int cp = tid & 127, rq = tid >> 7; const bool isk = cp >= 64;
                const int col = isk ? 1024 + h * 128 + 2 * (cp - 64) : h * 128 + 2 * cp;
                float w0[4], w1[4];
#pragma unroll
                for (int j = 0; j < 4; ++j) { w0[j] = a.m_cw[j * 2048 + col]; w1[j] = a.m_cw[j * 2048 + col + 1]; }
                const float b0 = a.m_cb[col], b1 = a.m_cb[col + 1];
                const LAS unsigned char* xp = lds + MP_XS + (16 * rq) * 528 + cp * 4;
                float xa[4], xb[4];
#pragma unroll
                for (int j = 0; j < 3; ++j) { const unsigned v = *(const LAS unsigned*)(xp + j * 528); xa[j] = bf_lo(v); xb[j] = bf_hi(v); }
                const float sc = isk ? 0.08838834764831845f : 1.f;
                LAS unsigned char* dst = lds + (isk ? MP_KS : MP_QS) + (isk ? cp - 64 : cp) * 4;
#pragma unroll
                for (int i = 0; i < 16; ++i) { const int t = 16 * rq + i;
                    const unsigned v = *(const LAS unsigned*)(xp + (i + 3) * 528); xa[3] = bf_lo(v); xb[3] = bf_hi(v);
                    float ya = b0 + w0[0] * xa[0] + w0[1] * xa[1] + w0[2] * xa[2] + w0[3] * xa[3];
                    float yb = b1 + w1[0] * xb[0] + w1[1] * xb[1] + w1[2] * xb[2] + w1[3] * xb[3];
                    ya = ya / (1.f + __expf(-ya)) * sc; yb = yb / (1.f + __expf(-yb)) * sc;
                    *(LAS unsigned*)(dst + t * 272) = cvt_pk_bf16(ya, yb);
                    xa[0] = xa[1]; xa[1] = xa[2]; xa[2] = xa[3]; xb[0] = xb[1]; xb[1] = xb[2]; xb[2] = xb[3]; }
            }
            __syncthreads();
            {
#pragma unroll
                for (int i = 0; i < 4; ++i) { const int c = tid + 512 * i, isk = c >> 10, r = (c >> 4) & 63, cc = c & 15;
                    *(u32x4*)(a.Qn + (isk ? (size_t)NT * 1024 : (size_t)0) + (row0 + r) * 1024 + h * 128 + cc * 8) = *(const LAS u32x4*)(lds + (isk ? MP_KS : MP_QS) + r * 272 + cc * 16); }
            }
            if (tid < 256) {
                const int dp = tid & 63, sq = tid >> 6; unsigned w[16];
#pragma unroll
                for (int i = 0; i < 16; ++i) w[i] = *(const LAS unsigned*)(lds + MP_KS + (16 * sq + i) * 272 + dp * 4);
                u32x4* d0p = (u32x4*)(a.KT + ((size_t)((b * 8 + h) * 64 + ck) * 128 + 2 * dp) * 64 + 16 * sq);
                d0p[0] = (u32x4){pk_lo(w[0], w[1]), pk_lo(w[2], w[3]), pk_lo(w[4], w[5]), pk_lo(w[6], w[7])};
                d0p[1] = (u32x4){pk_lo(w[8], w[9]), pk_lo(w[10], w[11]), pk_lo(w[12], w[13]), pk_lo(w[14], w[15])};
                d0p[8] = (u32x4){pk_hi(w[0], w[1]), pk_hi(w[2], w[3]), pk_hi(w[4], w[5]), pk_hi(w[6], w[7])};
                d0p[9] = (u32x4){pk_hi(w[8], w[9]), pk_hi(w[10], w[11]), pk_hi(w[12], w[13]), pk_hi(w[14], w[15])};
            }
            {
                const int ep = tid & 127, sq = tid >> 7; unsigned w[16];
#pragma unroll
                for (int i = 0; i < 16; ++i) w[i] = *(const LAS unsigned*)(lds + MP_VT + (16 * sq + i) * 528 + ep * 4);
                u32x4* d0p = (u32x4*)(a.VT + ((size_t)((b * 8 + h) * 64 + ck) * 256 + 2 * ep) * 64 + 16 * sq);
                d0p[0] = (u32x4){pk_lo(w[0], w[1]), pk_lo(w[2], w[3]), pk_lo(w[4], w[5]), pk_lo(w[6], w[7])};
                d0p[1] = (u32x4){pk_lo(w[8], w[9]), pk_lo(w[10], w[11]), pk_lo(w[12], w[13]), pk_lo(w[14], w[15])};
                d0p[8] = (u32x4){pk_hi(w[0], w[1]), pk_hi(w[2], w[3]), pk_hi(w[4], w[5]), pk_hi(w[6], w[7])};
                d0p[9] = (u32x4){pk_hi(w[8], w[9]), pk_hi(w[10], w[11]), pk_hi(w[12], w[13]), pk_hi(w[14], w[15])};
            }
            __syncthreads();
        }
    }
}

constexpr int ML_QS = 0, ML_KS = 17408, ML_KTS = 34816, ML_VTS = 53248, ML_GL = 60160, ML_PL = 60928, ML_QD = 70144, ML_CL = 87552, ML_MP = 113664, ML_END = 113920;
typedef short bf16x8s __attribute__((ext_vector_type(8)));
__device__ __forceinline__ void phase_mlstm(const Args& a, LAS unsigned char* lds, int vcu, int G, int tid, int wave, int lane) {
    const int r16 = lane & 15, q4 = lane >> 4;
    for (int unit = vcu; unit < 256; unit += G) {
        const int bh = unit >> 3, es = unit & 7, b = bh >> 3, h = bh & 7;
        __syncthreads();
        for (int i = tid; i < 16 * 36; i += NTHR) { const int r = i / 36, c = i % 36; *(LAS unsigned*)(lds + ML_VTS + (32 + r) * 144 + c * 4) = (r == 0) ? 0x3F803F80u : 0u; }
        for (int i = tid; i < 48 * 68; i += NTHR) *(LAS unsigned*)(lds + ML_CL + i * 4) = 0u;
        if (tid < 64) { ((LAS float*)(lds + ML_END))[2 * tid] = a.GS[(size_t)(bh * 64 + tid) * 2]; ((LAS float*)(lds + ML_END))[2 * tid + 1] = a.GS[(size_t)(bh * 64 + tid) * 2 + 1]; }
        __syncthreads();
        if (tid == 0) { float m = 0.f; LAS float* mp = (LAS float*)(lds + ML_MP); const LAS float* gs = (const LAS float*)(lds + ML_END);
            for (int k = 0; k < 64; ++k) { mp[k] = m; m = gs[2 * k + 1] + fmaxf(m, gs[2 * k]); } }
        f32x4 accC[2][3];
#pragma unroll
        for (int i = 0; i < 2; ++i)
#pragma unroll
            for (int j = 0; j < 3; ++j) accC[i][j] = (f32x4){0.f, 0.f, 0.f, 0.f};
        u32x4 rq[2], rk[2], rkt[2], rv, rg, sq[2], sk[2], skt[2], sv, sg;
        rv = (u32x4){0u, 0u, 0u, 0u}; rg = rv; sv = rv; sg = rv;
#define ML_LOAD(k, Q_, K_, KT_, V_, G_) do { const int kc_ = (k) < 64 ? (k) : 63; const size_t row0_ = (size_t)b * S + (size_t)kc_ * 64; const size_t cb_ = (size_t)(bh * 64 + kc_); \
        _Pragma("unroll") for (int i_ = 0; i_ < 2; ++i_) { const int c_ = tid + 512 * i_; \
            Q_[i_] = *(const u32x4*)(a.Qn + (row0_ + (c_ >> 4)) * 1024 + h * 128 + (c_ & 15) * 8); \
            K_[i_] = *(const u32x4*)(a.Kn + (row0_ + (c_ >> 4)) * 1024 + h * 128 + (c_ & 15) * 8); \
            KT_[i_] = *(const u32x4*)(a.KT + cb_ * 8192 + (size_t)c_ * 8); } \
        V_ = *(const u32x4*)(a.VT + cb_ * 16384 + (size_t)es * 2048 + (size_t)(tid & 255) * 8); \
        G_ = *(const u32x4*)(a.GA + cb_ * 192 + (tid & 31) * 4); } while (0)
#define ML_STORE(Q_, K_, KT_, V_, G_) do { \
        _Pragma("unroll") for (int i_ = 0; i_ < 2; ++i_) { const int c_ = tid + 512 * i_; \
            *(LAS u32x4*)(lds + ML_QS + (c_ >> 4) * 272 + (c_ & 15) * 16) = Q_[i_]; \
            *(LAS u32x4*)(lds + ML_KS + (c_ >> 4) * 272 + (c_ & 15) * 16) = K_[i_]; \
            *(LAS u32x4*)(lds + ML_KTS + (c_ >> 3) * 144 + (c_ & 7) * 16) = KT_[i_]; } \
        if (tid < 256) *(LAS u32x4*)(lds + ML_VTS + (tid >> 3) * 144 + (tid & 7) * 16) = V_; \
        if (tid < 48) *(LAS u32x4*)(lds + ML_GL + tid * 16) = G_; } while (0)
        ML_LOAD(0, rq, rk, rkt, rv, rg);
        ML_STORE(rq, rk, rkt, rv, rg);
        __syncthreads();
        ML_LOAD(1, rq, rk, rkt, rv, rg); ML_LOAD(2, sq, sk, skt, sv, sg);
        auto chunk = [&](const int k) __attribute__((always_inline)) {
            const LAS float* ga = (const LAS float*)(lds + ML_GL);
            const float m = ((const LAS float*)(lds + ML_MP))[k];
            const int cur = k & 1;
            if (wave < 4) {
                const int tr = wave, t = 16 * tr + r16;
                const float Mt = fmaxf(m, ga[64 + t]);
                bf16x8s qf[4];
#pragma unroll
                for (int kk = 0; kk < 4; ++kk) qf[kk] = *(const LAS bf16x8s*)(lds + ML_QS + t * 272 + kk * 64 + q4 * 16);
#pragma unroll
                for (int sc = 0; sc < 4; ++sc) {
                    u32x2 w0 = {0u, 0u};
                    if (sc <= tr) {
                        f32x4 s0 = {0.f, 0.f, 0.f, 0.f};
#pragma unroll
                        for (int kk = 0; kk < 4; ++kk) { const bf16x8s kf = *(const LAS bf16x8s*)(lds + ML_KS + (16 * sc + r16) * 272 + kk * 64 + q4 * 16);
                            s0 = __builtin_amdgcn_mfma_f32_16x16x32_bf16(kf, qf[kk], s0, 0, 0, 0); }
                        const f32x4 a0 = *(const LAS f32x4*)(lds + ML_GL + (16 * sc + 4 * q4) * 4);
                        float p[4];
#pragma unroll
                        for (int j = 0; j < 4; ++j) { const int sA = 16 * sc + 4 * q4 + j; p[j] = (sA <= t) ? s0[j] * __expf(a0[j] - Mt) : 0.f; }
                        w0.x = cvt_pk_bf16(p[0], p[1]); w0.y = cvt_pk_bf16(p[2], p[3]);
                    }
                    *(LAS u32x2*)(lds + ML_PL + t * 144 + (16 * sc + 4 * q4) * 2) = w0;
                }
                {
                    const int tq = 16 * tr + (lane >> 2), c0 = (lane & 3) * 32;
                    const float dec = __expf(m - fmaxf(m, ga[64 + tq]));
#pragma unroll
                    for (int i = 0; i < 4; ++i) { const u32x4 v = *(const LAS u32x4*)(lds + ML_QS + tq * 272 + (c0 + 8 * i) * 2); u32x4 o;
                        o.x = cvt_pk_bf16(bf_lo(v.x) * dec, bf_hi(v.x) * dec); o.y = cvt_pk_bf16(bf_lo(v.y) * dec, bf_hi(v.y) * dec);
                        o.z = cvt_pk_bf16(bf_lo(v.z) * dec, bf_hi(v.z) * dec); o.w = cvt_pk_bf16(bf_lo(v.w) * dec, bf_hi(v.w) * dec);
                        *(LAS u32x4*)(lds + ML_QD + tq * 272 + (c0 + 8 * i) * 2) = o; }
                }
                asm volatile("s_waitcnt lgkmcnt(0)" ::: "memory");
                f32x4 o0 = {0.f, 0.f, 0.f, 0.f}, o1 = o0, o2 = o0;
#pragma unroll
                for (int kk = 0; kk < 2; ++kk) {
                    if (kk * 2 <= tr) {
                    const bf16x8s pf = *(const LAS bf16x8s*)(lds + ML_PL + t * 144 + kk * 64 + q4 * 16);
                    const bf16x8s v0 = *(const LAS bf16x8s*)(lds + ML_VTS + (r16) * 144 + kk * 64 + q4 * 16);
                    const bf16x8s v1 = *(const LAS bf16x8s*)(lds + ML_VTS + (16 + r16) * 144 + kk * 64 + q4 * 16);
                    const bf16x8s v2 = *(const LAS bf16x8s*)(lds + ML_VTS + (32 + r16) * 144 + kk * 64 + q4 * 16);
                    o0 = __builtin_amdgcn_mfma_f32_16x16x32_bf16(v0, pf, o0, 0, 0, 0);
                    o1 = __builtin_amdgcn_mfma_f32_16x16x32_bf16(v1, pf, o1, 0, 0, 0);
                    o2 = __builtin_amdgcn_mfma_f32_16x16x32_bf16(v2, pf, o2, 0, 0, 0); }
                }
#pragma unroll
                for (int kk = 0; kk < 4; ++kk) {
                    const bf16x8s qd = *(const LAS bf16x8s*)(lds + ML_QD + t * 272 + kk * 64 + q4 * 16);
                    const bf16x8s c0 = *(const LAS bf16x8s*)(lds + ML_CL + cur * 13056 + (r16) * 272 + kk * 64 + q4 * 16);
                    const bf16x8s c1 = *(const LAS bf16x8s*)(lds + ML_CL + cur * 13056 + (16 + r16) * 272 + kk * 64 + q4 * 16);
                    const bf16x8s c2 = *(const LAS bf16x8s*)(lds + ML_CL + cur * 13056 + (32 + r16) * 272 + kk * 64 + q4 * 16);
                    o0 = __builtin_amdgcn_mfma_f32_16x16x32_bf16(c0, qd, o0, 0, 0, 0);
                    o1 = __builtin_amdgcn_mfma_f32_16x16x32_bf16(c1, qd, o1, 0, 0, 0);
                    o2 = __builtin_amdgcn_mfma_f32_16x16x32_bf16(c2, qd, o2, 0, 0, 0);
                }
                const float den = __shfl(o2[0], r16);
                const float mt = ga[128 + t] + Mt;
                const float inv = 1.f / fmaxf(fabsf(den), __expf(-mt));
                bf16_t* hp = a.HS + ((size_t)b * S + (size_t)k * 64 + t) * 2048 + h * 256 + es * 32 + 4 * q4;
                u32x2 w0, w1; w0.x = cvt_pk_bf16(o0[0] * inv, o0[1] * inv); w0.y = cvt_pk_bf16(o0[2] * inv, o0[3] * inv);
                w1.x = cvt_pk_bf16(o1[0] * inv, o1[1] * inv); w1.y = cvt_pk_bf16(o1[2] * inv, o1[3] * inv);
                *(u32x2*)hp = w0; *(u32x2*)(hp + 16) = w1;
            } else {
                const int dj = wave - 4;
                const float Ml = fmaxf(m, ga[64 + 63]), cd = __expf(m - Ml);
#pragma unroll
                for (int i = 0; i < 2; ++i)
#pragma unroll
                    for (int et = 0; et < 3; ++et) accC[i][et] = accC[i][et] * cd;
#pragma unroll
                for (int kk = 0; kk < 2; ++kk) {
                    const f32x4 aA = *(const LAS f32x4*)(lds + ML_GL + (32 * kk + 8 * q4) * 4), aB = *(const LAS f32x4*)(lds + ML_GL + (32 * kk + 8 * q4 + 4) * 4);
                    float wg[8];
#pragma unroll
                    for (int j = 0; j < 4; ++j) { wg[j] = __expf(aA[j] - Ml); wg[4 + j] = __expf(aB[j] - Ml); }
                    bf16x8s vw[3];
#pragma unroll
                    for (int et = 0; et < 3; ++et) { const u32x4 v = *(const LAS u32x4*)(lds + ML_VTS + (16 * et + r16) * 144 + kk * 64 + q4 * 16); u32x4 o;
                        o.x = cvt_pk_bf16(bf_lo(v.x) * wg[0], bf_hi(v.x) * wg[1]); o.y = cvt_pk_bf16(bf_lo(v.y) * wg[2], bf_hi(v.y) * wg[3]);
                        o.z = cvt_pk_bf16(bf_lo(v.z) * wg[4], bf_hi(v.z) * wg[5]); o.w = cvt_pk_bf16(bf_lo(v.w) * wg[6], bf_hi(v.w) * wg[7]);
                        vw[et] = __builtin_bit_cast(bf16x8s, o); }
#pragma unroll
                    for (int i = 0; i < 2; ++i) { const bf16x8s kf = *(const LAS bf16x8s*)(lds + ML_KTS + (16 * (2 * dj + i) + r16) * 144 + kk * 64 + q4 * 16);
#pragma unroll
                        for (int et = 0; et < 3; ++et) accC[i][et] = __builtin_amdgcn_mfma_f32_16x16x32_bf16(kf, vw[et], accC[i][et], 0, 0, 0); }
                }
#pragma unroll
                for (int i = 0; i < 2; ++i)
#pragma unroll
                    for (int et = 0; et < 3; ++et) { u32x2 w; w.x = cvt_pk_bf16(accC[i][et][0], accC[i][et][1]); w.y = cvt_pk_bf16(accC[i][et][2], accC[i][et][3]);
                        *(LAS u32x2*)(lds + ML_CL + (cur ^ 1) * 13056 + (16 * et + r16) * 272 + (16 * (2 * dj + i) + 4 * q4) * 2) = w; }
            }
        };
        for (int k = 0; k < 64; k += 2) {
            chunk(k);
            __syncthreads();
            ML_STORE(rq, rk, rkt, rv, rg);
            __syncthreads();
            ML_LOAD(k + 3, rq, rk, rkt, rv, rg);
            chunk(k + 1);
            __syncthreads();
            ML_STORE(sq, sk, skt, sv, sg);
            __syncthreads();
            ML_LOAD(k + 4, sq, sk, skt, sv, sg);
        }
#undef ML_LOAD
#undef ML_STORE
    }
}
__device__ __forceinline__ void phase_mnorm(const Args& a, int gw, int NGW, int lane) {
    const bf16_t* SG = a.P3 + (size_t)2 * NT * 2048;
    float gv[32];
#pragma unroll
    for (int i = 0; i < 8; ++i) { const f32x4 t = *(const f32x4*)(a.m_hg + 32 * lane + 4 * i); gv[4 * i] = t[0]; gv[4 * i + 1] = t[1]; gv[4 * i + 2] = t[2]; gv[4 * i + 3] = t[3]; }
    const int RPW = (NT + NGW - 1) / NGW; int m = gw * RPW; const int mend = (m + RPW < NT) ? m + RPW : NT;
    if (m >= mend) return;
    u32x4 p0[4], p1[4], n0[4], n1[4];
#pragma unroll
    for (int i = 0; i < 4; ++i) { p0[i] = *(const u32x4*)(a.HS + (size_t)m * D + 32 * lane + 8 * i); p1[i] = *(const u32x4*)(SG + (size_t)m * D + 32 * lane + 8 * i); }
    for (;;) {
        const bool more = m + 1 < mend;
        if (more) {
#pragma unroll
            for (int i = 0; i < 4; ++i) { n0[i] = *(const u32x4*)(a.HS + (size_t)(m + 1) * D + 32 * lane + 8 * i); n1[i] = *(const u32x4*)(SG + (size_t)(m + 1) * D + 32 * lane + 8 * i); } }
        float o[32], sg[32]; float ss = 0.f;
#pragma unroll
        for (int i = 0; i < 4; ++i) { float f0[8], f1[8]; bf8_to_f32(p0[i], f0); bf8_to_f32(p1[i], f1);
#pragma unroll
            for (int j = 0; j < 8; ++j) { o[8 * i + j] = f0[j]; sg[8 * i + j] = f1[j]; ss += f0[j] * f0[j]; } }
        ss += __shfl_xor(ss, 1); ss += __shfl_xor(ss, 2); ss += __shfl_xor(ss, 4);
        const float r = rsqrtf(ss * (1.f / 256.f) + EPS);
        unsigned char* orow = a.ob8 + (size_t)m * D + 32 * lane;
#pragma unroll
        for (int i = 0; i < 4; ++i) { float y[8];
#pragma unroll
            for (int j = 0; j < 8; ++j) y[j] = o[8 * i + j] * r * gv[8 * i + j] * sg[8 * i + j];
            u32x2 w; w.x = pk4_fp8(y[0] * 8.f, y[1] * 8.f, y[2] * 8.f, y[3] * 8.f); w.y = pk4_fp8(y[4] * 8.f, y[5] * 8.f, y[6] * 8.f, y[7] * 8.f);
            *(u32x2*)(orow + 8 * i) = w; }
        if (!more) break;
        ++m;
#pragma unroll
        for (int i = 0; i < 4; ++i) { p0[i] = n0[i]; p1[i] = n1[i]; }
    }
}

#define XB_TMO      128
#define XB_XCNT(j)  (256  + 64 * (j))
#define XB_XSUB(j)  (1280 + 64 * (j))
#define XB_XGEN(j)  (2304 + 64 * (j))
#define XB_TOP      3328
#define XB_TOPGEN   3392
#define XCD_BAR_WORDS 3456
#define XB_SPIN_CAP (1u << 18)

__device__ __forceinline__ unsigned xb_ld(unsigned* p)              { return __hip_atomic_load(p, __ATOMIC_RELAXED, __HIP_MEMORY_SCOPE_AGENT); }
__device__ __forceinline__ unsigned xb_add(unsigned* p, unsigned v) { return __hip_atomic_fetch_add(p, v, __ATOMIC_RELAXED, __HIP_MEMORY_SCOPE_AGENT); }
__device__ __forceinline__ unsigned xb_xcc_id() { return (unsigned)__builtin_amdgcn_s_getreg((3 << 11) | 20) & 0xFu; }
#define XB_SPIN(cond, bar) do { unsigned _sp = 0; while (cond) { __builtin_amdgcn_s_sleep(1); \
    if ((++_sp & 255u) == 0u) { if (xb_ld(&(bar)[XB_TMO])) break; if (_sp > XB_SPIN_CAP) { atomicAdd(&(bar)[XB_TMO], 1u); break; } } } } while (0)

struct XcdBarrier {
    unsigned* bar; unsigned x;
    volatile LAS unsigned* st;
};

__device__ __forceinline__ XcdBarrier xcd_barrier_post(unsigned* bar, volatile LAS unsigned* st) {
    XcdBarrier b; b.bar = bar; b.x = xb_xcc_id(); b.st = st;
    if (threadIdx.x == 0) (void)xb_add(&bar[XB_XCNT(b.x)], 1u);
    return b;
}
__device__ __forceinline__ void xcd_barrier_complete(unsigned* bar, unsigned x, unsigned& nloc, unsigned& nx) {
    const unsigned G = gridDim.x * gridDim.y * gridDim.z;
    unsigned sum, cnt, mine, sp = 0u;
    for (;;) {
        sum = 0u; cnt = 0u; mine = 0u;
#pragma unroll
        for (unsigned j = 0; j < 16; ++j) { const unsigned c = xb_ld(&bar[XB_XCNT(j)]); sum += c; cnt += (c > 0u) ? 1u : 0u; mine = (j == x) ? c : mine; }
        if (sum == G) break;
        __builtin_amdgcn_s_sleep(1);
        if ((++sp & 255u) == 0u) { if (xb_ld(&bar[XB_TMO])) break; if (sp > XB_SPIN_CAP) { atomicAdd(&bar[XB_TMO], 1u); break; } }
    }
    nloc = mine > 0u ? mine : 1u; nx = cnt > 0u ? cnt : 1u;
}

__device__ __forceinline__ void xcd_barrier(const XcdBarrier& b) {
    asm volatile("s_waitcnt vmcnt(0)" ::: "memory");
    __syncthreads();
    if (threadIdx.x == 0) {
        unsigned* bar = b.bar;
        __builtin_amdgcn_s_waitcnt(0);
        unsigned nloc = b.st[0], nx = b.st[1];
        if (nloc == 0u) { xcd_barrier_complete(bar, b.x, nloc, nx); b.st[0] = nloc; b.st[1] = nx; }
        const unsigned old = xb_add(&bar[XB_XSUB(b.x)], 1u);
        const unsigned gen = old / nloc;
        if (old + 1u == (gen + 1u) * nloc) {
            __builtin_amdgcn_fence(__ATOMIC_RELEASE, "agent");
            asm volatile("s_waitcnt vmcnt(0)" ::: "memory");
            const unsigned og = xb_add(&bar[XB_TOP], 1u);
            const unsigned tg = og / nx;
            if (og + 1u == (tg + 1u) * nx) xb_add(&bar[XB_TOPGEN], 1u);
            else XB_SPIN(xb_ld(&bar[XB_TOPGEN]) == tg, bar);
            __builtin_amdgcn_fence(__ATOMIC_ACQUIRE, "agent");
            xb_add(&bar[XB_XGEN(b.x)], 1u);
            asm volatile("s_waitcnt vmcnt(0)" ::: "memory");
        } else {
            XB_SPIN(xb_ld(&bar[XB_XGEN(b.x)]) == gen, bar);
            __builtin_amdgcn_fence(__ATOMIC_ACQUIRE, "agent");
            asm volatile("s_waitcnt vmcnt(0)" ::: "memory");
        }
    }
    __syncthreads();
}


#ifndef MK_REP_MASK
#define MK_REP_MASK 0u
#endif
__device__ __forceinline__ constexpr int REPS(int k) { return ((MK_REP_MASK >> k) & 1u) ? 2 : 1; }
__global__ void __launch_bounds__(NTHR, 2) mk_fwd(Args a) {
    extern __shared__ __attribute__((aligned(16))) unsigned char lds_raw[];
    LAS unsigned char* lds = (LAS unsigned char*)lds_raw;
    LAS unsigned char* misc = lds + LDS_MISC;
    const int tid = threadIdx.x, lane = tid & 63, wave = __builtin_amdgcn_readfirstlane(tid >> 6);
    const int G = gridDim.x; const int bx = blockIdx.x; const int vcu = (G % 8 == 0) ? (bx % 8) * (G / 8) + bx / 8 : bx;
    const int gw = vcu * NWAVES + wave, NGW = G * NWAVES;
    if (tid < 16) ((LAS unsigned*)(misc + MISC_BAR))[tid] = 0u;
    __syncthreads();
    const int lo = a.ph_lo, hi = a.ph_hi;
    XcdBarrier bar; bar.bar = a.ctl + 4096; bar.x = 0; bar.st = nullptr;
    if (hi - lo > 1) bar = xcd_barrier_post(a.ctl + 4096, (volatile LAS unsigned*)(misc + MISC_BAR));
#define IN(k) (lo <= (k) && (k) < hi)
#define SEAM(k) do { if (IN(k) && IN((k) + 1)) xcd_barrier(bar); } while (0)
    const float* mod0 = a.mod; const float* mod1 = a.mod + (size_t)NB * 6 * D;

#define PH(k) if (IN(k)) _Pragma("unroll") for (int rep_ = 0; rep_ < REPS(k); (REPS(k) > 1 ? __syncthreads() : (void)0, ++rep_))
    PH(0) { p0_prologue(a, lds, vcu, G, opq(tid), wave, opq(lane)); } SEAM(0);
    PH(1) { phase_norm(a.x, a.nmg, mod0, 0, 1, a.hb, gw, NGW, opq(lane)); } SEAM(1);
    PH(2) {
        pg8::Gemm g{a.hb, a.Bt_qkv, NT, 6144, D}; pg8::StaticOrder So; So.init(NT, 6144, G, bx);
        EpiQKV E{a.Qh, a.Kh, a.Vh, a.cs};
        pg8::gemm_phase<EpiQKV, pg8::StaticOrder, true, true>(lds, g, So, E);
    } SEAM(2);
    PH(3) { phase_attn(a, (char*)lds_raw, vcu, G); } SEAM(3);
    PH(4) { phase_attn_combine(a, gw, NGW, opq(lane)); } SEAM(4);
    PH(5) {
        pg8::Gemm g{a.ob, a.Bt_ao, NT, D, D}; pg8::StaticOrder So; So.init(NT, D, G, bx);
        EpiResid<true> E{a.x, a.xres, mod0 + 2 * D, 1.f};
        pg8::gemm_phase<EpiResid<true>, pg8::StaticOrder, true, true>(lds, g, So, E);
    } SEAM(5);
#define MOE_PHASES(P, layer, modl)                                                                                                   \
    PH(P) { phase_norm_route(a, layer, modl, lds, misc, vcu, G, opq(tid), wave, opq(lane)); } SEAM(P);                            \
    PH(P + 1) { const int NP = moe_tables(a.counts + (layer) * 64, misc, tid);                                                    \
        pg8::Gemm g{(const bf16_t*)a.hb8, (const bf16_t*)(a.Bt_gu8 + (size_t)(layer) * NE * 2048 * D), NP * 256, NE * 2048, D / 2};     \
        GroupedOrderG So; So.NP = NP; So.total = NP * 8; So.G = G; So.c = vcu; So.pe = (const LAS int*)(misc + MISC_PE);          \
        So.ps = (const LAS int*)(misc + MISC_PS); So.cn = (const LAS int*)(misc + MISC_CNT); So.inv = a.inv; EpiGU E{a.Hm8};      \
        pg8::gemm_phase_gather<EpiGU, GroupedOrderG, true, 125, 121>(lds, g, So, E); } SEAM(P + 1);                                               \
    PH(P + 2) { const int NP = moe_tables(a.counts + (layer) * 64, misc, tid);                                                    \
        pg8::Gemm g{(const bf16_t*)a.Hm8, (const bf16_t*)(a.Bt_dn8 + (size_t)(layer) * NE * D * MH), NP * 256, NE * 2048, MH / 2};   \
        GroupedOrder So{NP, NP * 8, G, vcu, (const LAS int*)(misc + MISC_PE)}; EpiBf16G E{a.Y, D, 1.f / 128.f};                                \
        pg8::gemm_phase<EpiBf16G, GroupedOrder, true, true, true, 125, 122>(lds, g, So, E); } SEAM(P + 2);
    MOE_PHASES(6, 0, mod0)
    PH(9) { moe_tables(a.counts, misc, tid); phase_combine_gates(a, mod0, mod1, a.nmg + D, (const LAS int*)(misc + MISC_PS), lds, vcu, G, opq(tid), wave, opq(lane)); } SEAM(9);
    PH(10) {
        pg8::Gemm g{(const bf16_t*)a.hb8, (const bf16_t*)a.Bt_min8, NT, 6144, D / 2}; pg8::StaticOrder So; So.init(NT, 6144, G, bx);
        EpiMin E{a.P3};
        pg8::gemm_phase<EpiMin, pg8::StaticOrder, true, true, true>(lds, g, So, E);
    } SEAM(10);
    PH(11) { phase_mprep(a, lds, vcu, G, opq(tid)); } SEAM(11);
    PH(12) { phase_mlstm(a, lds, vcu, G, opq(tid), wave, opq(lane)); } SEAM(12);
    PH(13) { phase_mnorm(a, gw, NGW, opq(lane)); } SEAM(13);
    PH(14) {
        pg8::Gemm g{(const bf16_t*)a.ob8, (const bf16_t*)a.Bt_mo8, NT, D, D / 2}; pg8::StaticOrder So; So.init(NT, D, G, bx);
        EpiResid<false> E{a.xres, a.xres, mod1 + 2 * D, 1.f / 512.f};
        pg8::gemm_phase<EpiResid<false>, pg8::StaticOrder, true, true, true>(lds, g, So, E);
    } SEAM(14);
    MOE_PHASES(15, 1, mod1)
    PH(18) { moe_tables(a.counts + 64, misc, tid); phase_combine_final(a, mod1, (const LAS int*)(misc + MISC_PS), gw, NGW, opq(lane)); }
#undef PH
#undef IN
#undef SEAM
}
}

extern "C" void kernel_launch(void* const* d_in, const int* in_sizes, int n_in, void* d_out, int out_size, void* d_ws, size_t ws_size, hipStream_t st) {
    using namespace mk;
    static int grid = 0;
    if (grid == 0) {
        int dev = 0, cus = 0;
        if (hipGetDevice(&dev) != hipSuccess || hipDeviceGetAttribute(&cus, hipDeviceAttributeMultiprocessorCount, dev) != hipSuccess || cus <= 0) cus = 256;
        (void)hipFuncSetAttribute((const void*)mk_fwd, hipFuncAttributeMaxDynamicSharedMemorySize, LDS_BYTES);
        int per_cu = 0; (void)hipOccupancyMaxActiveBlocksPerMultiprocessor(&per_cu, (const void*)mk_fwd, NTHR, LDS_BYTES);
        (void)hipGetLastError();
        grid = cus;
    }
    Args a{};
    a.x = (const float*)d_in[0]; a.c = (const float*)d_in[1]; a.pos = (const int*)d_in[2];
    a.ada_w = (const float*)d_in[3]; a.ada_b = (const float*)d_in[4]; a.nmg = (const float*)d_in[5]; a.nfg = (const float*)d_in[6]; a.fng = (const float*)d_in[7];
    a.a_win = (const float*)d_in[8]; a.a_wout = (const float*)d_in[9];
    a.lq1 = (const float*)d_in[10]; a.lk1 = (const float*)d_in[11]; a.lq2 = (const float*)d_in[12]; a.lk2 = (const float*)d_in[13]; a.a_hg = (const float*)d_in[14];
    a.m_win = (const float*)d_in[15]; a.m_cw = (const float*)d_in[16]; a.m_cb = (const float*)d_in[17]; a.m_gb = (const float*)d_in[18]; a.m_hg = (const float*)d_in[19]; a.m_wout = (const float*)d_in[20];
    a.wg = (const float*)d_in[21]; a.bg = (const float*)d_in[22]; a.we = (const float*)d_in[23]; a.be = (const float*)d_in[24]; a.wgu = (const float*)d_in[25]; a.wdn = (const float*)d_in[26];
    a.out = (float*)d_out;
    char* w = (char*)d_ws; size_t off = 0;
    auto alloc = [&](size_t bytes) { void* p = w + off; off += (bytes + 4095) & ~(size_t)4095; return p; };
    a.ctl = (unsigned*)alloc(1 << 20);
    a.counts = (int*)(a.ctl + 65536);
    a.mod = (float*)alloc((size_t)2 * NB * 6 * D * 4);
    a.cs = (float2*)alloc((size_t)NT * 16 * 8);
    a.Bt_qkv = (bf16_t*)alloc((size_t)6144 * D * 2); a.Bt_ao = (bf16_t*)alloc((size_t)D * D * 2); a.Bt_min = nullptr; a.Bt_mo = nullptr; a.Bt_min8 = (unsigned char*)alloc((size_t)6144 * D); a.Bt_mo8 = (unsigned char*)alloc((size_t)D * D);
    a.Bt_rt = (bf16_t*)alloc((size_t)2 * 256 * D * 2); a.Bt_g = (bf16_t*)alloc((size_t)16 * D * 2); a.Bt_gu = nullptr; a.Bt_dn = nullptr;
    a.Bt_gu8 = (unsigned char*)alloc((size_t)2 * NE * 2048 * D); a.Bt_dn8 = (unsigned char*)alloc((size_t)2 * NE * D * MH); a.hb8 = (unsigned char*)alloc((size_t)(NT + 1) * D);
    a.xres = (bf16_t*)alloc((size_t)NT * D * 2); a.hb = (bf16_t*)alloc((size_t)(NT + 1) * D * 2); a.ob = (bf16_t*)alloc((size_t)NT * D * 2); a.ob8 = (unsigned char*)a.ob;

    a.logits = nullptr; a.eid = (int*)alloc((size_t)NA * 4); a.wts = (float*)alloc((size_t)NA * 4); a.pos_in_e = (int*)alloc((size_t)NA * 4); a.slot = nullptr; a.inv = (int*)alloc((size_t)NE * 32768 * 4);
    a.Qh = (bf16_t*)alloc((size_t)3 * NT * 2048 * 2); a.Kh = a.Qh + (size_t)NT * 2048; a.Vh = a.Kh + (size_t)NT * 2048; a.Oa = (bf16_t*)alloc((size_t)NT * 4096 * 2);
    a.P3 = (bf16_t*)alloc((size_t)3 * NT * 2048 * 2); a.Qn = (bf16_t*)alloc((size_t)2 * NT * 1024 * 2); a.Kn = a.Qn + (size_t)NT * 1024;
    a.KT = (bf16_t*)alloc((size_t)NT * 1024 * 2); a.VT = (bf16_t*)alloc((size_t)NT * 2048 * 2); a.HS = (bf16_t*)alloc((size_t)NT * 2048 * 2);
    a.gates = (float*)alloc((size_t)NT * 16 * 4); a.GA = (float*)alloc((size_t)32 * 64 * 192 * 4); a.GS = (float*)alloc((size_t)32 * 64 * 2 * 4);
    a.XG = nullptr; a.Hm = nullptr; a.Hm8 = (unsigned char*)alloc((size_t)PMAX * MH); a.Y = (bf16_t*)alloc((size_t)PMAX * D * 2);
    if (off > ws_size) return;

    (void)hipMemsetAsync(a.ctl, 0, 1 << 20, st);
    auto run = [&](int lo, int hi) { a.ph_lo = lo; a.ph_hi = hi; hipLaunchKernelGGL(mk_fwd, dim3(grid), dim3(NTHR), LDS_BYTES, st, a); };
#ifndef MK_N_LAUNCHES
#define MK_N_LAUNCHES 1
#endif
#if MK_N_LAUNCHES == 1
    run(0, 19);
#else
    for (int p = 0; p <= 18; ++p) run(p, p + 1);
#endif
}
```

```cpp
#include <hip/hip_runtime.h>
#include <math.h>
#include <stdint.h>


namespace pg8 {
#define PG8_LAS __attribute__((address_space(3)))
typedef unsigned short bf16_t;
typedef short bf16x8 __attribute__((ext_vector_type(8)));
typedef float f32x4 __attribute__((ext_vector_type(4)));
typedef unsigned u32x4 __attribute__((ext_vector_type(4)));
constexpr int BM = 256, BK = 64, HALF = 128, KBP = 1088  , HTB = 16 * KBP  , STAGE_BYTES = 8 * HTB, NXCD = 8, WGM = 8;

__host__ __device__ __forceinline__ int lds_byte(int r, int c) { const int ch = c >> 3, p = (ch & 4) | ((ch & 3) ^ ((r >> 1) & 3)); return (r >> 3) * KBP + (r & 7) * 128 + p * 16 + (c & 7) * 2; }
__host__ __device__ __forceinline__ void stage_rc(int tid, int i, int& R, int& C) { const int g = (tid >> 6) + 8 * i, l = tid & 63, rr = l >> 3, p = l & 7, ch = (p & 4) | ((p & 3) ^ ((rr >> 1) & 3)); R = 8 * g + rr; C = ch * 8; }
__host__ __device__ __forceinline__ int perm32(int rho) { const int n = rho >> 4, i = rho & 15; return 8 * (i >> 2) + 4 * n + (i & 3); }

typedef int i32x4 __attribute__((ext_vector_type(4)));
typedef int i32x8 __attribute__((ext_vector_type(8)));
typedef int i32x2 __attribute__((ext_vector_type(2)));
__device__ __forceinline__ i32x8 cat8(i32x4 l, i32x4 h) { return __builtin_shufflevector(l, h, 0, 1, 2, 3, 4, 5, 6, 7); }
__device__ __forceinline__ void mfma_scale_f8(f32x4& acc, i32x8 b, i32x8 a, int sc) {
    asm volatile("v_mfma_scale_f32_16x16x128_f8f6f4 %0, %1, %2, %0, %3, %3 op_sel_hi:[0,0,0]" : "+v"(acc) : "v"(b), "v"(a), "v"(sc));
}
struct Unit { int pm, pn; };
struct Gemm { const bf16_t* A; const bf16_t* Bt; int M, N, K; };

struct StaticOrder {
    int nM, nN, nwg, G, c;
    __host__ __device__ void init(int M, int N, int G_, int c_) { nM = M / BM; nN = N / BM; nwg = nM * nN; G = G_; c = c_; }
    __host__ __device__ bool next(int i, Unit& u) const {
        const long L = (long)i * G + c; if (L >= nwg) return false;
        int wgid = (int)L; { const int q = nwg / NXCD, r = nwg % NXCD, xcd = wgid % NXCD, off = wgid / NXCD; wgid = (xcd < r ? xcd * (q + 1) : r * (q + 1) + (xcd - r) * q) + off; }
        const int nig = WGM * nN, gid = wgid / nig, fm = gid * WGM, gsz = (nM - fm) < WGM ? (nM - fm) : WGM;
        u.pm = fm + ((wgid % nig) % gsz); u.pn = (wgid % nig) / gsz; return true;
    }
    __device__ __forceinline__ void a_ready(const Unit&) const {}
    __device__ __forceinline__ void done(const Unit&) const {}
};

__device__ __forceinline__ unsigned cvt_pk_bf16(float lo, float hi) { unsigned r; asm volatile("v_cvt_pk_bf16_f32 %0, %1, %2" : "=v"(r) : "v"(lo), "v"(hi)); return r; }
typedef float f32x2 __attribute__((ext_vector_type(2)));
__device__ __forceinline__ f32x2 gelu_pk(f32x2 v) {
    const f32x2 av = __builtin_elementwise_abs(v), d = av * 0.2316418882f + 1.0f;
    f32x2 t; t.x = __builtin_amdgcn_rcpf(d.x); t.y = __builtin_amdgcn_rcpf(d.y);
    f32x2 q = t * 0.5307027145f + (-0.7265760135f); q = q * t + 0.7107068705f; q = q * t + (-0.142248368f); q = q * t + 0.127414796f; q = q * t;
    const f32x2 s = (v * v) * (-0.72134752044f);
    f32x2 e; e.x = __builtin_amdgcn_exp2f(s.x); e.y = __builtin_amdgcn_exp2f(s.y);
    const f32x2 m = v * (q * e), r = v - m;
    f32x2 o; o.x = v.x < 0.f ? m.x : r.x; o.y = v.y < 0.f ? m.y : r.y; return o;
}


template <class Epi, class Sched, bool ALIGN_EPI = false, bool SP2 = false, bool F8 = false, int SCA = 127, int SCB = 127>
__device__ __forceinline__ void gemm_phase(PG8_LAS unsigned char* lds, const Gemm g, const Sched& S, const Epi& E) {
    const int tid = threadIdx.x, wid = __builtin_amdgcn_readfirstlane(tid >> 6), lane = tid & 63, wr = wid >> 2, wc = wid & 3, fr = lane & 15, fq = lane >> 4;
    const int K = g.K, nt = K / BK;
    unsigned voffA[2], voffB[2];
#pragma unroll
    for (int i = 0; i < 2; ++i) { int R, C; stage_rc(tid, i, R, C); const int Rb = Epi::PERM ? ((R & ~31) + perm32(R & 31)) : R;
        voffA[i] = (unsigned)(R * K + C) * 2u; voffB[i] = (unsigned)(Rb * K + C) * 2u; }
    const size_t kstep = (size_t)(BK * 2);
    const size_t hstep = (size_t)HALF * K * 2;
    const size_t tstep = 2 * hstep;
    const unsigned ldsw = (unsigned)wid * (unsigned)KBP;
    const int aoff = lds_byte(wr * 64 + fr, fq * 8), boff = lds_byte(wc * 32 + fr, fq * 8);
#define PG8_SA(b, h) (((b) * 2 + (h)) * HTB)
#define PG8_SB(b, h) ((4 + (b) * 2 + (h)) * HTB)
#define PG8_STAGE(bufoff, gbase, voff) do { _Pragma("unroll") for (int _i = 0; _i < 2; ++_i) \
        __builtin_amdgcn_global_load_lds((const unsigned*)((const char*)(gbase) + (voff)[_i]), (PG8_LAS unsigned*)(lds + (bufoff) + ldsw + _i * (8 * KBP)), 16, 0, 0); } while (0)
#define PG8_LDA(dst, b, h) do { if constexpr (F8) { _Pragma("unroll") for (int m = 0; m < 4; ++m) dst##8[m] = cat8(*(const PG8_LAS i32x4*)(lds + PG8_SA(b, h) + aoff + m * (2 * KBP)), *(const PG8_LAS i32x4*)(lds + PG8_SA(b, h) + aoff + m * (2 * KBP) + 64)); } \
        else { _Pragma("unroll") for (int m = 0; m < 4; ++m) _Pragma("unroll") for (int k = 0; k < 2; ++k) dst[m][k] = *(const PG8_LAS bf16x8*)(lds + PG8_SA(b, h) + aoff + m * (2 * KBP) + k * 64); } } while (0)
#define PG8_LDB(dst, b, h) do { if constexpr (F8) { _Pragma("unroll") for (int n = 0; n < 2; ++n) dst##8[n] = cat8(*(const PG8_LAS i32x4*)(lds + PG8_SB(b, h) + boff + n * (2 * KBP)), *(const PG8_LAS i32x4*)(lds + PG8_SB(b, h) + boff + n * (2 * KBP) + 64)); } \
        else { _Pragma("unroll") for (int n = 0; n < 2; ++n) _Pragma("unroll") for (int k = 0; k < 2; ++k) dst[n][k] = *(const PG8_LAS bf16x8*)(lds + PG8_SB(b, h) + boff + n * (2 * KBP) + k * 64); } } while (0)
#define PG8_MMA(ai, bj, At, Bt) do { __builtin_amdgcn_s_setprio(1); _Pragma("unroll") for (int m = 0; m < 4; ++m) _Pragma("unroll") for (int n = 0; n < 2; ++n) { \
        if constexpr (F8) { mfma_scale_f8(acc[ai][bj][m][n], Bt##8[n], At##8[m], sc1); } \
        else { _Pragma("unroll") for (int k = 0; k < 2; ++k) acc[ai][bj][m][n] = __builtin_amdgcn_mfma_f32_16x16x32_bf16(Bt[n][k], At[m][k], acc[ai][bj][m][n], 0, 0, 0); } } \
        __builtin_amdgcn_s_setprio(0); } while (0)
#define PG8_WAIT_V(n) asm volatile("s_waitcnt vmcnt(" #n ")" ::: "memory")
#define PG8_WAIT_L(n) asm volatile("s_waitcnt lgkmcnt(" #n ")" ::: "memory")
#define PG8_BAR __builtin_amdgcn_s_barrier()
#define PG8_SCHED __builtin_amdgcn_sched_barrier(0)
    Unit cur, nxt; int ui = 0;
    if (!S.next(0, cur)) return;
    f32x4 acc[2][2][4][2];
#pragma unroll
    for (int a = 0; a < 2; ++a)
#pragma unroll
        for (int b = 0; b < 2; ++b)
#pragma unroll
            for (int m = 0; m < 4; ++m)
#pragma unroll
                for (int n = 0; n < 2; ++n) acc[a][b][m][n] = (f32x4){0.f, 0.f, 0.f, 0.f};
    bf16x8 At[4][2], B0[2][2], B1[2][2]; i32x8 At8[4], B08[2], B18[2]; int sc1 = 0x7f7f7f7f; asm volatile("" : "+v"(sc1));
    const char* cA = (const char*)g.A + (size_t)cur.pm * tstep; const char* cB = (const char*)g.Bt + (size_t)cur.pn * tstep;
    S.a_ready(cur);
    if constexpr (SP2) {
        PG8_STAGE(PG8_SB(0, 0), cB, voffB); PG8_STAGE(PG8_SB(0, 1), cB + hstep, voffB); PG8_STAGE(PG8_SA(0, 0), cA, voffA); PG8_STAGE(PG8_SA(0, 1), cA + hstep, voffA);
        if (wr == 1) PG8_BAR;
        PG8_WAIT_V(2); PG8_BAR;
        PG8_STAGE(PG8_SB(1, 0), cB + kstep, voffB); PG8_STAGE(PG8_SA(1, 0), cA + kstep, voffA); PG8_STAGE(PG8_SB(1, 1), cB + hstep + kstep, voffB);
        PG8_WAIT_V(6); PG8_BAR;
    } else {
        PG8_STAGE(PG8_SB(0, 0), cB, voffB); PG8_STAGE(PG8_SA(0, 0), cA, voffA); PG8_STAGE(PG8_SB(0, 1), cB + hstep, voffB); PG8_STAGE(PG8_SA(0, 1), cA + hstep, voffA);
        if (wr == 1) PG8_BAR;
        PG8_WAIT_V(4); PG8_BAR;
        PG8_STAGE(PG8_SB(1, 0), cB + kstep, voffB); PG8_STAGE(PG8_SA(1, 0), cA + kstep, voffA); PG8_STAGE(PG8_SB(1, 1), cB + hstep + kstep, voffB);
        PG8_WAIT_V(6); PG8_BAR;
    }
    for (;;) {
        const bool has_next = S.next(ui + 1, nxt);
        const char* nA = has_next ? (const char*)g.A + (size_t)nxt.pm * tstep : cA; const char* nB = has_next ? (const char*)g.Bt + (size_t)nxt.pn * tstep : cB;
#pragma nounroll
        for (int t = 0; t < nt; t += 2) {
            const bool last = (t == nt - 2);
            const char* a1 = cA + (size_t)(t + 1) * kstep;
            const char* a2 = last ? nA : cA + (size_t)(t + 2) * kstep; const char* b2 = last ? nB : cB + (size_t)(t + 2) * kstep;
            const char* a3 = a2 + kstep; const char* b3 = b2 + kstep;
            if (last && has_next) S.a_ready(nxt);
            if constexpr (SP2) {
            PG8_LDB(B0, 0, 0); PG8_LDB(B1, 0, 1); PG8_SCHED; PG8_LDA(At, 0, 0); PG8_STAGE(PG8_SA(1, 1), a1 + hstep, voffA);
            PG8_WAIT_V(8); PG8_WAIT_L(0); PG8_BAR; PG8_MMA(0, 0, At, B0); PG8_MMA(0, 1, At, B1); PG8_BAR; PG8_SCHED;
            PG8_LDA(At, 0, 1); PG8_STAGE(PG8_SB(0, 0), b2, voffB); PG8_STAGE(PG8_SB(0, 1), b2 + hstep, voffB); PG8_STAGE(PG8_SA(0, 0), a2, voffA);
            PG8_WAIT_V(8); PG8_WAIT_L(0); PG8_BAR; PG8_MMA(1, 0, At, B0); PG8_MMA(1, 1, At, B1); PG8_BAR; PG8_SCHED;
            PG8_LDB(B0, 1, 0); PG8_LDB(B1, 1, 1); PG8_SCHED; PG8_LDA(At, 1, 0); PG8_STAGE(PG8_SA(0, 1), a2 + hstep, voffA);
            PG8_WAIT_V(8); PG8_WAIT_L(0); PG8_BAR; PG8_MMA(0, 0, At, B0); PG8_MMA(0, 1, At, B1); PG8_BAR; PG8_SCHED;
            PG8_LDA(At, 1, 1); PG8_STAGE(PG8_SB(1, 0), b3, voffB); PG8_STAGE(PG8_SB(1, 1), b3 + hstep, voffB); PG8_STAGE(PG8_SA(1, 0), a3, voffA);
            PG8_WAIT_V(8); PG8_WAIT_L(0); PG8_BAR; PG8_MMA(1, 0, At, B0); PG8_MMA(1, 1, At, B1); PG8_BAR; PG8_SCHED;
            } else {
            PG8_LDB(B0, 0, 0); PG8_SCHED; PG8_LDA(At, 0, 0); PG8_STAGE(PG8_SA(1, 1), a1 + hstep, voffA);
            PG8_WAIT_L(8); PG8_BAR; PG8_WAIT_L(0); PG8_MMA(0, 0, At, B0); PG8_BAR; PG8_SCHED;
            PG8_LDB(B1, 0, 1); PG8_STAGE(PG8_SB(0, 0), b2, voffB);
            PG8_BAR; PG8_WAIT_L(0); PG8_MMA(0, 1, At, B1); PG8_BAR;
            PG8_LDA(At, 0, 1); PG8_STAGE(PG8_SA(0, 0), a2, voffA);
            PG8_BAR; PG8_WAIT_L(0); PG8_MMA(1, 0, At, B0); PG8_BAR; PG8_SCHED;
            PG8_STAGE(PG8_SB(0, 1), b2 + hstep, voffB);
            PG8_WAIT_V(6); PG8_BAR; PG8_MMA(1, 1, At, B1); PG8_BAR;
            PG8_LDB(B0, 1, 0); PG8_SCHED; PG8_LDA(At, 1, 0); PG8_STAGE(PG8_SA(0, 1), a2 + hstep, voffA);
            PG8_WAIT_L(8); PG8_BAR; PG8_WAIT_L(0); PG8_MMA(0, 0, At, B0); PG8_BAR; PG8_SCHED;
            PG8_LDB(B1, 1, 1); PG8_STAGE(PG8_SB(1, 0), b3, voffB);
            PG8_BAR; PG8_WAIT_L(0); PG8_MMA(0, 1, At, B1); PG8_BAR;
            PG8_LDA(At, 1, 1); PG8_STAGE(PG8_SA(1, 0), a3, voffA);
            PG8_BAR; PG8_WAIT_L(0); PG8_MMA(1, 0, At, B0); PG8_BAR; PG8_SCHED;
            PG8_STAGE(PG8_SB(1, 1), b3 + hstep, voffB);
            PG8_WAIT_V(6); PG8_BAR; PG8_MMA(1, 1, At, B1); PG8_BAR;
            }
        }
        if constexpr (F8) {
            asm volatile("s_nop 15\n\ts_nop 15" ::: "memory");
            _Pragma("unroll") for (int a = 0; a < 2; ++a) _Pragma("unroll") for (int b = 0; b < 2; ++b) _Pragma("unroll") for (int m = 0; m < 4; ++m) _Pragma("unroll") for (int n = 0; n < 2; ++n) asm volatile("" : "+v"(acc[a][b][m][n]));
        }
        if constexpr (ALIGN_EPI) { if (wr == 0) PG8_BAR; }
        if constexpr (!Epi::AFTER_DRAIN) { E(acc, cur, wr, wc, fr, fq); S.done(cur); }
        if (!has_next) break;
#pragma unroll
        for (int a = 0; a < 2; ++a)
#pragma unroll
            for (int b = 0; b < 2; ++b)
#pragma unroll
                for (int m = 0; m < 4; ++m)
#pragma unroll
                    for (int n = 0; n < 2; ++n) acc[a][b][m][n] = (f32x4){0.f, 0.f, 0.f, 0.f};
        cur = nxt; cA = nA; cB = nB; ++ui;
        if constexpr (ALIGN_EPI) { if (wr == 1) PG8_BAR; }
    }
    PG8_WAIT_V(0);
    if constexpr (!ALIGN_EPI) { if (wr == 0) PG8_BAR; }
    PG8_BAR;
    if constexpr (Epi::AFTER_DRAIN) { E.fused(acc, cur, wr, wc, fr, fq, lds, wid, lane); S.done(cur); }
#undef PG8_SA
#undef PG8_SB
#undef PG8_STAGE
#undef PG8_LDA
#undef PG8_LDB
#undef PG8_MMA
#undef PG8_WAIT_V
#undef PG8_WAIT_L
#undef PG8_BAR
#undef PG8_SCHED
}
template <class Epi, class Sched, bool F8 = false, int SCA = 127, int SCB = 127>
__device__ __forceinline__ void gemm_phase_gather(PG8_LAS unsigned char* lds, const Gemm g, const Sched& S, const Epi& E) {
    const int tid = threadIdx.x, wid = __builtin_amdgcn_readfirstlane(tid >> 6), lane = tid & 63, wr = wid >> 2, wc = wid & 3, fr = lane & 15, fq = lane >> 4;
    constexpr bool ALIGN_EPI = true, SP2 = true;
    const int K = g.K, nt = K / BK;
    unsigned voffA[2], voffB[2]; int rowA[2];
#pragma unroll
    for (int i = 0; i < 2; ++i) { int R, C; stage_rc(tid, i, R, C); const int Rb = Epi::PERM ? ((R & ~31) + perm32(R & 31)) : R;
        voffA[i] = (unsigned)C * 2u; rowA[i] = R; voffB[i] = (unsigned)(Rb * K + C) * 2u; }
    const size_t kstep = (size_t)(BK * 2);
    const size_t hstep = (size_t)HALF * K * 2;
    const size_t tstep = 2 * hstep;
    const unsigned ldsw = (unsigned)wid * (unsigned)KBP;
    const int aoff = lds_byte(wr * 64 + fr, fq * 8), boff = lds_byte(wc * 32 + fr, fq * 8);
#define PG8_SA(b, h) (((b) * 2 + (h)) * HTB)
#define PG8_SB(b, h) ((4 + (b) * 2 + (h)) * HTB)
#define PG8_STAGE(bufoff, gbase, voff) do { _Pragma("unroll") for (int _i = 0; _i < 2; ++_i) \
        __builtin_amdgcn_global_load_lds((const unsigned*)((const char*)(gbase) + (voff)[_i]), (PG8_LAS unsigned*)(lds + (bufoff) + ldsw + _i * (8 * KBP)), 16, 0, 0); } while (0)
#define PG8_STAGE_A(bufoff, gbase, o0, o1) do { \
        __builtin_amdgcn_global_load_lds((const unsigned*)((const char*)(gbase) + (o0)), (PG8_LAS unsigned*)(lds + (bufoff) + ldsw), 16, 0, 0); \
        __builtin_amdgcn_global_load_lds((const unsigned*)((const char*)(gbase) + (o1)), (PG8_LAS unsigned*)(lds + (bufoff) + ldsw + 8 * KBP), 16, 0, 0); } while (0)
#define PG8_GOFF(dst, u) do { _Pragma("unroll") for (int h_ = 0; h_ < 2; ++h_) _Pragma("unroll") for (int i_ = 0; i_ < 2; ++i_) dst[h_][i_] = (unsigned)S.a_row(u, 128 * h_ + rowA[i_]) * (unsigned)(K * 2) + voffA[i_]; } while (0)
#define PG8_LDA(dst, b, h) do { if constexpr (F8) { _Pragma("unroll") for (int m = 0; m < 4; ++m) dst##8[m] = cat8(*(const PG8_LAS i32x4*)(lds + PG8_SA(b, h) + aoff + m * (2 * KBP)), *(const PG8_LAS i32x4*)(lds + PG8_SA(b, h) + aoff + m * (2 * KBP) + 64)); } \
        else { _Pragma("unroll") for (int m = 0; m < 4; ++m) _Pragma("unroll") for (int k = 0; k < 2; ++k) dst[m][k] = *(const PG8_LAS bf16x8*)(lds + PG8_SA(b, h) + aoff + m * (2 * KBP) + k * 64); } } while (0)
#define PG8_LDB(dst, b, h) do { if constexpr (F8) { _Pragma("unroll") for (int n = 0; n < 2; ++n) dst##8[n] = cat8(*(const PG8_LAS i32x4*)(lds + PG8_SB(b, h) + boff + n * (2 * KBP)), *(const PG8_LAS i32x4*)(lds + PG8_SB(b, h) + boff + n * (2 * KBP) + 64)); } \
        else { _Pragma("unroll") for (int n = 0; n < 2; ++n) _Pragma("unroll") for (int k = 0; k < 2; ++k) dst[n][k] = *(const PG8_LAS bf16x8*)(lds + PG8_SB(b, h) + boff + n * (2 * KBP) + k * 64); } } while (0)
#define PG8_MMA(ai, bj, At, Bt) do { __builtin_amdgcn_s_setprio(1); _Pragma("unroll") for (int m = 0; m < 4; ++m) _Pragma("unroll") for (int n = 0; n < 2; ++n) { \
        if constexpr (F8) { mfma_scale_f8(acc[ai][bj][m][n], Bt##8[n], At##8[m], sc1); } \
        else { _Pragma("unroll") for (int k = 0; k < 2; ++k) acc[ai][bj][m][n] = __builtin_amdgcn_mfma_f32_16x16x32_bf16(Bt[n][k], At[m][k], acc[ai][bj][m][n], 0, 0, 0); } } \
        __builtin_amdgcn_s_setprio(0); } while (0)
#define PG8_WAIT_V(n) asm volatile("s_waitcnt vmcnt(" #n ")" ::: "memory")
#define PG8_WAIT_L(n) asm volatile("s_waitcnt lgkmcnt(" #n ")" ::: "memory")
#define PG8_BAR __builtin_amdgcn_s_barrier()
#define PG8_SCHED __builtin_amdgcn_sched_barrier(0)
    Unit cur, nxt; int ui = 0;
    if (!S.next(0, cur)) return;
    f32x4 acc[2][2][4][2];
#pragma unroll
    for (int a = 0; a < 2; ++a)
#pragma unroll
        for (int b = 0; b < 2; ++b)
#pragma unroll
            for (int m = 0; m < 4; ++m)
#pragma unroll
                for (int n = 0; n < 2; ++n) acc[a][b][m][n] = (f32x4){0.f, 0.f, 0.f, 0.f};
    bf16x8 At[4][2], B0[2][2], B1[2][2]; i32x8 At8[4], B08[2], B18[2]; int sc1 = 0x7f7f7f7f; asm volatile("" : "+v"(sc1));
    const char* const cA = (const char*)g.A; const char* cB = (const char*)g.Bt + (size_t)cur.pn * tstep;
    unsigned gc[2][2], gn[2][2];
    S.a_ready(cur); PG8_GOFF(gc, cur);
    if constexpr (SP2) {
        PG8_STAGE(PG8_SB(0, 0), cB, voffB); PG8_STAGE(PG8_SB(0, 1), cB + hstep, voffB); PG8_STAGE_A(PG8_SA(0, 0), cA, gc[0][0], gc[0][1]); PG8_STAGE_A(PG8_SA(0, 1), cA, gc[1][0], gc[1][1]);
        if (wr == 1) PG8_BAR;
        PG8_WAIT_V(2); PG8_BAR;
        PG8_STAGE(PG8_SB(1, 0), cB + kstep, voffB); PG8_STAGE_A(PG8_SA(1, 0), cA + kstep, gc[0][0], gc[0][1]); PG8_STAGE(PG8_SB(1, 1), cB + hstep + kstep, voffB);
        PG8_WAIT_V(6); PG8_BAR;
    }
    for (;;) {
        const bool has_next = S.next(ui + 1, nxt);
        const char* nB = has_next ? (const char*)g.Bt + (size_t)nxt.pn * tstep : cB;
        if (has_next) { PG8_GOFF(gn, nxt); } else { _Pragma("unroll") for (int h_ = 0; h_ < 2; ++h_) _Pragma("unroll") for (int i_ = 0; i_ < 2; ++i_) gn[h_][i_] = gc[h_][i_]; }
#pragma nounroll
        for (int t = 0; t < nt; t += 2) {
            const bool last = (t == nt - 2);
            const char* a1 = cA + (size_t)(t + 1) * kstep;
            const char* a2 = last ? cA : cA + (size_t)(t + 2) * kstep; const char* b2 = last ? nB : cB + (size_t)(t + 2) * kstep;
            const unsigned g200 = last ? gn[0][0] : gc[0][0], g201 = last ? gn[0][1] : gc[0][1], g210 = last ? gn[1][0] : gc[1][0], g211 = last ? gn[1][1] : gc[1][1];
            const char* a3 = a2 + kstep; const char* b3 = b2 + kstep;
            if (last && has_next) S.a_ready(nxt);
            if constexpr (SP2) {
            PG8_LDB(B0, 0, 0); PG8_LDB(B1, 0, 1); PG8_SCHED; PG8_LDA(At, 0, 0); PG8_STAGE_A(PG8_SA(1, 1), a1, gc[1][0], gc[1][1]);
            PG8_WAIT_V(8); PG8_WAIT_L(0); PG8_BAR; PG8_MMA(0, 0, At, B0); PG8_MMA(0, 1, At, B1); PG8_BAR; PG8_SCHED;
            PG8_LDA(At, 0, 1); PG8_STAGE(PG8_SB(0, 0), b2, voffB); PG8_STAGE(PG8_SB(0, 1), b2 + hstep, voffB); PG8_STAGE_A(PG8_SA(0, 0), a2, g200, g201);
            PG8_WAIT_V(8); PG8_WAIT_L(0); PG8_BAR; PG8_MMA(1, 0, At, B0); PG8_MMA(1, 1, At, B1); PG8_BAR; PG8_SCHED;
            PG8_LDB(B0, 1, 0); PG8_LDB(B1, 1, 1); PG8_SCHED; PG8_LDA(At, 1, 0); PG8_STAGE_A(PG8_SA(0, 1), a2, g210, g211);
            PG8_WAIT_V(8); PG8_WAIT_L(0); PG8_BAR; PG8_MMA(0, 0, At, B0); PG8_MMA(0, 1, At, B1); PG8_BAR; PG8_SCHED;
            PG8_LDA(At, 1, 1); PG8_STAGE(PG8_SB(1, 0), b3, voffB); PG8_STAGE(PG8_SB(1, 1), b3 + hstep, voffB); PG8_STAGE_A(PG8_SA(1, 0), a3, g200, g201);
            PG8_WAIT_V(8); PG8_WAIT_L(0); PG8_BAR; PG8_MMA(1, 0, At, B0); PG8_MMA(1, 1, At, B1); PG8_BAR; PG8_SCHED;
            }
        }
        if constexpr (F8) {
            asm volatile("s_nop 15\n\ts_nop 15" ::: "memory");
            _Pragma("unroll") for (int a = 0; a < 2; ++a) _Pragma("unroll") for (int b = 0; b < 2; ++b) _Pragma("unroll") for (int m = 0; m < 4; ++m) _Pragma("unroll") for (int n = 0; n < 2; ++n) asm volatile("" : "+v"(acc[a][b][m][n]));
        }
        if constexpr (ALIGN_EPI) { if (wr == 0) PG8_BAR; }
        if constexpr (!Epi::AFTER_DRAIN) { E(acc, cur, wr, wc, fr, fq); S.done(cur); }
        if (!has_next) break;
#pragma unroll
        for (int a = 0; a < 2; ++a)
#pragma unroll
            for (int b = 0; b < 2; ++b)
#pragma unroll
                for (int m = 0; m < 4; ++m)
#pragma unroll
                    for (int n = 0; n < 2; ++n) acc[a][b][m][n] = (f32x4){0.f, 0.f, 0.f, 0.f};
        cur = nxt; cB = nB; ++ui;
#pragma unroll
        for (int h_ = 0; h_ < 2; ++h_)
#pragma unroll
            for (int i_ = 0; i_ < 2; ++i_) gc[h_][i_] = gn[h_][i_];
        if constexpr (ALIGN_EPI) { if (wr == 1) PG8_BAR; }
    }
    PG8_WAIT_V(0);
    if constexpr (!ALIGN_EPI) { if (wr == 0) PG8_BAR; }
    PG8_BAR;
    if constexpr (Epi::AFTER_DRAIN) { E.fused(acc, cur, wr, wc, fr, fq, lds, wid, lane); S.done(cur); }
#undef PG8_SA
#undef PG8_SB
#undef PG8_STAGE
#undef PG8_STAGE_A
#undef PG8_GOFF
#undef PG8_LDA
#undef PG8_LDB
#undef PG8_MMA
#undef PG8_WAIT_V
#undef PG8_WAIT_L
#undef PG8_BAR
#undef PG8_SCHED
}
}

namespace att {
constexpr int D = 128;
constexpr float THR = 8.f;
constexpr bool WSKIP = false;
constexpr float SCALE = 0.08838834764831845f;
constexpr int NW = 8, QBLK = 32, KVBLK = 64, QB = NW * QBLK;
constexpr int SHM_V = KVBLK * D * 2, SHM_K = KVBLK * D * 2;
constexpr int ATT_LDS_BYTES = 2 * SHM_V + 2 * SHM_K + NW * 64 * 4;
typedef short bf16x8 __attribute__((ext_vector_type(8)));
typedef short s16x4 __attribute__((ext_vector_type(4)));
typedef float f32x16 __attribute__((ext_vector_type(16)));
typedef float f32x4 __attribute__((ext_vector_type(4)));
typedef unsigned u32x4 __attribute__((ext_vector_type(4)));
template <class A, class Bt> struct same_t { static constexpr bool v = false; };
template <class A> struct same_t<A, A> { static constexpr bool v = true; };

#define KSWZ(row, colB) ((row) * 256 + ((colB) ^ (((row) & 7) << 4)))
#define SBAR() __builtin_amdgcn_sched_barrier(0)
__device__ __forceinline__ int v_st(int k, int c) { const int kk = (k & ~0xC) | ((k & 4) << 1) | ((k & 8) >> 1); return ((kk >> 3) * 4 + (c >> 5)) * 512 + ((kk & 7) * 32 + (c & 31)) * 2; }
__device__ __forceinline__ int v_rd_base(int lane) { return ((lane & 3) << 3) | (((lane >> 2) & 3) << 6) | (((lane >> 4) & 1) << 5) | (((lane >> 5) & 1) << 8); }
constexpr int v_rd_off(int d0, int ks, int half) { return d0 * 512 + ks * 4096 + half * 2048; }
__device__ __forceinline__ int crow(int r, int hi) { return (r & 3) + 8 * (r >> 2) + 4 * hi; }
__device__ __forceinline__ unsigned cvtpk(float lo, float hi) {
    unsigned r; asm volatile("v_cvt_pk_bf16_f32 %0, %1, %2" : "=v"(r) : "v"(lo), "v"(hi)); return r;
}
__device__ __forceinline__ bf16x8 pack8(f32x4 a, f32x4 b) {
    u32x4 w = {cvtpk(a[0], a[1]), cvtpk(a[2], a[3]), cvtpk(b[0], b[1]), cvtpk(b[2], b[3])};
    return *reinterpret_cast<bf16x8*>(&w);
}
template <class T> __device__ __forceinline__ bf16x8 load8(const T* p) {
    if constexpr (same_t<T, float>::v) { return pack8(*(const f32x4*)p, *(const f32x4*)(p + 4)); }
    else { return *reinterpret_cast<const bf16x8*>(p); }
}
__device__ __forceinline__ void mask_tile(f32x16& p0, f32x16& p1, int dq, unsigned W) {
    const float NEG = -__builtin_inff();
#pragma unroll
    for (int r = 0; r < 16; ++r) {
        const int c = (r & 3) + 8 * (r >> 2);
        if ((unsigned)(dq - c) >= W) p0[r] = NEG;
        if ((unsigned)(dq - c - 32) >= W) p1[r] = NEG;
    }
}
__device__ __forceinline__ void partialSM(f32x16& p0, f32x16& p1, float& m_reg, float& mn, float& alpha) {
    float pmax = p0[0]; for (int r = 1; r < 16; ++r) pmax = fmaxf(pmax, p0[r]); for (int r = 0; r < 16; ++r) pmax = fmaxf(pmax, p1[r]);
    { auto rr = __builtin_amdgcn_permlane32_swap(__float_as_uint(pmax), __float_as_uint(pmax), false, false);
      pmax = fmaxf(__uint_as_float(rr[0]), __uint_as_float(rr[1])); }
    constexpr float C2 = 1.4426950408889634f * SCALE;
    if (__builtin_expect(__all((pmax - m_reg) * SCALE <= THR), 1)) { mn = m_reg; alpha = 1.f; }
    else { mn = fmaxf(m_reg, pmax); alpha = __builtin_amdgcn_exp2f((m_reg - mn) * C2); m_reg = mn; }
    const float mnL = -mn * C2;
    for (int r = 0; r < 16; ++r) p0[r] = fmaf(p0[r], C2, mnL); for (int r = 0; r < 16; ++r) p1[r] = fmaf(p1[r], C2, mnL);
    for (int r = 0; r < 16; ++r) p0[r] = __builtin_amdgcn_exp2f(p0[r]);
}
__device__ __forceinline__ void finishSM(f32x16& p0, f32x16& p1, float alpha, float& l_reg, bf16x8& pa0, bf16x8& pa1, bf16x8& pa2, bf16x8& pa3) {
    for (int r = 0; r < 16; ++r) p1[r] = __builtin_amdgcn_exp2f(p1[r]);
    float ps = 0; for (int r = 0; r < 16; ++r) ps += p0[r]; for (int r = 0; r < 16; ++r) ps += p1[r];
    { auto rr = __builtin_amdgcn_permlane32_swap(__float_as_uint(ps), __float_as_uint(ps), false, false);
      ps = __uint_as_float(rr[0]) + __uint_as_float(rr[1]); }
    l_reg = l_reg * alpha + ps;
#define PK4(P, B_, OUT) do { unsigned a0 = cvtpk(P[B_+0], P[B_+1]), a1 = cvtpk(P[B_+2], P[B_+3]);                          \
        unsigned b0 = cvtpk(P[B_+4], P[B_+5]), b1 = cvtpk(P[B_+6], P[B_+7]);                                             \
        auto r0 = __builtin_amdgcn_permlane32_swap(a0, b0, false, false); auto r1 = __builtin_amdgcn_permlane32_swap(a1, b1, false, false); \
        u32x4 w = {r0[0], r1[0], r0[1], r1[1]}; OUT = *reinterpret_cast<bf16x8*>(&w); } while (0)
    PK4(p0, 0, pa0); PK4(p0, 8, pa1); PK4(p1, 0, pa2); PK4(p1, 8, pa3);
#undef PK4
}
template <int KB, bool SK>
__device__ __forceinline__ void qkt(f32x16& p0, f32x16& p1, const char* K_lds, int r32, int hi, const bf16x8* qr, bool act) {
    if (SK && !act) { const float NEG = -__builtin_inff();
#pragma unroll
        for (int r = 0; r < 16; ++r) { p0[r] = NEG; p1[r] = NEG; } return; }
    p0 = f32x16{}; p1 = f32x16{};
    const char* kb[4];
#pragma unroll
    for (int dd = 0; dd < 4; ++dd) kb[dd] = K_lds + KB * SHM_K + KSWZ(r32, (dd * 16 + hi * 8) * 2);
#pragma unroll
    for (int d0 = 0; d0 < 8; ++d0) { const char* a = kb[d0 & 3] + (d0 >> 2) * 128;
        bf16x8 b0 = *reinterpret_cast<const bf16x8*>(a);
        bf16x8 b1 = *reinterpret_cast<const bf16x8*>(a + 32 * 256);
        p0 = __builtin_amdgcn_mfma_f32_32x32x16_bf16(b0, qr[d0], p0, 0, 0, 0);
        p1 = __builtin_amdgcn_mfma_f32_32x32x16_bf16(b1, qr[d0], p1, 0, 0, 0); }
}
template <int VB, bool SK>
__device__ __forceinline__ void pv_tile(f32x16* o, int vb0, bf16x8 pa0, bf16x8 pa1, bf16x8 pa2, bf16x8 pa3, bool act) {
    if (SK && !act) return;
#define TRRD(dst, off) asm volatile("ds_read_b64_tr_b16 %0, %1 offset:%2" : "=&v"(dst) : "v"(vb0), "i"(off) : "memory")
#define PV_D0(d0) do { s16x4 l0, l1, l2, l3, h0, h1, h2, h3; constexpr int b_ = VB * SHM_V + v_rd_off(d0, 0, 0);     \
        TRRD(l0, b_); TRRD(h0, b_ + 2048); TRRD(l1, b_ + 4096); TRRD(h1, b_ + 6144); TRRD(l2, b_ + 8192); TRRD(h2, b_ + 10240); TRRD(l3, b_ + 12288); TRRD(h3, b_ + 14336); \
        asm volatile("s_waitcnt lgkmcnt(0)" ::: "memory"); SBAR();                 \
        o[d0] = __builtin_amdgcn_mfma_f32_32x32x16_bf16(pa0, (bf16x8){l0[0], l0[1], l0[2], l0[3], h0[0], h0[1], h0[2], h0[3]}, o[d0], 0, 0, 0);   \
        o[d0] = __builtin_amdgcn_mfma_f32_32x32x16_bf16(pa1, (bf16x8){l1[0], l1[1], l1[2], l1[3], h1[0], h1[1], h1[2], h1[3]}, o[d0], 0, 0, 0);   \
        o[d0] = __builtin_amdgcn_mfma_f32_32x32x16_bf16(pa2, (bf16x8){l2[0], l2[1], l2[2], l2[3], h2[0], h2[1], h2[2], h2[3]}, o[d0], 0, 0, 0);   \
        o[d0] = __builtin_amdgcn_mfma_f32_32x32x16_bf16(pa3, (bf16x8){l3[0], l3[1], l3[2], l3[3], h3[0], h3[1], h3[2], h3[3]}, o[d0], 0, 0, 0); } while (0)
    PV_D0(0); PV_D0(1); PV_D0(2); PV_D0(3);
#undef PV_D0
#undef TRRD
}

template <class TIn, class TOut> struct BlockRef { const TIn* Q; const TIn* K; const TIn* V; TOut* O; int P0; };
template <class TIn> struct Seam {
    bf16x8 qr[8];
    bf16x8 st_v0, st_v1, st_k0, st_k1; f32x4 sf0, sf1, sf2, sf3;
    f32x4 tq[16];
};
__device__ __forceinline__ int swa_jlo(int P0, int W) { const int lowk = P0 - W + 1; return lowk > 0 ? lowk / KVBLK : 0; }
#define ROW(p, k0, rr) ((p) + (size_t)((k0) + (rr)) * D + sc)
#define VMW() asm volatile("s_waitcnt vmcnt(0)" ::: "memory")
#define VMWN(n) asm volatile("s_waitcnt vmcnt(%0)" :: "i"(n) : "memory")
#define SLOAD_H(Kp, Vp, k0) do { S.st_v0 = load8<TIn>(ROW(Vp, k0, sr)); S.st_v1 = load8<TIn>(ROW(Vp, k0, 32 + sr));              \
                         S.st_k0 = load8<TIn>(ROW(Kp, k0, sr)); S.st_k1 = load8<TIn>(ROW(Kp, k0, 32 + sr)); } while (0)
#define SWRITE_HK(bf) do { *(bf16x8*)(K_lds + (bf) * SHM_K + kws) = S.st_k0; *(bf16x8*)(K_lds + (bf) * SHM_K + kws + 32 * 256) = S.st_k1; } while (0)
#define SWRITE_HV(bf) do { *(bf16x8*)(V_lds + (bf) * SHM_V + vst0) = S.st_v0; *(bf16x8*)(V_lds + (bf) * SHM_V + vst1) = S.st_v1; } while (0)
#define SWRITE_H(bf) do { SWRITE_HV(bf); SWRITE_HK(bf); } while (0)
#define SLOAD_F(p, k0) do { S.sf0 = *(const f32x4*)ROW(p, k0, sr); S.sf1 = *(const f32x4*)(ROW(p, k0, sr) + 4);                \
                            S.sf2 = *(const f32x4*)ROW(p, k0, 32 + sr); S.sf3 = *(const f32x4*)(ROW(p, k0, 32 + sr) + 4); } while (0)
#define SWRITE_KF(bf) do { *(bf16x8*)(K_lds + (bf) * SHM_K + kws) = pack8(S.sf0, S.sf1); *(bf16x8*)(K_lds + (bf) * SHM_K + kws + 32 * 256) = pack8(S.sf2, S.sf3); } while (0)
#define SWRITE_VF(bf) do { *(bf16x8*)(V_lds + (bf) * SHM_V + vst0) = pack8(S.sf0, S.sf1); *(bf16x8*)(V_lds + (bf) * SHM_V + vst1) = pack8(S.sf2, S.sf3); } while (0)
template <class TIn, class TOut>
__device__ __forceinline__ void causal_swa_prime(const BlockRef<TIn, TOut>& cur, int W, char* lds, Seam<TIn>& S) {
    constexpr bool F32 = same_t<TIn, float>::v;
    const int tid = threadIdx.x, wid = __builtin_amdgcn_readfirstlane(tid >> 6), lane = tid & 63, r32 = lane & 31, hi = lane >> 5;
    const int sr = tid >> 4, sc = (tid & 15) * 8, kws = KSWZ(sr, sc * 2); char* K_lds = lds + 2 * SHM_V;
    const int kb0 = swa_jlo(cur.P0, W) * KVBLK;
    for (int d0 = 0; d0 < 8; ++d0) S.qr[d0] = load8<TIn>(cur.Q + (size_t)(wid * QBLK + r32) * D + d0 * 16 + hi * 8);
    if constexpr (F32) { SLOAD_F((const float*)cur.K, kb0); VMW(); SWRITE_KF(0); SBAR(); SLOAD_F((const float*)cur.V, kb0); }
    else { SLOAD_H(cur.K, cur.V, kb0); VMW(); SWRITE_HK(0); }
    __syncthreads();
}
template <class TIn, class TOut, class CV>
__device__ __forceinline__ void causal_swa_block(const BlockRef<TIn, TOut>& cur, const BlockRef<TIn, TOut>& nxt, int skv, int W, char* lds, Seam<TIn>& S, CV& cv) {
    constexpr bool F32 = same_t<TIn, float>::v;
    const int tid = threadIdx.x, wid = __builtin_amdgcn_readfirstlane(tid >> 6), lane = tid & 63, r32 = lane & 31, hi = lane >> 5;
    const int j_lo = swa_jlo(cur.P0, W);
    int j_hi = (cur.P0 + QB - 1) / KVBLK + 1; if (j_hi > skv / KVBLK) j_hi = skv / KVBLK;
    const int NT = j_hi - j_lo;
    const int kbn = swa_jlo(nxt.P0, W) * KVBLK;
    const int qlo = cur.P0 + wid * QBLK, qm = ((qlo + r32) | 63) - 4 * hi;
    char* V_lds = lds; char* K_lds = lds + 2 * SHM_V;
    float* ws = (float*)(lds + 2 * SHM_V + 2 * SHM_K) + wid * 64; float* li_l = ws, * al_l = ws + 32;
    float m_reg = -1e30f, l_reg = 0; f32x16 o[4] = {};
    const int sr = tid >> 4, sc = (tid & 15) * 8, vst0 = v_st(sr, sc), vst1 = v_st(32 + sr, sc), kws = KSWZ(sr, sc * 2);
    const int vb0 = (int)(uintptr_t)V_lds + v_rd_base(lane);
    const TIn* Kh = cur.K; const TIn* Vh = cur.V;
#define RESC(a) do { if (__any((a) < 1.f)) { if (hi == 0) al_l[r32] = (a); asm volatile("s_waitcnt lgkmcnt(0)" ::: "memory");              \
                     for (int d_ = 0; d_ < 4; ++d_) for (int r = 0; r < 16; ++r) o[d_][r] *= al_l[crow(r, hi)]; } } while (0)
#define KBASE(t) ((j_lo + (t)) * KVBLK)
#define ACT(t) (KBASE(t) <= qlo + QBLK - 1 && KBASE(t) + KVBLK - 1 >= qlo - W + 1)
#define MASKT(P0_, P1_, t) do { const int kb_ = KBASE(t); if ((!SK || ACT(t)) && (kb_ > qlo)) mask_tile(P0_, P1_, qm - kb_, (unsigned)W); } while (0)
    constexpr int NQL = F32 ? 16 : 8;
    constexpr bool SK = WSKIP && !F32;
#define SEAM_K0() do { VMWN(NQL); if constexpr (F32) { SWRITE_KF(0); SBAR(); SLOAD_F((const float*)nxt.V, kbn); } else { SWRITE_HK(0); } SBAR(); } while (0)
    f32x16 pA0, pA1, pB0, pB1; float mnA, mnB, alA, alB; bf16x8 pa0, pa1, pa2, pa3;
    if constexpr (F32) { VMW(); SWRITE_VF(0); SBAR(); } else { SWRITE_HV(0); SBAR(); }
    if (NT > 1) { if constexpr (F32) SLOAD_F((const float*)Kh, KBASE(1)); else SLOAD_H(Kh, Vh, KBASE(1)); }
    SBAR(); qkt<0, SK>(pA0, pA1, K_lds, r32, hi, S.qr, ACT(0));
    if constexpr (F32) { if (NT > 1) { VMW(); SWRITE_KF(1); SBAR(); SLOAD_F((const float*)Vh, KBASE(1)); } }
    MASKT(pA0, pA1, 0); partialSM(pA0, pA1, m_reg, mnA, alA);
    if (NT > 1) { VMW(); if constexpr (F32) { SWRITE_VF(1); SBAR(); if (NT > 2) SLOAD_F((const float*)Kh, KBASE(2)); } else SWRITE_H(1); }
    __syncthreads();
#define LBAR() do { asm volatile("s_waitcnt lgkmcnt(0)" ::: "memory"); __builtin_amdgcn_s_barrier(); asm volatile("" ::: "memory"); } while (0)
#define HALF_STEP(PX0, PX1, mnX, alX, PY0, PY1, alY, t, KB, VB, SB) do {                                                      \
        SBAR(); cv.issue(); SBAR(); qkt<KB, SK>(PX0, PX1, K_lds, r32, hi, S.qr, ACT(t));                                             \
        finishSM(PY0, PY1, alY, l_reg, pa0, pa1, pa2, pa3); SBAR();                                                           \
        if ((t) + 1 < NT) { if constexpr (F32) { VMW(); SWRITE_KF(SB); SBAR(); SLOAD_F((const float*)Vh, KBASE((t) + 1)); }  \
                            else { SLOAD_H(Kh, Vh, KBASE((t) + 1)); } SBAR(); }                                               \
        pv_tile<VB, SK>(o, vb0, pa0, pa1, pa2, pa3, ACT((t) - 1)); MASKT(PX0, PX1, (t)); partialSM(PX0, PX1, m_reg, mnX, alX);                                        \
        LBAR();                                                                                                               \
        if ((t) + 1 < NT) { VMW(); if constexpr (F32) { SWRITE_VF(SB); SBAR(); if ((t) + 2 < NT) SLOAD_F((const float*)Kh, KBASE((t) + 2)); } \
                            else { SWRITE_H(SB); } }                                                                          \
        RESC(alX); SBAR(); cv.consume(); SBAR(); LBAR(); } while (0)
    __builtin_amdgcn_s_waitcnt(0x0F70);
    for (int t = 1; t + 1 < NT; t += 2) {
        HALF_STEP(pB0, pB1, mnB, alB, pA0, pA1, alA, t, 1, 0, 0);
        HALF_STEP(pA0, pA1, mnA, alA, pB0, pB1, alB, t + 1, 0, 1, 1);
    }
    const bool even = (NT & 1) == 0;
    if (even) { SBAR(); qkt<1, SK>(pB0, pB1, K_lds, r32, hi, S.qr, ACT(NT - 1)); SBAR(); }
#define QROW(e) (nxt.Q + (size_t)(wid * QBLK + r32) * D + ((e) >> 1) * 16 + hi * 8 + ((e) & 1) * 4)
    if constexpr (F32) { SLOAD_F((const float*)nxt.K, kbn); SBAR();
#pragma unroll
        for (int e = 0; e < 8; ++e) S.tq[e] = *(const f32x4*)QROW(e); }
    else { SLOAD_H(nxt.K, nxt.V, kbn); SBAR();
#pragma unroll
        for (int d0 = 0; d0 < 8; ++d0) S.qr[d0] = load8<TIn>(nxt.Q + (size_t)(wid * QBLK + r32) * D + d0 * 16 + hi * 8); }
    SBAR();
    finishSM(pA0, pA1, alA, l_reg, pa0, pa1, pa2, pa3); SBAR();
    if constexpr (F32) {
#pragma unroll
        for (int e = 8; e < 16; ++e) S.tq[e] = *(const f32x4*)QROW(e); SBAR(); }
#undef QROW
    pv_tile<0, SK>(o, vb0, pa0, pa1, pa2, pa3, ACT(even ? NT - 2 : NT - 1));
    if (even) { MASKT(pB0, pB1, NT - 1); partialSM(pB0, pB1, m_reg, mnB, alB); __syncthreads(); RESC(alB);
        finishSM(pB0, pB1, alB, l_reg, pa0, pa1, pa2, pa3); SBAR(); pv_tile<1, SK>(o, vb0, pa0, pa1, pa2, pa3, ACT(NT - 1)); }
    SBAR(); SEAM_K0();
    if (hi == 0) li_l[r32] = l_reg; asm volatile("s_waitcnt lgkmcnt(0)" ::: "memory");
    float rli[16];
#pragma unroll
    for (int r = 0; r < 16; ++r) rli[r] = __builtin_amdgcn_rcpf(li_l[crow(r, hi)]);
    TOut* Ow = cur.O + (size_t)(wid * QBLK) * D;
#pragma unroll
    for (int r = 0; r < 16; ++r) { const int orow = crow(r, hi);
#pragma unroll
        for (int d0 = 0; d0 < 4; ++d0) { const float v = o[d0][r] * rli[r];
            if constexpr (same_t<TOut, float>::v) { Ow[(size_t)orow * D + d0 * 32 + r32] = v; }
            else { const float vn = __shfl_xor(v, 1);
                   if ((r32 & 1) == 0) *(unsigned*)(Ow + (size_t)orow * D + d0 * 32 + r32) = cvtpk(v, vn); } } }
    if constexpr (F32) {
#pragma unroll
        for (int d0 = 0; d0 < 8; ++d0) S.qr[d0] = pack8(S.tq[2 * d0], S.tq[2 * d0 + 1]); }
    __syncthreads();
#undef RESC
#undef KBASE
#undef ACT
#undef MASKT
#undef SEAM_K0
#undef HALF_STEP
#undef LBAR
}
#undef ROW
#undef VMW
#undef VMWN
#undef SLOAD_H
#undef SWRITE_HK
#undef SWRITE_HV
#undef SWRITE_H
#undef SLOAD_F
#undef SWRITE_KF
#undef SWRITE_VF
}


namespace mk {
using pg8::bf16_t; using pg8::f32x4; using pg8::u32x4; using pg8::Unit;
typedef float f32x2v __attribute__((ext_vector_type(2)));
typedef __bf16 bf16x2v __attribute__((ext_vector_type(2)));
__device__ __forceinline__ unsigned cvt_pk_bf16(float lo, float hi) { const f32x2v v = {lo, hi}; return __builtin_bit_cast(unsigned, __builtin_convertvector(v, bf16x2v)); }
#define LAS __attribute__((address_space(3)))
#define LDS_WAIT() asm volatile("s_waitcnt lgkmcnt(0)" ::: "memory")
#define VM_WAIT() asm volatile("s_waitcnt vmcnt(0)" ::: "memory")
constexpr int D = 2048, NB = 4, S = 4096, NT = NB * S, NE = 32, NA = 2 * NT, MH = 1024;
constexpr int NWAVES = 8, NTHR = 512;
constexpr int LDS_MISC = 147456, LDS_BYTES = 163840;
constexpr int MISC_BAR = 0, MISC_PE = 64, MISC_PS = 64 + 1024, MISC_HIST = 64 + 1024 + 256, MISC_BASE = MISC_HIST + 128, MISC_NP = MISC_BASE + 128, MISC_CNT = MISC_NP + 64;
constexpr int PMAX = NA + NE * 256;
constexpr float EPS = 1e-6f;
typedef unsigned u32x2 __attribute__((ext_vector_type(2)));

struct Args {
    const float *x, *c; const int* pos; const float *ada_w, *ada_b, *nmg, *nfg, *fng, *a_win, *a_wout, *lq1, *lk1, *lq2, *lk2, *a_hg,
        *m_win, *m_cw, *m_cb, *m_gb, *m_hg, *m_wout, *wg, *bg, *we, *be, *wgu, *wdn;
    float* out;
    unsigned* ctl; float* mod; float2* cs;
    bf16_t *Bt_qkv, *Bt_ao, *Bt_min, *Bt_mo, *Bt_rt, *Bt_g, *Bt_gu, *Bt_dn;
    bf16_t* xres; bf16_t* hb; bf16_t* ob; float* proj;
    float* logits; int* eid; float* wts; int* pos_in_e; int* slot; int* counts; int* inv;
    bf16_t *XG, *Hm, *Y;
    bf16_t *Qh, *Kh, *Vh, *Oa;
    unsigned char *hb8, *Hm8, *Bt_gu8, *Bt_dn8;
    unsigned char *Bt_min8, *Bt_mo8, *ob8;
    bf16_t *P3, *Qn, *Kn, *KT, *VT, *HS; float *gates, *GA, *GS;
    int ph_lo, ph_hi;
};

__device__ __forceinline__ unsigned pk4_fp8(float x0, float x1, float x2, float x3) { unsigned w = 0u; w = __builtin_amdgcn_cvt_pk_fp8_f32(x0, x1, w, false); w = __builtin_amdgcn_cvt_pk_fp8_f32(x2, x3, w, true); return w; }
__device__ __forceinline__ float wave_sum(float v) {
#pragma unroll
    for (int o = 1; o < 64; o <<= 1) v += __shfl_xor(v, o);
    return v;
}
__device__ __forceinline__ float silu_f(float v) { return v / (1.f + __expf(-v)); }
__device__ __forceinline__ f32x4 bf4_to_f32(const u32x2 p) { f32x4 r; r[0] = __uint_as_float(p.x << 16); r[1] = __uint_as_float(p.x & 0xffff0000u); r[2] = __uint_as_float(p.y << 16); r[3] = __uint_as_float(p.y & 0xffff0000u); return r; }
__device__ __forceinline__ int opq(int v) { asm volatile("" : "+v"(v)); return v; }

template <bool IN_F32>
struct EpiResid {
    static constexpr bool PERM = true, AFTER_DRAIN = false;
    const void* xin; bf16_t* xout; const float* gt; float sc;
    __device__ __forceinline__ void operator()(const f32x4 (&acc)[2][2][4][2], const Unit& u, int wr, int wc, int fr, int fq) const {
        const int row0 = u.pm * 256 + wr * 64 + fr, col0 = u.pn * 256 + wc * 32 + 8 * fq, b = (u.pm * 256) / S;
        f32x4 gv[2][2];
#pragma unroll
        for (int bj = 0; bj < 2; ++bj)
#pragma unroll
            for (int n = 0; n < 2; ++n) gv[bj][n] = *(const f32x4*)(gt + (size_t)b * 6 * D + col0 + bj * 128 + n * 4) * sc;
#pragma unroll
        for (int ai = 0; ai < 2; ++ai) {
            f32x4 X0[4][2], X1[4][2];
#pragma unroll
            for (int m = 0; m < 4; ++m) { const size_t off = (size_t)(row0 + ai * 128 + m * 16) * D + col0;
#pragma unroll
                for (int bj = 0; bj < 2; ++bj) {
                    if (IN_F32) { X0[m][bj] = *(const f32x4*)((const float*)xin + off + bj * 128); X1[m][bj] = *(const f32x4*)((const float*)xin + off + bj * 128 + 4); }
                    else { const u32x4 p = *(const u32x4*)((const bf16_t*)xin + off + bj * 128); X0[m][bj] = __builtin_bit_cast(f32x4, p); } } }
            __builtin_amdgcn_sched_barrier(0);
#pragma unroll
            for (int m = 0; m < 4; ++m) { const size_t off = (size_t)(row0 + ai * 128 + m * 16) * D + col0;
#pragma unroll
                for (int bj = 0; bj < 2; ++bj) { f32x4 x0, x1;
                    if (IN_F32) { x0 = X0[m][bj]; x1 = X1[m][bj]; }
                    else { const u32x4 p = __builtin_bit_cast(u32x4, X0[m][bj]); x0 = bf4_to_f32((u32x2){p.x, p.y}); x1 = bf4_to_f32((u32x2){p.z, p.w}); }
                    const f32x4 y0 = x0 + gv[bj][0] * acc[ai][bj][m][0], y1 = x1 + gv[bj][1] * acc[ai][bj][m][1];
                    u32x4 w; w.x = cvt_pk_bf16(y0[0], y0[1]); w.y = cvt_pk_bf16(y0[2], y0[3]); w.z = cvt_pk_bf16(y1[0], y1[1]); w.w = cvt_pk_bf16(y1[2], y1[3]);
                    *(u32x4*)(xout + off + bj * 128) = w; } }
            __builtin_amdgcn_sched_barrier(0);
        }
    }
};
struct EpiGU {
    static constexpr bool PERM = true, AFTER_DRAIN = false;
    unsigned char* Hm8;
    __device__ __forceinline__ void operator()(const f32x4 (&acc)[2][2][4][2], const Unit& u, int wr, int wc, int fr, int fq) const {
        const int row0 = u.pm * 256 + wr * 64 + fr, col0 = (u.pn & 7) * 128 + wc * 32 + 8 * fq;
#pragma unroll
        for (int ai = 0; ai < 2; ++ai)
#pragma unroll
            for (int m = 0; m < 4; ++m) { unsigned char* rowp = Hm8 + (size_t)(row0 + ai * 128 + m * 16) * MH + col0;
                float h[8];
#pragma unroll
                for (int n = 0; n < 2; ++n)
#pragma unroll
                    for (int j = 0; j < 4; ++j) { const float g = acc[ai][0][m][n][j] * (1.f / 256.f), up = acc[ai][1][m][n][j] * (1.f / 256.f); h[n * 4 + j] = silu_f(g) * up * 4.f; }
                u32x2 w; w.x = pk4_fp8(h[0], h[1], h[2], h[3]); w.y = pk4_fp8(h[4], h[5], h[6], h[7]);
                *(u32x2*)rowp = w; }
    }
};
struct EpiBf16G {
    static constexpr bool PERM = true, AFTER_DRAIN = false;
    bf16_t* O; int ldc; float sc;
    __device__ __forceinline__ void operator()(const f32x4 (&acc)[2][2][4][2], const Unit& u, int wr, int wc, int fr, int fq) const {
        const int row0 = u.pm * 256 + wr * 64 + fr, col0 = (u.pn & 7) * 256 + wc * 32 + 8 * fq;
#pragma unroll
        for (int ai = 0; ai < 2; ++ai)
#pragma unroll
            for (int m = 0; m < 4; ++m) { bf16_t* rowp = O + (size_t)(row0 + ai * 128 + m * 16) * ldc + col0;
#pragma unroll
                for (int bj = 0; bj < 2; ++bj) { const f32x4 v0 = acc[ai][bj][m][0] * sc, v1 = acc[ai][bj][m][1] * sc;
                    u32x4 w; w.x = cvt_pk_bf16(v0[0], v0[1]); w.y = cvt_pk_bf16(v0[2], v0[3]); w.z = cvt_pk_bf16(v1[0], v1[1]); w.w = cvt_pk_bf16(v1[2], v1[3]);
                    *(u32x4*)(rowp + bj * 128) = w; } }
    }
};
struct GroupedOrder {
    int NP, total, G, c; const LAS int* pe;
    __device__ __forceinline__ bool next(int i, Unit& u) const {
        int p, j;
        if (G == 256) { const int x = c >> 5, l = c & 31, gidx = i * 8 + x; p = gidx * 4 + (l >> 3); j = l & 7; if (p >= NP) return false; }
        else { const long L = (long)i * G + c; if (L >= total) return false; p = (int)(L % NP); j = (int)(L / NP); }
        u.pm = p; u.pn = __builtin_amdgcn_readfirstlane(pe[p]) * 8 + j; return true; }
    __device__ __forceinline__ void a_ready(const Unit&) const {}
    __device__ __forceinline__ void done(const Unit&) const {}
};
struct GroupedOrderG : GroupedOrder {
    const LAS int* ps; const LAS int* cn; const int* inv;
    __device__ __forceinline__ int a_row(const Unit& u, int r) const {
        const int e = u.pn >> 3, local = u.pm * 256 + r - ps[e];
        return local < cn[e] ? inv[e * 32768 + local] : NT; }
};
struct CvItem { const float* W; bf16_t* WT; int ldw, K, n0, s0, k0; };
__device__ __forceinline__ void tr_load(const CvItem& d, int lane, f32x4 (&v)[8]) {
    const int kp = lane >> 3, c4 = lane & 7;
#pragma unroll
    for (int i = 0; i < 8; ++i) v[i] = *(const f32x4*)(d.W + (size_t)(d.k0 + 2 * kp + 16 * (i >> 1) + (i & 1)) * d.ldw + d.s0 + 4 * c4);
}
__device__ __forceinline__ void tr_finish(const CvItem& d, const f32x4 (&v)[8], LAS float* scr, int lane) {
    const int kp = lane >> 3, c4 = lane & 7; LAS unsigned* sp = (LAS unsigned*)scr;
#pragma unroll
    for (int i = 0; i < 4; ++i) { u32x4 o; o.x = cvt_pk_bf16(v[2 * i][0], v[2 * i + 1][0]); o.y = cvt_pk_bf16(v[2 * i][1], v[2 * i + 1][1]); o.z = cvt_pk_bf16(v[2 * i][2], v[2 * i + 1][2]); o.w = cvt_pk_bf16(v[2 * i][3], v[2 * i + 1][3]);
        *(LAS u32x4*)(sp + (kp + 8 * i) * 36 + 4 * c4) = o; }
    LDS_WAIT(); asm volatile("" ::: "memory");
    const int c = lane & 7;
#pragma unroll
    for (int j = 0; j < 4; ++j) { const int n = (lane >> 3) + 8 * j; const LAS unsigned* q = sp + (4 * c) * 36 + n;
        u32x4 o; o.x = q[0]; o.y = q[36]; o.z = q[72]; o.w = q[108];
        *(u32x4*)(d.WT + (size_t)(d.n0 + n) * d.K + d.k0 + 8 * c) = o; }
    LDS_WAIT(); asm volatile("" ::: "memory");
}
__device__ __forceinline__ int gu_src(int n) { const int t = n >> 8, r = n & 255; return r < 128 ? t * 128 + r : 1024 + t * 128 + (r - 128); }

constexpr int CV_I1 = 32 * 192, CV_I2 = 32 * 64, CV_ALL = CV_I1 + CV_I2;
__device__ __forceinline__ CvItem cv_decode(const Args& a, int r) {
    CvItem d;
    if (r < CV_I1) { const int kb = r / 192, nb = r % 192; d.W = a.a_win; d.ldw = 6144; d.WT = a.Bt_qkv; d.K = D; d.n0 = nb * 32; d.s0 = nb * 32; d.k0 = kb * 64; return d; } r -= CV_I1;
    { const int kb = r / 64, nb = r % 64; d.W = a.a_wout; d.ldw = D; d.WT = a.Bt_ao; d.K = D; d.n0 = nb * 32; d.s0 = nb * 32; d.k0 = kb * 64; return d; }
}
__device__ __forceinline__ void conv_items(const Args& a, LAS unsigned char* lds, int w, int nw, int lo, int hi, int wave, int lane) {
    LAS float* scr = (LAS float*)(lds + wave * 16384);
    const int it = lo + w; if (it >= hi) return;
    CvItem d0 = cv_decode(a, it), d1 = d0, d2 = d0; f32x4 v0[8], v1[8], v2[8];
    bool h1 = it + nw < hi, h2 = it + 2 * nw < hi, h0;
    tr_load(d0, lane, v0);
    if (h1) { d1 = cv_decode(a, it + nw); tr_load(d1, lane, v1); }
    if (h2) { d2 = cv_decode(a, it + 2 * nw); tr_load(d2, lane, v2); }
    int nx = it + 3 * nw;
    for (;;) {
        tr_finish(d0, v0, scr, lane); h0 = nx < hi; if (h0) { d0 = cv_decode(a, nx); tr_load(d0, lane, v0); nx += nw; }
        if (!h1) break;
        tr_finish(d1, v1, scr, lane); h1 = nx < hi; if (h1) { d1 = cv_decode(a, nx); tr_load(d1, lane, v1); nx += nw; }
        if (!h2) break;
        tr_finish(d2, v2, scr, lane); h2 = nx < hi; if (h2) { d2 = cv_decode(a, nx); tr_load(d2, lane, v2); nx += nw; }
        if (!h0) break;
    }
}
__device__ __forceinline__ void p0_prologue(const Args& a, LAS unsigned char* lds, int vcu, int G, int tid, int wave, int lane) {
    {
        LAS float* sc = (LAS float*)lds;
        LAS float* red = (LAS float*)(lds + 32768);
        for (int i = tid; i < NB * D; i += NTHR) sc[i] = silu_f(a.c[i]);
        __syncthreads();
        for (int it = vcu; it < 2 * 384; it += G) {
            const int l = it / 384, col = (it % 384) * 32 + (lane & 31), kh = lane >> 5;
            const float* w = a.ada_w + (size_t)l * D * 6 * D + (size_t)(wave * 256 + kh * 128) * 6 * D + col;
            float a0 = 0.f, a1 = 0.f, a2 = 0.f, a3 = 0.f;
#pragma unroll 8
            for (int k = 0; k < 128; ++k) { const float wv = w[(size_t)k * 6 * D]; const int kk = wave * 256 + kh * 128 + k;
                a0 += sc[kk] * wv; a1 += sc[D + kk] * wv; a2 += sc[2 * D + kk] * wv; a3 += sc[3 * D + kk] * wv; }
            a0 += __shfl_xor(a0, 32); a1 += __shfl_xor(a1, 32); a2 += __shfl_xor(a2, 32); a3 += __shfl_xor(a3, 32);
            if (lane < 32) { red[(wave * 4 + 0) * 32 + lane] = a0; red[(wave * 4 + 1) * 32 + lane] = a1; red[(wave * 4 + 2) * 32 + lane] = a2; red[(wave * 4 + 3) * 32 + lane] = a3; }
            __syncthreads();
            if (tid < 128) { const int bb = tid >> 5, cl = tid & 31; float sacc = 0.f;
#pragma unroll
                for (int w8 = 0; w8 < 8; ++w8) sacc += red[(w8 * 4 + bb) * 32 + cl];
                const int cg = (it % 384) * 32 + cl;
                a.mod[((size_t)l * NB + bb) * 6 * D + cg] = sacc + a.ada_b[l * 6 * D + cg]; }
            __syncthreads();
        }
    }
    for (int i = vcu * NTHR + tid; i < NT * 16; i += G * NTHR) {
        const int row = i >> 4, j = i & 15;
        const double ang = (double)a.pos[row] * pow(500000.0, -(double)j / 16.0);
        a.cs[i] = make_float2((float)cos(ang), (float)sin(ang));
    }
    for (int i = vcu * NTHR + tid; i < 2 * 256 * D; i += G * NTHR) {
        const int k = i % D, n = (i / D) % 256, l = i / (256 * D);
        float v = 0.f; if (n < 4) v = a.wg[((size_t)l * D + k) * 4 + n]; else if (n < 36) v = a.we[((size_t)l * D + k) * 32 + (n - 4)];
        a.Bt_rt[i] = (bf16_t)(cvt_pk_bf16(v, 0.f) & 0xffffu);
    }
    if (vcu == 0) for (int i = tid; i < D / 4; i += NTHR) ((unsigned*)(a.hb8 + (size_t)NT * D))[i] = 0u;
    for (int i = vcu * NTHR + tid; i < 16 * D; i += G * NTHR) { const int k = i % D, n = i / D; a.Bt_g[i] = (bf16_t)(cvt_pk_bf16(a.m_win[(size_t)k * 6160 + 6144 + n], 0.f) & 0xffffu); }
    __syncthreads();
    conv_items(a, lds, vcu * NWAVES + wave, G * NWAVES, 0, CV_I1 + CV_I2, wave, lane);
}
template <bool TOLDS>
__device__ __forceinline__ void norm_store(const f32x4 (&v)[8], float ss, const float* g, const float* scv, const float* shv, bf16_t* orow, int lane, LAS unsigned char* yrow) {
    const float rstd = rsqrtf(wave_sum(ss) * (1.f / D) + EPS);
#pragma unroll
    for (int j = 0; j < 8; ++j) { const int c = 4 * lane + 256 * j;
        const f32x4 gg = *(const f32x4*)(g + c), sc = *(const f32x4*)(scv + c), sh = *(const f32x4*)(shv + c);
        const f32x4 y = v[j] * rstd * gg * (sc + 1.f) + sh;
        u32x2 w; w.x = cvt_pk_bf16(y[0], y[1]); w.y = cvt_pk_bf16(y[2], y[3]);
        *(u32x2*)(orow + c) = w;
        if (TOLDS) *(LAS u32x2*)(yrow + c * 2) = w; }
}
constexpr int YT_PITCH = 4112, NR_YT = 0, NR_RED = 16 * YT_PITCH, NR_LG = NR_RED + 24576, NR_TOK = NR_LG + 3072, CG_AN = 100352, CG_SH = CG_AN + 8192;
typedef short bf16x8r __attribute__((ext_vector_type(8)));
template <int NTL>
__device__ __forceinline__ void rows16_logits(const bf16_t* Bt, LAS unsigned char* lds, int wave, int lane, int tid) {
    const int r16 = lane & 15, q4 = lane >> 4;
    f32x4 acc[NTL];
#pragma unroll
    for (int nt = 0; nt < NTL; ++nt) acc[nt] = (f32x4){0.f, 0.f, 0.f, 0.f};
#pragma unroll
    for (int h = 0; h < 2; ++h) { bf16x8r wf[4][NTL];
#pragma unroll
        for (int kk = 0; kk < 4; ++kk)
#pragma unroll
            for (int nt = 0; nt < NTL; ++nt) wf[kk][nt] = *(const bf16x8r*)(Bt + (size_t)(16 * nt + r16) * D + 256 * wave + 32 * (4 * h + kk) + 8 * q4);
        __builtin_amdgcn_sched_barrier(0);
#pragma unroll
        for (int kk = 0; kk < 4; ++kk) { const int k0 = 256 * wave + 32 * (4 * h + kk) + 8 * q4;
            const bf16x8r yf = *(const LAS bf16x8r*)(lds + NR_YT + r16 * YT_PITCH + k0 * 2);
#pragma unroll
            for (int nt = 0; nt < NTL; ++nt) acc[nt] = __builtin_amdgcn_mfma_f32_16x16x32_bf16(wf[kk][nt], yf, acc[nt], 0, 0, 0); }
        __builtin_amdgcn_sched_barrier(0); }
#pragma unroll
    for (int nt = 0; nt < NTL; ++nt) *(LAS f32x4*)(lds + NR_RED + ((wave * NTL + nt) * 64 + lane) * 16) = acc[nt];
    __syncthreads();
    if (tid < NTL * 64) { const int nt = tid >> 6, ln = tid & 63; f32x4 sum = {0.f, 0.f, 0.f, 0.f};
#pragma unroll
        for (int w = 0; w < 8; ++w) sum += *(const LAS f32x4*)(lds + NR_RED + ((w * NTL + nt) * 64 + ln) * 16);
        LAS float* lg = (LAS float*)(lds + NR_LG) + (ln & 15) * 48 + 16 * nt + 4 * (ln >> 4);
        lg[0] = sum[0]; lg[1] = sum[1]; lg[2] = sum[2]; lg[3] = sum[3]; }
    __syncthreads();
}
__device__ __forceinline__ void phase_norm(const float* xin, const float* g, const float* modl, int sh_idx, int sc_idx, bf16_t* hb, int gw, int NGW, int lane) {
    const int RPW = (NT + NGW - 1) / NGW; int m = gw * RPW; const int mend = (m + RPW < NT) ? m + RPW : NT;
    if (m >= mend) return;
    f32x4 A[8], Bv[8], v[8], vn[8]; int bcur = -1;
#pragma unroll
    for (int j = 0; j < 8; ++j) v[j] = *(const f32x4*)(xin + (size_t)m * D + 4 * lane + 256 * j);
    for (;;) {
        const bool more = m + 1 < mend;
        if (more) {
#pragma unroll
            for (int j = 0; j < 8; ++j) vn[j] = *(const f32x4*)(xin + (size_t)(m + 1) * D + 4 * lane + 256 * j); }
        const int b = m / S;
        if (b != bcur) { bcur = b; const float* scv = modl + (size_t)b * 6 * D + sc_idx * D; const float* shv = modl + (size_t)b * 6 * D + sh_idx * D;
#pragma unroll
            for (int j = 0; j < 8; ++j) { const int c = 4 * lane + 256 * j; A[j] = *(const f32x4*)(g + c) * (*(const f32x4*)(scv + c) + 1.f); Bv[j] = *(const f32x4*)(shv + c); } }
        float ss = 0.f;
#pragma unroll
        for (int j = 0; j < 8; ++j) ss += (v[j][0] * v[j][0] + v[j][1] * v[j][1]) + (v[j][2] * v[j][2] + v[j][3] * v[j][3]);
        const float rstd = rsqrtf(wave_sum(ss) * (1.f / D) + EPS);
        bf16_t* orow = hb + (size_t)m * D;
#pragma unroll
        for (int j = 0; j < 8; ++j) { const f32x4 y = v[j] * rstd * A[j] + Bv[j]; u32x2 w; w.x = cvt_pk_bf16(y[0], y[1]); w.y = cvt_pk_bf16(y[2], y[3]); *(u32x2*)(orow + 4 * lane + 256 * j) = w; }
        if (!more) break;
        ++m;
#pragma unroll
        for (int j = 0; j < 8; ++j) v[j] = vn[j];
    }
}
__device__ __forceinline__ void phase_combine_final(const Args& a, const float* modl, const LAS int* ps, int gw, int NGW, int lane) {
    const int RPW = (NT + NGW - 1) / NGW; const int m0 = gw * RPW; const int mend = (m0 + RPW < NT) ? m0 + RPW : NT;
    if (m0 >= mend) return;
    int slot_l = 0; float w_l = 0.f;
    if (lane < 2 * (mend - m0) && lane < 64) { const int as = 2 * m0 + lane; slot_l = ps[a.eid[as]] + a.pos_in_e[as]; w_l = a.wts[as]; }
    f32x4 G4[8], F4[8];
    { const float* gt = modl + (size_t)(m0 / S) * 6 * D + 5 * D;
#pragma unroll
      for (int j = 0; j < 8; ++j) { G4[j] = *(const f32x4*)(gt + 4 * lane + 256 * j); F4[j] = *(const f32x4*)(a.fng + 4 * lane + 256 * j); } }
    for (int m = m0; m < mend; ++m) {
        const int r = m - m0; const int s0 = __shfl(slot_l, 2 * r), s1 = __shfl(slot_l, 2 * r + 1); const float w0 = __shfl(w_l, 2 * r), w1 = __shfl(w_l, 2 * r + 1);
        const bf16_t* xr = a.xres + (size_t)m * D; const bf16_t* y0 = a.Y + (size_t)s0 * D; const bf16_t* y1 = a.Y + (size_t)s1 * D;
        f32x4 v[8]; float ss = 0.f;
#pragma unroll
        for (int j = 0; j < 8; ++j) { const int c = 4 * lane + 256 * j;
            const f32x4 x1 = bf4_to_f32(*(const u32x2*)(xr + c)); const u32x2 p0 = *(const u32x2*)(y0 + c), p1 = *(const u32x2*)(y1 + c);
            f32x4 ya, yb;
            ya[0] = __uint_as_float(p0.x << 16); ya[1] = __uint_as_float(p0.x & 0xffff0000u); ya[2] = __uint_as_float(p0.y << 16); ya[3] = __uint_as_float(p0.y & 0xffff0000u);
            yb[0] = __uint_as_float(p1.x << 16); yb[1] = __uint_as_float(p1.x & 0xffff0000u); yb[2] = __uint_as_float(p1.y << 16); yb[3] = __uint_as_float(p1.y & 0xffff0000u);
            v[j] = x1 + G4[j] * (ya * w0 + yb * w1);
            ss += (v[j][0] * v[j][0] + v[j][1] * v[j][1]) + (v[j][2] * v[j][2] + v[j][3] * v[j][3]); }
        const float rstd = rsqrtf(wave_sum(ss) * (1.f / D) + EPS);
#pragma unroll
        for (int j = 0; j < 8; ++j) *(f32x4*)(a.out + (size_t)m * D + 4 * lane + 256 * j) = v[j] * rstd * F4[j];
    }
}
__device__ __forceinline__ void phase_combine_gates(const Args& a, const float* modl, const float* modn, const float* gnext, const LAS int* ps, LAS unsigned char* lds, int vcu, int G, int tid, int wave, int lane) {
    const int NGRP = NT / 16, GPW = (NGRP + G - 1) / G, g0 = vcu * GPW, gend = (g0 + GPW < NGRP) ? g0 + GPW : NGRP;
    if (g0 >= gend) return;
    int slot_l = 0; float w_l = 0.f;
    if (lane < 4 * (gend - g0)) { const int m = (g0 + (lane >> 2)) * 16 + 2 * wave + ((lane >> 1) & 1), as = 2 * m + (lane & 1); slot_l = ps[a.eid[as]] + a.pos_in_e[as]; w_l = a.wts[as]; }
    const int b = (g0 * 16) / S;
    const float* gt = modl + (size_t)b * 6 * D + 5 * D; const float* scv = modn + (size_t)b * 6 * D + 1 * D; const float* shv = modn + (size_t)b * 6 * D;
    LAS float* anl = (LAS float*)(lds + CG_AN); LAS float* shl = (LAS float*)(lds + CG_SH);
    for (int i = tid; i < D / 4; i += NTHR) { *(LAS f32x4*)(anl + 4 * i) = *(const f32x4*)(gnext + 4 * i) * (*(const f32x4*)(scv + 4 * i) + 1.f); *(LAS f32x4*)(shl + 4 * i) = *(const f32x4*)(shv + 4 * i); }
    __syncthreads();
    u32x2 xc[8], xn[8]; u32x2 pc0[8], pc1[8], pn0[8], pn1[8];
#define CG_LOAD(s_, X, P0, P1) do { const int m_ = (g0 + ((s_) >> 1)) * 16 + 2 * wave + ((s_) & 1), li_ = 2 * (s_); \
        const bf16_t* y0_ = a.Y + (size_t)__shfl(slot_l, li_) * D; const bf16_t* y1_ = a.Y + (size_t)__shfl(slot_l, li_ + 1) * D; \
        _Pragma("unroll") for (int j_ = 0; j_ < 8; ++j_) { const int c_ = 4 * lane + 256 * j_; X[j_] = *(const u32x2*)(a.xres + (size_t)m_ * D + c_); P0[j_] = *(const u32x2*)(y0_ + c_); P1[j_] = *(const u32x2*)(y1_ + c_); } } while (0)
    const int nrow = 2 * (gend - g0);
    CG_LOAD(0, xc, pc0, pc1);
    for (int sq = 0; sq < nrow; ++sq) {
        const int grp = g0 + (sq >> 1), rr = sq & 1, m = grp * 16 + 2 * wave + rr;
        if (sq + 1 < nrow) CG_LOAD(sq + 1, xn, pn0, pn1);
        const float w0 = __shfl(w_l, 2 * sq), w1 = __shfl(w_l, 2 * sq + 1);
        f32x4 v[8]; float ss = 0.f;
#pragma unroll
        for (int jg = 0; jg < 2; ++jg) { f32x4 Gt[4];
#pragma unroll
            for (int jj = 0; jj < 4; ++jj) Gt[jj] = *(const f32x4*)(gt + 4 * lane + 256 * (4 * jg + jj));
            __builtin_amdgcn_sched_barrier(0);
#pragma unroll
            for (int jj = 0; jj < 4; ++jj) { const int j = 4 * jg + jj; const u32x2 p0 = pc0[j], p1 = pc1[j]; f32x4 ya, yb;
                ya[0] = __uint_as_float(p0.x << 16); ya[1] = __uint_as_float(p0.x & 0xffff0000u); ya[2] = __uint_as_float(p0.y << 16); ya[3] = __uint_as_float(p0.y & 0xffff0000u);
                yb[0] = __uint_as_float(p1.x << 16); yb[1] = __uint_as_float(p1.x & 0xffff0000u); yb[2] = __uint_as_float(p1.y << 16); yb[3] = __uint_as_float(p1.y & 0xffff0000u);
                v[j] = bf4_to_f32(xc[j]) + Gt[jj] * (ya * w0 + yb * w1);
                ss += (v[j][0] * v[j][0] + v[j][1] * v[j][1]) + (v[j][2] * v[j][2] + v[j][3] * v[j][3]); } }
        const float rstd = rsqrtf(wave_sum(ss) * (1.f / D) + EPS);
        LAS unsigned char* yrow = lds + NR_YT + (2 * wave + rr) * YT_PITCH;
#pragma unroll
        for (int j = 0; j < 8; ++j) { const int c = 4 * lane + 256 * j; { u32x2 xw; xw.x = cvt_pk_bf16(v[j][0], v[j][1]); xw.y = cvt_pk_bf16(v[j][2], v[j][3]); *(u32x2*)(a.xres + (size_t)m * D + c) = xw; }
            const f32x4 y = v[j] * rstd * (*(const LAS f32x4*)(anl + c)) + *(const LAS f32x4*)(shl + c); u32x2 w; w.x = cvt_pk_bf16(y[0], y[1]); w.y = cvt_pk_bf16(y[2], y[3]);
            *(unsigned*)(a.hb8 + (size_t)m * D + c) = pk4_fp8(y[0] * 4.f, y[1] * 4.f, y[2] * 4.f, y[3] * 4.f); *(LAS u32x2*)(yrow + c * 2) = w; }
#pragma unroll
        for (int j = 0; j < 8; ++j) { xc[j] = xn[j]; pc0[j] = pn0[j]; pc1[j] = pn1[j]; }
        if (rr == 1) {
            __syncthreads();
            rows16_logits<1>(a.Bt_g, lds, wave, lane, tid);
            if (tid < 256) a.gates[(size_t)(grp * 16 + (tid >> 4)) * 16 + (tid & 15)] = ((const LAS float*)(lds + NR_LG))[(tid >> 4) * 48 + (tid & 15)];
        }
    }
#undef CG_LOAD
}
__device__ __forceinline__ void phase_norm_route(const Args& a, int layer, const float* modl, LAS unsigned char* lds, LAS unsigned char* misc, int vcu, int G, int tid, int wave, int lane) {
    LAS int* hist = (LAS int*)(misc + MISC_HIST); LAS int* base = (LAS int*)(misc + MISC_BASE);
    LAS int* tk = (LAS int*)(lds + NR_TOK);
    LAS float* tw = (LAS float*)(lds + NR_TOK + 2048);
    int* counts = a.counts + layer * 64;
    const float* bg = a.bg + layer * 4; const float* be = a.be + layer * 32; const float* g = a.nfg + layer * D;
    if (tid < 32) hist[tid] = 0;
    LAS float* bl = (LAS float*)(lds + NR_TOK + 3072);
    if (tid < 36) bl[tid] = tid < 4 ? bg[tid] : be[tid - 4];
    __syncthreads();
    const int NGRP = NT / 16, GPW = (NGRP + G - 1) / G, g0 = vcu * GPW, gend = (g0 + GPW < NGRP) ? g0 + GPW : NGRP;
    const int ng = gend > g0 ? gend - g0 : 0;
    if (ng > 0) {
        const int b = (g0 * 16) / S;
        f32x4 A[8]; const float* shv = modl + (size_t)b * 6 * D + 3 * D;
        { const float* scv = modl + (size_t)b * 6 * D + 4 * D;
#pragma unroll
          for (int j = 0; j < 8; ++j) { const int c = 4 * lane + 256 * j; A[j] = *(const f32x4*)(g + c) * (*(const f32x4*)(scv + c) + 1.f); } }
        u32x2 x1[2][8];
#define NR_LOAD(grp_) do { _Pragma("unroll") for (int rr_ = 0; rr_ < 2; ++rr_) { const bf16_t* xr_ = a.xres + (size_t)((grp_) * 16 + 2 * wave + rr_) * D; \
        _Pragma("unroll") for (int j_ = 0; j_ < 8; ++j_) x1[rr_][j_] = *(const u32x2*)(xr_ + 4 * lane + 256 * j_); } } while (0)
        NR_LOAD(g0);
        for (int grp = g0; grp < gend; ++grp) {
            const int gi = grp - g0;
#pragma unroll
            for (int rr = 0; rr < 2; ++rr) { const int m = grp * 16 + 2 * wave + rr; float ss = 0.f;
#pragma unroll
                for (int j = 0; j < 8; ++j) { const f32x4 v = bf4_to_f32(x1[rr][j]); ss += (v[0] * v[0] + v[1] * v[1]) + (v[2] * v[2] + v[3] * v[3]); }
                const float rstd = rsqrtf(wave_sum(ss) * (1.f / D) + EPS);
                LAS unsigned char* yrow = lds + NR_YT + (2 * wave + rr) * YT_PITCH;
                f32x4 Bs[8];
#pragma unroll
                for (int j = 0; j < 8; ++j) Bs[j] = *(const f32x4*)(shv + 4 * lane + 256 * j);
                __builtin_amdgcn_sched_barrier(0);
#pragma unroll
                for (int j = 0; j < 8; ++j) { const int c = 4 * lane + 256 * j; const f32x4 y = bf4_to_f32(x1[rr][j]) * rstd * A[j] + Bs[j];
                    u32x2 w; w.x = cvt_pk_bf16(y[0], y[1]); w.y = cvt_pk_bf16(y[2], y[3]); *(LAS u32x2*)(yrow + c * 2) = w;
                    *(unsigned*)(a.hb8 + (size_t)m * D + c) = pk4_fp8(y[0] * 4.f, y[1] * 4.f, y[2] * 4.f, y[3] * 4.f); } }
            if (grp + 1 < gend) NR_LOAD(grp + 1);
            __syncthreads();
            rows16_logits<3>(a.Bt_rt + (size_t)layer * 256 * D, lds, wave, lane, tid);
            if (tid < 16 && gi < 8) {
                const LAS float* lg = (const LAS float*)(lds + NR_LG) + tid * 48;
                float gmax = -INFINITY; int grpi = 0;
#pragma unroll
                for (int i = 0; i < 4; ++i) { const float v = lg[i] + bl[i]; if (v > gmax) { gmax = v; grpi = i; } }
                float gs = 0.f;
#pragma unroll
                for (int i = 0; i < 4; ++i) gs += expf(lg[i] + bl[i] - gmax);
                const float pg = 1.f / gs;
                float v1 = -INFINITY, v2 = -INFINITY; int i1 = 0, i2 = 0;
                for (int i = 0; i < 8; ++i) { const float v = lg[4 + grpi * 8 + i] + bl[4 + grpi * 8 + i];
                    if (v > v1) { v2 = v1; i2 = i1; v1 = v; i1 = i; } else if (v > v2) { v2 = v; i2 = i; } }
                const float ex = expf(v2 - v1); const int e1 = grpi * 8 + i1, e2 = grpi * 8 + i2, sl = gi * 16 + tid;
                tk[sl] = e1; tk[128 + sl] = e2; tk[256 + sl] = atomicAdd((int*)&hist[e1], 1); tk[384 + sl] = atomicAdd((int*)&hist[e2], 1);
                tw[sl] = pg / (1.f + ex); tw[128 + sl] = pg * ex / (1.f + ex);
            }
        }
#undef NR_LOAD
    }
    __syncthreads();
    if (tid < 32) { const int h = hist[tid]; base[tid] = h ? atomicAdd(&counts[tid], h) : 0; }
    __syncthreads();
    if (tid < ng * 16 && tid < 128) { const int t = (g0 + (tid >> 4)) * 16 + (tid & 15), e1 = tk[tid], e2 = tk[128 + tid];
        a.eid[2 * t] = e1; a.eid[2 * t + 1] = e2; a.wts[2 * t] = tw[tid]; a.wts[2 * t + 1] = tw[128 + tid];
        const int p1 = base[e1] + tk[256 + tid], p2 = base[e2] + tk[384 + tid];
        a.pos_in_e[2 * t] = p1; a.pos_in_e[2 * t + 1] = p2; a.inv[e1 * 32768 + p1] = t; a.inv[e2 * 32768 + p2] = t; }
    __syncthreads();
}
__device__ __forceinline__ int moe_tables(const int* counts, LAS unsigned char* misc, int tid) {
    LAS int* ps = (LAS int*)(misc + MISC_PS); LAS int* pe = (LAS int*)(misc + MISC_PE); LAS int* npw = (LAS int*)(misc + MISC_NP);
    __syncthreads();
    if (tid < 64) {
        LAS int* cn = (LAS int*)(misc + MISC_CNT); const int e = tid & 31;
        const int c = __hip_atomic_load(&counts[e], __ATOMIC_RELAXED, __HIP_MEMORY_SCOPE_AGENT), np = (c + 255) >> 8;
        int incl = np;
#pragma unroll
        for (int d = 1; d < 32; d <<= 1) { const int t = __shfl_up(incl, d); if (tid >= d) incl += t; }
        if (tid < 32) { const int start = incl - np; ps[e] = start << 8; cn[e] = c;
            for (int p = 0; p < np; ++p) pe[start + p] = e;
            if (e == NE - 1) { ps[NE] = incl << 8; npw[0] = incl; } }
    }
    __syncthreads();
    return npw[0];
}
struct EpiQKV {
    static constexpr bool PERM = true, AFTER_DRAIN = false;
    bf16_t *Qh, *Kh, *Vh; const float2* cs;
    __device__ __forceinline__ void operator()(const f32x4 (&acc)[2][2][4][2], const Unit& u, int wr, int wc, int fr, int fq) const {
        const int t = u.pn >> 3, hh = u.pn & 7;
        bf16_t* base = Qh + (size_t)t * ((size_t)NT * 2048);
        const int row0 = u.pm * 256 + wr * 64 + fr;
        const bool rope = (t < 2) && (wc == 0);
#pragma unroll
        for (int am = 0; am < 4; ++am) { const int ai = am >> 1;
            f32x4 C[2][4];
            if (rope) {
#pragma unroll
                for (int mm = 0; mm < 2; ++mm) { const f32x4* cp = (const f32x4*)(cs + (size_t)(row0 + ai * 128 + (2 * (am & 1) + mm) * 16) * 16 + 8 * (fq & 1)); C[mm][0] = cp[0]; C[mm][1] = cp[1]; C[mm][2] = cp[2]; C[mm][3] = cp[3]; }
            } else {
#pragma unroll
                for (int mm = 0; mm < 2; ++mm) { C[mm][0] = (f32x4){0.f, 0.f, 0.f, 0.f}; C[mm][1] = C[mm][0]; C[mm][2] = C[mm][0]; C[mm][3] = C[mm][0]; }
            }
            __builtin_amdgcn_sched_barrier(0);
#pragma unroll
            for (int mm = 0; mm < 2; ++mm) { const int m = 2 * (am & 1) + mm, row = row0 + ai * 128 + m * 16;
                const f32x4 c0 = C[mm][0], c1 = C[mm][1], c2 = C[mm][2], c3 = C[mm][3];
#pragma unroll
                for (int bj = 0; bj < 2; ++bj) { f32x4 v0 = acc[ai][bj][m][0], v1 = acc[ai][bj][m][1];
                    if (rope) {
                        const float sg = (fq < 2) ? -1.f : 1.f;
                        float v[8] = {v0[0], v0[1], v0[2], v0[3], v1[0], v1[1], v1[2], v1[3]};
                        const float cc[8] = {c0[0], c0[2], c1[0], c1[2], c2[0], c2[2], c3[0], c3[2]}, sn[8] = {c0[1], c0[3], c1[1], c1[3], c2[1], c2[3], c3[1], c3[3]};
#pragma unroll
                        for (int i = 0; i < 8; ++i) { const float pv = __shfl_xor(v[i], 32); v[i] = v[i] * cc[i] + sg * pv * sn[i]; }
                        v0 = (f32x4){v[0], v[1], v[2], v[3]}; v1 = (f32x4){v[4], v[5], v[6], v[7]};
                    }
                    u32x4 w; w.x = cvt_pk_bf16(v0[0], v0[1]); w.y = cvt_pk_bf16(v0[2], v0[3]); w.z = cvt_pk_bf16(v1[0], v1[1]); w.w = cvt_pk_bf16(v1[2], v1[3]);
                    *(u32x4*)(base + ((size_t)(hh * 2 + bj) * NT + row) * 128 + wc * 32 + 8 * fq) = w; } }
            __builtin_amdgcn_sched_barrier(0);
        }
    }
};
typedef att::BlockRef<bf16_t, bf16_t> ARef;
__device__ __forceinline__ ARef att_ref(const Args& a, int hd, int qb) {
    const int b = hd >> 5, vh = hd & 31, h = vh >> 2, m = (vh >> 1) & 1, half = vh & 1;
    ARef r;
    r.Q = a.Qh + ((size_t)(h * 2 + m) * NT + (size_t)b * S + (size_t)qb * 256) * 128;
    r.K = a.Kh + ((size_t)(h * 2 + m) * NT + (size_t)b * S) * 128;
    r.V = a.Vh + ((size_t)(h * 2 + half) * NT + (size_t)b * S) * 128;
    r.O = a.Oa + ((size_t)((h * 2 + m) * 2 + half) * NT + (size_t)b * S + (size_t)qb * 256) * 128;
    r.P0 = qb * 256;
    return r;
}
__device__ __forceinline__ bool att_pos(int w, int N, int r, int& hd, int& qb) {
    const int p = r * N + ((r & 1) ? (N - 1 - w) : w); if (p >= 2048) return false;
    const int c = p >> 9, pl = p & 511; hd = pl >> 2; qb = 15 - 4 * c - (pl & 3); return true;
}
constexpr int CVA_MIN = 16 * 96, CVA_MO = 16 * 32, CVA_GU = 64 * 512, CVA_DN = 64 * 256, CVA_ITEMS = CVA_MIN + CVA_MO + CVA_GU + CVA_DN, CVA_BUF = 4224;
struct CvaItem { const float* W; unsigned char* WT; int ldw, K, k0, n0, s0; float sc; };
__device__ __forceinline__ CvaItem cva_decode(const Args& a, int r) {
    CvaItem d; d.ldw = 2048; d.K = D; d.sc = 64.f;
    if (r < CVA_MIN) { const int kb = r / 96, nb = r - kb * 96; d.W = a.m_win; d.ldw = 6160; d.WT = a.Bt_min8; d.k0 = kb * 128; d.n0 = nb * 64; d.s0 = d.n0; return d; } r -= CVA_MIN;
    if (r < CVA_MO) { d.W = a.m_wout; d.WT = a.Bt_mo8; d.k0 = (r >> 5) * 128; d.n0 = (r & 31) * 64; d.s0 = d.n0; return d; } r -= CVA_MO;
    if (r < CVA_GU) { const int ex = r >> 9, q = r & 511; d.W = a.wgu + (size_t)ex * D * 2048; d.WT = a.Bt_gu8 + (size_t)ex * 2048 * D; d.k0 = (q >> 5) * 128; d.n0 = (q & 31) * 64; d.s0 = gu_src(d.n0); return d; } r -= CVA_GU;
    { const int ex = r >> 8, q = r & 255; d.W = a.wdn + (size_t)ex * MH * D; d.WT = a.Bt_dn8 + (size_t)ex * D * MH; d.K = MH; d.k0 = (q >> 5) * 128; d.n0 = (q & 31) * 64; d.s0 = d.n0; d.sc = 32.f; return d; }
}
struct AttConv {
    const Args* a; LAS unsigned char* buf;
    int nxt, stride, cur, wave; unsigned bufa;
    __device__ __forceinline__ void issue() {
        if (nxt >= CVA_ITEMS) return;
        const CvaItem d = cva_decode(*a, nxt);
        const int l = opq((int)threadIdx.x) & 63, kq = wave & 3, nh = wave >> 2;
        cur = nxt; nxt += stride;
        const char* base = (const char*)(d.W + (size_t)(d.k0 + 32 * kq) * d.ldw + d.s0 + 32 * nh);
        const unsigned voff = (unsigned)(((l >> 3) * d.ldw + 4 * (l & 7)) * 4);
#pragma unroll
        for (int j = 0; j < 4; ++j) asm volatile("s_mov_b32 m0, %2\n\ts_nop 0\n\tglobal_load_lds_dwordx4 %0, %1" :: "v"(voff), "s"(base + (size_t)(8 * j) * d.ldw * 4), "s"(bufa + j * 1024 + (j >= 2 ? 128 : 0)) : "memory", "m0");
    }
    __device__ __forceinline__ void consume() {
        if (cur < 0) return;
        asm volatile("s_waitcnt vmcnt(0)" ::: "memory");
        const CvaItem d = cva_decode(*a, cur);
        const int l = opq((int)threadIdx.x) & 63, n = l & 31, kh = l >> 5, kq = wave & 3, nh = wave >> 2;
        const LAS float* p = (const LAS float*)(buf + kh * (17 * 128) + n * 4);
        float v[16];
#pragma unroll
        for (int i = 0; i < 16; ++i) v[i] = p[i * 32] * d.sc;
        u32x4 o; o.x = pk4_fp8(v[0], v[1], v[2], v[3]); o.y = pk4_fp8(v[4], v[5], v[6], v[7]); o.z = pk4_fp8(v[8], v[9], v[10], v[11]); o.w = pk4_fp8(v[12], v[13], v[14], v[15]);
        *(u32x4*)(d.WT + (size_t)(d.n0 + 32 * nh + n) * d.K + d.k0 + 32 * kq + 16 * kh) = o;
        asm volatile("s_waitcnt lgkmcnt(0)" ::: "memory");
        cur = -1;
    }
    __device__ __forceinline__ void finish() {
        consume();
        while (nxt < CVA_ITEMS) { issue(); consume(); }
    }
};
__device__ __forceinline__ void phase_attn(const Args& a, char* lds, int w, int N  ) {
    AttConv cv; cv.a = &a; cv.wave = __builtin_amdgcn_readfirstlane((int)threadIdx.x >> 6); cv.buf = (LAS unsigned char*)lds + att::ATT_LDS_BYTES + cv.wave * CVA_BUF; cv.bufa = __builtin_amdgcn_readfirstlane((unsigned)(uintptr_t)lds + att::ATT_LDS_BYTES + cv.wave * CVA_BUF);
    cv.nxt = w; cv.stride = N; cv.cur = -1;
    int hd, qb, r = 0;
    if (att_pos(w, N, 0, hd, qb)) {
        ARef cur = att_ref(a, hd, qb);
        att::Seam<bf16_t> Sm;
        att::causal_swa_prime<bf16_t, bf16_t>(cur, 1 << 30, lds, Sm);
        for (;;) {
            int hn, qn; const bool more = att_pos(w, N, r + 1, hn, qn);
            const ARef nxt = more ? att_ref(a, hn, qn) : cur;
            att::causal_swa_block<bf16_t, bf16_t, AttConv>(cur, nxt, S, 1 << 30, lds, Sm, cv);
            if (!more) break;
            cur = nxt; ++r;
        }
    }
    cv.finish();
}
__device__ __forceinline__ float bf_lo(unsigned u) { return __uint_as_float(u << 16); }
__device__ __forceinline__ float bf_hi(unsigned u) { return __uint_as_float(u & 0xffff0000u); }
typedef unsigned short u16x8 __attribute__((ext_vector_type(8)));
__device__ __forceinline__ void bf8_to_f32(const u32x4 p, float (&f)[8]) {
    f[0] = bf_lo(p.x); f[1] = bf_hi(p.x); f[2] = bf_lo(p.y); f[3] = bf_hi(p.y); f[4] = bf_lo(p.z); f[5] = bf_hi(p.z); f[6] = bf_lo(p.w); f[7] = bf_hi(p.w); }
__device__ __forceinline__ void phase_attn_combine(const Args& a, int gw, int NGW, int lane) {
    float d1 = a.lq1[lane] * a.lk1[lane] + a.lq1[lane + 64] * a.lk1[lane + 64], d2 = a.lq2[lane] * a.lk2[lane] + a.lq2[lane + 64] * a.lk2[lane + 64];
    const float lam = __expf(wave_sum(d1)) - __expf(wave_sum(d2)) + 0.2f;
    const int hh = lane >> 3, e0 = (lane & 7) * 32, half = e0 >> 7, d0 = e0 & 127;
    float gv[32];
#pragma unroll
    for (int i = 0; i < 8; ++i) { const f32x4 t = *(const f32x4*)(a.a_hg + e0 + 4 * i); gv[4 * i] = t[0]; gv[4 * i + 1] = t[1]; gv[4 * i + 2] = t[2]; gv[4 * i + 3] = t[3]; }
    const bf16_t* O0 = a.Oa + ((size_t)((hh * 2 + 0) * 2 + half) * NT) * 128 + d0;
    const bf16_t* O1 = a.Oa + ((size_t)((hh * 2 + 1) * 2 + half) * NT) * 128 + d0;
    const int RPW = (NT + NGW - 1) / NGW; int m = gw * RPW; const int mend = (m + RPW < NT) ? m + RPW : NT;
    if (m >= mend) return;
    u32x4 p0[4], p1[4], n0[4], n1[4];
#pragma unroll
    for (int i = 0; i < 4; ++i) { p0[i] = *(const u32x4*)(O0 + (size_t)m * 128 + 8 * i); p1[i] = *(const u32x4*)(O1 + (size_t)m * 128 + 8 * i); }
    for (;;) {
        const bool more = m + 1 < mend;
        if (more) {
#pragma unroll
            for (int i = 0; i < 4; ++i) { n0[i] = *(const u32x4*)(O0 + (size_t)(m + 1) * 128 + 8 * i); n1[i] = *(const u32x4*)(O1 + (size_t)(m + 1) * 128 + 8 * i); } }
        float o[32]; float ss = 0.f;
#pragma unroll
        for (int i = 0; i < 4; ++i) { float f0[8], f1[8]; bf8_to_f32(p0[i], f0); bf8_to_f32(p1[i], f1);
#pragma unroll
            for (int j = 0; j < 8; ++j) { o[8 * i + j] = f0[j] - lam * f1[j]; ss += o[8 * i + j] * o[8 * i + j]; } }
        ss += __shfl_xor(ss, 1); ss += __shfl_xor(ss, 2); ss += __shfl_xor(ss, 4);
        const float r = rsqrtf(ss * (1.f / 256.f) + EPS) * 0.8f;
        bf16_t* orow = a.ob + (size_t)m * D + hh * 256 + e0;
#pragma unroll
        for (int i = 0; i < 4; ++i) { u32x4 w; w.x = cvt_pk_bf16(o[8 * i] * r * gv[8 * i], o[8 * i + 1] * r * gv[8 * i + 1]); w.y = cvt_pk_bf16(o[8 * i + 2] * r * gv[8 * i + 2], o[8 * i + 3] * r * gv[8 * i + 3]);
            w.z = cvt_pk_bf16(o[8 * i + 4] * r * gv[8 * i + 4], o[8 * i + 5] * r * gv[8 * i + 5]); w.w = cvt_pk_bf16(o[8 * i + 6] * r * gv[8 * i + 6], o[8 * i + 7] * r * gv[8 * i + 7]);
            *(u32x4*)(orow + 8 * i) = w; }
        if (!more) break;
        ++m;
#pragma unroll
        for (int i = 0; i < 4; ++i) { p0[i] = n0[i]; p1[i] = n1[i]; }
    }
}

struct EpiMin {
    static constexpr bool PERM = true, AFTER_DRAIN = false;
    bf16_t* P3;
    __device__ __forceinline__ void operator()(const f32x4 (&acc)[2][2][4][2], const Unit& u, int wr, int wc, int fr, int fq) const {
        const int t = u.pn >> 3; const int row0 = u.pm * 256 + wr * 64 + fr;
        bf16_t* base = P3 + (size_t)t * ((size_t)NT * 2048); const int col0 = (u.pn & 7) * 256 + wc * 32 + 8 * fq;
#pragma unroll
        for (int ai = 0; ai < 2; ++ai)
#pragma unroll
            for (int m = 0; m < 4; ++m) { bf16_t* rowp = base + (size_t)(row0 + ai * 128 + m * 16) * 2048 + col0;
#pragma unroll
                for (int bj = 0; bj < 2; ++bj) { f32x4 v0 = acc[ai][bj][m][0] * (1.f / 256.f), v1 = acc[ai][bj][m][1] * (1.f / 256.f);
                    if (t == 2) {
#pragma unroll
                        for (int j = 0; j < 4; ++j) { v0[j] = 1.f / (1.f + __expf(-v0[j])); v1[j] = 1.f / (1.f + __expf(-v1[j])); } }
                    u32x4 w; w.x = cvt_pk_bf16(v0[0], v0[1]); w.y = cvt_pk_bf16(v0[2], v0[3]); w.z = cvt_pk_bf16(v1[0], v1[1]); w.w = cvt_pk_bf16(v1[2], v1[3]);
                    *(u32x4*)(rowp + bj * 128) = w; } }
    }
};
constexpr int MP_XS = 0, MP_VT = 35840, MP_QS = 69632, MP_KS = 87040, MP_GT = 104448;
__device__ __forceinline__ unsigned pk_lo(unsigned a, unsigned b) { return (a & 0xffffu) | (b << 16); }
__device__ __forceinline__ unsigned pk_hi(unsigned a, unsigned b) { return (a >> 16) | (b & 0xffff0000u); }
__device__ __forceinline__ void phase_mprep(const Args& a, LAS unsigned char* lds, int vcu, int G, int tid) {
    const bf16_t* QKP = a.P3; const bf16_t* VB = a.P3 + (size_t)NT * 2048;
    for (int it = vcu; it < NB * 64; it += G) {
        const int b = it >> 6, ck = it & 63; const size_t row0 = (size_t)b * S + (size_t)ck * 64;
        __syncthreads();
        {
            const int t = tid >> 3, h = tid & 7; LAS float* gt = (LAS float*)(lds + MP_GT);
            const float gi = a.gates[(row0 + t) * 16 + h] + a.m_gb[h], z = a.gates[(row0 + t) * 16 + 8 + h] + a.m_gb[8 + h];
            gt[t * 8 + h] = gi; gt[512 + t * 8 + h] = fminf(z, 0.f) - log1pf(expf(-fabsf(z)));
        }
        __syncthreads();
        if (tid < 8) {
            const int h = tid; float bc = 0.f, cm = -INFINITY; const LAS float* gt = (const LAS float*)(lds + MP_GT);
            float* ga = a.GA + (size_t)((b * 8 + h) * 64 + ck) * 192;
            for (int t = 0; t < 64; ++t) { bc += gt[512 + t * 8 + h]; const float av = gt[t * 8 + h] - bc; cm = fmaxf(cm, av); ga[t] = av; ga[64 + t] = cm; ga[128 + t] = bc; }
            a.GS[(size_t)((b * 8 + h) * 64 + ck) * 2 + 0] = cm; a.GS[(size_t)((b * 8 + h) * 64 + ck) * 2 + 1] = bc;
        }
        for (int h = 0; h < 8; ++h) {
            {
                const int tq = opq(tid); u32x4 xs[5];
#pragma unroll
                for (int i = 0; i < 5; ++i) { const int c0 = tq + 512 * i, c = c0 < 67 * 32 ? c0 : 67 * 32 - 1, r = c >> 5, cc = c & 31; long gr = (long)row0 + r - 3; if (gr < 0) gr = 0;
                    xs[i] = *(const u32x4*)(QKP + (size_t)gr * 2048 + (cc < 16 ? h * 128 + cc * 8 : 1024 + h * 128 + (cc - 16) * 8)); }
                __builtin_amdgcn_sched_barrier(0);
#pragma unroll
                for (int i = 0; i < 5; ++i) { const int c = tq + 512 * i, r = c >> 5, cc = c & 31;
                    if (c < 67 * 32) *(LAS u32x4*)(lds + MP_XS + r * 528 + cc * 16) = (ck * 64 + r - 3 >= 0) ? xs[i] : (u32x4){0u, 0u, 0u, 0u}; }
                __builtin_amdgcn_sched_barrier(0);
            }
            {   const int tq = opq(tid); u32x4 vv[4];
#pragma unroll
                for (int i = 0; i < 4; ++i) { const int c = tq + 512 * i, sr = c >> 5, e16 = c & 31; vv[i] = *(const u32x4*)(VB + (row0 + sr) * 2048 + h * 256 + e16 * 8); }
                __builtin_amdgcn_sched_barrier(0);
#pragma unroll
                for (int i = 0; i < 4; ++i) { const int c = tq + 512 * i, sr = c >> 5, e16 = c & 31; *(LAS u32x4*)(lds + MP_VT + sr * 528 + e16 * 16) = vv[i]; }
            }
            __syncthreads();
            {
                const int cp = tid & 127, rq = tid >> 7; const bool isk = cp >= 64;
                const int col = isk ? 1024 + h * 128 + 2 * (cp - 64) : h * 128 + 2 * cp;
                float w0[4], w1[4];
#pragma unroll
                for (int j = 0; j < 4; ++j) { w0[j] = a.m_cw[j * 2048 + col]; w1[j] = a.m_cw[j * 2048 + col + 1]; }
                const float b0 = a.m_cb[col], b1 = a.m_cb[col + 1];
                const LAS unsigned char* xp = lds + MP_XS + (16 * rq) * 528 + cp * 4;
                float xa[4], xb[4];
#pragma unroll
                for (int j = 0; j < 3; ++j) { const unsigned v = *(const LAS unsigned*)(xp + j * 528); xa[j] = bf_lo(v); xb[j] = bf_hi(v); }
                const float sc = isk ? 0.08838834764831845f : 1.f;
                LAS unsigned char* dst = lds + (isk ? MP_KS : MP_QS) + (isk ? cp - 64 : cp) * 4;
#pragma unroll
                for (int i = 0; i < 16; ++i) { const int t = 16 * rq + i;
                    const unsigned v = *(const LAS unsigned*)(xp + (i + 3) * 528); xa[3] = bf_lo(v); xb[3] = bf_hi(v);
                    float ya = b0 + w0[0] * xa[0] + w0[1] * xa[1] + w0[2] * xa[2] + w0[3] * xa[3];
                    float yb = b1 + w1[0] * xb[0] + w1[1] * xb[1] + w1[2] * xb[2] + w1[3] * xb[3];
                    ya = ya / (1.f + __expf(-ya)) * sc; yb = yb / (1.f + __expf(-yb)) * sc;
                    *(LAS unsigned*)(dst + t * 272) = cvt_pk_bf16(ya, yb);
                    xa[0] = xa[1]; xa[1] = xa[2]; xa[2] = xa[3]; xb[0] = xb[1]; xb[1] = xb[2]; xb[2] = xb[3]; }
            }
            __syncthreads();
            {
#pragma unroll
                for (int i = 0; i < 4; ++i) { const int c = tid + 512 * i, isk = c >> 10, r = (c >> 4) & 63, cc = c & 15;
                    *(u32x4*)(a.Qn + (isk ? (size_t)NT * 1024 : (size_t)0) + (row0 + r) * 1024 + h * 128 + cc * 8) = *(const LAS u32x4*)(lds + (isk ? MP_KS : MP_QS) + r * 272 + cc * 16); }
            }
            if (tid < 256) {
                const int dp = tid & 63, sq = tid >> 6; unsigned w[16];
#pragma unroll
                for (int i = 0; i < 16; ++i) w[i] = *(const LAS unsigned*)(lds + MP_KS + (16 * sq + i) * 272 + dp * 4);
                u32x4* d0p = (u32x4*)(a.KT + ((size_t)((b * 8 + h) * 64 + ck) * 128 + 2 * dp) * 64 + 16 * sq);
                d0p[0] = (u32x4){pk_lo(w[0], w[1]), pk_lo(w[2], w[3]), pk_lo(w[4], w[5]), pk_lo(w[6], w[7])};
                d0p[1] = (u32x4){pk_lo(w[8], w[9]), pk_lo(w[10], w[11]), pk_lo(w[12], w[13]), pk_lo(w[14], w[15])};
                d0p[8] = (u32x4){pk_hi(w[0], w[1]), pk_hi(w[2], w[3]), pk_hi(w[4], w[5]), pk_hi(w[6], w[7])};
                d0p[9] = (u32x4){pk_hi(w[8], w[9]), pk_hi(w[10], w[11]), pk_hi(w[12], w[13]), pk_hi(w[14], w[15])};
            }
            {
                const int ep = tid & 127, sq = tid >> 7; unsigned w[16];
#pragma unroll
                for (int i = 0; i < 16; ++i) w[i] = *(const LAS unsigned*)(lds + MP_VT + (16 * sq + i) * 528 + ep * 4);
                u32x4* d0p = (u32x4*)(a.VT + ((size_t)((b * 8 + h) * 64 + ck) * 256 + 2 * ep) * 64 + 16 * sq);
                d0p[0] = (u32x4){pk_lo(w[0], w[1]), pk_lo(w[2], w[3]), pk_lo(w[4], w[5]), pk_lo(w[6], w[7])};
                d0p[1] = (u32x4){pk_lo(w[8], w[9]), pk_lo(w[10], w[11]), pk_lo(w[12], w[13]), pk_lo(w[14], w[15])};
                d0p[8] = (u32x4){pk_hi(w[0], w[1]), pk_hi(w[2], w[3]), pk_hi(w[4], w[5]), pk_hi(w[6], w[7])};
                d0p[9] = (u32x4){pk_hi(w[8], w[9]), pk_hi(w[10], w[11]), pk_hi(w[12], w[13]), pk_hi(w[14], w[15])};
            }
            __syncthreads();
        }
    }
}

constexpr int ML_QS = 0, ML_KS = 17408, ML_KTS = 34816, ML_VTS = 53248, ML_GL = 60160, ML_PL = 60928, ML_QD = 70144, ML_CL = 87552, ML_MP = 113664, ML_END = 113920;
typedef short bf16x8s __attribute__((ext_vector_type(8)));
__device__ __forceinline__ void phase_mlstm(const Args& a, LAS unsigned char* lds, int vcu, int G, int tid, int wave, int lane) {
    const int r16 = lane & 15, q4 = lane >> 4;
    for (int unit = vcu; unit < 256; unit += G) {
        const int bh = unit >> 3, es = unit & 7, b = bh >> 3, h = bh & 7;
        __syncthreads();
        for (int i = tid; i < 16 * 36; i += NTHR) { const int r = i / 36, c = i % 36; *(LAS unsigned*)(lds + ML_VTS + (32 + r) * 144 + c * 4) = (r == 0) ? 0x3F803F80u : 0u; }
        for (int i = tid; i < 48 * 68; i += NTHR) *(LAS unsigned*)(lds + ML_CL + i * 4) = 0u;
        if (tid < 64) { ((LAS float*)(lds + ML_END))[2 * tid] = a.GS[(size_t)(bh * 64 + tid) * 2]; ((LAS float*)(lds + ML_END))[2 * tid + 1] = a.GS[(size_t)(bh * 64 + tid) * 2 + 1]; }
        __syncthreads();
        if (tid == 0) { float m = 0.f; LAS float* mp = (LAS float*)(lds + ML_MP); const LAS float* gs = (const LAS float*)(lds + ML_END);
            for (int k = 0; k < 64; ++k) { mp[k] = m; m = gs[2 * k + 1] + fmaxf(m, gs[2 * k]); } }
        f32x4 accC[2][3];
#pragma unroll
        for (int i = 0; i < 2; ++i)
#pragma unroll
            for (int j = 0; j < 3; ++j) accC[i][j] = (f32x4){0.f, 0.f, 0.f, 0.f};
        u32x4 rq[2], rk[2], rkt[2], rv, rg, sq[2], sk[2], skt[2], sv, sg;
        rv = (u32x4){0u, 0u, 0u, 0u}; rg = rv; sv = rv; sg = rv;
#define ML_LOAD(k, Q_, K_, KT_, V_, G_) do { const int kc_ = (k) < 64 ? (k) : 63; const size_t row0_ = (size_t)b * S + (size_t)kc_ * 64; const size_t cb_ = (size_t)(bh * 64 + kc_); \
        _Pragma("unroll") for (int i_ = 0; i_ < 2; ++i_) { const int c_ = tid + 512 * i_; \
            Q_[i_] = *(const u32x4*)(a.Qn + (row0_ + (c_ >> 4)) * 1024 + h * 128 + (c_ & 15) * 8); \
            K_[i_] = *(const u32x4*)(a.Kn + (row0_ + (c_ >> 4)) * 1024 + h * 128 + (c_ & 15) * 8); \
            KT_[i_] = *(const u32x4*)(a.KT + cb_ * 8192 + (size_t)c_ * 8); } \
        V_ = *(const u32x4*)(a.VT + cb_ * 16384 + (size_t)es * 2048 + (size_t)(tid & 255) * 8); \
        G_ = *(const u32x4*)(a.GA + cb_ * 192 + (tid & 31) * 4); } while (0)
#define ML_STORE(Q_, K_, KT_, V_, G_) do { \
        _Pragma("unroll") for (int i_ = 0; i_ < 2; ++i_) { const int c_ = tid + 512 * i_; \
            *(LAS u32x4*)(lds + ML_QS + (c_ >> 4) * 272 + (c_ & 15) * 16) = Q_[i_]; \
            *(LAS u32x4*)(lds + ML_KS + (c_ >> 4) * 272 + (c_ & 15) * 16) = K_[i_]; \
            *(LAS u32x4*)(lds + ML_KTS + (c_ >> 3) * 144 + (c_ & 7) * 16) = KT_[i_]; } \
        if (tid < 256) *(LAS u32x4*)(lds + ML_VTS + (tid >> 3) * 144 + (tid & 7) * 16) = V_; \
        if (tid < 48) *(LAS u32x4*)(lds + ML_GL + tid * 16) = G_; } while (0)
        ML_LOAD(0, rq, rk, rkt, rv, rg);
        ML_STORE(rq, rk, rkt, rv, rg);
        __syncthreads();
        ML_LOAD(1, rq, rk, rkt, rv, rg); ML_LOAD(2, sq, sk, skt, sv, sg);
        auto chunk = [&](const int k) __attribute__((always_inline)) {
            const LAS float* ga = (const LAS float*)(lds + ML_GL);
            const float m = ((const LAS float*)(lds + ML_MP))[k];
            const int cur = k & 1;
            if (wave < 4) {
                const int tr = wave, t = 16 * tr + r16;
                const float Mt = fmaxf(m, ga[64 + t]);
                bf16x8s qf[4];
#pragma unroll
                for (int kk = 0; kk < 4; ++kk) qf[kk] = *(const LAS bf16x8s*)(lds + ML_QS + t * 272 + kk * 64 + q4 * 16);
#pragma unroll
                for (int sc = 0; sc < 4; ++sc) {
                    u32x2 w0 = {0u, 0u};
                    if (sc <= tr) {
                        f32x4 s0 = {0.f, 0.f, 0.f, 0.f};
#pragma unroll
                        for (int kk = 0; kk < 4; ++kk) { const bf16x8s kf = *(const LAS bf16x8s*)(lds + ML_KS + (16 * sc + r16) * 272 + kk * 64 + q4 * 16);
                            s0 = __builtin_amdgcn_mfma_f32_16x16x32_bf16(kf, qf[kk], s0, 0, 0, 0); }
                        const f32x4 a0 = *(const LAS f32x4*)(lds + ML_GL + (16 * sc + 4 * q4) * 4);
                        float p[4];
#pragma unroll
                        for (int j = 0; j < 4; ++j) { const int sA = 16 * sc + 4 * q4 + j; p[j] = (sA <= t) ? s0[j] * __expf(a0[j] - Mt) : 0.f; }
                        w0.x = cvt_pk_bf16(p[0], p[1]); w0.y = cvt_pk_bf16(p[2], p[3]);
                    }
                    *(LAS u32x2*)(lds + ML_PL + t * 144 + (16 * sc + 4 * q4) * 2) = w0;
                }
                {
                    const int tq = 16 * tr + (lane >> 2), c0 = (lane & 3) * 32;
                    const float dec = __expf(m - fmaxf(m, ga[64 + tq]));
#pragma unroll
                    for (int i = 0; i < 4; ++i) { const u32x4 v = *(const LAS u32x4*)(lds + ML_QS + tq * 272 + (c0 + 8 * i) * 2); u32x4 o;
                        o.x = cvt_pk_bf16(bf_lo(v.x) * dec, bf_hi(v.x) * dec); o.y = cvt_pk_bf16(bf_lo(v.y) * dec, bf_hi(v.y) * dec);
                        o.z = cvt_pk_bf16(bf_lo(v.z) * dec, bf_hi(v.z) * dec); o.w = cvt_pk_bf16(bf_lo(v.w) * dec, bf_hi(v.w) * dec);
                        *(LAS u32x4*)(lds + ML_QD + tq * 272 + (c0 + 8 * i) * 2) = o; }
                }
                asm volatile("s_waitcnt lgkmcnt(0)" ::: "memory");
                f32x4 o0 = {0.f, 0.f, 0.f, 0.f}, o1 = o0, o2 = o0;
#pragma unroll
                for (int kk = 0; kk < 2; ++kk) {
                    if (kk * 2 <= tr) {
                    const bf16x8s pf = *(const LAS bf16x8s*)(lds + ML_PL + t * 144 + kk * 64 + q4 * 16);
                    const bf16x8s v0 = *(const LAS bf16x8s*)(lds + ML_VTS + (r16) * 144 + kk * 64 + q4 * 16);
                    const bf16x8s v1 = *(const LAS bf16x8s*)(lds + ML_VTS + (16 + r16) * 144 + kk * 64 + q4 * 16);
                    const bf16x8s v2 = *(const LAS bf16x8s*)(lds + ML_VTS + (32 + r16) * 144 + kk * 64 + q4 * 16);
                    o0 = __builtin_amdgcn_mfma_f32_16x16x32_bf16(v0, pf, o0, 0, 0, 0);
                    o1 = __builtin_amdgcn_mfma_f32_16x16x32_bf16(v1, pf, o1, 0, 0, 0);
                    o2 = __builtin_amdgcn_mfma_f32_16x16x32_bf16(v2, pf, o2, 0, 0, 0); }
                }
#pragma unroll
                for (int kk = 0; kk < 4; ++kk) {
                    const bf16x8s qd = *(const LAS bf16x8s*)(lds + ML_QD + t * 272 + kk * 64 + q4 * 16);
                    const bf16x8s c0 = *(const LAS bf16x8s*)(lds + ML_CL + cur * 13056 + (r16) * 272 + kk * 64 + q4 * 16);
                    const bf16x8s c1 = *(const LAS bf16x8s*)(lds + ML_CL + cur * 13056 + (16 + r16) * 272 + kk * 64 + q4 * 16);
                    const bf16x8s c2 = *(const LAS bf16x8s*)(lds + ML_CL + cur * 13056 + (32 + r16) * 272 + kk * 64 + q4 * 16);
                    o0 = __builtin_amdgcn_mfma_f32_16x16x32_bf16(c0, qd, o0, 0, 0, 0);
                    o1 = __builtin_amdgcn_mfma_f32_16x16x32_bf16(c1, qd, o1, 0, 0, 0);
                    o2 = __builtin_amdgcn_mfma_f32_16x16x32_bf16(c2, qd, o2, 0, 0, 0);
                }
                const float den = __shfl(o2[0], r16);
                const float mt = ga[128 + t] + Mt;
                const float inv = 1.f / fmaxf(fabsf(den), __expf(-mt));
                bf16_t* hp = a.HS + ((size_t)b * S + (size_t)k * 64 + t) * 2048 + h * 256 + es * 32 + 4 * q4;
                u32x2 w0, w1; w0.x = cvt_pk_bf16(o0[0] * inv, o0[1] * inv); w0.y = cvt_pk_bf16(o0[2] * inv, o0[3] * inv);
                w1.x = cvt_pk_bf16(o1[0] * inv, o1[1] * inv); w1.y = cvt_pk_bf16(o1[2] * inv, o1[3] * inv);
                *(u32x2*)hp = w0; *(u32x2*)(hp + 16) = w1;
            } else {
                const int dj = wave - 4;
                const float Ml = fmaxf(m, ga[64 + 63]), cd = __expf(m - Ml);
#pragma unroll
                for (int i = 0; i < 2; ++i)
#pragma unroll
                    for (int et = 0; et < 3; ++et) accC[i][et] = accC[i][et] * cd;
#pragma unroll
                for (int kk = 0; kk < 2; ++kk) {
                    const f32x4 aA = *(const LAS f32x4*)(lds + ML_GL + (32 * kk + 8 * q4) * 4), aB = *(const LAS f32x4*)(lds + ML_GL + (32 * kk + 8 * q4 + 4) * 4);
                    float wg[8];
#pragma unroll
                    for (int j = 0; j < 4; ++j) { wg[j] = __expf(aA[j] - Ml); wg[4 + j] = __expf(aB[j] - Ml); }
                    bf16x8s vw[3];
#pragma unroll
                    for (int et = 0; et < 3; ++et) { const u32x4 v = *(const LAS u32x4*)(lds + ML_VTS + (16 * et + r16) * 144 + kk * 64 + q4 * 16); u32x4 o;
                        o.x = cvt_pk_bf16(bf_lo(v.x) * wg[0], bf_hi(v.x) * wg[1]); o.y = cvt_pk_bf16(bf_lo(v.y) * wg[2], bf_hi(v.y) * wg[3]);
                        o.z = cvt_pk_bf16(bf_lo(v.z) * wg[4], bf_hi(v.z) * wg[5]); o.w = cvt_pk_bf16(bf_lo(v.w) * wg[6], bf_hi(v.w) * wg[7]);
                        vw[et] = __builtin_bit_cast(bf16x8s, o); }
#pragma unroll
                    for (int i = 0; i < 2; ++i) { const bf16x8s kf = *(const LAS bf16x8s*)(lds + ML_KTS + (16 * (2 * dj + i) + r16) * 144 + kk * 64 + q4 * 16);
#pragma unroll
                        for (int et = 0; et < 3; ++et) accC[i][et] = __builtin_amdgcn_mfma_f32_16x16x32_bf16(kf, vw[et], accC[i][et], 0, 0, 0); }
                }
#pragma unroll
                for (int i = 0; i < 2; ++i)
#pragma unroll
                    for (int et = 0; et < 3; ++et) { u32x2 w; w.x = cvt_pk_bf16(accC[i][et][0], accC[i][et][1]); w.y = cvt_pk_bf16(accC[i][et][2], accC[i][et][3]);
                        *(LAS u32x2*)(lds + ML_CL + (cur ^ 1) * 13056 + (16 * et + r16) * 272 + (16 * (2 * dj + i) + 4 * q4) * 2) = w; }
            }
        };
        for (int k = 0; k < 64; k += 2) {
            chunk(k);
            __syncthreads();
            ML_STORE(rq, rk, rkt, rv, rg);
            __syncthreads();
            ML_LOAD(k + 3, rq, rk, rkt, rv, rg);
            chunk(k + 1);
            __syncthreads();
            ML_STORE(sq, sk, skt, sv, sg);
            __syncthreads();
            ML_LOAD(k + 4, sq, sk, skt, sv, sg);
        }
#undef ML_LOAD
#undef ML_STORE
    }
}
__device__ __forceinline__ void phase_mnorm(const Args& a, int gw, int NGW, int lane) {
    const bf16_t* SG = a.P3 + (size_t)2 * NT * 2048;
    float gv[32];
#pragma unroll
    for (int i = 0; i < 8; ++i) { const f32x4 t = *(const f32x4*)(a.m_hg + 32 * lane + 4 * i); gv[4 * i] = t[0]; gv[4 * i + 1] = t[1]; gv[4 * i + 2] = t[2]; gv[4 * i + 3] = t[3]; }
    const int RPW = (NT + NGW - 1) / NGW; int m = gw * RPW; const int mend = (m + RPW < NT) ? m + RPW : NT;
    if (m >= mend) return;
    u32x4 p0[4], p1[4], n0[4], n1[4];
#pragma unroll
    for (int i = 0; i < 4; ++i) { p0[i] = *(const u32x4*)(a.HS + (size_t)m * D + 32 * lane + 8 * i); p1[i] = *(const u32x4*)(SG + (size_t)m * D + 32 * lane + 8 * i); }
    for (;;) {
        const bool more = m + 1 < mend;
        if (more) {
#pragma unroll
            for (int i = 0; i < 4; ++i) { n0[i] = *(const u32x4*)(a.HS + (size_t)(m + 1) * D + 32 * lane + 8 * i); n1[i] = *(const u32x4*)(SG + (size_t)(m + 1) * D + 32 * lane + 8 * i); } }
        float o[32], sg[32]; float ss = 0.f;
#pragma unroll
        for (int i = 0; i < 4; ++i) { float f0[8], f1[8]; bf8_to_f32(p0[i], f0); bf8_to_f32(p1[i], f1);
#pragma unroll
            for (int j = 0; j < 8; ++j) { o[8 * i + j] = f0[j]; sg[8 * i + j] = f1[j]; ss += f0[j] * f0[j]; } }
        ss += __shfl_xor(ss, 1); ss += __shfl_xor(ss, 2); ss += __shfl_xor(ss, 4);
        const float r = rsqrtf(ss * (1.f / 256.f) + EPS);
        unsigned char* orow = a.ob8 + (size_t)m * D + 32 * lane;
#pragma unroll
        for (int i = 0; i < 4; ++i) { float y[8];
#pragma unroll
            for (int j = 0; j < 8; ++j) y[j] = o[8 * i + j] * r * gv[8 * i + j] * sg[8 * i + j];
            u32x2 w; w.x = pk4_fp8(y[0] * 8.f, y[1] * 8.f, y[2] * 8.f, y[3] * 8.f); w.y = pk4_fp8(y[4] * 8.f, y[5] * 8.f, y[6] * 8.f, y[7] * 8.f);
            *(u32x2*)(orow + 8 * i) = w; }
        if (!more) break;
        ++m;
#pragma unroll
        for (int i = 0; i < 4; ++i) { p0[i] = n0[i]; p1[i] = n1[i]; }
    }
}

#define XB_TMO      128
#define XB_XCNT(j)  (256  + 64 * (j))
#define XB_XSUB(j)  (1280 + 64 * (j))
#define XB_XGEN(j)  (2304 + 64 * (j))
#define XB_TOP      3328
#define XB_TOPGEN   3392
#define XCD_BAR_WORDS 3456
#define XB_SPIN_CAP (1u << 18)

__device__ __forceinline__ unsigned xb_ld(unsigned* p)              { return __hip_atomic_load(p, __ATOMIC_RELAXED, __HIP_MEMORY_SCOPE_AGENT); }
__device__ __forceinline__ unsigned xb_add(unsigned* p, unsigned v) { return __hip_atomic_fetch_add(p, v, __ATOMIC_RELAXED, __HIP_MEMORY_SCOPE_AGENT); }
__device__ __forceinline__ unsigned xb_xcc_id() { return (unsigned)__builtin_amdgcn_s_getreg((3 << 11) | 20) & 0xFu; }
#define XB_SPIN(cond, bar) do { unsigned _sp = 0; while (cond) { __builtin_amdgcn_s_sleep(1); \
    if ((++_sp & 255u) == 0u) { if (xb_ld(&(bar)[XB_TMO])) break; if (_sp > XB_SPIN_CAP) { atomicAdd(&(bar)[XB_TMO], 1u); break; } } } } while (0)

struct XcdBarrier {
    unsigned* bar; unsigned x;
    volatile LAS unsigned* st;
};

__device__ __forceinline__ XcdBarrier xcd_barrier_post(unsigned* bar, volatile LAS unsigned* st) {
    XcdBarrier b; b.bar = bar; b.x = xb_xcc_id(); b.st = st;
    if (threadIdx.x == 0) (void)xb_add(&bar[XB_XCNT(b.x)], 1u);
    return b;
}
__device__ __forceinline__ void xcd_barrier_complete(unsigned* bar, unsigned x, unsigned& nloc, unsigned& nx) {
    const unsigned G = gridDim.x * gridDim.y * gridDim.z;
    unsigned sum, cnt, mine, sp = 0u;
    for (;;) {
        sum = 0u; cnt = 0u; mine = 0u;
#pragma unroll
        for (unsigned j = 0; j < 16; ++j) { const unsigned c = xb_ld(&bar[XB_XCNT(j)]); sum += c; cnt += (c > 0u) ? 1u : 0u; mine = (j == x) ? c : mine; }
        if (sum == G) break;
        __builtin_amdgcn_s_sleep(1);
        if ((++sp & 255u) == 0u) { if (xb_ld(&bar[XB_TMO])) break; if (sp > XB_SPIN_CAP) { atomicAdd(&bar[XB_TMO], 1u); break; } }
    }
    nloc = mine > 0u ? mine : 1u; nx = cnt > 0u ? cnt : 1u;
}

__device__ __forceinline__ void xcd_barrier(const XcdBarrier& b) {
    asm volatile("s_waitcnt vmcnt(0)" ::: "memory");
    __syncthreads();
    if (threadIdx.x == 0) {
        unsigned* bar = b.bar;
        __builtin_amdgcn_s_waitcnt(0);
        unsigned nloc = b.st[0], nx = b.st[1];
        if (nloc == 0u) { xcd_barrier_complete(bar, b.x, nloc, nx); b.st[0] = nloc; b.st[1] = nx; }
        const unsigned old = xb_add(&bar[XB_XSUB(b.x)], 1u);
        const unsigned gen = old / nloc;
        if (old + 1u == (gen + 1u) * nloc) {
            __builtin_amdgcn_fence(__ATOMIC_RELEASE, "agent");
            asm volatile("s_waitcnt vmcnt(0)" ::: "memory");
            const unsigned og = xb_add(&bar[XB_TOP], 1u);
            const unsigned tg = og / nx;
            if (og + 1u == (tg + 1u) * nx) xb_add(&bar[XB_TOPGEN], 1u);
            else XB_SPIN(xb_ld(&bar[XB_TOPGEN]) == tg, bar);
            __builtin_amdgcn_fence(__ATOMIC_ACQUIRE, "agent");
            xb_add(&bar[XB_XGEN(b.x)], 1u);
            asm volatile("s_waitcnt vmcnt(0)" ::: "memory");
        } else {
            XB_SPIN(xb_ld(&bar[XB_XGEN(b.x)]) == gen, bar);
            __builtin_amdgcn_fence(__ATOMIC_ACQUIRE, "agent");
            asm volatile("s_waitcnt vmcnt(0)" ::: "memory");
        }
    }
    __syncthreads();
}


#ifndef MK_REP_MASK
#define MK_REP_MASK 0u
#endif
__device__ __forceinline__ constexpr int REPS(int k) { return ((MK_REP_MASK >> k) & 1u) ? 2 : 1; }
__global__ void __launch_bounds__(NTHR, 2) mk_fwd(Args a) {
    extern __shared__ __attribute__((aligned(16))) unsigned char lds_raw[];
    LAS unsigned char* lds = (LAS unsigned char*)lds_raw;
    LAS unsigned char* misc = lds + LDS_MISC;
    const int tid = threadIdx.x, lane = tid & 63, wave = __builtin_amdgcn_readfirstlane(tid >> 6);
    const int G = gridDim.x; const int bx = blockIdx.x; const int vcu = (G % 8 == 0) ? (bx % 8) * (G / 8) + bx / 8 : bx;
    const int gw = vcu * NWAVES + wave, NGW = G * NWAVES;
    if (tid < 16) ((LAS unsigned*)(misc + MISC_BAR))[tid] = 0u;
    __syncthreads();
    const int lo = a.ph_lo, hi = a.ph_hi;
    XcdBarrier bar; bar.bar = a.ctl + 4096; bar.x = 0; bar.st = nullptr;
    if (hi - lo > 1) bar = xcd_barrier_post(a.ctl + 4096, (volatile LAS unsigned*)(misc + MISC_BAR));
#define IN(k) (lo <= (k) && (k) < hi)
#define SEAM(k) do { if (IN(k) && IN((k) + 1)) xcd_barrier(bar); } while (0)
    const float* mod0 = a.mod; const float* mod1 = a.mod + (size_t)NB * 6 * D;

#define PH(k) if (IN(k)) _Pragma("unroll") for (int rep_ = 0; rep_ < REPS(k); (REPS(k) > 1 ? __syncthreads() : (void)0, ++rep_))
    PH(0) { p0_prologue(a, lds, vcu, G, opq(tid), wave, opq(lane)); } SEAM(0);
    PH(1) { phase_norm(a.x, a.nmg, mod0, 0, 1, a.hb, gw, NGW, opq(lane)); } SEAM(1);
    PH(2) {
        pg8::Gemm g{a.hb, a.Bt_qkv, NT, 6144, D}; pg8::StaticOrder So; So.init(NT, 6144, G, bx);
        EpiQKV E{a.Qh, a.Kh, a.Vh, a.cs};
        pg8::gemm_phase<EpiQKV, pg8::StaticOrder, true, true>(lds, g, So, E);
    } SEAM(2);
    PH(3) { phase_attn(a, (char*)lds_raw, vcu, G); } SEAM(3);
    PH(4) { phase_attn_combine(a, gw, NGW, opq(lane)); } SEAM(4);
    PH(5) {
        pg8::Gemm g{a.ob, a.Bt_ao, NT, D, D}; pg8::StaticOrder So; So.init(NT, D, G, bx);
        EpiResid<true> E{a.x, a.xres, mod0 + 2 * D, 1.f};
        pg8::gemm_phase<EpiResid<true>, pg8::StaticOrder, true, true>(lds, g, So, E);
    } SEAM(5);
#define MOE_PHASES(P, layer, modl)                                                                                                   \
    PH(P) { phase_norm_route(a, layer, modl, lds, misc, vcu, G, opq(tid), wave, opq(lane)); } SEAM(P);                            \
    PH(P + 1) { const int NP = moe_tables(a.counts + (layer) * 64, misc, tid);                                                    \
        pg8::Gemm g{(const bf16_t*)a.hb8, (const bf16_t*)(a.Bt_gu8 + (size_t)(layer) * NE * 2048 * D), NP * 256, NE * 2048, D / 2};     \
        GroupedOrderG So; So.NP = NP; So.total = NP * 8; So.G = G; So.c = vcu; So.pe = (const LAS int*)(misc + MISC_PE);          \
        So.ps = (const LAS int*)(misc + MISC_PS); So.cn = (const LAS int*)(misc + MISC_CNT); So.inv = a.inv; EpiGU E{a.Hm8};      \
        pg8::gemm_phase_gather<EpiGU, GroupedOrderG, true, 125, 121>(lds, g, So, E); } SEAM(P + 1);                                               \
    PH(P + 2) { const int NP = moe_tables(a.counts + (layer) * 64, misc, tid);                                                    \
        pg8::Gemm g{(const bf16_t*)a.Hm8, (const bf16_t*)(a.Bt_dn8 + (size_t)(layer) * NE * D * MH), NP * 256, NE * 2048, MH / 2};   \
        GroupedOrder So{NP, NP * 8, G, vcu, (const LAS int*)(misc + MISC_PE)}; EpiBf16G E{a.Y, D, 1.f / 128.f};                                \
        pg8::gemm_phase<EpiBf16G, GroupedOrder, true, true, true, 125, 122>(lds, g, So, E); } SEAM(P + 2);
    MOE_PHASES(6, 0, mod0)
    PH(9) { moe_tables(a.counts, misc, tid); phase_combine_gates(a, mod0, mod1, a.nmg + D, (const LAS int*)(misc + MISC_PS), lds, vcu, G, opq(tid), wave, opq(lane)); } SEAM(9);
    PH(10) {
        pg8::Gemm g{(const bf16_t*)a.hb8, (const bf16_t*)a.Bt_min8, NT, 6144, D / 2}; pg8::StaticOrder So; So.init(NT, 6144, G, bx);
        EpiMin E{a.P3};
        pg8::gemm_phase<EpiMin, pg8::StaticOrder, true, true, true>(lds, g, So, E);
    } SEAM(10);
    PH(11) { phase_mprep(a, lds, vcu, G, opq(tid)); } SEAM(11);
    PH(12) { phase_mlstm(a, lds, vcu, G, opq(tid), wave, opq(lane)); } SEAM(12);
    PH(13) { phase_mnorm(a, gw, NGW, opq(lane)); } SEAM(13);
    PH(14) {
        pg8::Gemm g{(const bf16_t*)a.ob8, (const bf16_t*)a.Bt_mo8, NT, D, D / 2}; pg8::StaticOrder So; So.init(NT, D, G, bx);
        EpiResid<false> E{a.xres, a.xres, mod1 + 2 * D, 1.f / 512.f};
        pg8::gemm_phase<EpiResid<false>, pg8::StaticOrder, true, true, true>(lds, g, So, E);
    } SEAM(14);
    MOE_PHASES(15, 1, mod1)
    PH(18) { moe_tables(a.counts + 64, misc, tid); phase_combine_final(a, mod1, (const LAS int*)(misc + MISC_PS), gw, NGW, opq(lane)); }
#undef PH
#undef IN
#undef SEAM
}
}

extern "C" void kernel_launch(void* const* d_in, const int* in_sizes, int n_in, void* d_out, int out_size, void* d_ws, size_t ws_size, hipStream_t st) {
    using namespace mk;
    static int grid = 0;
    if (grid == 0) {
        int dev = 0, cus = 0;
        if (hipGetDevice(&dev) != hipSuccess || hipDeviceGetAttribute(&cus, hipDeviceAttributeMultiprocessorCount, dev) != hipSuccess || cus <= 0) cus = 256;
        (void)hipFuncSetAttribute((const void*)mk_fwd, hipFuncAttributeMaxDynamicSharedMemorySize, LDS_BYTES);
        int per_cu = 0; (void)hipOccupancyMaxActiveBlocksPerMultiprocessor(&per_cu, (const void*)mk_fwd, NTHR, LDS_BYTES);
        (void)hipGetLastError();
        grid = cus;
    }
    Args a{};
    a.x = (const float*)d_in[0]; a.c = (const float*)d_in[1]; a.pos = (const int*)d_in[2];
    a.ada_w = (const float*)d_in[3]; a.ada_b = (const float*)d_in[4]; a.nmg = (const float*)d_in[5]; a.nfg = (const float*)d_in[6]; a.fng = (const float*)d_in[7];
    a.a_win = (const float*)d_in[8]; a.a_wout = (const float*)d_in[9];
    a.lq1 = (const float*)d_in[10]; a.lk1 = (const float*)d_in[11]; a.lq2 = (const float*)d_in[12]; a.lk2 = (const float*)d_in[13]; a.a_hg = (const float*)d_in[14];
    a.m_win = (const float*)d_in[15]; a.m_cw = (const float*)d_in[16]; a.m_cb = (const float*)d_in[17]; a.m_gb = (const float*)d_in[18]; a.m_hg = (const float*)d_in[19]; a.m_wout = (const float*)d_in[20];
    a.wg = (const float*)d_in[21]; a.bg = (const float*)d_in[22]; a.we = (const float*)d_in[23]; a.be = (const float*)d_in[24]; a.wgu = (const float*)d_in[25]; a.wdn = (const float*)d_in[26];
    a.out = (float*)d_out;
    char* w = (char*)d_ws; size_t off = 0;
    auto alloc = [&](size_t bytes) { void* p = w + off; off += (bytes + 4095) & ~(size_t)4095; return p; };
    a.ctl = (unsigned*)alloc(1 << 20);
    a.counts = (int*)(a.ctl + 65536);
    a.mod = (float*)alloc((size_t)2 * NB * 6 * D * 4);
    a.cs = (float2*)alloc((size_t)NT * 16 * 8);
    a.Bt_qkv = (bf16_t*)alloc((size_t)6144 * D * 2); a.Bt_ao = (bf16_t*)alloc((size_t)D * D * 2); a.Bt_min = nullptr; a.Bt_mo = nullptr; a.Bt_min8 = (unsigned char*)alloc((size_t)6144 * D); a.Bt_mo8 = (unsigned char*)alloc((size_t)D * D);
    a.Bt_rt = (bf16_t*)alloc((size_t)2 * 256 * D * 2); a.Bt_g = (bf16_t*)alloc((size_t)16 * D * 2); a.Bt_gu = nullptr; a.Bt_dn = nullptr;
    a.Bt_gu8 = (unsigned char*)alloc((size_t)2 * NE * 2048 * D); a.Bt_dn8 = (unsigned char*)alloc((size_t)2 * NE * D * MH); a.hb8 = (unsigned char*)alloc((size_t)(NT + 1) * D);
    a.xres = (bf16_t*)alloc((size_t)NT * D * 2); a.hb = (bf16_t*)alloc((size_t)(NT + 1) * D * 2); a.ob = (bf16_t*)alloc((size_t)NT * D * 2); a.ob8 = (unsigned char*)a.ob;

    a.logits = nullptr; a.eid = (int*)alloc((size_t)NA * 4); a.wts = (float*)alloc((size_t)NA * 4); a.pos_in_e = (int*)alloc((size_t)NA * 4); a.slot = nullptr; a.inv = (int*)alloc((size_t)NE * 32768 * 4);
    a.Qh = (bf16_t*)alloc((size_t)3 * NT * 2048 * 2); a.Kh = a.Qh + (size_t)NT * 2048; a.Vh = a.Kh + (size_t)NT * 2048; a.Oa = (bf16_t*)alloc((size_t)NT * 4096 * 2);
    a.P3 = (bf16_t*)alloc((size_t)3 * NT * 2048 * 2); a.Qn = (bf16_t*)alloc((size_t)2 * NT * 1024 * 2); a.Kn = a.Qn + (size_t)NT * 1024;
    a.KT = (bf16_t*)alloc((size_t)NT * 1024 * 2); a.VT = (bf16_t*)alloc((size_t)NT * 2048 * 2); a.HS = (bf16_t*)alloc((size_t)NT * 2048 * 2);
    a.gates = (float*)alloc((size_t)NT * 16 * 4); a.GA = (float*)alloc((size_t)32 * 64 * 192 * 4); a.GS = (float*)alloc((size_t)32 * 64 * 2 * 4);
    a.XG = nullptr; a.Hm = nullptr; a.Hm8 = (unsigned char*)alloc((size_t)PMAX * MH); a.Y = (bf16_t*)alloc((size_t)PMAX * D * 2);
    if (off > ws_size) return;

    (void)hipMemsetAsync(a.ctl, 0, 1 << 20, st);
    auto run = [&](int lo, int hi) { a.ph_lo = lo; a.ph_hi = hi; hipLaunchKernelGGL(mk_fwd, dim3(grid), dim3(NTHR), LDS_BYTES, st, a); };
#ifndef MK_N_LAUNCHES
#define MK_N_LAUNCHES 1
#endif
#if MK_N_LAUNCHES == 1
    run(0, 19);
#else
    for (int p = 0; p <= 18; ++p) run(p, p + 1);
#endif
}
```

```cpp
#include <hip/hip_runtime.h>
#include <math.h>
#include <stdint.h>


namespace pg8 {
#define PG8_LAS __attribute__((address_space(3)))
typedef unsigned short bf16_t;
typedef short bf16x8 __attribute__((ext_vector_type(8)));
typedef float f32x4 __attribute__((ext_vector_type(4)));
typedef unsigned u32x4 __attribute__((ext_vector_type(4)));
constexpr int BM = 256, BK = 64, HALF = 128, KBP = 1088  , HTB = 16 * KBP  , STAGE_BYTES = 8 * HTB, NXCD = 8, WGM = 8;

__host__ __device__ __forceinline__ int lds_byte(int r, int c) { const int ch = c >> 3, p = (ch & 4) | ((ch & 3) ^ ((r >> 1) & 3)); return (r >> 3) * KBP + (r & 7) * 128 + p * 16 + (c & 7) * 2; }
__host__ __device__ __forceinline__ void stage_rc(int tid, int i, int& R, int& C) { const int g = (tid >> 6) + 8 * i, l = tid & 63, rr = l >> 3, p = l & 7, ch = (p & 4) | ((p & 3) ^ ((rr >> 1) & 3)); R = 8 * g + rr; C = ch * 8; }
__host__ __device__ __forceinline__ int perm32(int rho) { const int n = rho >> 4, i = rho & 15; return 8 * (i >> 2) + 4 * n + (i & 3); }

typedef int i32x4 __attribute__((ext_vector_type(4)));
typedef int i32x8 __attribute__((ext_vector_type(8)));
typedef int i32x2 __attribute__((ext_vector_type(2)));
__device__ __forceinline__ i32x8 cat8(i32x4 l, i32x4 h) { return __builtin_shufflevector(l, h, 0, 1, 2, 3, 4, 5, 6, 7); }
__device__ __forceinline__ void mfma_scale_f8(f32x4& acc, i32x8 b, i32x8 a, int sc) {
    asm volatile("v_mfma_scale_f32_16x16x128_f8f6f4 %0, %1, %2, %0, %3, %3 op_sel_hi:[0,0,0]" : "+v"(acc) : "v"(b), "v"(a), "v"(sc));
}
struct Unit { int pm, pn; };
struct Gemm { const bf16_t* A; const bf16_t* Bt; int M, N, K; };

struct StaticOrder {
    int nM, nN, nwg, G, c;
    __host__ __device__ void init(int M, int N, int G_, int c_) { nM = M / BM; nN = N / BM; nwg = nM * nN; G = G_; c = c_; }
    __host__ __device__ bool next(int i, Unit& u) const {
        const long L = (long)i * G + c; if (L >= nwg) return false;
        int wgid = (int)L; { const int q = nwg / NXCD, r = nwg % NXCD, xcd = wgid % NXCD, off = wgid / NXCD; wgid = (xcd < r ? xcd * (q + 1) : r * (q + 1) + (xcd - r) * q) + off; }
        const int nig = WGM * nN, gid = wgid / nig, fm = gid * WGM, gsz = (nM - fm) < WGM ? (nM - fm) : WGM;
        u.pm = fm + ((wgid % nig) % gsz); u.pn = (wgid % nig) / gsz; return true;
    }
    __device__ __forceinline__ void a_ready(const Unit&) const {}
    __device__ __forceinline__ void done(const Unit&) const {}
};

__device__ __forceinline__ unsigned cvt_pk_bf16(float lo, float hi) { unsigned r; asm volatile("v_cvt_pk_bf16_f32 %0, %1, %2" : "=v"(r) : "v"(lo), "v"(hi)); return r; }
typedef float f32x2 __attribute__((ext_vector_type(2)));
__device__ __forceinline__ f32x2 gelu_pk(f32x2 v) {
    const f32x2 av = __builtin_elementwise_abs(v), d = av * 0.2316418882f + 1.0f;
    f32x2 t; t.x = __builtin_amdgcn_rcpf(d.x); t.y = __builtin_amdgcn_rcpf(d.y);
    f32x2 q = t * 0.5307027145f + (-0.7265760135f); q = q * t + 0.7107068705f; q = q * t + (-0.142248368f); q = q * t + 0.127414796f; q = q * t;
    const f32x2 s = (v * v) * (-0.72134752044f);
    f32x2 e; e.x = __builtin_amdgcn_exp2f(s.x); e.y = __builtin_amdgcn_exp2f(s.y);
    const f32x2 m = v * (q * e), r = v - m;
    f32x2 o; o.x = v.x < 0.f ? m.x : r.x; o.y = v.y < 0.f ? m.y : r.y; return o;
}


template <class Epi, class Sched, bool ALIGN_EPI = false, bool SP2 = false, bool F8 = false, int SCA = 127, int SCB = 127>
__device__ __forceinline__ void gemm_phase(PG8_LAS unsigned char* lds, const Gemm g, const Sched& S, const Epi& E) {
    const int tid = threadIdx.x, wid = __builtin_amdgcn_readfirstlane(tid >> 6), lane = tid & 63, wr = wid >> 2, wc = wid & 3, fr = lane & 15, fq = lane >> 4;
    const int K = g.K, nt = K / BK;
    unsigned voffA[2], voffB[2];
#pragma unroll
    for (int i = 0; i < 2; ++i) { int R, C; stage_rc(tid, i, R, C); const int Rb = Epi::PERM ? ((R & ~31) + perm32(R & 31)) : R;
        voffA[i] = (unsigned)(R * K + C) * 2u; voffB[i] = (unsigned)(Rb * K + C) * 2u; }
    const size_t kstep = (size_t)(BK * 2);
    const size_t hstep = (size_t)HALF * K * 2;
    const size_t tstep = 2 * hstep;
    const unsigned ldsw = (unsigned)wid * (unsigned)KBP;
    const int aoff = lds_byte(wr * 64 + fr, fq * 8), boff = lds_byte(wc * 32 + fr, fq * 8);
#define PG8_SA(b, h) (((b) * 2 + (h)) * HTB)
#define PG8_SB(b, h) ((4 + (b) * 2 + (h)) * HTB)
#define PG8_STAGE(bufoff, gbase, voff) do { _Pragma("unroll") for (int _i = 0; _i < 2; ++_i) \
        __builtin_amdgcn_global_load_lds((const unsigned*)((const char*)(gbase) + (voff)[_i]), (PG8_LAS unsigned*)(lds + (bufoff) + ldsw + _i * (8 * KBP)), 16, 0, 0); } while (0)
#define PG8_LDA(dst, b, h) do { if constexpr (F8) { _Pragma("unroll") for (int m = 0; m < 4; ++m) dst##8[m] = cat8(*(const PG8_LAS i32x4*)(lds + PG8_SA(b, h) + aoff + m * (2 * KBP)), *(const PG8_LAS i32x4*)(lds + PG8_SA(b, h) + aoff + m * (2 * KBP) + 64)); } \
        else { _Pragma("unroll") for (int m = 0; m < 4; ++m) _Pragma("unroll") for (int k = 0; k < 2; ++k) dst[m][k] = *(const PG8_LAS bf16x8*)(lds + PG8_SA(b, h) + aoff + m * (2 * KBP) + k * 64); } } while (0)
#define PG8_LDB(dst, b, h) do { if constexpr (F8) { _Pragma("unroll") for (int n = 0; n < 2; ++n) dst##8[n] = cat8(*(const PG8_LAS i32x4*)(lds + PG8_SB(b, h) + boff + n * (2 * KBP)), *(const PG8_LAS i32x4*)(lds + PG8_SB(b, h) + boff + n * (2 * KBP) + 64)); } \
        else { _Pragma("unroll") for (int n = 0; n < 2; ++n) _Pragma("unroll") for (int k = 0; k < 2; ++k) dst[n][k] = *(const PG8_LAS bf16x8*)(lds + PG8_SB(b, h) + boff + n * (2 * KBP) + k * 64); } } while (0)
#define PG8_MMA(ai, bj, At, Bt) do { __builtin_amdgcn_s_setprio(1); _Pragma("unroll") for (int m = 0; m < 4; ++m) _Pragma("unroll") for (int n = 0; n < 2; ++n) { \
        if constexpr (F8) { mfma_scale_f8(acc[ai][bj][m][n], Bt##8[n], At##8[m], sc1); } \
        else { _Pragma("unroll") for (int k = 0; k < 2; ++k) acc[ai][bj][m][n] = __builtin_amdgcn_mfma_f32_16x16x32_bf16(Bt[n][k], At[m][k], acc[ai][bj][m][n], 0, 0, 0); } } \
        __builtin_amdgcn_s_setprio(0); } while (0)
#define PG8_WAIT_V(n) asm volatile("s_waitcnt vmcnt(" #n ")" ::: "memory")
#define PG8_WAIT_L(n) asm volatile("s_waitcnt lgkmcnt(" #n ")" ::: "memory")
#define PG8_BAR __builtin_amdgcn_s_barrier()
#define PG8_SCHED __builtin_amdgcn_sched_barrier(0)
    Unit cur, nxt; int ui = 0;
    if (!S.next(0, cur)) return;
    f32x4 acc[2][2][4][2];
#pragma unroll
    for (int a = 0; a < 2; ++a)
#pragma unroll
        for (int b = 0; b < 2; ++b)
#pragma unroll
            for (int m = 0; m < 4; ++m)
#pragma unroll
                for (int n = 0; n < 2; ++n) acc[a][b][m][n] = (f32x4){0.f, 0.f, 0.f, 0.f};
    bf16x8 At[4][2], B0[2][2], B1[2][2]; i32x8 At8[4], B08[2], B18[2]; int sc1 = 0x7f7f7f7f; asm volatile("" : "+v"(sc1));
    const char* cA = (const char*)g.A + (size_t)cur.pm * tstep; const char* cB = (const char*)g.Bt + (size_t)cur.pn * tstep;
    S.a_ready(cur);
    if constexpr (SP2) {
        PG8_STAGE(PG8_SB(0, 0), cB, voffB); PG8_STAGE(PG8_SB(0, 1), cB + hstep, voffB); PG8_STAGE(PG8_SA(0, 0), cA, voffA); PG8_STAGE(PG8_SA(0, 1), cA + hstep, voffA);
        if (wr == 1) PG8_BAR;
        PG8_WAIT_V(2); PG8_BAR;
        PG8_STAGE(PG8_SB(1, 0), cB + kstep, voffB); PG8_STAGE(PG8_SA(1, 0), cA + kstep, voffA); PG8_STAGE(PG8_SB(1, 1), cB + hstep + kstep, voffB);
        PG8_WAIT_V(6); PG8_BAR;
    } else {
        PG8_STAGE(PG8_SB(0, 0), cB, voffB); PG8_STAGE(PG8_SA(0, 0), cA, voffA); PG8_STAGE(PG8_SB(0, 1), cB + hstep, voffB); PG8_STAGE(PG8_SA(0, 1), cA + hstep, voffA);
        if (wr == 1) PG8_BAR;
        PG8_WAIT_V(4); PG8_BAR;
        PG8_STAGE(PG8_SB(1, 0), cB + kstep, voffB); PG8_STAGE(PG8_SA(1, 0), cA + kstep, voffA); PG8_STAGE(PG8_SB(1, 1), cB + hstep + kstep, voffB);
        PG8_WAIT_V(6); PG8_BAR;
    }
    for (;;) {
        const bool has_next = S.next(ui + 1, nxt);
        const char* nA = has_next ? (const char*)g.A + (size_t)nxt.pm * tstep : cA; const char* nB = has_next ? (const char*)g.Bt + (size_t)nxt.pn * tstep : cB;
#pragma nounroll
        for (int t = 0; t < nt; t += 2) {
            const bool last = (t == nt - 2);
            const char* a1 = cA + (size_t)(t + 1) * kstep;
            const char* a2 = last ? nA : cA + (size_t)(t + 2) * kstep; const char* b2 = last ? nB : cB + (size_t)(t + 2) * kstep;
            const char* a3 = a2 + kstep; const char* b3 = b2 + kstep;
            if (last && has_next) S.a_ready(nxt);
            if constexpr (SP2) {
            PG8_LDB(B0, 0, 0); PG8_LDB(B1, 0, 1); PG8_SCHED; PG8_LDA(At, 0, 0); PG8_STAGE(PG8_SA(1, 1), a1 + hstep, voffA);
            PG8_WAIT_V(8); PG8_WAIT_L(0); PG8_BAR; PG8_MMA(0, 0, At, B0); PG8_MMA(0, 1, At, B1); PG8_BAR; PG8_SCHED;
            PG8_LDA(At, 0, 1); PG8_STAGE(PG8_SB(0, 0), b2, voffB); PG8_STAGE(PG8_SB(0, 1), b2 + hstep, voffB); PG8_STAGE(PG8_SA(0, 0), a2, voffA);
            PG8_WAIT_V(8); PG8_WAIT_L(0); PG8_BAR; PG8_MMA(1, 0, At, B0); PG8_MMA(1, 1, At, B1); PG8_BAR; PG8_SCHED;
            PG8_LDB(B0, 1, 0); PG8_LDB(B1, 1, 1); PG8_SCHED; PG8_LDA(At, 1, 0); PG8_STAGE(PG8_SA(0, 1), a2 + hstep, voffA);
            PG8_WAIT_V(8); PG8_WAIT_L(0); PG8_BAR; PG8_MMA(0, 0, At, B0); PG8_MMA(0, 1, At, B1); PG8_BAR; PG8_SCHED;
            PG8_LDA(At, 1, 1); PG8_STAGE(PG8_SB(1, 0), b3, voffB); PG8_STAGE(PG8_SB(1, 1), b3 + hstep, voffB); PG8_STAGE(PG8_SA(1, 0), a3, voffA);
            PG8_WAIT_V(8); PG8_WAIT_L(0); PG8_BAR; PG8_MMA(1, 0, At, B0); PG8_MMA(1, 1, At, B1); PG8_BAR; PG8_SCHED;
            } else {
            PG8_LDB(B0, 0, 0); PG8_SCHED; PG8_LDA(At, 0, 0); PG8_STAGE(PG8_SA(1, 1), a1 + hstep, voffA);
            PG8_WAIT_L(8); PG8_BAR; PG8_WAIT_L(0); PG8_MMA(0, 0, At, B0); PG8_BAR; PG8_SCHED;
            PG8_LDB(B1, 0, 1); PG8_STAGE(PG8_SB(0, 0), b2, voffB);
            PG8_BAR; PG8_WAIT_L(0); PG8_MMA(0, 1, At, B1); PG8_BAR;
            PG8_LDA(At, 0, 1); PG8_STAGE(PG8_SA(0, 0), a2, voffA);
            PG8_BAR; PG8_WAIT_L(0); PG8_MMA(1, 0, At, B0); PG8_BAR; PG8_SCHED;
            PG8_STAGE(PG8_SB(0, 1), b2 + hstep, voffB);
            PG8_WAIT_V(6); PG8_BAR; PG8_MMA(1, 1, At, B1); PG8_BAR;
            PG8_LDB(B0, 1, 0); PG8_SCHED; PG8_LDA(At, 1, 0); PG8_STAGE(PG8_SA(0, 1), a2 + hstep, voffA);
            PG8_WAIT_L(8); PG8_BAR; PG8_WAIT_L(0); PG8_MMA(0, 0, At, B0); PG8_BAR; PG8_SCHED;
            PG8_LDB(B1, 1, 1); PG8_STAGE(PG8_SB(1, 0), b3, voffB);
            PG8_BAR; PG8_WAIT_L(0); PG8_MMA(0, 1, At, B1); PG8_BAR;
            PG8_LDA(At, 1, 1); PG8_STAGE(PG8_SA(1, 0), a3, voffA);
            PG8_BAR; PG8_WAIT_L(0); PG8_MMA(1, 0, At, B0); PG8_BAR; PG8_SCHED;
            PG8_STAGE(PG8_SB(1, 1), b3 + hstep, voffB);
            PG8_WAIT_V(6); PG8_BAR; PG8_MMA(1, 1, At, B1); PG8_BAR;
            }
        }
        if constexpr (F8) {
            asm volatile("s_nop 15\n\ts_nop 15" ::: "memory");
            _Pragma("unroll") for (int a = 0; a < 2; ++a) _Pragma("unroll") for (int b = 0; b < 2; ++b) _Pragma("unroll") for (int m = 0; m < 4; ++m) _Pragma("unroll") for (int n = 0; n < 2; ++n) asm volatile("" : "+v"(acc[a][b][m][n]));
        }
        if constexpr (ALIGN_EPI) { if (wr == 0) PG8_BAR; }
        if constexpr (!Epi::AFTER_DRAIN) { E(acc, cur, wr, wc, fr, fq); S.done(cur); }
        if (!has_next) break;
#pragma unroll
        for (int a = 0; a < 2; ++a)
#pragma unroll
            for (int b = 0; b < 2; ++b)
#pragma unroll
                for (int m = 0; m < 4; ++m)
#pragma unroll
                    for (int n = 0; n < 2; ++n) acc[a][b][m][n] = (f32x4){0.f, 0.f, 0.f, 0.f};
        cur = nxt; cA = nA; cB = nB; ++ui;
        if constexpr (ALIGN_EPI) { if (wr == 1) PG8_BAR; }
    }
    PG8_WAIT_V(0);
    if constexpr (!ALIGN_EPI) { if (wr == 0) PG8_BAR; }
    PG8_BAR;
    if constexpr (Epi::AFTER_DRAIN) { E.fused(acc, cur, wr, wc, fr, fq, lds, wid, lane); S.done(cur); }
#undef PG8_SA
#undef PG8_SB
#undef PG8_STAGE
#undef PG8_LDA
#undef PG8_LDB
#undef PG8_MMA
#undef PG8_WAIT_V
#undef PG8_WAIT_L
#undef PG8_BAR
#undef PG8_SCHED
}
template <class Epi, class Sched, bool F8 = false, int SCA = 127, int SCB = 127>
__device__ __forceinline__ void gemm_phase_gather(PG8_LAS unsigned char* lds, const Gemm g, const Sched& S, const Epi& E) {
    const int tid = threadIdx.x, wid = __builtin_amdgcn_readfirstlane(tid >> 6), lane = tid & 63, wr = wid >> 2, wc = wid & 3, fr = lane & 15, fq = lane >> 4;
    constexpr bool ALIGN_EPI = true, SP2 = true;
    const int K = g.K, nt = K / BK;
    unsigned voffA[2], voffB[2]; int rowA[2];
#pragma unroll
    for (int i = 0; i < 2; ++i) { int R, C; stage_rc(tid, i, R, C); const int Rb = Epi::PERM ? ((R & ~31) + perm32(R & 31)) : R;
        voffA[i] = (unsigned)C * 2u; rowA[i] = R; voffB[i] = (unsigned)(Rb * K + C) * 2u; }
    const size_t kstep = (size_t)(BK * 2);
    const size_t hstep = (size_t)HALF * K * 2;
    const size_t tstep = 2 * hstep;
    const unsigned ldsw = (unsigned)wid * (unsigned)KBP;
    const int aoff = lds_byte(wr * 64 + fr, fq * 8), boff = lds_byte(wc * 32 + fr, fq * 8);
#define PG8_SA(b, h) (((b) * 2 + (h)) * HTB)
#define PG8_SB(b, h) ((4 + (b) * 2 + (h)) * HTB)
#define PG8_STAGE(bufoff, gbase, voff) do { _Pragma("unroll") for (int _i = 0; _i < 2; ++_i) \
        __builtin_amdgcn_global_load_lds((const unsigned*)((const char*)(gbase) + (voff)[_i]), (PG8_LAS unsigned*)(lds + (bufoff) + ldsw + _i * (8 * KBP)), 16, 0, 0); } while (0)
#define PG8_STAGE_A(bufoff, gbase, o0, o1) do { \
        __builtin_amdgcn_global_load_lds((const unsigned*)((const char*)(gbase) + (o0)), (PG8_LAS unsigned*)(lds + (bufoff) + ldsw), 16, 0, 0); \
        __builtin_amdgcn_global_load_lds((const unsigned*)((const char*)(gbase) + (o1)), (PG8_LAS unsigned*)(lds + (bufoff) + ldsw + 8 * KBP), 16, 0, 0); } while (0)
#define PG8_GOFF(dst, u) do { _Pragma("unroll") for (int h_ = 0; h_ < 2; ++h_) _Pragma("unroll") for (int i_ = 0; i_ < 2; ++i_) dst[h_][i_] = (unsigned)S.a_row(u, 128 * h_ + rowA[i_]) * (unsigned)(K * 2) + voffA[i_]; } while (0)
#define PG8_LDA(dst, b, h) do { if constexpr (F8) { _Pragma("unroll") for (int m = 0; m < 4; ++m) dst##8[m] = cat8(*(const PG8_LAS i32x4*)(lds + PG8_SA(b, h) + aoff + m * (2 * KBP)), *(const PG8_LAS i32x4*)(lds + PG8_SA(b, h) + aoff + m * (2 * KBP) + 64)); } \
        else { _Pragma("unroll") for (int m = 0; m < 4; ++m) _Pragma("unroll") for (int k = 0; k < 2; ++k) dst[m][k] = *(const PG8_LAS bf16x8*)(lds + PG8_SA(b, h) + aoff + m * (2 * KBP) + k * 64); } } while (0)
#define PG8_LDB(dst, b, h) do { if constexpr (F8) { _Pragma("unroll") for (int n = 0; n < 2; ++n) dst##8[n] = cat8(*(const PG8_LAS i32x4*)(lds + PG8_SB(b, h) + boff + n * (2 * KBP)), *(const PG8_LAS i32x4*)(lds + PG8_SB(b, h) + boff + n * (2 * KBP) + 64)); } \
        else { _Pragma("unroll") for (int n = 0; n < 2; ++n) _Pragma("unroll") for (int k = 0; k < 2; ++k) dst[n][k] = *(const PG8_LAS bf16x8*)(lds + PG8_SB(b, h) + boff + n * (2 * KBP) + k * 64); } } while (0)
#define PG8_MMA(ai, bj, At, Bt) do { __builtin_amdgcn_s_setprio(1); _Pragma("unroll") for (int m = 0; m < 4; ++m) _Pragma("unroll") for (int n = 0; n < 2; ++n) { \
        if constexpr (F8) { mfma_scale_f8(acc[ai][bj][m][n], Bt##8[n], At##8[m], sc1); } \
        else { _Pragma("unroll") for (int k = 0; k < 2; ++k) acc[ai][bj][m][n] = __builtin_amdgcn_mfma_f32_16x16x32_bf16(Bt[n][k], At[m][k], acc[ai][bj][m][n], 0, 0, 0); } } \
        __builtin_amdgcn_s_setprio(0); } while (0)
#define PG8_WAIT_V(n) asm volatile("s_waitcnt vmcnt(" #n ")" ::: "memory")
#define PG8_WAIT_L(n) asm volatile("s_waitcnt lgkmcnt(" #n ")" ::: "memory")
#define PG8_BAR __builtin_amdgcn_s_barrier()
#define PG8_SCHED __builtin_amdgcn_sched_barrier(0)
    Unit cur, nxt; int ui = 0;
    if (!S.next(0, cur)) return;
    f32x4 acc[2][2][4][2];
#pragma unroll
    for (int a = 0; a < 2; ++a)
#pragma unroll
        for (int b = 0; b < 2; ++b)
#pragma unroll
            for (int m = 0; m < 4; ++m)
#pragma unroll
                for (int n = 0; n < 2; ++n) acc[a][b][m][n] = (f32x4){0.f, 0.f, 0.f, 0.f};
    bf16x8 At[4][2], B0[2][2], B1[2][2]; i32x8 At8[4], B08[2], B18[2]; int sc1 = 0x7f7f7f7f; asm volatile("" : "+v"(sc1));
    const char* const cA = (const char*)g.A; const char* cB = (const char*)g.Bt + (size_t)cur.pn * tstep;
    unsigned gc[2][2], gn[2][2];
    S.a_ready(cur); PG8_GOFF(gc, cur);
    if constexpr (SP2) {
        PG8_STAGE(PG8_SB(0, 0), cB, voffB); PG8_STAGE(PG8_SB(0, 1), cB + hstep, voffB); PG8_STAGE_A(PG8_SA(0, 0), cA, gc[0][0], gc[0][1]); PG8_STAGE_A(PG8_SA(0, 1), cA, gc[1][0], gc[1][1]);
        if (wr == 1) PG8_BAR;
        PG8_WAIT_V(2); PG8_BAR;
        PG8_STAGE(PG8_SB(1, 0), cB + kstep, voffB); PG8_STAGE_A(PG8_SA(1, 0), cA + kstep, gc[0][0], gc[0][1]); PG8_STAGE(PG8_SB(1, 1), cB + hstep + kstep, voffB);
        PG8_WAIT_V(6); PG8_BAR;
    }
    for (;;) {
        const bool has_next = S.next(ui + 1, nxt);
        const char* nB = has_next ? (const char*)g.Bt + (size_t)nxt.pn * tstep : cB;
        if (has_next) { PG8_GOFF(gn, nxt); } else { _Pragma("unroll") for (int h_ = 0; h_ < 2; ++h_) _Pragma("unroll") for (int i_ = 0; i_ < 2; ++i_) gn[h_][i_] = gc[h_][i_]; }
#pragma nounroll
        for (int t = 0; t < nt; t += 2) {
            const bool last = (t == nt - 2);
            const char* a1 = cA + (size_t)(t + 1) * kstep;
            const char* a2 = last ? cA : cA + (size_t)(t + 2) * kstep; const char* b2 = last ? nB : cB + (size_t)(t + 2) * kstep;
            const unsigned g200 = last ? gn[0][0] : gc[0][0], g201 = last ? gn[0][1] : gc[0][1], g210 = last ? gn[1][0] : gc[1][0], g211 = last ? gn[1][1] : gc[1][1];
            const char* a3 = a2 + kstep; const char* b3 = b2 + kstep;
            if (last && has_next) S.a_ready(nxt);
            if constexpr (SP2) {
            PG8_LDB(B0, 0, 0); PG8_LDB(B1, 0, 1); PG8_SCHED; PG8_LDA(At, 0, 0); PG8_STAGE_A(PG8_SA(1, 1), a1, gc[1][0], gc[1][1]);
            PG8_WAIT_V(8); PG8_WAIT_L(0); PG8_BAR; PG8_MMA(0, 0, At, B0); PG8_MMA(0, 1, At, B1); PG8_BAR; PG8_SCHED;
            PG8_LDA(At, 0, 1); PG8_STAGE(PG8_SB(0, 0), b2, voffB); PG8_STAGE(PG8_SB(0, 1), b2 + hstep, voffB); PG8_STAGE_A(PG8_SA(0, 0), a2, g200, g201);
            PG8_WAIT_V(8); PG8_WAIT_L(0); PG8_BAR; PG8_MMA(1, 0, At, B0); PG8_MMA(1, 1, At, B1); PG8_BAR; PG8_SCHED;
            PG8_LDB(B0, 1, 0); PG8_LDB(B1, 1, 1); PG8_SCHED; PG8_LDA(At, 1, 0); PG8_STAGE_A(PG8_SA(0, 1), a2, g210, g211);
            PG8_WAIT_V(8); PG8_WAIT_L(0); PG8_BAR; PG8_MMA(0, 0, At, B0); PG8_MMA(0, 1, At, B1); PG8_BAR; PG8_SCHED;
            PG8_LDA(At, 1, 1); PG8_STAGE(PG8_SB(1, 0), b3, voffB); PG8_STAGE(PG8_SB(1, 1), b3 + hstep, voffB); PG8_STAGE_A(PG8_SA(1, 0), a3, g200, g201);
            PG8_WAIT_V(8); PG8_WAIT_L(0); PG8_BAR; PG8_MMA(1, 0, At, B0); PG8_MMA(1, 1, At, B1); PG8_BAR; PG8_SCHED;
            }
        }
        if constexpr (F8) {
            asm volatile("s_nop 15\n\ts_nop 15" ::: "memory");
            _Pragma("unroll") for (int a = 0; a < 2; ++a) _Pragma("unroll") for (int b = 0; b < 2; ++b) _Pragma("unroll") for (int m = 0; m < 4; ++m) _Pragma("unroll") for (int n = 0; n < 2; ++n) asm volatile("" : "+v"(acc[a][b][m][n]));
        }
        if constexpr (ALIGN_EPI) { if (wr == 0) PG8_BAR; }
        if constexpr (!Epi::AFTER_DRAIN) { E(acc, cur, wr, wc, fr, fq); S.done(cur); }
        if (!has_next) break;
#pragma unroll
        for (int a = 0; a < 2; ++a)
#pragma unroll
            for (int b = 0; b < 2; ++b)
#pragma unroll
                for (int m = 0; m < 4; ++m)
#pragma unroll
                    for (int n = 0; n < 2; ++n) acc[a][b][m][n] = (f32x4){0.f, 0.f, 0.f, 0.f};
        cur = nxt; cB = nB; ++ui;
#pragma unroll
        for (int h_ = 0; h_ < 2; ++h_)
#pragma unroll
            for (int i_ = 0; i_ < 2; ++i_) gc[h_][i_] = gn[h_][i_];
        if constexpr (ALIGN_EPI) { if (wr == 1) PG8_BAR; }
    }
    PG8_WAIT_V(0);
    if constexpr (!ALIGN_EPI) { if (wr == 0) PG8_BAR; }
    PG8_BAR;
    if constexpr (Epi::AFTER_DRAIN) { E.fused(acc, cur, wr, wc, fr, fq, lds, wid, lane); S.done(cur); }
#undef PG8_SA
#undef PG8_SB
#undef PG8_STAGE
#undef PG8_STAGE_A
#undef PG8_GOFF
#undef PG8_LDA
#undef PG8_LDB
#undef PG8_MMA
#undef PG8_WAIT_V
#undef PG8_WAIT_L
#undef PG8_BAR
#undef PG8_SCHED
}
}

namespace att {
constexpr int D = 128;
constexpr float THR = 8.f;
constexpr bool WSKIP = false;
constexpr float SCALE = 0.08838834764831845f;
constexpr int NW = 8, QBLK = 32, KVBLK = 64, QB = NW * QBLK;
constexpr int SHM_V = KVBLK * D * 2, SHM_K = KVBLK * D * 2;
constexpr int ATT_LDS_BYTES = 2 * SHM_V + 2 * SHM_K + NW * 64 * 4;
typedef short bf16x8 __attribute__((ext_vector_type(8)));
typedef short s16x4 __attribute__((ext_vector_type(4)));
typedef float f32x16 __attribute__((ext_vector_type(16)));
typedef float f32x4 __attribute__((ext_vector_type(4)));
typedef unsigned u32x4 __attribute__((ext_vector_type(4)));
template <class A, class Bt> struct same_t { static constexpr bool v = false; };
template <class A> struct same_t<A, A> { static constexpr bool v = true; };

#define KSWZ(row, colB) ((row) * 256 + ((colB) ^ (((row) & 7) << 4)))
#define SBAR() __builtin_amdgcn_sched_barrier(0)
__device__ __forceinline__ int v_st(int k, int c) { const int kk = (k & ~0xC) | ((k & 4) << 1) | ((k & 8) >> 1); return ((kk >> 3) * 4 + (c >> 5)) * 512 + ((kk & 7) * 32 + (c & 31)) * 2; }
__device__ __forceinline__ int v_rd_base(int lane) { return ((lane & 3) << 3) | (((lane >> 2) & 3) << 6) | (((lane >> 4) & 1) << 5) | (((lane >> 5) & 1) << 8); }
constexpr int v_rd_off(int d0, int ks, int half) { return d0 * 512 + ks * 4096 + half * 2048; }
__device__ __forceinline__ int crow(int r, int hi) { return (r & 3) + 8 * (r >> 2) + 4 * hi; }
__device__ __forceinline__ unsigned cvtpk(float lo, float hi) {
    unsigned r; asm volatile("v_cvt_pk_bf16_f32 %0, %1, %2" : "=v"(r) : "v"(lo), "v"(hi)); return r;
}
__device__ __forceinline__ bf16x8 pack8(f32x4 a, f32x4 b) {
    u32x4 w = {cvtpk(a[0], a[1]), cvtpk(a[2], a[3]), cvtpk(b[0], b[1]), cvtpk(b[2], b[3])};
    return *reinterpret_cast<bf16x8*>(&w);
}
template <class T> __device__ __forceinline__ bf16x8 load8(const T* p) {
    if constexpr (same_t<T, float>::v) { return pack8(*(const f32x4*)p, *(const f32x4*)(p + 4)); }
    else { return *reinterpret_cast<const bf16x8*>(p); }
}
__device__ __forceinline__ void mask_tile(f32x16& p0, f32x16& p1, int dq, unsigned W) {
    const float NEG = -__builtin_inff();
#pragma unroll
    for (int r = 0; r < 16; ++r) {
        const int c = (r & 3) + 8 * (r >> 2);
        if ((unsigned)(dq - c) >= W) p0[r] = NEG;
        if ((unsigned)(dq - c - 32) >= W) p1[r] = NEG;
    }
}
__device__ __forceinline__ void partialSM(f32x16& p0, f32x16& p1, float& m_reg, float& mn, float& alpha) {
    float pmax = p0[0]; for (int r = 1; r < 16; ++r) pmax = fmaxf(pmax, p0[r]); for (int r = 0; r < 16; ++r) pmax = fmaxf(pmax, p1[r]);
    { auto rr = __builtin_amdgcn_permlane32_swap(__float_as_uint(pmax), __float_as_uint(pmax), false, false);
      pmax = fmaxf(__uint_as_float(rr[0]), __uint_as_float(rr[1])); }
    constexpr float C2 = 1.4426950408889634f * SCALE;
    if (__builtin_expect(__all((pmax - m_reg) * SCALE <= THR), 1)) { mn = m_reg; alpha = 1.f; }
    else { mn = fmaxf(m_reg, pmax); alpha = __builtin_amdgcn_exp2f((m_reg - mn) * C2); m_reg = mn; }
    const float mnL = -mn * C2;
    for (int r = 0; r < 16; ++r) p0[r] = fmaf(p0[r], C2, mnL); for (int r = 0; r < 16; ++r) p1[r] = fmaf(p1[r], C2, mnL);
    for (int r = 0; r < 16; ++r) p0[r] = __builtin_amdgcn_exp2f(p0[r]);
}
__device__ __forceinline__ void finishSM(f32x16& p0, f32x16& p1, float alpha, float& l_reg, bf16x8& pa0, bf16x8& pa1, bf16x8& pa2, bf16x8& pa3) {
    for (int r = 0; r < 16; ++r) p1[r] = __builtin_amdgcn_exp2f(p1[r]);
    float ps = 0; for (int r = 0; r < 16; ++r) ps += p0[r]; for (int r = 0; r < 16; ++r) ps += p1[r];
    { auto rr = __builtin_amdgcn_permlane32_swap(__float_as_uint(ps), __float_as_uint(ps), false, false);
      ps = __uint_as_float(rr[0]) + __uint_as_float(rr[1]); }
    l_reg = l_reg * alpha + ps;
#define PK4(P, B_, OUT) do { unsigned a0 = cvtpk(P[B_+0], P[B_+1]), a1 = cvtpk(P[B_+2], P[B_+3]);                          \
        unsigned b0 = cvtpk(P[B_+4], P[B_+5]), b1 = cvtpk(P[B_+6], P[B_+7]);                                             \
        auto r0 = __builtin_amdgcn_permlane32_swap(a0, b0, false, false); auto r1 = __builtin_amdgcn_permlane32_swap(a1, b1, false, false); \
        u32x4 w = {r0[0], r1[0], r0[1], r1[1]}; OUT = *reinterpret_cast<bf16x8*>(&w); } while (0)
    PK4(p0, 0, pa0); PK4(p0, 8, pa1); PK4(p1, 0, pa2); PK4(p1, 8, pa3);
#undef PK4
}
template <int KB, bool SK>
__device__ __forceinline__ void qkt(f32x16& p0, f32x16& p1, const char* K_lds, int r32, int hi, const bf16x8* qr, bool act) {
    if (SK && !act) { const float NEG = -__builtin_inff();
#pragma unroll
        for (int r = 0; r < 16; ++r) { p0[r] = NEG; p1[r] = NEG; } return; }
    p0 = f32x16{}; p1 = f32x16{};
    const char* kb[4];
#pragma unroll
    for (int dd = 0; dd < 4; ++dd) kb[dd] = K_lds + KB * SHM_K + KSWZ(r32, (dd * 16 + hi * 8) * 2);
#pragma unroll
    for (int d0 = 0; d0 < 8; ++d0) { const char* a = kb[d0 & 3] + (d0 >> 2) * 128;
        bf16x8 b0 = *reinterpret_cast<const bf16x8*>(a);
        bf16x8 b1 = *reinterpret_cast<const bf16x8*>(a + 32 * 256);
        p0 = __builtin_amdgcn_mfma_f32_32x32x16_bf16(b0, qr[d0], p0, 0, 0, 0);
        p1 = __builtin_amdgcn_mfma_f32_32x32x16_bf16(b1, qr[d0], p1, 0, 0, 0); }
}
template <int VB, bool SK>
__device__ __forceinline__ void pv_tile(f32x16* o, int vb0, bf16x8 pa0, bf16x8 pa1, bf16x8 pa2, bf16x8 pa3, bool act) {
    if (SK && !act) return;
#define TRRD(dst, off) asm volatile("ds_read_b64_tr_b16 %0, %1 offset:%2" : "=&v"(dst) : "v"(vb0), "i"(off) : "memory")
#define PV_D0(d0) do { s16x4 l0, l1, l2, l3, h0, h1, h2, h3; constexpr int b_ = VB * SHM_V + v_rd_off(d0, 0, 0);     \
        TRRD(l0, b_); TRRD(h0, b_ + 2048); TRRD(l1, b_ + 4096); TRRD(h1, b_ + 6144); TRRD(l2, b_ + 8192); TRRD(h2, b_ + 10240); TRRD(l3, b_ + 12288); TRRD(h3, b_ + 14336); \
        asm volatile("s_waitcnt lgkmcnt(0)" ::: "memory"); SBAR();                 \
        o[d0] = __builtin_amdgcn_mfma_f32_32x32x16_bf16(pa0, (bf16x8){l0[0], l0[1], l0[2], l0[3], h0[0], h0[1], h0[2], h0[3]}, o[d0], 0, 0, 0);   \
        o[d0] = __builtin_amdgcn_mfma_f32_32x32x16_bf16(pa1, (bf16x8){l1[0], l1[1], l1[2], l1[3], h1[0], h1[1], h1[2], h1[3]}, o[d0], 0, 0, 0);   \
        o[d0] = __builtin_amdgcn_mfma_f32_32x32x16_bf16(pa2, (bf16x8){l2[0], l2[1], l2[2], l2[3], h2[0], h2[1], h2[2], h2[3]}, o[d0], 0, 0, 0);   \
        o[d0] = __builtin_amdgcn_mfma_f32_32x32x16_bf16(pa3, (bf16x8){l3[0], l3[1], l3[2], l3[3], h3[0], h3[1], h3[2], h3[3]}, o[d0], 0, 0, 0); } while (0)
    PV_D0(0); PV_D0(1); PV_D0(2); PV_D0(3);
#undef PV_D0
#undef TRRD
}

template <class TIn, class TOut> struct BlockRef { const TIn* Q; const TIn* K; const TIn* V; TOut* O; int P0; };
template <class TIn> struct Seam {
    bf16x8 qr[8];
    bf16x8 st_v0, st_v1, st_k0, st_k1; f32x4 sf0, sf1, sf2, sf3;
    f32x4 tq[16];
};
__device__ __forceinline__ int swa_jlo(int P0, int W) { const int lowk = P0 - W + 1; return lowk > 0 ? lowk / KVBLK : 0; }
#define ROW(p, k0, rr) ((p) + (size_t)((k0) + (rr)) * D + sc)
#define VMW() asm volatile("s_waitcnt vmcnt(0)" ::: "memory")
#define VMWN(n) asm volatile("s_waitcnt vmcnt(%0)" :: "i"(n) : "memory")
#define SLOAD_H(Kp, Vp, k0) do { S.st_v0 = load8<TIn>(ROW(Vp, k0, sr)); S.st_v1 = load8<TIn>(ROW(Vp, k0, 32 + sr));              \
                         S.st_k0 = load8<TIn>(ROW(Kp, k0, sr)); S.st_k1 = load8<TIn>(ROW(Kp, k0, 32 + sr)); } while (0)
#define SWRITE_HK(bf) do { *(bf16x8*)(K_lds + (bf) * SHM_K + kws) = S.st_k0; *(bf16x8*)(K_lds + (bf) * SHM_K + kws + 32 * 256) = S.st_k1; } while (0)
#define SWRITE_HV(bf) do { *(bf16x8*)(V_lds + (bf) * SHM_V + vst0) = S.st_v0; *(bf16x8*)(V_lds + (bf) * SHM_V + vst1) = S.st_v1; } while (0)
#define SWRITE_H(bf) do { SWRITE_HV(bf); SWRITE_HK(bf); } while (0)
#define SLOAD_F(p, k0) do { S.sf0 = *(const f32x4*)ROW(p, k0, sr); S.sf1 = *(const f32x4*)(ROW(p, k0, sr) + 4);                \
                            S.sf2 = *(const f32x4*)ROW(p, k0, 32 + sr); S.sf3 = *(const f32x4*)(ROW(p, k0, 32 + sr) + 4); } while (0)
#define SWRITE_KF(bf) do { *(bf16x8*)(K_lds + (bf) * SHM_K + kws) = pack8(S.sf0, S.sf1); *(bf16x8*)(K_lds + (bf) * SHM_K + kws + 32 * 256) = pack8(S.sf2, S.sf3); } while (0)
#define SWRITE_VF(bf) do { *(bf16x8*)(V_lds + (bf) * SHM_V + vst0) = pack8(S.sf0, S.sf1); *(bf16x8*)(V_lds + (bf) * SHM_V + vst1) = pack8(S.sf2, S.sf3); } while (0)
template <class TIn, class TOut>
__device__ __forceinline__ void causal_swa_prime(const BlockRef<TIn, TOut>& cur, int W, char* lds, Seam<TIn>& S) {
    constexpr bool F32 = same_t<TIn, float>::v;
    const int tid = threadIdx.x, wid = __builtin_amdgcn_readfirstlane(tid >> 6), lane = tid & 63, r32 = lane & 31, hi = lane >> 5;
    const int sr = tid >> 4, sc = (tid & 15) * 8, kws = KSWZ(sr, sc * 2); char* K_lds = lds + 2 * SHM_V;
    const int kb0 = swa_jlo(cur.P0, W) * KVBLK;
    for (int d0 = 0; d0 < 8; ++d0) S.qr[d0] = load8<TIn>(cur.Q + (size_t)(wid * QBLK + r32) * D + d0 * 16 + hi * 8);
    if constexpr (F32) { SLOAD_F((const float*)cur.K, kb0); VMW(); SWRITE_KF(0); SBAR(); SLOAD_F((const float*)cur.V, kb0); }
    else { SLOAD_H(cur.K, cur.V, kb0); VMW(); SWRITE_HK(0); }
    __syncthreads();
}
template <class TIn, class TOut, class CV>
__device__ __forceinline__ void causal_swa_block(const BlockRef<TIn, TOut>& cur, const BlockRef<TIn, TOut>& nxt, int skv, int W, char* lds, Seam<TIn>& S, CV& cv) {
    constexpr bool F32 = same_t<TIn, float>::v;
    const int tid = threadIdx.x, wid = __builtin_amdgcn_readfirstlane(tid >> 6), lane = tid & 63, r32 = lane & 31, hi = lane >> 5;
    const int j_lo = swa_jlo(cur.P0, W);
    int j_hi = (cur.P0 + QB - 1) / KVBLK + 1; if (j_hi > skv / KVBLK) j_hi = skv / KVBLK;
    const int NT = j_hi - j_lo;
    const int kbn = swa_jlo(nxt.P0, W) * KVBLK;
    const int qlo = cur.P0 + wid * QBLK, qm = ((qlo + r32) | 63) - 4 * hi;
    char* V_lds = lds; char* K_lds = lds + 2 * SHM_V;
    float* ws = (float*)(lds + 2 * SHM_V + 2 * SHM_K) + wid * 64; float* li_l = ws, * al_l = ws + 32;
    float m_reg = -1e30f, l_reg = 0; f32x16 o[4] = {};
    const int sr = tid >> 4, sc = (tid & 15) * 8, vst0 = v_st(sr, sc), vst1 = v_st(32 + sr, sc), kws = KSWZ(sr, sc * 2);
    const int vb0 = (int)(uintptr_t)V_lds + v_rd_base(lane);
    const TIn* Kh = cur.K; const TIn* Vh = cur.V;
#define RESC(a) do { if (__any((a) < 1.f)) { if (hi == 0) al_l[r32] = (a); asm volatile("s_waitcnt lgkmcnt(0)" ::: "memory");              \
                     for (int d_ = 0; d_ < 4; ++d_) for (int r = 0; r < 16; ++r) o[d_][r] *= al_l[crow(r, hi)]; } } while (0)
#define KBASE(t) ((j_lo + (t)) * KVBLK)
#define ACT(t) (KBASE(t) <= qlo + QBLK - 1 && KBASE(t) + KVBLK - 1 >= qlo - W + 1)
#define MASKT(P0_, P1_, t) do { const int kb_ = KBASE(t); if ((!SK || ACT(t)) && (kb_ > qlo)) mask_tile(P0_, P1_, qm - kb_, (unsigned)W); } while (0)
    constexpr int NQL = F32 ? 16 : 8;
    constexpr bool SK = WSKIP && !F32;
#define SEAM_K0() do { VMWN(NQL); if constexpr (F32) { SWRITE_KF(0); SBAR(); SLOAD_F((const float*)nxt.V, kbn); } else { SWRITE_HK(0); } SBAR(); } while (0)
    f32x16 pA0, pA1, pB0, pB1; float mnA, mnB, alA, alB; bf16x8 pa0, pa1, pa2, pa3;
    if constexpr (F32) { VMW(); SWRITE_VF(0); SBAR(); } else { SWRITE_HV(0); SBAR(); }
    if (NT > 1) { if constexpr (F32) SLOAD_F((const float*)Kh, KBASE(1)); else SLOAD_H(Kh, Vh, KBASE(1)); }
    SBAR(); qkt<0, SK>(pA0, pA1, K_lds, r32, hi, S.qr, ACT(0));
    if constexpr (F32) { if (NT > 1) { VMW(); SWRITE_KF(1); SBAR(); SLOAD_F((const float*)Vh, KBASE(1)); } }
    MASKT(pA0, pA1, 0); partialSM(pA0, pA1, m_reg, mnA, alA);
    if (NT > 1) { VMW(); if constexpr (F32) { SWRITE_VF(1); SBAR(); if (NT > 2) SLOAD_F((const float*)Kh, KBASE(2)); } else SWRITE_H(1); }
    __syncthreads();
#define LBAR() do { asm volatile("s_waitcnt lgkmcnt(0)" ::: "memory"); __builtin_amdgcn_s_barrier(); asm volatile("" ::: "memory"); } while (0)
#define HALF_STEP(PX0, PX1, mnX, alX, PY0, PY1, alY, t, KB, VB, SB) do {                                                      \
        SBAR(); cv.issue(); SBAR(); qkt<KB, SK>(PX0, PX1, K_lds, r32, hi, S.qr, ACT(t));                                             \
        finishSM(PY0, PY1, alY, l_reg, pa0, pa1, pa2, pa3); SBAR();                                                           \
        if ((t) + 1 < NT) { if constexpr (F32) { VMW(); SWRITE_KF(SB); SBAR(); SLOAD_F((const float*)Vh, KBASE((t) + 1)); }  \
                            else { SLOAD_H(Kh, Vh, KBASE((t) + 1)); } SBAR(); }                                               \
        pv_tile<VB, SK>(o, vb0, pa0, pa1, pa2, pa3, ACT((t) - 1)); MASKT(PX0, PX1, (t)); partialSM(PX0, PX1, m_reg, mnX, alX);                                        \
        LBAR();                                                                                                               \
        if ((t) + 1 < NT) { VMW(); if constexpr (F32) { SWRITE_VF(SB); SBAR(); if ((t) + 2 < NT) SLOAD_F((const float*)Kh, KBASE((t) + 2)); } \
                            else { SWRITE_H(SB); } }                                                                          \
        RESC(alX); SBAR(); cv.consume(); SBAR(); LBAR(); } while (0)
    __builtin_amdgcn_s_waitcnt(0x0F70);
    for (int t = 1; t + 1 < NT; t += 2) {
        HALF_STEP(pB0, pB1, mnB, alB, pA0, pA1, alA, t, 1, 0, 0);
        HALF_STEP(pA0, pA1, mnA, alA, pB0, pB1, alB, t + 1, 0, 1, 1);
    }
    const bool even = (NT & 1) == 0;
    if (even) { SBAR(); qkt<1, SK>(pB0, pB1, K_lds, r32, hi, S.qr, ACT(NT - 1)); SBAR(); }
#define QROW(e) (nxt.Q + (size_t)(wid * QBLK + r32) * D + ((e) >> 1) * 16 + hi * 8 + ((e) & 1) * 4)
    if constexpr (F32) { SLOAD_F((const float*)nxt.K, kbn); SBAR();
#pragma unroll
        for (int e = 0; e < 8; ++e) S.tq[e] = *(const f32x4*)QROW(e); }
    else { SLOAD_H(nxt.K, nxt.V, kbn); SBAR();
#pragma unroll
        for (int d0 = 0; d0 < 8; ++d0) S.qr[d0] = load8<TIn>(nxt.Q + (size_t)(wid * QBLK + r32) * D + d0 * 16 + hi * 8); }
    SBAR();
    finishSM(pA0, pA1, alA, l_reg, pa0, pa1, pa2, pa3); SBAR();
    if constexpr (F32) {
#pragma unroll
        for (int e = 8; e < 16; ++e) S.tq[e] = *(const f32x4*)QROW(e); SBAR(); }
#undef QROW
    pv_tile<0, SK>(o, vb0, pa0, pa1, pa2, pa3, ACT(even ? NT - 2 : NT - 1));
    if (even) { MASKT(pB0, pB1, NT - 1); partialSM(pB0, pB1, m_reg, mnB, alB); __syncthreads(); RESC(alB);
        finishSM(pB0, pB1, alB, l_reg, pa0, pa1, pa2, pa3); SBAR(); pv_tile<1, SK>(o, vb0, pa0, pa1, pa2, pa3, ACT(NT - 1)); }
    SBAR(); SEAM_K0();
    if (hi == 0) li_l[r32] = l_reg; asm volatile("s_waitcnt lgkmcnt(0)" ::: "memory");
    float rli[16];
#pragma unroll
    for (int r = 0; r < 16; ++r) rli[r] = __builtin_amdgcn_rcpf(li_l[crow(r, hi)]);
    TOut* Ow = cur.O + (size_t)(wid * QBLK) * D;
#pragma unroll
    for (int r = 0; r < 16; ++r) { const int orow = crow(r, hi);
#pragma unroll
        for (int d0 = 0; d0 < 4; ++d0) { const float v = o[d0][r] * rli[r];
            if constexpr (same_t<TOut, float>::v) { Ow[(size_t)orow * D + d0 * 32 + r32] = v; }
            else { const float vn = __shfl_xor(v, 1);
                   if ((r32 & 1) == 0) *(unsigned*)(Ow + (size_t)orow * D + d0 * 32 + r32) = cvtpk(v, vn); } } }
    if constexpr (F32) {
#pragma unroll
        for (int d0 = 0; d0 < 8; ++d0) S.qr[d0] = pack8(S.tq[2 * d0], S.tq[2 * d0 + 1]); }
    __syncthreads();
#undef RESC
#undef KBASE
#undef ACT
#undef MASKT
#undef SEAM_K0
#undef HALF_STEP
#undef LBAR
}
#undef ROW
#undef VMW
#undef VMWN
#undef SLOAD_H
#undef SWRITE_HK
#undef SWRITE_HV
#undef SWRITE_H
#undef SLOAD_F
#undef SWRITE_KF
#undef SWRITE_VF
}


namespace mk {
using pg8::bf16_t; using pg8::f32x4; using pg8::u32x4; using pg8::Unit;
typedef float f32x2v __attribute__((ext_vector_type(2)));
typedef __bf16 bf16x2v __attribute__((ext_vector_type(2)));
__device__ __forceinline__ unsigned cvt_pk_bf16(float lo, float hi) { const f32x2v v = {lo, hi}; return __builtin_bit_cast(unsigned, __builtin_convertvector(v, bf16x2v)); }
#define LAS __attribute__((address_space(3)))
#define LDS_WAIT() asm volatile("s_waitcnt lgkmcnt(0)" ::: "memory")
#define VM_WAIT() asm volatile("s_waitcnt vmcnt(0)" ::: "memory")
constexpr int D = 2048, NB = 4, S = 4096, NT = NB * S, NE = 32, NA = 2 * NT, MH = 1024;
constexpr int NWAVES = 8, NTHR = 512;
constexpr int LDS_MISC = 147456, LDS_BYTES = 163840;
constexpr int MISC_BAR = 0, MISC_PE = 64, MISC_PS = 64 + 1024, MISC_HIST = 64 + 1024 + 256, MISC_BASE = MISC_HIST + 128, MISC_NP = MISC_BASE + 128, MISC_CNT = MISC_NP + 64;
constexpr int PMAX = NA + NE * 256;
constexpr float EPS = 1e-6f;
typedef unsigned u32x2 __attribute__((ext_vector_type(2)));

struct Args {
    const float *x, *c; const int* pos; const float *ada_w, *ada_b, *nmg, *nfg, *fng, *a_win, *a_wout, *lq1, *lk1, *lq2, *lk2, *a_hg,
        *m_win, *m_cw, *m_cb, *m_gb, *m_hg, *m_wout, *wg, *bg, *we, *be, *wgu, *wdn;
    float* out;
    unsigned* ctl; float* mod; float2* cs;
    bf16_t *Bt_qkv, *Bt_ao, *Bt_min, *Bt_mo, *Bt_rt, *Bt_g, *Bt_gu, *Bt_dn;
    bf16_t* xres; bf16_t* hb; bf16_t* ob; float* proj;
    float* logits; int* eid; float* wts; int* pos_in_e; int* slot; int* counts; int* inv;
    bf16_t *XG, *Hm, *Y;
    bf16_t *Qh, *Kh, *Vh, *Oa;
    unsigned char *hb8, *Hm8, *Bt_gu8, *Bt_dn8;
    unsigned char *Bt_min8, *Bt_mo8, *ob8;
    bf16_t *P3, *Qn, *Kn, *KT, *VT, *HS; float *gates, *GA, *GS;
    int ph_lo, ph_hi;
};

__device__ __forceinline__ unsigned pk4_fp8(float x0, float x1, float x2, float x3) { unsigned w = 0u; w = __builtin_amdgcn_cvt_pk_fp8_f32(x0, x1, w, false); w = __builtin_amdgcn_cvt_pk_fp8_f32(x2, x3, w, true); return w; }
__device__ __forceinline__ float wave_sum(float v) {
#pragma unroll
    for (int o = 1; o < 64; o <<= 1) v += __shfl_xor(v, o);
    return v;
}
__device__ __forceinline__ float silu_f(float v) { return v / (1.f + __expf(-v)); }
__device__ __forceinline__ f32x4 bf4_to_f32(const u32x2 p) { f32x4 r; r[0] = __uint_as_float(p.x << 16); r[1] = __uint_as_float(p.x & 0xffff0000u); r[2] = __uint_as_float(p.y << 16); r[3] = __uint_as_float(p.y & 0xffff0000u); return r; }
__device__ __forceinline__ int opq(int v) { asm volatile("" : "+v"(v)); return v; }

template <bool IN_F32>
struct EpiResid {
    static constexpr bool PERM = true, AFTER_DRAIN = false;
    const void* xin; bf16_t* xout; const float* gt; float sc;
    __device__ __forceinline__ void operator()(const f32x4 (&acc)[2][2][4][2], const Unit& u, int wr, int wc, int fr, int fq) const {
        const int row0 = u.pm * 256 + wr * 64 + fr, col0 = u.pn * 256 + wc * 32 + 8 * fq, b = (u.pm * 256) / S;
        f32x4 gv[2][2];
#pragma unroll
        for (int bj = 0; bj < 2; ++bj)
#pragma unroll
            for (int n = 0; n < 2; ++n) gv[bj][n] = *(const f32x4*)(gt + (size_t)b * 6 * D + col0 + bj * 128 + n * 4) * sc;
#pragma unroll
        for (int ai = 0; ai < 2; ++ai) {
            f32x4 X0[4][2], X1[4][2];
#pragma unroll
            for (int m = 0; m < 4; ++m) { const size_t off = (size_t)(row0 + ai * 128 + m * 16) * D + col0;
#pragma unroll
                for (int bj = 0; bj < 2; ++bj) {
                    if (IN_F32) { X0[m][bj] = *(const f32x4*)((const float*)xin + off + bj * 128); X1[m][bj] = *(const f32x4*)((const float*)xin + off + bj * 128 + 4); }
                    else { const u32x4 p = *(const u32x4*)((const bf16_t*)xin + off + bj * 128); X0[m][bj] = __builtin_bit_cast(f32x4, p); } } }
            __builtin_amdgcn_sched_barrier(0);
#pragma unroll
            for (int m = 0; m < 4; ++m) { const size_t off = (size_t)(row0 + ai * 128 + m * 16) * D + col0;
#pragma unroll
                for (int bj = 0; bj < 2; ++bj) { f32x4 x0, x1;
                    if (IN_F32) { x0 = X0[m][bj]; x1 = X1[m][bj]; }
                    else { const u32x4 p = __builtin_bit_cast(u32x4, X0[m][bj]); x0 = bf4_to_f32((u32x2){p.x, p.y}); x1 = bf4_to_f32((u32x2){p.z, p.w}); }
                    const f32x4 y0 = x0 + gv[bj][0] * acc[ai][bj][m][0], y1 = x1 + gv[bj][1] * acc[ai][bj][m][1];
                    u32x4 w; w.x = cvt_pk_bf16(y0[0], y0[1]); w.y = cvt_pk_bf16(y0[2], y0[3]); w.z = cvt_pk_bf16(y1[0], y1[1]); w.w = cvt_pk_bf16(y1[2], y1[3]);
                    *(u32x4*)(xout + off + bj * 128) = w; } }
            __builtin_amdgcn_sched_barrier(0);
        }
    }
};
struct EpiGU {
    static constexpr bool PERM = true, AFTER_DRAIN = false;
    unsigned char* Hm8;
    __device__ __forceinline__ void operator()(const f32x4 (&acc)[2][2][4][2], const Unit& u, int wr, int wc, int fr, int fq) const {
        const int row0 = u.pm * 256 + wr * 64 + fr, col0 = (u.pn & 7) * 128 + wc * 32 + 8 * fq;
#pragma unroll
        for (int ai = 0; ai < 2; ++ai)
#pragma unroll
            for (int m = 0; m < 4; ++m) { unsigned char* rowp = Hm8 + (size_t)(row0 + ai * 128 + m * 16) * MH + col0;
                float h[8];
#pragma unroll
                for (int n = 0; n < 2; ++n)
#pragma unroll
                    for (int j = 0; j < 4; ++j) { const float g = acc[ai][0][m][n][j] * (1.f / 256.f), up = acc[ai][1][m][n][j] * (1.f / 256.f); h[n * 4 + j] = silu_f(g) * up * 4.f; }
                u32x2 w; w.x = pk4_fp8(h[0], h[1], h[2], h[3]); w.y = pk4_fp8(h[4], h[5], h[6], h[7]);
                *(u32x2*)rowp = w; }
    }
};
struct EpiBf16G {
    static constexpr bool PERM = true, AFTER_DRAIN = false;
    bf16_t* O; int ldc; float sc;
    __device__ __forceinline__ void operator()(const f32x4 (&acc)[2][2][4][2], const Unit& u, int wr, int wc, int fr, int fq) const {
        const int row0 = u.pm * 256 + wr * 64 + fr, col0 = (u.pn & 7) * 256 + wc * 32 + 8 * fq;
#pragma unroll
        for (int ai = 0; ai < 2; ++ai)
#pragma unroll
            for (int m = 0; m < 4; ++m) { bf16_t* rowp = O + (size_t)(row0 + ai * 128 + m * 16) * ldc + col0;
#pragma unroll
                for (int bj = 0; bj < 2; ++bj) { const f32x4 v0 = acc[ai][bj][m][0] * sc, v1 = acc[ai][bj][m][1] * sc;
                    u32x4 w; w.x = cvt_pk_bf16(v0[0], v0[1]); w.y = cvt_pk_bf16(v0[2], v0[3]); w.z = cvt_pk_bf16(v1[0], v1[1]); w.w = cvt_pk_bf16(v1[2], v1[3]);
                    *(u32x4*)(rowp + bj * 128) = w; } }
    }
};
struct GroupedOrder {
    int NP, total, G, c; const LAS int* pe;
    __device__ __forceinline__ bool next(int i, Unit& u) const {
        int p, j;
        if (G == 256) { const int x = c >> 5, l = c & 31, gidx = i * 8 + x; p = gidx * 4 + (l >> 3); j = l & 7; if (p >= NP) return false; }
        else { const long L = (long)i * G + c; if (L >= total) return false; p = (int)(L % NP); j = (int)(L / NP); }
        u.pm = p; u.pn = __builtin_amdgcn_readfirstlane(pe[p]) * 8 + j; return true; }
    __device__ __forceinline__ void a_ready(const Unit&) const {}
    __device__ __forceinline__ void done(const Unit&) const {}
};
struct GroupedOrderG : GroupedOrder {
    const LAS int* ps; const LAS int* cn; const int* inv;
    __device__ __forceinline__ int a_row(const Unit& u, int r) const {
        const int e = u.pn >> 3, local = u.pm * 256 + r - ps[e];
        return local < cn[e] ? inv[e * 32768 + local] : NT; }
};
struct CvItem { const float* W; bf16_t* WT; int ldw, K, n0, s0, k0; };
__device__ __forceinline__ void tr_load(const CvItem& d, int lane, f32x4 (&v)[8]) {
    const int kp = lane >> 3, c4 = lane & 7;
#pragma unroll
    for (int i = 0; i < 8; ++i) v[i] = *(const f32x4*)(d.W + (size_t)(d.k0 + 2 * kp + 16 * (i >> 1) + (i & 1)) * d.ldw + d.s0 + 4 * c4);
}
__device__ __forceinline__ void tr_finish(const CvItem& d, const f32x4 (&v)[8], LAS float* scr, int lane) {
    const int kp = lane >> 3, c4 = lane & 7; LAS unsigned* sp = (LAS unsigned*)scr;
#pragma unroll
    for (int i = 0; i < 4; ++i) { u32x4 o; o.x = cvt_pk_bf16(v[2 * i][0], v[2 * i + 1][0]); o.y = cvt_pk_bf16(v[2 * i][1], v[2 * i + 1][1]); o.z = cvt_pk_bf16(v[2 * i][2], v[2 * i + 1][2]); o.w = cvt_pk_bf16(v[2 * i][3], v[2 * i + 1][3]);
        *(LAS u32x4*)(sp + (kp + 8 * i) * 36 + 4 * c4) = o; }
    LDS_WAIT(); asm volatile("" ::: "memory");
    const int c = lane & 7;
#pragma unroll
    for (int j = 0; j < 4; ++j) { const int n = (lane >> 3) + 8 * j; const LAS unsigned* q = sp + (4 * c) * 36 + n;
        u32x4 o; o.x = q[0]; o.y = q[36]; o.z = q[72]; o.w = q[108];
        *(u32x4*)(d.WT + (size_t)(d.n0 + n) * d.K + d.k0 + 8 * c) = o; }
    LDS_WAIT(); asm volatile("" ::: "memory");
}
__device__ __forceinline__ int gu_src(int n) { const int t = n >> 8, r = n & 255; return r < 128 ? t * 128 + r : 1024 + t * 128 + (r - 128); }

constexpr int CV_I1 = 32 * 192, CV_I2 = 32 * 64, CV_ALL = CV_I1 + CV_I2;
__device__ __forceinline__ CvItem cv_decode(const Args& a, int r) {
    CvItem d;
    if (r < CV_I1) { const int kb = r / 192, nb = r % 192; d.W = a.a_win; d.ldw = 6144; d.WT = a.Bt_qkv; d.K = D; d.n0 = nb * 32; d.s0 = nb * 32; d.k0 = kb * 64; return d; } r -= CV_I1;
    { const int kb = r / 64, nb = r % 64; d.W = a.a_wout; d.ldw = D; d.WT = a.Bt_ao; d.K = D; d.n0 = nb * 32; d.s0 = nb * 32; d.k0 = kb * 64; return d; }
}
__device__ __forceinline__ void conv_items(const Args& a, LAS unsigned char* lds, int w, int nw, int lo, int hi, int wave, int lane) {
    LAS float* scr = (LAS float*)(lds + wave * 16384);
    const int it = lo + w; if (it >= hi) return;
    CvItem d0 = cv_decode(a, it), d1 = d0, d2 = d0; f32x4 v0[8], v1[8], v2[8];
    bool h1 = it + nw < hi, h2 = it + 2 * nw < hi, h0;
    tr_load(d0, lane, v0);
    if (h1) { d1 = cv_decode(a, it + nw); tr_load(d1, lane, v1); }
    if (h2) { d2 = cv_decode(a, it + 2 * nw); tr_load(d2, lane, v2); }
    int nx = it + 3 * nw;
    for (;;) {
        tr_finish(d0, v0, scr, lane); h0 = nx < hi; if (h0) { d0 = cv_decode(a, nx); tr_load(d0, lane, v0); nx += nw; }
        if (!h1) break;
        tr_finish(d1, v1, scr, lane); h1 = nx < hi; if (h1) { d1 = cv_decode(a, nx); tr_load(d1, lane, v1); nx += nw; }
        if (!h2) break;
        tr_finish(d2, v2, scr, lane); h2 = nx < hi; if (h2) { d2 = cv_decode(a, nx); tr_load(d2, lane, v2); nx += nw; }
        if (!h0) break;
    }
}
__device__ __forceinline__ void p0_prologue(const Args& a, LAS unsigned char* lds, int vcu, int G, int tid, int wave, int lane) {
    {
        LAS float* sc = (LAS float*)lds;
        LAS float* red = (LAS float*)(lds + 32768);
        for (int i = tid; i < NB * D; i += NTHR) sc[i] = silu_f(a.c[i]);
        __syncthreads();
        for (int it = vcu; it < 2 * 384; it += G) {
            const int l = it / 384, col = (it % 384) * 32 + (lane & 31), kh = lane >> 5;
            const float* w = a.ada_w + (size_t)l * D * 6 * D + (size_t)(wave * 256 + kh * 128) * 6 * D + col;
            float a0 = 0.f, a1 = 0.f, a2 = 0.f, a3 = 0.f;
#pragma unroll 8
            for (int k = 0; k < 128; ++k) { const float wv = w[(size_t)k * 6 * D]; const int kk = wave * 256 + kh * 128 + k;
                a0 += sc[kk] * wv; a1 += sc[D + kk] * wv; a2 += sc[2 * D + kk] * wv; a3 += sc[3 * D + kk] * wv; }
            a0 += __shfl_xor(a0, 32); a1 += __shfl_xor(a1, 32); a2 += __shfl_xor(a2, 32); a3 += __shfl_xor(a3, 32);
            if (lane < 32) { red[(wave * 4 + 0) * 32 + lane] = a0; red[(wave * 4 + 1) * 32 + lane] = a1; red[(wave * 4 + 2) * 32 + lane] = a2; red[(wave * 4 + 3) * 32 + lane] = a3; }
            __syncthreads();
            if (tid < 128) { const int bb = tid >> 5, cl = tid & 31; float sacc = 0.f;
#pragma unroll
                for (int w8 = 0; w8 < 8; ++w8) sacc += red[(w8 * 4 + bb) * 32 + cl];
                const int cg = (it % 384) * 32 + cl;
                a.mod[((size_t)l * NB + bb) * 6 * D + cg] = sacc + a.ada_b[l * 6 * D + cg]; }
            __syncthreads();
        }
    }
    for (int i = vcu * NTHR + tid; i < NT * 16; i += G * NTHR) {
        const int row = i >> 4, j = i & 15;
        const double ang = (double)a.pos[row] * pow(500000.0, -(double)j / 16.0);
        a.cs[i] = make_float2((float)cos(ang), (float)sin(ang));
    }
    for (int i0 = vcu * NTHR + tid; i0 < 2 * 256 * D; i0 += 8 * G * NTHR) {
        float v[8];
#pragma unroll
        for (int j = 0; j < 8; ++j) { const int i = i0 + j * G * NTHR, ic = i < 2 * 256 * D ? i : 0, k = ic % D, n = (ic / D) % 256, l = ic / (256 * D);
            const float* p = n < 4 ? a.wg + ((size_t)l * D + k) * 4 + n : a.we + ((size_t)l * D + k) * 32 + (n < 36 ? n - 4 : 0);
            const float t = *p; v[j] = n < 36 ? t : 0.f; }
        __builtin_amdgcn_sched_barrier(0);
#pragma unroll
        for (int j = 0; j < 8; ++j) { const int i = i0 + j * G * NTHR; if (i < 2 * 256 * D) a.Bt_rt[i] = (bf16_t)(cvt_pk_bf16(v[j], 0.f) & 0xffffu); }
    }
    if (vcu == 0) for (int i = tid; i < D / 4; i += NTHR) ((unsigned*)(a.hb8 + (size_t)NT * D))[i] = 0u;
    for (int i = vcu * NTHR + tid; i < 16 * D; i += G * NTHR) { const int k = i % D, n = i / D; a.Bt_g[i] = (bf16_t)(cvt_pk_bf16(a.m_win[(size_t)k * 6160 + 6144 + n], 0.f) & 0xffffu); }
    __syncthreads();
    conv_items(a, lds, vcu * NWAVES + wave, G * NWAVES, 0, CV_I1 + CV_I2, wave, lane);
}
template <bool TOLDS>
__device__ __forceinline__ void norm_store(const f32x4 (&v)[8], float ss, const float* g, const float* scv, const float* shv, bf16_t* orow, int lane, LAS unsigned char* yrow) {
    const float rstd = rsqrtf(wave_sum(ss) * (1.f / D) + EPS);
#pragma unroll
    for (int j = 0; j < 8; ++j) { const int c = 4 * lane + 256 * j;
        const f32x4 gg = *(const f32x4*)(g + c), sc = *(const f32x4*)(scv + c), sh = *(const f32x4*)(shv + c);
        const f32x4 y = v[j] * rstd * gg * (sc + 1.f) + sh;
        u32x2 w; w.x = cvt_pk_bf16(y[0], y[1]); w.y = cvt_pk_bf16(y[2], y[3]);
        *(u32x2*)(orow + c) = w;
        if (TOLDS) *(LAS u32x2*)(yrow + c * 2) = w; }
}
constexpr int YT_PITCH = 4112, NR_YT = 0, NR_RED = 16 * YT_PITCH, NR_LG = NR_RED + 24576, NR_TOK = NR_LG + 3072, CG_AN = 100352, CG_SH = CG_AN + 8192;
typedef short bf16x8r __attribute__((ext_vector_type(8)));
template <int NTL>
__device__ __forceinline__ void rows16_logits(const bf16_t* Bt, LAS unsigned char* lds, int wave, int lane, int tid) {
    const int r16 = lane & 15, q4 = lane >> 4;
    f32x4 acc[NTL];
#pragma unroll
    for (int nt = 0; nt < NTL; ++nt) acc[nt] = (f32x4){0.f, 0.f, 0.f, 0.f};
#pragma unroll
    for (int h = 0; h < 2; ++h) { bf16x8r wf[4][NTL];
#pragma unroll
        for (int kk = 0; kk < 4; ++kk)
#pragma unroll
            for (int nt = 0; nt < NTL; ++nt) wf[kk][nt] = *(const bf16x8r*)(Bt + (size_t)(16 * nt + r16) * D + 256 * wave + 32 * (4 * h + kk) + 8 * q4);
        __builtin_amdgcn_sched_barrier(0);
#pragma unroll
        for (int kk = 0; kk < 4; ++kk) { const int k0 = 256 * wave + 32 * (4 * h + kk) + 8 * q4;
            const bf16x8r yf = *(const LAS bf16x8r*)(lds + NR_YT + r16 * YT_PITCH + k0 * 2);
#pragma unroll
            for (int nt = 0; nt < NTL; ++nt) acc[nt] = __builtin_amdgcn_mfma_f32_16x16x32_bf16(wf[kk][nt], yf, acc[nt], 0, 0, 0); }
        __builtin_amdgcn_sched_barrier(0); }
#pragma unroll
    for (int nt = 0; nt < NTL; ++nt) *(LAS f32x4*)(lds + NR_RED + ((wave * NTL + nt) * 64 + lane) * 16) = acc[nt];
    __syncthreads();
    if (tid < NTL * 64) { const int nt = tid >> 6, ln = tid & 63; f32x4 sum = {0.f, 0.f, 0.f, 0.f};
#pragma unroll
        for (int w = 0; w < 8; ++w) sum += *(const LAS f32x4*)(lds + NR_RED + ((w * NTL + nt) * 64 + ln) * 16);
        LAS float* lg = (LAS float*)(lds + NR_LG) + (ln & 15) * 48 + 16 * nt + 4 * (ln >> 4);
        lg[0] = sum[0]; lg[1] = sum[1]; lg[2] = sum[2]; lg[3] = sum[3]; }
    __syncthreads();
}
__device__ __forceinline__ void phase_norm(const float* xin, const float* g, const float* modl, int sh_idx, int sc_idx, bf16_t* hb, int gw, int NGW, int lane) {
    const int RPW = (NT + NGW - 1) / NGW; int m = gw * RPW; const int mend = (m + RPW < NT) ? m + RPW : NT;
    if (m >= mend) return;
    f32x4 A[8], Bv[8], v[8], vn[8]; int bcur = -1;
#pragma unroll
    for (int j = 0; j < 8; ++j) v[j] = *(const f32x4*)(xin + (size_t)m * D + 4 * lane + 256 * j);
    for (;;) {
        const bool more = m + 1 < mend;
        if (more) {
#pragma unroll
            for (int j = 0; j < 8; ++j) vn[j] = *(const f32x4*)(xin + (size_t)(m + 1) * D + 4 * lane + 256 * j); }
        const int b = m / S;
        if (b != bcur) { bcur = b; const float* scv = modl + (size_t)b * 6 * D + sc_idx * D; const float* shv = modl + (size_t)b * 6 * D + sh_idx * D;
#pragma unroll
            for (int j = 0; j < 8; ++j) { const int c = 4 * lane + 256 * j; A[j] = *(const f32x4*)(g + c) * (*(const f32x4*)(scv + c) + 1.f); Bv[j] = *(const f32x4*)(shv + c); } }
        float ss = 0.f;
#pragma unroll
        for (int j = 0; j < 8; ++j) ss += (v[j][0] * v[j][0] + v[j][1] * v[j][1]) + (v[j][2] * v[j][2] + v[j][3] * v[j][3]);
        const float rstd = rsqrtf(wave_sum(ss) * (1.f / D) + EPS);
        bf16_t* orow = hb + (size_t)m * D;
#pragma unroll
        for (int j = 0; j < 8; ++j) { const f32x4 y = v[j] * rstd * A[j] + Bv[j]; u32x2 w; w.x = cvt_pk_bf16(y[0], y[1]); w.y = cvt_pk_bf16(y[2], y[3]); *(u32x2*)(orow + 4 * lane + 256 * j) = w; }
        if (!more) break;
        ++m;
#pragma unroll
        for (int j = 0; j < 8; ++j) v[j] = vn[j];
    }
}
__device__ __forceinline__ void phase_combine_final(const Args& a, const float* modl, const LAS int* ps, int gw, int NGW, int lane) {
    const int RPW = (NT + NGW - 1) / NGW; const int m0 = gw * RPW; const int mend = (m0 + RPW < NT) ? m0 + RPW : NT;
    if (m0 >= mend) return;
    int slot_l = 0; float w_l = 0.f;
    if (lane < 2 * (mend - m0) && lane < 64) { const int as = 2 * m0 + lane; slot_l = ps[a.eid[as]] + a.pos_in_e[as]; w_l = a.wts[as]; }
    f32x4 G4[8], F4[8];
    { const float* gt = modl + (size_t)(m0 / S) * 6 * D + 5 * D;
#pragma unroll
      for (int j = 0; j < 8; ++j) { G4[j] = *(const f32x4*)(gt + 4 * lane + 256 * j); F4[j] = *(const f32x4*)(a.fng + 4 * lane + 256 * j); } }
    for (int m = m0; m < mend; ++m) {
        const int r = m - m0; const int s0 = __shfl(slot_l, 2 * r), s1 = __shfl(slot_l, 2 * r + 1); const float w0 = __shfl(w_l, 2 * r), w1 = __shfl(w_l, 2 * r + 1);
        const bf16_t* xr = a.xres + (size_t)m * D; const bf16_t* y0 = a.Y + (size_t)s0 * D; const bf16_t* y1 = a.Y + (size_t)s1 * D;
        f32x4 v[8]; float ss = 0.f;
#pragma unroll
        for (int j = 0; j < 8; ++j) { const int c = 4 * lane + 256 * j;
            const f32x4 x1 = bf4_to_f32(*(const u32x2*)(xr + c)); const u32x2 p0 = *(const u32x2*)(y0 + c), p1 = *(const u32x2*)(y1 + c);
            f32x4 ya, yb;
            ya[0] = __uint_as_float(p0.x << 16); ya[1] = __uint_as_float(p0.x & 0xffff0000u); ya[2] = __uint_as_float(p0.y << 16); ya[3] = __uint_as_float(p0.y & 0xffff0000u);
            yb[0] = __uint_as_float(p1.x << 16); yb[1] = __uint_as_float(p1.x & 0xffff0000u); yb[2] = __uint_as_float(p1.y << 16); yb[3] = __uint_as_float(p1.y & 0xffff0000u);
            v[j] = x1 + G4[j] * (ya * w0 + yb * w1);
            ss += (v[j][0] * v[j][0] + v[j][1] * v[j][1]) + (v[j][2] * v[j][2] + v[j][3] * v[j][3]); }
        const float rstd = rsqrtf(wave_sum(ss) * (1.f / D) + EPS);
#pragma unroll
        for (int j = 0; j < 8; ++j) *(f32x4*)(a.out + (size_t)m * D + 4 * lane + 256 * j) = v[j] * rstd * F4[j];
    }
}
__device__ __forceinline__ void phase_combine_gates(const Args& a, const float* modl, const float* modn, const float* gnext, const LAS int* ps, LAS unsigned char* lds, int vcu, int G, int tid, int wave, int lane) {
    const int NGRP = NT / 16, GPW = (NGRP + G - 1) / G, g0 = vcu * GPW, gend = (g0 + GPW < NGRP) ? g0 + GPW : NGRP;
    if (g0 >= gend) return;
    int slot_l = 0; float w_l = 0.f;
    if (lane < 4 * (gend - g0)) { const int m = (g0 + (lane >> 2)) * 16 + 2 * wave + ((lane >> 1) & 1), as = 2 * m + (lane & 1); slot_l = ps[a.eid[as]] + a.pos_in_e[as]; w_l = a.wts[as]; }
    const int b = (g0 * 16) / S;
    const float* gt = modl + (size_t)b * 6 * D + 5 * D; const float* scv = modn + (size_t)b * 6 * D + 1 * D; const float* shv = modn + (size_t)b * 6 * D;
    LAS float* anl = (LAS float*)(lds + CG_AN); LAS float* shl = (LAS float*)(lds + CG_SH);
    for (int i = tid; i < D / 4; i += NTHR) { *(LAS f32x4*)(anl + 4 * i) = *(const f32x4*)(gnext + 4 * i) * (*(const f32x4*)(scv + 4 * i) + 1.f); *(LAS f32x4*)(shl + 4 * i) = *(const f32x4*)(shv + 4 * i); }
    __syncthreads();
    u32x2 xc[8], xn[8]; u32x2 pc0[8], pc1[8], pn0[8], pn1[8];
#define CG_LOAD(s_, X, P0, P1) do { const int m_ = (g0 + ((s_) >> 1)) * 16 + 2 * wave + ((s_) & 1), li_ = 2 * (s_); \
        const bf16_t* y0_ = a.Y + (size_t)__shfl(slot_l, li_) * D; const bf16_t* y1_ = a.Y + (size_t)__shfl(slot_l, li_ + 1) * D; \
        _Pragma("unroll") for (int j_ = 0; j_ < 8; ++j_) { const int c_ = 4 * lane + 256 * j_; X[j_] = *(const u32x2*)(a.xres + (size_t)m_ * D + c_); P0[j_] = *(const u32x2*)(y0_ + c_); P1[j_] = *(const u32x2*)(y1_ + c_); } } while (0)
    const int nrow = 2 * (gend - g0);
    CG_LOAD(0, xc, pc0, pc1);
    for (int sq = 0; sq < nrow; ++sq) {
        const int grp = g0 + (sq >> 1), rr = sq & 1, m = grp * 16 + 2 * wave + rr;
        if (sq + 1 < nrow) CG_LOAD(sq + 1, xn, pn0, pn1);
        const float w0 = __shfl(w_l, 2 * sq), w1 = __shfl(w_l, 2 * sq + 1);
        f32x4 v[8]; float ss = 0.f;
#pragma unroll
        for (int jg = 0; jg < 2; ++jg) { f32x4 Gt[4];
#pragma unroll
            for (int jj = 0; jj < 4; ++jj) Gt[jj] = *(const f32x4*)(gt + 4 * lane + 256 * (4 * jg + jj));
            __builtin_amdgcn_sched_barrier(0);
#pragma unroll
            for (int jj = 0; jj < 4; ++jj) { const int j = 4 * jg + jj; const u32x2 p0 = pc0[j], p1 = pc1[j]; f32x4 ya, yb;
                ya[0] = __uint_as_float(p0.x << 16); ya[1] = __uint_as_float(p0.x & 0xffff0000u); ya[2] = __uint_as_float(p0.y << 16); ya[3] = __uint_as_float(p0.y & 0xffff0000u);
                yb[0] = __uint_as_float(p1.x << 16); yb[1] = __uint_as_float(p1.x & 0xffff0000u); yb[2] = __uint_as_float(p1.y << 16); yb[3] = __uint_as_float(p1.y & 0xffff0000u);
                v[j] = bf4_to_f32(xc[j]) + Gt[jj] * (ya * w0 + yb * w1);
                ss += (v[j][0] * v[j][0] + v[j][1] * v[j][1]) + (v[j][2] * v[j][2] + v[j][3] * v[j][3]); } }
        const float rstd = rsqrtf(wave_sum(ss) * (1.f / D) + EPS);
        LAS unsigned char* yrow = lds + NR_YT + (2 * wave + rr) * YT_PITCH;
#pragma unroll
        for (int j = 0; j < 8; ++j) { const int c = 4 * lane + 256 * j; { u32x2 xw; xw.x = cvt_pk_bf16(v[j][0], v[j][1]); xw.y = cvt_pk_bf16(v[j][2], v[j][3]); *(u32x2*)(a.xres + (size_t)m * D + c) = xw; }
            const f32x4 y = v[j] * rstd * (*(const LAS f32x4*)(anl + c)) + *(const LAS f32x4*)(shl + c); u32x2 w; w.x = cvt_pk_bf16(y[0], y[1]); w.y = cvt_pk_bf16(y[2], y[3]);
            *(unsigned*)(a.hb8 + (size_t)m * D + c) = pk4_fp8(y[0] * 4.f, y[1] * 4.f, y[2] * 4.f, y[3] * 4.f); *(LAS u32x2*)(yrow + c * 2) = w; }
#pragma unroll
        for (int j = 0; j < 8; ++j) { xc[j] = xn[j]; pc0[j] = pn0[j]; pc1[j] = pn1[j]; }
        if (rr == 1) {
            __syncthreads();
            rows16_logits<1>(a.Bt_g, lds, wave, lane, tid);
            if (tid < 256) a.gates[(size_t)(grp * 16 + (tid >> 4)) * 16 + (tid & 15)] = ((const LAS float*)(lds + NR_LG))[(tid >> 4) * 48 + (tid & 15)];
        }
    }
#undef CG_LOAD
}
__device__ __forceinline__ void phase_norm_route(const Args& a, int layer, const float* modl, LAS unsigned char* lds, LAS unsigned char* misc, int vcu, int G, int tid, int wave, int lane) {
    LAS int* hist = (LAS int*)(misc + MISC_HIST); LAS int* base = (LAS int*)(misc + MISC_BASE);
    LAS int* tk = (LAS int*)(lds + NR_TOK);
    LAS float* tw = (LAS float*)(lds + NR_TOK + 2048);
    int* counts = a.counts + layer * 64;
    const float* bg = a.bg + layer * 4; const float* be = a.be + layer * 32; const float* g = a.nfg + layer * D;
    if (tid < 32) hist[tid] = 0;
    LAS float* bl = (LAS float*)(lds + NR_TOK + 3072);
    if (tid < 36) bl[tid] = tid < 4 ? bg[tid] : be[tid - 4];
    __syncthreads();
    const int NGRP = NT / 16, GPW = (NGRP + G - 1) / G, g0 = vcu * GPW, gend = (g0 + GPW < NGRP) ? g0 + GPW : NGRP;
    const int ng = gend > g0 ? gend - g0 : 0;
    if (ng > 0) {
        const int b = (g0 * 16) / S;
        f32x4 A[8]; const float* shv = modl + (size_t)b * 6 * D + 3 * D;
        { const float* scv = modl + (size_t)b * 6 * D + 4 * D;
#pragma unroll
          for (int j = 0; j < 8; ++j) { const int c = 4 * lane + 256 * j; A[j] = *(const f32x4*)(g + c) * (*(const f32x4*)(scv + c) + 1.f); } }
        u32x2 x1[2][8];
#define NR_LOAD(grp_) do { _Pragma("unroll") for (int rr_ = 0; rr_ < 2; ++rr_) { const bf16_t* xr_ = a.xres + (size_t)((grp_) * 16 + 2 * wave + rr_) * D; \
        _Pragma("unroll") for (int j_ = 0; j_ < 8; ++j_) x1[rr_][j_] = *(const u32x2*)(xr_ + 4 * lane + 256 * j_); } } while (0)
        NR_LOAD(g0);
        for (int grp = g0; grp < gend; ++grp) {
            const int gi = grp - g0;
#pragma unroll
            for (int rr = 0; rr < 2; ++rr) { const int m = grp * 16 + 2 * wave + rr; float ss = 0.f;
#pragma unroll
                for (int j = 0; j < 8; ++j) { const f32x4 v = bf4_to_f32(x1[rr][j]); ss += (v[0] * v[0] + v[1] * v[1]) + (v[2] * v[2] + v[3] * v[3]); }
                const float rstd = rsqrtf(wave_sum(ss) * (1.f / D) + EPS);
                LAS unsigned char* yrow = lds + NR_YT + (2 * wave + rr) * YT_PITCH;
                f32x4 Bs[8];
#pragma unroll
                for (int j = 0; j < 8; ++j) Bs[j] = *(const f32x4*)(shv + 4 * lane + 256 * j);
                __builtin_amdgcn_sched_barrier(0);
#pragma unroll
                for (int j = 0; j < 8; ++j) { const int c = 4 * lane + 256 * j; const f32x4 y = bf4_to_f32(x1[rr][j]) * rstd * A[j] + Bs[j];
                    u32x2 w; w.x = cvt_pk_bf16(y[0], y[1]); w.y = cvt_pk_bf16(y[2], y[3]); *(LAS u32x2*)(yrow + c * 2) = w;
                    *(unsigned*)(a.hb8 + (size_t)m * D + c) = pk4_fp8(y[0] * 4.f, y[1] * 4.f, y[2] * 4.f, y[3] * 4.f); } }
            if (grp + 1 < gend) NR_LOAD(grp + 1);
            __syncthreads();
            rows16_logits<3>(a.Bt_rt + (size_t)layer * 256 * D, lds, wave, lane, tid);
            if (tid < 16 && gi < 8) {
                const LAS float* lg = (const LAS float*)(lds + NR_LG) + tid * 48;
                float gmax = -INFINITY; int grpi = 0;
#pragma unroll
                for (int i = 0; i < 4; ++i) { const float v = lg[i] + bl[i]; if (v > gmax) { gmax = v; grpi = i; } }
                float gs = 0.f;
#pragma unroll
                for (int i = 0; i < 4; ++i) gs += expf(lg[i] + bl[i] - gmax);
                const float pg = 1.f / gs;
                float v1 = -INFINITY, v2 = -INFINITY; int i1 = 0, i2 = 0;
                for (int i = 0; i < 8; ++i) { const float v = lg[4 + grpi * 8 + i] + bl[4 + grpi * 8 + i];
                    if (v > v1) { v2 = v1; i2 = i1; v1 = v; i1 = i; } else if (v > v2) { v2 = v; i2 = i; } }
                const float ex = expf(v2 - v1); const int e1 = grpi * 8 + i1, e2 = grpi * 8 + i2, sl = gi * 16 + tid;
                tk[sl] = e1; tk[128 + sl] = e2; tk[256 + sl] = atomicAdd((int*)&hist[e1], 1); tk[384 + sl] = atomicAdd((int*)&hist[e2], 1);
                tw[sl] = pg / (1.f + ex); tw[128 + sl] = pg * ex / (1.f + ex);
            }
        }
#undef NR_LOAD
    }
    __syncthreads();
    if (tid < 32) { const int h = hist[tid]; base[tid] = h ? atomicAdd(&counts[tid], h) : 0; }
    __syncthreads();
    if (tid < ng * 16 && tid < 128) { const int t = (g0 + (tid >> 4)) * 16 + (tid & 15), e1 = tk[tid], e2 = tk[128 + tid];
        a.eid[2 * t] = e1; a.eid[2 * t + 1] = e2; a.wts[2 * t] = tw[tid]; a.wts[2 * t + 1] = tw[128 + tid];
        const int p1 = base[e1] + tk[256 + tid], p2 = base[e2] + tk[384 + tid];
        a.pos_in_e[2 * t] = p1; a.pos_in_e[2 * t + 1] = p2; a.inv[e1 * 32768 + p1] = t; a.inv[e2 * 32768 + p2] = t; }
    __syncthreads();
}
__device__ __forceinline__ int moe_tables(const int* counts, LAS unsigned char* misc, int tid) {
    LAS int* ps = (LAS int*)(misc + MISC_PS); LAS int* pe = (LAS int*)(misc + MISC_PE); LAS int* npw = (LAS int*)(misc + MISC_NP);
    __syncthreads();
    if (tid < 64) {
        LAS int* cn = (LAS int*)(misc + MISC_CNT); const int e = tid & 31;
        const int c = __hip_atomic_load(&counts[e], __ATOMIC_RELAXED, __HIP_MEMORY_SCOPE_AGENT), np = (c + 255) >> 8;
        int incl = np;
#pragma unroll
        for (int d = 1; d < 32; d <<= 1) { const int t = __shfl_up(incl, d); if (tid >= d) incl += t; }
        if (tid < 32) { const int start = incl - np; ps[e] = start << 8; cn[e] = c;
            for (int p = 0; p < np; ++p) pe[start + p] = e;
            if (e == NE - 1) { ps[NE] = incl << 8; npw[0] = incl; } }
    }
    __syncthreads();
    return npw[0];
}
struct EpiQKV {
    static constexpr bool PERM = true, AFTER_DRAIN = false;
    bf16_t *Qh, *Kh, *Vh; const float2* cs;
    __device__ __forceinline__ void operator()(const f32x4 (&acc)[2][2][4][2], const Unit& u, int wr, int wc, int fr, int fq) const {
        const int t = u.pn >> 3, hh = u.pn & 7;
        bf16_t* base = Qh + (size_t)t * ((size_t)NT * 2048);
        const int row0 = u.pm * 256 + wr * 64 + fr;
        const bool rope = (t < 2) && (wc == 0);
#pragma unroll
        for (int am = 0; am < 4; ++am) { const int ai = am >> 1;
            f32x4 C[2][4];
            if (rope) {
#pragma unroll
                for (int mm = 0; mm < 2; ++mm) { const f32x4* cp = (const f32x4*)(cs + (size_t)(row0 + ai * 128 + (2 * (am & 1) + mm) * 16) * 16 + 8 * (fq & 1)); C[mm][0] = cp[0]; C[mm][1] = cp[1]; C[mm][2] = cp[2]; C[mm][3] = cp[3]; }
            } else {
#pragma unroll
                for (int mm = 0; mm < 2; ++mm) { C[mm][0] = (f32x4){0.f, 0.f, 0.f, 0.f}; C[mm][1] = C[mm][0]; C[mm][2] = C[mm][0]; C[mm][3] = C[mm][0]; }
            }
            __builtin_amdgcn_sched_barrier(0);
#pragma unroll
            for (int mm = 0; mm < 2; ++mm) { const int m = 2 * (am & 1) + mm, row = row0 + ai * 128 + m * 16;
                const f32x4 c0 = C[mm][0], c1 = C[mm][1], c2 = C[mm][2], c3 = C[mm][3];
#pragma unroll
                for (int bj = 0; bj < 2; ++bj) { f32x4 v0 = acc[ai][bj][m][0], v1 = acc[ai][bj][m][1];
                    if (rope) {
                        const float sg = (fq < 2) ? -1.f : 1.f;
                        float v[8] = {v0[0], v0[1], v0[2], v0[3], v1[0], v1[1], v1[2], v1[3]};
                        const float cc[8] = {c0[0], c0[2], c1[0], c1[2], c2[0], c2[2], c3[0], c3[2]}, sn[8] = {c0[1], c0[3], c1[1], c1[3], c2[1], c2[3], c3[1], c3[3]};
#pragma unroll
                        for (int i = 0; i < 8; ++i) { const float pv = __shfl_xor(v[i], 32); v[i] = v[i] * cc[i] + sg * pv * sn[i]; }
                        v0 = (f32x4){v[0], v[1], v[2], v[3]}; v1 = (f32x4){v[4], v[5], v[6], v[7]};
                    }
                    u32x4 w; w.x = cvt_pk_bf16(v0[0], v0[1]); w.y = cvt_pk_bf16(v0[2], v0[3]); w.z = cvt_pk_bf16(v1[0], v1[1]); w.w = cvt_pk_bf16(v1[2], v1[3]);
                    *(u32x4*)(base + ((size_t)(hh * 2 + bj) * NT + row) * 128 + wc * 32 + 8 * fq) = w; } }
            __builtin_amdgcn_sched_barrier(0);
        }
    }
};
typedef att::BlockRef<bf16_t, bf16_t> ARef;
__device__ __forceinline__ ARef att_ref(const Args& a, int hd, int qb) {
    const int b = hd >> 5, vh = hd & 31, h = vh >> 2, m = (vh >> 1) & 1, half = vh & 1;
    ARef r;
    r.Q = a.Qh + ((size_t)(h * 2 + m) * NT + (size_t)b * S + (size_t)qb * 256) * 128;
    r.K = a.Kh + ((size_t)(h * 2 + m) * NT + (size_t)b * S) * 128;
    r.V = a.Vh + ((size_t)(h * 2 + half) * NT + (size_t)b * S) * 128;
    r.O = a.Oa + ((size_t)((h * 2 + m) * 2 + half) * NT + (size_t)b * S + (size_t)qb * 256) * 128;
    r.P0 = qb * 256;
    return r;
}
__device__ __forceinline__ bool att_pos(int w, int N, int r, int& hd, int& qb) {
    const int p = r * N + ((r & 1) ? (N - 1 - w) : w); if (p >= 2048) return false;
    const int c = p >> 9, pl = p & 511; hd = pl >> 2; qb = 15 - 4 * c - (pl & 3); return true;
}
constexpr int CVA_MIN = 16 * 96, CVA_MO = 16 * 32, CVA_GU = 64 * 512, CVA_DN = 64 * 256, CVA_ITEMS = CVA_MIN + CVA_MO + CVA_GU + CVA_DN, CVA_BUF = 4224;
struct CvaItem { const float* W; unsigned char* WT; int ldw, K, k0, n0, s0; float sc; };
__device__ __forceinline__ CvaItem cva_decode(const Args& a, int r) {
    CvaItem d; d.ldw = 2048; d.K = D; d.sc = 64.f;
    if (r < CVA_MIN) { const int kb = r / 96, nb = r - kb * 96; d.W = a.m_win; d.ldw = 6160; d.WT = a.Bt_min8; d.k0 = kb * 128; d.n0 = nb * 64; d.s0 = d.n0; return d; } r -= CVA_MIN;
    if (r < CVA_MO) { d.W = a.m_wout; d.WT = a.Bt_mo8; d.k0 = (r >> 5) * 128; d.n0 = (r & 31) * 64; d.s0 = d.n0; return d; } r -= CVA_MO;
    if (r < CVA_GU) { const int ex = r >> 9, q = r & 511; d.W = a.wgu + (size_t)ex * D * 2048; d.WT = a.Bt_gu8 + (size_t)ex * 2048 * D; d.k0 = (q >> 5) * 128; d.n0 = (q & 31) * 64; d.s0 = gu_src(d.n0); return d; } r -= CVA_GU;
    { const int ex = r >> 8, q = r & 255; d.W = a.wdn + (size_t)ex * MH * D; d.WT = a.Bt_dn8 + (size_t)ex * D * MH; d.K = MH; d.k0 = (q >> 5) * 128; d.n0 = (q & 31) * 64; d.s0 = d.n0; d.sc = 32.f; return d; }
}
struct AttConv {
    const Args* a; LAS unsigned char* buf;
    int nxt, stride, cur, wave; unsigned bufa;
    __device__ __forceinline__ void issue() {
        if (nxt >= CVA_ITEMS) return;
        const CvaItem d = cva_decode(*a, nxt);
        const int l = opq((int)threadIdx.x) & 63, kq = wave & 3, nh = wave >> 2;
        cur = nxt; nxt += stride;
        const char* base = (const char*)(d.W + (size_t)(d.k0 + 32 * kq) * d.ldw + d.s0 + 32 * nh);
        const unsigned voff = (unsigned)(((l >> 3) * d.ldw + 4 * (l & 7)) * 4);
#pragma unroll
        for (int j = 0; j < 4; ++j) asm volatile("s_mov_b32 m0, %2\n\ts_nop 0\n\tglobal_load_lds_dwordx4 %0, %1" :: "v"(voff), "s"(base + (size_t)(8 * j) * d.ldw * 4), "s"(bufa + j * 1024 + (j >= 2 ? 128 : 0)) : "memory", "m0");
    }
    __device__ __forceinline__ void consume() {
        if (cur < 0) return;
        asm volatile("s_waitcnt vmcnt(0)" ::: "memory");
        const CvaItem d = cva_decode(*a, cur);
        const int l = opq((int)threadIdx.x) & 63, n = l & 31, kh = l >> 5, kq = wave & 3, nh = wave >> 2;
        const LAS float* p = (const LAS float*)(buf + kh * (17 * 128) + n * 4);
        float v[16];
#pragma unroll
        for (int i = 0; i < 16; ++i) v[i] = p[i * 32] * d.sc;
        u32x4 o; o.x = pk4_fp8(v[0], v[1], v[2], v[3]); o.y = pk4_fp8(v[4], v[5], v[6], v[7]); o.z = pk4_fp8(v[8], v[9], v[10], v[11]); o.w = pk4_fp8(v[12], v[13], v[14], v[15]);
        *(u32x4*)(d.WT + (size_t)(d.n0 + 32 * nh + n) * d.K + d.k0 + 32 * kq + 16 * kh) = o;
        asm volatile("s_waitcnt lgkmcnt(0)" ::: "memory");
        cur = -1;
    }
    __device__ __forceinline__ void finish() {
        consume();
        while (nxt < CVA_ITEMS) { issue(); consume(); }
    }
};
__device__ __forceinline__ void phase_attn(const Args& a, char* lds, int w, int N  ) {
    AttConv cv; cv.a = &a; cv.wave = __builtin_amdgcn_readfirstlane((int)threadIdx.x >> 6); cv.buf = (LAS unsigned char*)lds + att::ATT_LDS_BYTES + cv.wave * CVA_BUF; cv.bufa = __builtin_amdgcn_readfirstlane((unsigned)(uintptr_t)lds + att::ATT_LDS_BYTES + cv.wave * CVA_BUF);
    cv.nxt = w; cv.stride = N; cv.cur = -1;
    int hd, qb, r = 0;
    if (att_pos(w, N, 0, hd, qb)) {
        ARef cur = att_ref(a, hd, qb);
        att::Seam<bf16_t> Sm;
        att::causal_swa_prime<bf16_t, bf16_t>(cur, 1 << 30, lds, Sm);
        for (;;) {
            int hn, qn; const bool more = att_pos(w, N, r + 1, hn, qn);
            const ARef nxt = more ? att_ref(a, hn, qn) : cur;
            att::causal_swa_block<bf16_t, bf16_t, AttConv>(cur, nxt, S, 1 << 30, lds, Sm, cv);
            if (!more) break;
            cur = nxt; ++r;
        }
    }
    cv.finish();
}
__device__ __forceinline__ float bf_lo(unsigned u) { return __uint_as_float(u << 16); }
__device__ __forceinline__ float bf_hi(unsigned u) { return __uint_as_float(u & 0xffff0000u); }
typedef unsigned short u16x8 __attribute__((ext_vector_type(8)));
__device__ __forceinline__ void bf8_to_f32(const u32x4 p, float (&f)[8]) {
    f[0] = bf_lo(p.x); f[1] = bf_hi(p.x); f[2] = bf_lo(p.y); f[3] = bf_hi(p.y); f[4] = bf_lo(p.z); f[5] = bf_hi(p.z); f[6] = bf_lo(p.w); f[7] = bf_hi(p.w); }
__device__ __forceinline__ void phase_attn_combine(const Args& a, int gw, int NGW, int lane) {
    float d1 = a.lq1[lane] * a.lk1[lane] + a.lq1[lane + 64] * a.lk1[lane + 64], d2 = a.lq2[lane] * a.lk2[lane] + a.lq2[lane + 64] * a.lk2[lane + 64];
    const float lam = __expf(wave_sum(d1)) - __expf(wave_sum(d2)) + 0.2f;
    const int hh = lane >> 3, e0 = (lane & 7) * 32, half = e0 >> 7, d0 = e0 & 127;
    float gv[32];
#pragma unroll
    for (int i = 0; i < 8; ++i) { const f32x4 t = *(const f32x4*)(a.a_hg + e0 + 4 * i); gv[4 * i] = t[0]; gv[4 * i + 1] = t[1]; gv[4 * i + 2] = t[2]; gv[4 * i + 3] = t[3]; }
    const bf16_t* O0 = a.Oa + ((size_t)((hh * 2 + 0) * 2 + half) * NT) * 128 + d0;
    const bf16_t* O1 = a.Oa + ((size_t)((hh * 2 + 1) * 2 + half) * NT) * 128 + d0;
    const int RPW = (NT + NGW - 1) / NGW; int m = gw * RPW; const int mend = (m + RPW < NT) ? m + RPW : NT;
    if (m >= mend) return;
    u32x4 p0[4], p1[4], n0[4], n1[4];
#pragma unroll
    for (int i = 0; i < 4; ++i) { p0[i] = *(const u32x4*)(O0 + (size_t)m * 128 + 8 * i); p1[i] = *(const u32x4*)(O1 + (size_t)m * 128 + 8 * i); }
    for (;;) {
        const bool more = m + 1 < mend;
        if (more) {
#pragma unroll
            for (int i = 0; i < 4; ++i) { n0[i] = *(const u32x4*)(O0 + (size_t)(m + 1) * 128 + 8 * i); n1[i] = *(const u32x4*)(O1 + (size_t)(m + 1) * 128 + 8 * i); } }
        float o[32]; float ss = 0.f;
#pragma unroll
        for (int i = 0; i < 4; ++i) { float f0[8], f1[8]; bf8_to_f32(p0[i], f0); bf8_to_f32(p1[i], f1);
#pragma unroll
            for (int j = 0; j < 8; ++j) { o[8 * i + j] = f0[j] - lam * f1[j]; ss += o[8 * i + j] * o[8 * i + j]; } }
        ss += __shfl_xor(ss, 1); ss += __shfl_xor(ss, 2); ss += __shfl_xor(ss, 4);
        const float r = rsqrtf(ss * (1.f / 256.f) + EPS) * 0.8f;
        bf16_t* orow = a.ob + (size_t)m * D + hh * 256 + e0;
#pragma unroll
        for (int i = 0; i < 4; ++i) { u32x4 w; w.x = cvt_pk_bf16(o[8 * i] * r * gv[8 * i], o[8 * i + 1] * r * gv[8 * i + 1]); w.y = cvt_pk_bf16(o[8 * i + 2] * r * gv[8 * i + 2], o[8 * i + 3] * r * gv[8 * i + 3]);
            w.z = cvt_pk_bf16(o[8 * i + 4] * r * gv[8 * i + 4], o[8 * i + 5] * r * gv[8 * i + 5]); w.w = cvt_pk_bf16(o[8 * i + 6] * r * gv[8 * i + 6], o[8 * i + 7] * r * gv[8 * i + 7]);
            *(u32x4*)(orow + 8 * i) = w; }
        if (!more) break;
        ++m;
#pragma unroll
        for (int i = 0; i < 4; ++i) { p0[i] = n0[i]; p1[i] = n1[i]; }
    }
}

struct EpiMin {
    static constexpr bool PERM = true, AFTER_DRAIN = false;
    bf16_t* P3;
    __device__ __forceinline__ void operator()(const f32x4 (&acc)[2][2][4][2], const Unit& u, int wr, int wc, int fr, int fq) const {
        const int t = u.pn >> 3; const int row0 = u.pm * 256 + wr * 64 + fr;
        bf16_t* base = P3 + (size_t)t * ((size_t)NT * 2048); const int col0 = (u.pn & 7) * 256 + wc * 32 + 8 * fq;
#pragma unroll
        for (int ai = 0; ai < 2; ++ai)
#pragma unroll
            for (int m = 0; m < 4; ++m) { bf16_t* rowp = base + (size_t)(row0 + ai * 128 + m * 16) * 2048 + col0;
#pragma unroll
                for (int bj = 0; bj < 2; ++bj) { f32x4 v0 = acc[ai][bj][m][0] * (1.f / 256.f), v1 = acc[ai][bj][m][1] * (1.f / 256.f);
                    if (t == 2) {
#pragma unroll
                        for (int j = 0; j < 4; ++j) { v0[j] = 1.f / (1.f + __expf(-v0[j])); v1[j] = 1.f / (1.f + __expf(-v1[j])); } }
                    u32x4 w; w.x = cvt_pk_bf16(v0[0], v0[1]); w.y = cvt_pk_bf16(v0[2], v0[3]); w.z = cvt_pk_bf16(v1[0], v1[1]); w.w = cvt_pk_bf16(v1[2], v1[3]);
                    *(u32x4*)(rowp + bj * 128) = w; } }
    }
};
constexpr int MP_XS = 0, MP_VT = 35840, MP_QS = 69632, MP_KS = 87040, MP_GT = 104448;
__device__ __forceinline__ unsigned pk_lo(unsigned a, unsigned b) { return (a & 0xffffu) | (b << 16); }
__device__ __forceinline__ unsigned pk_hi(unsigned a, unsigned b) { return (a >> 16) | (b & 0xffff0000u); }
__device__ __forceinline__ void phase_mprep(const Args& a, LAS unsigned char* lds, int vcu, int G, int tid) {
    const bf16_t* QKP = a.P3; const bf16_t* VB = a.P3 + (size_t)NT * 2048;
    for (int it = vcu; it < NB * 64; it += G) {
        const int b = it >> 6, ck = it & 63; const size_t row0 = (size_t)b * S + (size_t)ck * 64;
        __syncthreads();
        {
            const int t = tid >> 3, h = tid & 7; LAS float* gt = (LAS float*)(lds + MP_GT);
            const float gi = a.gates[(row0 + t) * 16 + h] + a.m_gb[h], z = a.gates[(row0 + t) * 16 + 8 + h] + a.m_gb[8 + h];
            gt[t * 8 + h] = gi; gt[512 + t * 8 + h] = fminf(z, 0.f) - log1pf(expf(-fabsf(z)));
        }
        __syncthreads();
        if (tid < 8) {
            const int h = tid; float bc = 0.f, cm = -INFINITY; const LAS float* gt = (const LAS float*)(lds + MP_GT);
            float* ga = a.GA + (size_t)((b * 8 + h) * 64 + ck) * 192;
            for (int t = 0; t < 64; ++t) { bc += gt[512 + t * 8 + h]; const float av = gt[t * 8 + h] - bc; cm = fmaxf(cm, av); ga[t] = av; ga[64 + t] = cm; ga[128 + t] = bc; }
            a.GS[(size_t)((b * 8 + h) * 64 + ck) * 2 + 0] = cm; a.GS[(size_t)((b * 8 + h) * 64 + ck) * 2 + 1] = bc;
        }
        for (int h = 0; h < 8; ++h) {
            {
                const int tq = opq(tid); u32x4 xs[5];
#pragma unroll
                for (int i = 0; i < 5; ++i) { const int c0 = tq + 512 * i, c = c0 < 67 * 32 ? c0 : 67 * 32 - 1, r = c >> 5, cc = c & 31; long gr = (long)row0 + r - 3; if (gr < 0) gr = 0;
                    xs[i] = *(const u32x4*)(QKP + (size_t)gr * 2048 + (cc < 16 ? h * 128 + cc * 8 : 1024 + h * 128 + (cc - 16) * 8)); }
                __builtin_amdgcn_sched_barrier(0);
#pragma unroll
                for (int i = 0; i < 5; ++i) { const int c = tq + 512 * i, r = c >> 5, cc = c & 31;
                    if (c < 67 * 32) *(LAS u32x4*)(lds + MP_XS + r * 528 + cc * 16) = (ck * 64 + r - 3 >= 0) ? xs[i] : (u32x4){0u, 0u, 0u, 0u}; }
                __builtin_amdgcn_sched_barrier(0);
            }
            {   const int tq = opq(tid); u32x4 vv[4];
#pragma unroll
                for (int i = 0; i < 4; ++i) { const int c = tq + 512 * i, sr = c >> 5, e16 = c & 31; vv[i] = *(const u32x4*)(VB + (row0 + sr) * 2048 + h * 256 + e16 * 8); }
                __builtin_amdgcn_sched_barrier(0);
#pragma unroll
                for (int i = 0; i < 4; ++i) { const int c = tq + 512 * i, sr = c >> 5, e16 = c & 31; *(LAS u32x4*)(lds + MP_VT + sr * 528 + e16 * 16) = vv[i]; }
            }
            __syncthreads();
            {
                const int cp = tid & 127, rq = tid >> 7; const bool isk = cp >= 64;
                const int col = isk ? 1024 + h * 128 + 2 * (cp - 64) : h * 128 + 2 * cp;
                float w0[4], w1[4];
#pragma unroll
                for (int j = 0; j < 4; ++j) { w0[j] = a.m_cw[j * 2048 + col]; w1[j] = a.m_cw[j * 2048 + col + 1]; }
                const float b0 = a.m_cb[col], b1 = a.m_cb[col + 1];
                const LAS unsigned char* xp = lds + MP_XS + (16 * rq) * 528 + cp * 4;
                float xa[4], xb[4];
#pragma unroll
                for (int j = 0; j < 3; ++j) { const unsigned v = *(const LAS unsigned*)(xp + j * 528); xa[j] = bf_lo(v); xb[j] = bf_hi(v); }
                const float sc = isk ? 0.08838834764831845f : 1.f;
                LAS unsigned char* dst = lds + (isk ? MP_KS : MP_QS) + (isk ? cp - 64 : cp) * 4;
#pragma unroll
                for (int i = 0; i < 16; ++i) { const int t = 16 * rq + i;
                    const unsigned v = *(const LAS unsigned*)(xp + (i + 3) * 528); xa[3] = bf_lo(v); xb[3] = bf_hi(v);
                    float ya = b0 + w0[0] * xa[0] + w0[1] * xa[1] + w0[2] * xa[2] + w0[3] * xa[3];
                    float yb = b1 + w1[0] * xb[0] + w1[1] * xb[1] + w1[2] * xb[2] + w1[3] * xb[3];
                    ya = ya / (1.f + __expf(-ya)) * sc; yb = yb / (1.f + __expf(-yb)) * sc;
                    *(LAS unsigned*)(dst + t * 272) = cvt_pk_bf16(ya, yb);
                    xa[0] = xa[1]; xa[1] = xa[2]; xa[2] = xa[3]; xb[0] = xb[1]; xb[1] = xb[2]; xb[2] = xb[3]; }
            }
            __syncthreads();
            {
#pragma unroll
                for (int i = 0; i < 4; ++i) { const int c = tid + 512 * i, isk = c >> 10, r = (c >> 4) & 63, cc = c & 15;
                    *(u32x4*)(a.Qn + (isk ? (size_t)NT * 1024 : (size_t)0) + (row0 + r) * 1024 + h * 128 + cc * 8) = *(const LAS u32x4*)(lds + (isk ? MP_KS : MP_QS) + r * 272 + cc * 16); }
            }
            if (tid < 256) {
                const int dp = tid & 63, sq = tid >> 6; unsigned w[16];
#pragma unroll
                for (int i = 0; i < 16; ++i) w[i] = *(const LAS unsigned*)(lds + MP_KS + (16 * sq + i) * 272 + dp * 4);
                u32x4* d0p = (u32x4*)(a.KT + ((size_t)((b * 8 + h) * 64 + ck) * 128 + 2 * dp) * 64 + 16 * sq);
                d0p[0] = (u32x4){pk_lo(w[0], w[1]), pk_lo(w[2], w[3]), pk_lo(w[4], w[5]), pk_lo(w[6], w[7])};
                d0p[1] = (u32x4){pk_lo(w[8], w[9]), pk_lo(w[10], w[11]), pk_lo(w[12], w[13]), pk_lo(w[14], w[15])};
                d0p[8] = (u32x4){pk_hi(w[0], w[1]), pk_hi(w[2], w[3]), pk_hi(w[4], w[5]), pk_hi(w[6], w[7])};
                d0p[9] = (u32x4){pk_hi(w[8], w[9]), pk_hi(w[10], w[11]), pk_hi(w[12], w[13]), pk_hi(w[14], w[15])};
            }
            {
                const int ep = tid & 127, sq = tid >> 7; unsigned w[16];
#pragma unroll
                for (int i = 0; i < 16; ++i) w[i] = *(const LAS unsigned*)(lds + MP_VT + (16 * sq + i) * 528 + ep * 4);
                u32x4* d0p = (u32x4*)(a.VT + ((size_t)((b * 8 + h) * 64 + ck) * 256 + 2 * ep) * 64 + 16 * sq);
                d0p[0] = (u32x4){pk_lo(w[0], w[1]), pk_lo(w[2], w[3]), pk_lo(w[4], w[5]), pk_lo(w[6], w[7])};
                d0p[1] = (u32x4){pk_lo(w[8], w[9]), pk_lo(w[10], w[11]), pk_lo(w[12], w[13]), pk_lo(w[14], w[15])};
                d0p[8] = (u32x4){pk_hi(w[0], w[1]), pk_hi(w[2], w[3]), pk_hi(w[4], w[5]), pk_hi(w[6], w[7])};
                d0p[9] = (u32x4){pk_hi(w[8], w[9]), pk_hi(w[10], w[11]), pk_hi(w[12], w[13]), pk_hi(w[14], w[15])};
            }
            __syncthreads();
        }
    }
}

constexpr int ML_QS = 0, ML_KS = 17408, ML_KTS = 34816, ML_VTS = 53248, ML_GL = 60160, ML_PL = 60928, ML_QD = 70144, ML_CL = 87552, ML_MP = 113664, ML_END = 113920;
typedef short bf16x8s __attribute__((ext_vector_type(8)));
__device__ __forceinline__ void phase_mlstm(const Args& a, LAS unsigned char* lds, int vcu, int G, int tid, int wave, int lane) {
    const int r16 = lane & 15, q4 = lane >> 4;
    for (int unit = vcu; unit < 256; unit += G) {
        const int bh = unit >> 3, es = unit & 7, b = bh >> 3, h = bh & 7;
        __syncthreads();
        for (int i = tid; i < 16 * 36; i += NTHR) { const int r = i / 36, c = i % 36; *(LAS unsigned*)(lds + ML_VTS + (32 + r) * 144 + c * 4) = (r == 0) ? 0x3F803F80u : 0u; }
        for (int i = tid; i < 48 * 68; i += NTHR) *(LAS unsigned*)(lds + ML_CL + i * 4) = 0u;
        if (tid < 64) { ((LAS float*)(lds + ML_END))[2 * tid] = a.GS[(size_t)(bh * 64 + tid) * 2]; ((LAS float*)(lds + ML_END))[2 * tid + 1] = a.GS[(size_t)(bh * 64 + tid) * 2 + 1]; }
        __syncthreads();
        if (tid == 0) { float m = 0.f; LAS float* mp = (LAS float*)(lds + ML_MP); const LAS float* gs = (const LAS float*)(lds + ML_END);
            for (int k = 0; k < 64; ++k) { mp[k] = m; m = gs[2 * k + 1] + fmaxf(m, gs[2 * k]); } }
        f32x4 accC[2][3];
#pragma unroll
        for (int i = 0; i < 2; ++i)
#pragma unroll
            for (int j = 0; j < 3; ++j) accC[i][j] = (f32x4){0.f, 0.f, 0.f, 0.f};
        u32x4 rq[2], rk[2], rkt[2], rv, rg, sq[2], sk[2], skt[2], sv, sg;
        rv = (u32x4){0u, 0u, 0u, 0u}; rg = rv; sv = rv; sg = rv;
#define ML_LOAD(k, Q_, K_, KT_, V_, G_) do { const int kc_ = (k) < 64 ? (k) : 63; const size_t row0_ = (size_t)b * S + (size_t)kc_ * 64; const size_t cb_ = (size_t)(bh * 64 + kc_); \
        _Pragma("unroll") for (int i_ = 0; i_ < 2; ++i_) { const int c_ = tid + 512 * i_; \
            Q_[i_] = *(const u32x4*)(a.Qn + (row0_ + (c_ >> 4)) * 1024 + h * 128 + (c_ & 15) * 8); \
            K_[i_] = *(const u32x4*)(a.Kn + (row0_ + (c_ >> 4)) * 1024 + h * 128 + (c_ & 15) * 8); \
            KT_[i_] = *(const u32x4*)(a.KT + cb_ * 8192 + (size_t)c_ * 8); } \
        V_ = *(const u32x4*)(a.VT + cb_ * 16384 + (size_t)es * 2048 + (size_t)(tid & 255) * 8); \
        G_ = *(const u32x4*)(a.GA + cb_ * 192 + (tid & 31) * 4); } while (0)
#define ML_STORE(Q_, K_, KT_, V_, G_) do { \
        _Pragma("unroll") for (int i_ = 0; i_ < 2; ++i_) { const int c_ = tid + 512 * i_; \
            *(LAS u32x4*)(lds + ML_QS + (c_ >> 4) * 272 + (c_ & 15) * 16) = Q_[i_]; \
            *(LAS u32x4*)(lds + ML_KS + (c_ >> 4) * 272 + (c_ & 15) * 16) = K_[i_]; \
            *(LAS u32x4*)(lds + ML_KTS + (c_ >> 3) * 144 + (c_ & 7) * 16) = KT_[i_]; } \
        if (tid < 256) *(LAS u32x4*)(lds + ML_VTS + (tid >> 3) * 144 + (tid & 7) * 16) = V_; \
        if (tid < 48) *(LAS u32x4*)(lds + ML_GL + tid * 16) = G_; } while (0)
        ML_LOAD(0, rq, rk, rkt, rv, rg);
        ML_STORE(rq, rk, rkt, rv, rg);
        __syncthreads();
        ML_LOAD(1, rq, rk, rkt, rv, rg); ML_LOAD(2, sq, sk, skt, sv, sg);
        auto chunk = [&](const int k) __attribute__((always_inline)) {
            const LAS float* ga = (const LAS float*)(lds + ML_GL);
            const float m = ((const LAS float*)(lds + ML_MP))[k];
            const int cur = k & 1;
            if (wave < 4) {
                const int tr = wave, t = 16 * tr + r16;
                const float Mt = fmaxf(m, ga[64 + t]);
                bf16x8s qf[4];
#pragma unroll
                for (int kk = 0; kk < 4; ++kk) qf[kk] = *(const LAS bf16x8s*)(lds + ML_QS + t * 272 + kk * 64 + q4 * 16);
#pragma unroll
                for (int sc = 0; sc < 4; ++sc) {
                    u32x2 w0 = {0u, 0u};
                    if (sc <= tr) {
                        f32x4 s0 = {0.f, 0.f, 0.f, 0.f};
#pragma unroll
                        for (int kk = 0; kk < 4; ++kk) { const bf16x8s kf = *(const LAS bf16x8s*)(lds + ML_KS + (16 * sc + r16) * 272 + kk * 64 + q4 * 16);
                            s0 = __builtin_amdgcn_mfma_f32_16x16x32_bf16(kf, qf[kk], s0, 0, 0, 0); }
                        const f32x4 a0 = *(const LAS f32x4*)(lds + ML_GL + (16 * sc + 4 * q4) * 4);
                        float p[4];
#pragma unroll
                        for (int j = 0; j < 4; ++j) { const int sA = 16 * sc + 4 * q4 + j; p[j] = (sA <= t) ? s0[j] * __expf(a0[j] - Mt) : 0.f; }
                        w0.x = cvt_pk_bf16(p[0], p[1]); w0.y = cvt_pk_bf16(p[2], p[3]);
                    }
                    *(LAS u32x2*)(lds + ML_PL + t * 144 + (16 * sc + 4 * q4) * 2) = w0;
                }
                {
                    const int tq = 16 * tr + (lane >> 2), c0 = (lane & 3) * 32;
                    const float dec = __expf(m - fmaxf(m, ga[64 + tq]));
#pragma unroll
                    for (int i = 0; i < 4; ++i) { const u32x4 v = *(const LAS u32x4*)(lds + ML_QS + tq * 272 + (c0 + 8 * i) * 2); u32x4 o;
                        o.x = cvt_pk_bf16(bf_lo(v.x) * dec, bf_hi(v.x) * dec); o.y = cvt_pk_bf16(bf_lo(v.y) * dec, bf_hi(v.y) * dec);
                        o.z = cvt_pk_bf16(bf_lo(v.z) * dec, bf_hi(v.z) * dec); o.w = cvt_pk_bf16(bf_lo(v.w) * dec, bf_hi(v.w) * dec);
                        *(LAS u32x4*)(lds + ML_QD + tq * 272 + (c0 + 8 * i) * 2) = o; }
                }
                asm volatile("s_waitcnt lgkmcnt(0)" ::: "memory");
                f32x4 o0 = {0.f, 0.f, 0.f, 0.f}, o1 = o0, o2 = o0;
#pragma unroll
                for (int kk = 0; kk < 2; ++kk) {
                    if (kk * 2 <= tr) {
                    const bf16x8s pf = *(const LAS bf16x8s*)(lds + ML_PL + t * 144 + kk * 64 + q4 * 16);
                    const bf16x8s v0 = *(const LAS bf16x8s*)(lds + ML_VTS + (r16) * 144 + kk * 64 + q4 * 16);
                    const bf16x8s v1 = *(const LAS bf16x8s*)(lds + ML_VTS + (16 + r16) * 144 + kk * 64 + q4 * 16);
                    const bf16x8s v2 = *(const LAS bf16x8s*)(lds + ML_VTS + (32 + r16) * 144 + kk * 64 + q4 * 16);
                    o0 = __builtin_amdgcn_mfma_f32_16x16x32_bf16(v0, pf, o0, 0, 0, 0);
                    o1 = __builtin_amdgcn_mfma_f32_16x16x32_bf16(v1, pf, o1, 0, 0, 0);
                    o2 = __builtin_amdgcn_mfma_f32_16x16x32_bf16(v2, pf, o2, 0, 0, 0); }
                }
#pragma unroll
                for (int kk = 0; kk < 4; ++kk) {
                    const bf16x8s qd = *(const LAS bf16x8s*)(lds + ML_QD + t * 272 + kk * 64 + q4 * 16);
                    const bf16x8s c0 = *(const LAS bf16x8s*)(lds + ML_CL + cur * 13056 + (r16) * 272 + kk * 64 + q4 * 16);
                    const bf16x8s c1 = *(const LAS bf16x8s*)(lds + ML_CL + cur * 13056 + (16 + r16) * 272 + kk * 64 + q4 * 16);
                    const bf16x8s c2 = *(const LAS bf16x8s*)(lds + ML_CL + cur * 13056 + (32 + r16) * 272 + kk * 64 + q4 * 16);
                    o0 = __builtin_amdgcn_mfma_f32_16x16x32_bf16(c0, qd, o0, 0, 0, 0);
                    o1 = __builtin_amdgcn_mfma_f32_16x16x32_bf16(c1, qd, o1, 0, 0, 0);
                    o2 = __builtin_amdgcn_mfma_f32_16x16x32_bf16(c2, qd, o2, 0, 0, 0);
                }
                const float den = __shfl(o2[0], r16);
                const float mt = ga[128 + t] + Mt;
                const float inv = 1.f / fmaxf(fabsf(den), __expf(-mt));
                bf16_t* hp = a.HS + ((size_t)b * S + (size_t)k * 64 + t) * 2048 + h * 256 + es * 32 + 4 * q4;
                u32x2 w0, w1; w0.x = cvt_pk_bf16(o0[0] * inv, o0[1] * inv); w0.y = cvt_pk_bf16(o0[2] * inv, o0[3] * inv);
                w1.x = cvt_pk_bf16(o1[0] * inv, o1[1] * inv); w1.y = cvt_pk_bf16(o1[2] * inv, o1[3] * inv);
                *(u32x2*)hp = w0; *(u32x2*)(hp + 16) = w1;
            } else {
                const int dj = wave - 4;
                const float Ml = fmaxf(m, ga[64 + 63]), cd = __expf(m - Ml);
#pragma unroll
                for (int i = 0; i < 2; ++i)
#pragma unroll
                    for (int et = 0; et < 3; ++et) accC[i][et] = accC[i][et] * cd;
#pragma unroll
                for (int kk = 0; kk < 2; ++kk) {
                    const f32x4 aA = *(const LAS f32x4*)(lds + ML_GL + (32 * kk + 8 * q4) * 4), aB = *(const LAS f32x4*)(lds + ML_GL + (32 * kk + 8 * q4 + 4) * 4);
                    float wg[8];
#pragma unroll
                    for (int j = 0; j < 4; ++j) { wg[j] = __expf(aA[j] - Ml); wg[4 + j] = __expf(aB[j] - Ml); }
                    bf16x8s vw[3];
#pragma unroll
                    for (int et = 0; et < 3; ++et) { const u32x4 v = *(const LAS u32x4*)(lds + ML_VTS + (16 * et + r16) * 144 + kk * 64 + q4 * 16); u32x4 o;
                        o.x = cvt_pk_bf16(bf_lo(v.x) * wg[0], bf_hi(v.x) * wg[1]); o.y = cvt_pk_bf16(bf_lo(v.y) * wg[2], bf_hi(v.y) * wg[3]);
                        o.z = cvt_pk_bf16(bf_lo(v.z) * wg[4], bf_hi(v.z) * wg[5]); o.w = cvt_pk_bf16(bf_lo(v.w) * wg[6], bf_hi(v.w) * wg[7]);
                        vw[et] = __builtin_bit_cast(bf16x8s, o); }
#pragma unroll
                    for (int i = 0; i < 2; ++i) { const bf16x8s kf = *(const LAS bf16x8s*)(lds + ML_KTS + (16 * (2 * dj + i) + r16) * 144 + kk * 64 + q4 * 16);
#pragma unroll
                        for (int et = 0; et < 3; ++et) accC[i][et] = __builtin_amdgcn_mfma_f32_16x16x32_bf16(kf, vw[et], accC[i][et], 0, 0, 0); }
                }
#pragma unroll
                for (int i = 0; i < 2; ++i)
#pragma unroll
                    for (int et = 0; et < 3; ++et) { u32x2 w; w.x = cvt_pk_bf16(accC[i][et][0], accC[i][et][1]); w.y = cvt_pk_bf16(accC[i][et][2], accC[i][et][3]);
                        *(LAS u32x2*)(lds + ML_CL + (cur ^ 1) * 13056 + (16 * et + r16) * 272 + (16 * (2 * dj + i) + 4 * q4) * 2) = w; }
            }
        };
        for (int k = 0; k < 64; k += 2) {
            chunk(k);
            __syncthreads();
            ML_STORE(rq, rk, rkt, rv, rg);
            __syncthreads();
            ML_LOAD(k + 3, rq, rk, rkt, rv, rg);
            chunk(k + 1);
            __syncthreads();
            ML_STORE(sq, sk, skt, sv, sg);
            __syncthreads();
            ML_LOAD(k + 4, sq, sk, skt, sv, sg);
        }
#undef ML_LOAD
#undef ML_STORE
    }
}
__device__ __forceinline__ void phase_mnorm(const Args& a, int gw, int NGW, int lane) {
    const bf16_t* SG = a.P3 + (size_t)2 * NT * 2048;
    float gv[32];
#pragma unroll
    for (int i = 0; i < 8; ++i) { const f32x4 t = *(const f32x4*)(a.m_hg + 32 * lane + 4 * i); gv[4 * i] = t[0]; gv[4 * i + 1] = t[1]; gv[4 * i + 2] = t[2]; gv[4 * i + 3] = t[3]; }
    const int RPW = (NT + NGW - 1) / NGW; int m = gw * RPW; const int mend = (m + RPW < NT) ? m + RPW : NT;
    if (m >= mend) return;
    u32x4 p0[4], p1[4], n0[4], n1[4];
#pragma unroll
    for (int i = 0; i < 4; ++i) { p0[i] = *(const u32x4*)(a.HS + (size_t)m * D + 32 * lane + 8 * i); p1[i] = *(const u32x4*)(SG + (size_t)m * D + 32 * lane + 8 * i); }
    for (;;) {
        const bool more = m + 1 < mend;
        if (more) {
#pragma unroll
            for (int i = 0; i < 4; ++i) { n0[i] = *(const u32x4*)(a.HS + (size_t)(m + 1) * D + 32 * lane + 8 * i); n1[i] = *(const u32x4*)(SG + (size_t)(m + 1) * D + 32 * lane + 8 * i); } }
        float o[32], sg[32]; float ss = 0.f;
#pragma unroll
        for (int i = 0; i < 4; ++i) { float f0[8], f1[8]; bf8_to_f32(p0[i], f0); bf8_to_f32(p1[i], f1);
#pragma unroll
            for (int j = 0; j < 8; ++j) { o[8 * i + j] = f0[j]; sg[8 * i + j] = f1[j]; ss += f0[j] * f0[j]; } }
        ss += __shfl_xor(ss, 1); ss += __shfl_xor(ss, 2); ss += __shfl_xor(ss, 4);
        const float r = rsqrtf(ss * (1.f / 256.f) + EPS);
        unsigned char* orow = a.ob8 + (size_t)m * D + 32 * lane;
#pragma unroll
        for (int i = 0; i < 4; ++i) { float y[8];
#pragma unroll
            for (int j = 0; j < 8; ++j) y[j] = o[8 * i + j] * r * gv[8 * i + j] * sg[8 * i + j];
            u32x2 w; w.x = pk4_fp8(y[0] * 8.f, y[1] * 8.f, y[2] * 8.f, y[3] * 8.f); w.y = pk4_fp8(y[4] * 8.f, y[5] * 8.f, y[6] * 8.f, y[7] * 8.f);
            *(u32x2*)(orow + 8 * i) = w; }
        if (!more) break;
        ++m;
#pragma unroll
        for (int i = 0; i < 4; ++i) { p0[i] = n0[i]; p1[i] = n1[i]; }
    }
}

#define XB_TMO      128
#define XB_XCNT(j)  (256  + 64 * (j))
#define XB_XSUB(j)  (1280 + 64 * (j))
#define XB_XGEN(j)  (2304 + 64 * (j))
#define XB_TOP      3328
#define XB_TOPGEN   3392
#define XCD_BAR_WORDS 3456
#define XB_SPIN_CAP (1u << 18)

__device__ __forceinline__ unsigned xb_ld(unsigned* p)              { return __hip_atomic_load(p, __ATOMIC_RELAXED, __HIP_MEMORY_SCOPE_AGENT); }
__device__ __forceinline__ unsigned xb_add(unsigned* p, unsigned v) { return __hip_atomic_fetch_add(p, v, __ATOMIC_RELAXED, __HIP_MEMORY_SCOPE_AGENT); }
__device__ __forceinline__ unsigned xb_xcc_id() { return (unsigned)__builtin_amdgcn_s_getreg((3 << 11) | 20) & 0xFu; }
#define XB_SPIN(cond, bar) do { unsigned _sp = 0; while (cond) { __builtin_amdgcn_s_sleep(1); \
    if ((++_sp & 255u) == 0u) { if (xb_ld(&(bar)[XB_TMO])) break; if (_sp > XB_SPIN_CAP) { atomicAdd(&(bar)[XB_TMO], 1u); break; } } } } while (0)

struct XcdBarrier {
    unsigned* bar; unsigned x;
    volatile LAS unsigned* st;
};

__device__ __forceinline__ XcdBarrier xcd_barrier_post(unsigned* bar, volatile LAS unsigned* st) {
    XcdBarrier b; b.bar = bar; b.x = xb_xcc_id(); b.st = st;
    if (threadIdx.x == 0) (void)xb_add(&bar[XB_XCNT(b.x)], 1u);
    return b;
}
__device__ __forceinline__ void xcd_barrier_complete(unsigned* bar, unsigned x, unsigned& nloc, unsigned& nx) {
    const unsigned G = gridDim.x * gridDim.y * gridDim.z;
    unsigned sum, cnt, mine, sp = 0u;
    for (;;) {
        sum = 0u; cnt = 0u; mine = 0u;
#pragma unroll
        for (unsigned j = 0; j < 16; ++j) { const unsigned c = xb_ld(&bar[XB_XCNT(j)]); sum += c; cnt += (c > 0u) ? 1u : 0u; mine = (j == x) ? c : mine; }
        if (sum == G) break;
        __builtin_amdgcn_s_sleep(1);
        if ((++sp & 255u) == 0u) { if (xb_ld(&bar[XB_TMO])) break; if (sp > XB_SPIN_CAP) { atomicAdd(&bar[XB_TMO], 1u); break; } }
    }
    nloc = mine > 0u ? mine : 1u; nx = cnt > 0u ? cnt : 1u;
}

__device__ __forceinline__ void xcd_barrier(const XcdBarrier& b) {
    asm volatile("s_waitcnt vmcnt(0)" ::: "memory");
    __syncthreads();
    if (threadIdx.x == 0) {
        unsigned* bar = b.bar;
        __builtin_amdgcn_s_waitcnt(0);
        unsigned nloc = b.st[0], nx = b.st[1];
        if (nloc == 0u) { xcd_barrier_complete(bar, b.x, nloc, nx); b.st[0] = nloc; b.st[1] = nx; }
        const unsigned old = xb_add(&bar[XB_XSUB(b.x)], 1u);
        const unsigned gen = old / nloc;
        if (old + 1u == (gen + 1u) * nloc) {
            __builtin_amdgcn_fence(__ATOMIC_RELEASE, "agent");
            asm volatile("s_waitcnt vmcnt(0)" ::: "memory");
            const unsigned og = xb_add(&bar[XB_TOP], 1u);
            const unsigned tg = og / nx;
            if (og + 1u == (tg + 1u) * nx) xb_add(&bar[XB_TOPGEN], 1u);
            else XB_SPIN(xb_ld(&bar[XB_TOPGEN]) == tg, bar);
            __builtin_amdgcn_fence(__ATOMIC_ACQUIRE, "agent");
            xb_add(&bar[XB_XGEN(b.x)], 1u);
            asm volatile("s_waitcnt vmcnt(0)" ::: "memory");
        } else {
            XB_SPIN(xb_ld(&bar[XB_XGEN(b.x)]) == gen, bar);
            __builtin_amdgcn_fence(__ATOMIC_ACQUIRE, "agent");
            asm volatile("s_waitcnt vmcnt(0)" ::: "memory");
        }
    }
    __syncthreads();
}


#ifndef MK_REP_MASK
#define MK_REP_MASK 0u
#endif
__device__ __forceinline__ constexpr int REPS(int k) { return ((MK_REP_MASK >> k) & 1u) ? 2 : 1; }
__global__ void __launch_bounds__(NTHR, 2) mk_fwd(Args a) {
    extern __shared__ __attribute__((aligned(16))) unsigned char lds_raw[];
    LAS unsigned char* lds = (LAS unsigned char*)lds_raw;
    LAS unsigned char* misc = lds + LDS_MISC;
    const int tid = threadIdx.x, lane = tid & 63, wave = __builtin_amdgcn_readfirstlane(tid >> 6);
    const int G = gridDim.x; const int bx = blockIdx.x; const int vcu = (G % 8 == 0) ? (bx % 8) * (G / 8) + bx / 8 : bx;
    const int gw = vcu * NWAVES + wave, NGW = G * NWAVES;
    if (tid < 16) ((LAS unsigned*)(misc + MISC_BAR))[tid] = 0u;
    __syncthreads();
    const int lo = a.ph_lo, hi = a.ph_hi;
    XcdBarrier bar; bar.bar = a.ctl + 4096; bar.x = 0; bar.st = nullptr;
    if (hi - lo > 1) bar = xcd_barrier_post(a.ctl + 4096, (volatile LAS unsigned*)(misc + MISC_BAR));
#define IN(k) (lo <= (k) && (k) < hi)
#define SEAM(k) do { if (IN(k) && IN((k) + 1)) xcd_barrier(bar); } while (0)
    const float* mod0 = a.mod; const float* mod1 = a.mod + (size_t)NB * 6 * D;

#define PH(k) if (IN(k)) _Pragma("unroll") for (int rep_ = 0; rep_ < REPS(k); (REPS(k) > 1 ? __syncthreads() : (void)0, ++rep_))
    PH(0) { p0_prologue(a, lds, vcu, G, opq(tid), wave, opq(lane)); } SEAM(0);
    PH(1) { phase_norm(a.x, a.nmg, mod0, 0, 1, a.hb, gw, NGW, opq(lane)); } SEAM(1);
    PH(2) {
        pg8::Gemm g{a.hb, a.Bt_qkv, NT, 6144, D}; pg8::StaticOrder So; So.init(NT, 6144, G, bx);
        EpiQKV E{a.Qh, a.Kh, a.Vh, a.cs};
        pg8::gemm_phase<EpiQKV, pg8::StaticOrder, true, true>(lds, g, So, E);
    } SEAM(2);
    PH(3) { phase_attn(a, (char*)lds_raw, vcu, G); } SEAM(3);
    PH(4) { phase_attn_combine(a, gw, NGW, opq(lane)); } SEAM(4);
    PH(5) {
        pg8::Gemm g{a.ob, a.Bt_ao, NT, D, D}; pg8::StaticOrder So; So.init(NT, D, G, bx);
        EpiResid<true> E{a.x, a.xres, mod0 + 2 * D, 1.f};
        pg8::gemm_phase<EpiResid<true>, pg8::StaticOrder, true, true>(lds, g, So, E);
    } SEAM(5);
#define MOE_PHASES(P, layer, modl)                                                                                                   \
    PH(P) { phase_norm_route(a, layer, modl, lds, misc, vcu, G, opq(tid), wave, opq(lane)); } SEAM(P);                            \
    PH(P + 1) { const int NP = moe_tables(a.counts + (layer) * 64, misc, tid);                                                    \
        pg8::Gemm g{(const bf16_t*)a.hb8, (const bf16_t*)(a.Bt_gu8 + (size_t)(layer) * NE * 2048 * D), NP * 256, NE * 2048, D / 2};     \
        GroupedOrderG So; So.NP = NP; So.total = NP * 8; So.G = G; So.c = vcu; So.pe = (const LAS int*)(misc + MISC_PE);          \
        So.ps = (const LAS int*)(misc + MISC_PS); So.cn = (const LAS int*)(misc + MISC_CNT); So.inv = a.inv; EpiGU E{a.Hm8};      \
        pg8::gemm_phase_gather<EpiGU, GroupedOrderG, true, 125, 121>(lds, g, So, E); } SEAM(P + 1);                                               \
    PH(P + 2) { const int NP = moe_tables(a.counts + (layer) * 64, misc, tid);                                                    \
        pg8::Gemm g{(const bf16_t*)a.Hm8, (const bf16_t*)(a.Bt_dn8 + (size_t)(layer) * NE * D * MH), NP * 256, NE * 2048, MH / 2};   \
        GroupedOrder So{NP, NP * 8, G, vcu, (const LAS int*)(misc + MISC_PE)}; EpiBf16G E{a.Y, D, 1.f / 128.f};                                \
        pg8::gemm_phase<EpiBf16G, GroupedOrder, true, true, true, 125, 122>(lds, g, So, E); } SEAM(P + 2);
    MOE_PHASES(6, 0, mod0)
    PH(9) { moe_tables(a.counts, misc, tid); phase_combine_gates(a, mod0, mod1, a.nmg + D, (const LAS int*)(misc + MISC_PS), lds, vcu, G, opq(tid), wave, opq(lane)); } SEAM(9);
    PH(10) {
        pg8::Gemm g{(const bf16_t*)a.hb8, (const bf16_t*)a.Bt_min8, NT, 6144, D / 2}; pg8::StaticOrder So; So.init(NT, 6144, G, bx);
        EpiMin E{a.P3};
        pg8::gemm_phase<EpiMin, pg8::StaticOrder, true, true, true>(lds, g, So, E);
    } SEAM(10);
    PH(11) { phase_mprep(a, lds, vcu, G, opq(tid)); } SEAM(11);
    PH(12) { phase_mlstm(a, lds, vcu, G, opq(tid), wave, opq(lane)); } SEAM(12);
    PH(13) { phase_mnorm(a, gw, NGW, opq(lane)); } SEAM(13);
    PH(14) {
        pg8::Gemm g{(const bf16_t*)a.ob8, (const bf16_t*)a.Bt_mo8, NT, D, D / 2}; pg8::StaticOrder So; So.init(NT, D, G, bx);
        EpiResid<false> E{a.xres, a.xres, mod1 + 2 * D, 1.f / 512.f};
        pg8::gemm_phase<EpiResid<false>, pg8::StaticOrder, true, true, true>(lds, g, So, E);
    } SEAM(14);
    MOE_PHASES(15, 1, mod1)
    PH(18) { moe_tables(a.counts + 64, misc, tid); phase_combine_final(a, mod1, (const LAS int*)(misc + MISC_PS), gw, NGW, opq(lane)); }
#undef PH
#undef IN
#undef SEAM
}
}

extern "C" void kernel_launch(void* const* d_in, const int* in_sizes, int n_in, void* d_out, int out_size, void* d_ws, size_t ws_size, hipStream_t st) {
    using namespace mk;
    static int grid = 0;
    if (grid == 0) {
        int dev = 0, cus = 0;
        if (hipGetDevice(&dev) != hipSuccess || hipDeviceGetAttribute(&cus, hipDeviceAttributeMultiprocessorCount, dev) != hipSuccess || cus <= 0) cus = 256;
        (void)hipFuncSetAttribute((const void*)mk_fwd, hipFuncAttributeMaxDynamicSharedMemorySize, LDS_BYTES);
        int per_cu = 0; (void)hipOccupancyMaxActiveBlocksPerMultiprocessor(&per_cu, (const void*)mk_fwd, NTHR, LDS_BYTES);
        (void)hipGetLastError();
        grid = cus;
    }
    Args a{};
    a.x = (const float*)d_in[0]; a.c = (const float*)d_in[1]; a.pos = (const int*)d_in[2];
    a.ada_w = (const float*)d_in[3]; a.ada_b = (const float*)d_in[4]; a.nmg = (const float*)d_in[5]; a.nfg = (const float*)d_in[6]; a.fng = (const float*)d_in[7];
    a.a_win = (const float*)d_in[8]; a.a_wout = (const float*)d_in[9];
    a.lq1 = (const float*)d_in[10]; a.lk1 = (const float*)d_in[11]; a.lq2 = (const float*)d_in[12]; a.lk2 = (const float*)d_in[13]; a.a_hg = (const float*)d_in[14];
    a.m_win = (const float*)d_in[15]; a.m_cw = (const float*)d_in[16]; a.m_cb = (const float*)d_in[17]; a.m_gb = (const float*)d_in[18]; a.m_hg = (const float*)d_in[19]; a.m_wout = (const float*)d_in[20];
    a.wg = (const float*)d_in[21]; a.bg = (const float*)d_in[22]; a.we = (const float*)d_in[23]; a.be = (const float*)d_in[24]; a.wgu = (const float*)d_in[25]; a.wdn = (const float*)d_in[26];
    a.out = (float*)d_out;
    char* w = (char*)d_ws; size_t off = 0;
    auto alloc = [&](size_t bytes) { void* p = w + off; off += (bytes + 4095) & ~(size_t)4095; return p; };
    a.ctl = (unsigned*)alloc(1 << 20);
    a.counts = (int*)(a.ctl + 65536);
    a.mod = (float*)alloc((size_t)2 * NB * 6 * D * 4);
    a.cs = (float2*)alloc((size_t)NT * 16 * 8);
    a.Bt_qkv = (bf16_t*)alloc((size_t)6144 * D * 2); a.Bt_ao = (bf16_t*)alloc((size_t)D * D * 2); a.Bt_min = nullptr; a.Bt_mo = nullptr; a.Bt_min8 = (unsigned char*)alloc((size_t)6144 * D); a.Bt_mo8 = (unsigned char*)alloc((size_t)D * D);
    a.Bt_rt = (bf16_t*)alloc((size_t)2 * 256 * D * 2); a.Bt_g = (bf16_t*)alloc((size_t)16 * D * 2); a.Bt_gu = nullptr; a.Bt_dn = nullptr;
    a.Bt_gu8 = (unsigned char*)alloc((size_t)2 * NE * 2048 * D); a.Bt_dn8 = (unsigned char*)alloc((size_t)2 * NE * D * MH); a.hb8 = (unsigned char*)alloc((size_t)(NT + 1) * D);
    a.xres = (bf16_t*)alloc((size_t)NT * D * 2); a.hb = (bf16_t*)alloc((size_t)(NT + 1) * D * 2); a.ob = (bf16_t*)alloc((size_t)NT * D * 2); a.ob8 = (unsigned char*)a.ob;

    a.logits = nullptr; a.eid = (int*)alloc((size_t)NA * 4); a.wts = (float*)alloc((size_t)NA * 4); a.pos_in_e = (int*)alloc((size_t)NA * 4); a.slot = nullptr; a.inv = (int*)alloc((size_t)NE * 32768 * 4);
    a.Qh = (bf16_t*)alloc((size_t)3 * NT * 2048 * 2); a.Kh = a.Qh + (size_t)NT * 2048; a.Vh = a.Kh + (size_t)NT * 2048; a.Oa = (bf16_t*)alloc((size_t)NT * 4096 * 2);
    a.P3 = (bf16_t*)alloc((size_t)3 * NT * 2048 * 2); a.Qn = (bf16_t*)alloc((size_t)2 * NT * 1024 * 2); a.Kn = a.Qn + (size_t)NT * 1024;
    a.KT = (bf16_t*)alloc((size_t)NT * 1024 * 2); a.VT = (bf16_t*)alloc((size_t)NT * 2048 * 2); a.HS = (bf16_t*)alloc((size_t)NT * 2048 * 2);
    a.gates = (float*)alloc((size_t)NT * 16 * 4); a.GA = (float*)alloc((size_t)32 * 64 * 192 * 4); a.GS = (float*)alloc((size_t)32 * 64 * 2 * 4);
    a.XG = nullptr; a.Hm = nullptr; a.Hm8 = (unsigned char*)alloc((size_t)PMAX * MH); a.Y = (bf16_t*)alloc((size_t)PMAX * D * 2);
    if (off > ws_size) return;

    (void)hipMemsetAsync(a.ctl, 0, 1 << 20, st);
    auto run = [&](int lo, int hi) { a.ph_lo = lo; a.ph_hi = hi; hipLaunchKernelGGL(mk_fwd, dim3(grid), dim3(NTHR), LDS_BYTES, st, a); };
#ifndef MK_N_LAUNCHES
#define MK_N_LAUNCHES 1
#endif
#if MK_N_LAUNCHES == 1
    run(0, 19);
#else
    for (int p = 0; p <= 18; ++p) run(p, p + 1);
#endif
}
```

```cpp
#include <hip/hip_runtime.h>
#include <math.h>
#include <stdint.h>


namespace pg8 {
#define PG8_LAS __attribute__((address_space(3)))
typedef unsigned short bf16_t;
typedef short bf16x8 __attribute__((ext_vector_type(8)));
typedef float f32x4 __attribute__((ext_vector_type(4)));
typedef unsigned u32x4 __attribute__((ext_vector_type(4)));
constexpr int BM = 256, BK = 64, HALF = 128, KBP = 1088  , HTB = 16 * KBP  , STAGE_BYTES = 8 * HTB, NXCD = 8, WGM = 8;

__host__ __device__ __forceinline__ int lds_byte(int r, int c) { const int ch = c >> 3, p = (ch & 4) | ((ch & 3) ^ ((r >> 1) & 3)); return (r >> 3) * KBP + (r & 7) * 128 + p * 16 + (c & 7) * 2; }
__host__ __device__ __forceinline__ void stage_rc(int tid, int i, int& R, int& C) { const int g = (tid >> 6) + 8 * i, l = tid & 63, rr = l >> 3, p = l & 7, ch = (p & 4) | ((p & 3) ^ ((rr >> 1) & 3)); R = 8 * g + rr; C = ch * 8; }
__host__ __device__ __forceinline__ int perm32(int rho) { const int n = rho >> 4, i = rho & 15; return 8 * (i >> 2) + 4 * n + (i & 3); }

typedef int i32x4 __attribute__((ext_vector_type(4)));
typedef int i32x8 __attribute__((ext_vector_type(8)));
typedef int i32x2 __attribute__((ext_vector_type(2)));
__device__ __forceinline__ i32x8 cat8(i32x4 l, i32x4 h) { return __builtin_shufflevector(l, h, 0, 1, 2, 3, 4, 5, 6, 7); }
__device__ __forceinline__ void mfma_scale_f8(f32x4& acc, i32x8 b, i32x8 a, int sc) {
    asm volatile("v_mfma_scale_f32_16x16x128_f8f6f4 %0, %1, %2, %0, %3, %3 op_sel_hi:[0,0,0]" : "+v"(acc) : "v"(b), "v"(a), "v"(sc));
}
struct Unit { int pm, pn; };
struct Gemm { const bf16_t* A; const bf16_t* Bt; int M, N, K; };

struct StaticOrder {
    int nM, nN, nwg, G, c;
    __host__ __device__ void init(int M, int N, int G_, int c_) { nM = M / BM; nN = N / BM; nwg = nM * nN; G = G_; c = c_; }
    __host__ __device__ bool next(int i, Unit& u) const {
        const long L = (long)i * G + c; if (L >= nwg) return false;
        int wgid = (int)L; { const int q = nwg / NXCD, r = nwg % NXCD, xcd = wgid % NXCD, off = wgid / NXCD; wgid = (xcd < r ? xcd * (q + 1) : r * (q + 1) + (xcd - r) * q) + off; }
        const int nig = WGM * nN, gid = wgid / nig, fm = gid * WGM, gsz = (nM - fm) < WGM ? (nM - fm) : WGM;
        u.pm = fm + ((wgid % nig) % gsz); u.pn = (wgid % nig) / gsz; return true;
    }
    __device__ __forceinline__ void a_ready(const Unit&) const {}
    __device__ __forceinline__ void done(const Unit&) const {}
};

__device__ __forceinline__ unsigned cvt_pk_bf16(float lo, float hi) { unsigned r; asm volatile("v_cvt_pk_bf16_f32 %0, %1, %2" : "=v"(r) : "v"(lo), "v"(hi)); return r; }
typedef float f32x2 __attribute__((ext_vector_type(2)));
__device__ __forceinline__ f32x2 gelu_pk(f32x2 v) {
    const f32x2 av = __builtin_elementwise_abs(v), d = av * 0.2316418882f + 1.0f;
    f32x2 t; t.x = __builtin_amdgcn_rcpf(d.x); t.y = __builtin_amdgcn_rcpf(d.y);
    f32x2 q = t * 0.5307027145f + (-0.7265760135f); q = q * t + 0.7107068705f; q = q * t + (-0.142248368f); q = q * t + 0.127414796f; q = q * t;
    const f32x2 s = (v * v) * (-0.72134752044f);
    f32x2 e; e.x = __builtin_amdgcn_exp2f(s.x); e.y = __builtin_amdgcn_exp2f(s.y);
    const f32x2 m = v * (q * e), r = v - m;
    f32x2 o; o.x = v.x < 0.f ? m.x : r.x; o.y = v.y < 0.f ? m.y : r.y; return o;
}


template <class Epi, class Sched, bool ALIGN_EPI = false, bool SP2 = false, bool F8 = false, int SCA = 127, int SCB = 127>
__device__ __forceinline__ void gemm_phase(PG8_LAS unsigned char* lds, const Gemm g, const Sched& S, const Epi& E) {
    const int tid = threadIdx.x, wid = __builtin_amdgcn_readfirstlane(tid >> 6), lane = tid & 63, wr = wid >> 2, wc = wid & 3, fr = lane & 15, fq = lane >> 4;
    const int K = g.K, nt = K / BK;
    unsigned voffA[2], voffB[2];
#pragma unroll
    for (int i = 0; i < 2; ++i) { int R, C; stage_rc(tid, i, R, C); const int Rb = Epi::PERM ? ((R & ~31) + perm32(R & 31)) : R;
        voffA[i] = (unsigned)(R * K + C) * 2u; voffB[i] = (unsigned)(Rb * K + C) * 2u; }
    const size_t kstep = (size_t)(BK * 2);
    const size_t hstep = (size_t)HALF * K * 2;
    const size_t tstep = 2 * hstep;
    const unsigned ldsw = (unsigned)wid * (unsigned)KBP;
    const int aoff = lds_byte(wr * 64 + fr, fq * 8), boff = lds_byte(wc * 32 + fr, fq * 8);
#define PG8_SA(b, h) (((b) * 2 + (h)) * HTB)
#define PG8_SB(b, h) ((4 + (b) * 2 + (h)) * HTB)
#define PG8_STAGE(bufoff, gbase, voff) do { _Pragma("unroll") for (int _i = 0; _i < 2; ++_i) \
        __builtin_amdgcn_global_load_lds((const unsigned*)((const char*)(gbase) + (voff)[_i]), (PG8_LAS unsigned*)(lds + (bufoff) + ldsw + _i * (8 * KBP)), 16, 0, 0); } while (0)
#define PG8_LDA(dst, b, h) do { if constexpr (F8) { _Pragma("unroll") for (int m = 0; m < 4; ++m) dst##8[m] = cat8(*(const PG8_LAS i32x4*)(lds + PG8_SA(b, h) + aoff + m * (2 * KBP)), *(const PG8_LAS i32x4*)(lds + PG8_SA(b, h) + aoff + m * (2 * KBP) + 64)); } \
        else { _Pragma("unroll") for (int m = 0; m < 4; ++m) _Pragma("unroll") for (int k = 0; k < 2; ++k) dst[m][k] = *(const PG8_LAS bf16x8*)(lds + PG8_SA(b, h) + aoff + m * (2 * KBP) + k * 64); } } while (0)
#define PG8_LDB(dst, b, h) do { if constexpr (F8) { _Pragma("unroll") for (int n = 0; n < 2; ++n) dst##8[n] = cat8(*(const PG8_LAS i32x4*)(lds + PG8_SB(b, h) + boff + n * (2 * KBP)), *(const PG8_LAS i32x4*)(lds + PG8_SB(b, h) + boff + n * (2 * KBP) + 64)); } \
        else { _Pragma("unroll") for (int n = 0; n < 2; ++n) _Pragma("unroll") for (int k = 0; k < 2; ++k) dst[n][k] = *(const PG8_LAS bf16x8*)(lds + PG8_SB(b, h) + boff + n * (2 * KBP) + k * 64); } } while (0)
#define PG8_MMA(ai, bj, At, Bt) do { __builtin_amdgcn_s_setprio(1); _Pragma("unroll") for (int m = 0; m < 4; ++m) _Pragma("unroll") for (int n = 0; n < 2; ++n) { \
        if constexpr (F8) { mfma_scale_f8(acc[ai][bj][m][n], Bt##8[n], At##8[m], sc1); } \
        else { _Pragma("unroll") for (int k = 0; k < 2; ++k) acc[ai][bj][m][n] = __builtin_amdgcn_mfma_f32_16x16x32_bf16(Bt[n][k], At[m][k], acc[ai][bj][m][n], 0, 0, 0); } } \
        __builtin_amdgcn_s_setprio(0); } while (0)
#define PG8_WAIT_V(n) asm volatile("s_waitcnt vmcnt(" #n ")" ::: "memory")
#define PG8_WAIT_L(n) asm volatile("s_waitcnt lgkmcnt(" #n ")" ::: "memory")
#define PG8_BAR __builtin_amdgcn_s_barrier()
#define PG8_SCHED __builtin_amdgcn_sched_barrier(0)
    Unit cur, nxt; int ui = 0;
    if (!S.next(0, cur)) return;
    f32x4 acc[2][2][4][2];
#pragma unroll
    for (int a = 0; a < 2; ++a)
#pragma unroll
        for (int b = 0; b < 2; ++b)
#pragma unroll
            for (int m = 0; m < 4; ++m)
#pragma unroll
                for (int n = 0; n < 2; ++n) acc[a][b][m][n] = (f32x4){0.f, 0.f, 0.f, 0.f};
    bf16x8 At[4][2], B0[2][2], B1[2][2]; i32x8 At8[4], B08[2], B18[2]; int sc1 = 0x7f7f7f7f; asm volatile("" : "+v"(sc1));
    const char* cA = (const char*)g.A + (size_t)cur.pm * tstep; const char* cB = (const char*)g.Bt + (size_t)cur.pn * tstep;
    S.a_ready(cur);
    if constexpr (SP2) {
        PG8_STAGE(PG8_SB(0, 0), cB, voffB); PG8_STAGE(PG8_SB(0, 1), cB + hstep, voffB); PG8_STAGE(PG8_SA(0, 0), cA, voffA); PG8_STAGE(PG8_SA(0, 1), cA + hstep, voffA);
        if (wr == 1) PG8_BAR;
        PG8_WAIT_V(2); PG8_BAR;
        PG8_STAGE(PG8_SB(1, 0), cB + kstep, voffB); PG8_STAGE(PG8_SA(1, 0), cA + kstep, voffA); PG8_STAGE(PG8_SB(1, 1), cB + hstep + kstep, voffB);
        PG8_WAIT_V(6); PG8_BAR;
    } else {
        PG8_STAGE(PG8_SB(0, 0), cB, voffB); PG8_STAGE(PG8_SA(0, 0), cA, voffA); PG8_STAGE(PG8_SB(0, 1), cB + hstep, voffB); PG8_STAGE(PG8_SA(0, 1), cA + hstep, voffA);
        if (wr == 1) PG8_BAR;
        PG8_WAIT_V(4); PG8_BAR;
        PG8_STAGE(PG8_SB(1, 0), cB + kstep, voffB); PG8_STAGE(PG8_SA(1, 0), cA + kstep, voffA); PG8_STAGE(PG8_SB(1, 1), cB + hstep + kstep, voffB);
        PG8_WAIT_V(6); PG8_BAR;
    }
    for (;;) {
        const bool has_next = S.next(ui + 1, nxt);
        const char* nA = has_next ? (const char*)g.A + (size_t)nxt.pm * tstep : cA; const char* nB = has_next ? (const char*)g.Bt + (size_t)nxt.pn * tstep : cB;
#pragma nounroll
        for (int t = 0; t < nt; t += 2) {
            const bool last = (t == nt - 2);
            const char* a1 = cA + (size_t)(t + 1) * kstep;
            const char* a2 = last ? nA : cA + (size_t)(t + 2) * kstep; const char* b2 = last ? nB : cB + (size_t)(t + 2) * kstep;
            const char* a3 = a2 + kstep; const char* b3 = b2 + kstep;
            if (last && has_next) S.a_ready(nxt);
            if constexpr (SP2) {
            PG8_LDB(B0, 0, 0); PG8_LDB(B1, 0, 1); PG8_SCHED; PG8_LDA(At, 0, 0); PG8_STAGE(PG8_SA(1, 1), a1 + hstep, voffA);
            PG8_WAIT_V(8); PG8_WAIT_L(0); PG8_BAR; PG8_MMA(0, 0, At, B0); PG8_MMA(0, 1, At, B1); PG8_BAR; PG8_SCHED;
            PG8_LDA(At, 0, 1); PG8_STAGE(PG8_SB(0, 0), b2, voffB); PG8_STAGE(PG8_SB(0, 1), b2 + hstep, voffB); PG8_STAGE(PG8_SA(0, 0), a2, voffA);
            PG8_WAIT_V(8); PG8_WAIT_L(0); PG8_BAR; PG8_MMA(1, 0, At, B0); PG8_MMA(1, 1, At, B1); PG8_BAR; PG8_SCHED;
            PG8_LDB(B0, 1, 0); PG8_LDB(B1, 1, 1); PG8_SCHED; PG8_LDA(At, 1, 0); PG8_STAGE(PG8_SA(0, 1), a2 + hstep, voffA);
            PG8_WAIT_V(8); PG8_WAIT_L(0); PG8_BAR; PG8_MMA(0, 0, At, B0); PG8_MMA(0, 1, At, B1); PG8_BAR; PG8_SCHED;
            PG8_LDA(At, 1, 1); PG8_STAGE(PG8_SB(1, 0), b3, voffB); PG8_STAGE(PG8_SB(1, 1), b3 + hstep, voffB); PG8_STAGE(PG8_SA(1, 0), a3, voffA);
            PG8_WAIT_V(8); PG8_WAIT_L(0); PG8_BAR; PG8_MMA(1, 0, At, B0); PG8_MMA(1, 1, At, B1); PG8_BAR; PG8_SCHED;
            } else {
            PG8_LDB(B0, 0, 0); PG8_SCHED; PG8_LDA(At, 0, 0); PG8_STAGE(PG8_SA(1, 1), a1 + hstep, voffA);
            PG8_WAIT_L(8); PG8_BAR; PG8_WAIT_L(0); PG8_MMA(0, 0, At, B0); PG8_BAR; PG8_SCHED;
            PG8_LDB(B1, 0, 1); PG8_STAGE(PG8_SB(0, 0), b2, voffB);
            PG8_BAR; PG8_WAIT_L(0); PG8_MMA(0, 1, At, B1); PG8_BAR;
            PG8_LDA(At, 0, 1); PG8_STAGE(PG8_SA(0, 0), a2, voffA);
            PG8_BAR; PG8_WAIT_L(0); PG8_MMA(1, 0, At, B0); PG8_BAR; PG8_SCHED;
            PG8_STAGE(PG8_SB(0, 1), b2 + hstep, voffB);
            PG8_WAIT_V(6); PG8_BAR; PG8_MMA(1, 1, At, B1); PG8_BAR;
            PG8_LDB(B0, 1, 0); PG8_SCHED; PG8_LDA(At, 1, 0); PG8_STAGE(PG8_SA(0, 1), a2 + hstep, voffA);
            PG8_WAIT_L(8); PG8_BAR; PG8_WAIT_L(0); PG8_MMA(0, 0, At, B0); PG8_BAR; PG8_SCHED;
            PG8_LDB(B1, 1, 1); PG8_STAGE(PG8_SB(1, 0), b3, voffB);
            PG8_BAR; PG8_WAIT_L(0); PG8_MMA(0, 1, At, B1); PG8_BAR;
            PG8_LDA(At, 1, 1); PG8_STAGE(PG8_SA(1, 0), a3, voffA);
            PG8_BAR; PG8_WAIT_L(0); PG8_MMA(1, 0, At, B0); PG8_BAR; PG8_SCHED;
            PG8_STAGE(PG8_SB(1, 1), b3 + hstep, voffB);
            PG8_WAIT_V(6); PG8_BAR; PG8_MMA(1, 1, At, B1); PG8_BAR;
            }
        }
        if constexpr (F8) {
            asm volatile("s_nop 15\n\ts_nop 15" ::: "memory");
            _Pragma("unroll") for (int a = 0; a < 2; ++a) _Pragma("unroll") for (int b = 0; b < 2; ++b) _Pragma("unroll") for (int m = 0; m < 4; ++m) _Pragma("unroll") for (int n = 0; n < 2; ++n) asm volatile("" : "+v"(acc[a][b][m][n]));
        }
        if constexpr (ALIGN_EPI) { if (wr == 0) PG8_BAR; }
        if constexpr (!Epi::AFTER_DRAIN) { E(acc, cur, wr, wc, fr, fq); S.done(cur); }
        if (!has_next) break;
#pragma unroll
        for (int a = 0; a < 2; ++a)
#pragma unroll
            for (int b = 0; b < 2; ++b)
#pragma unroll
                for (int m = 0; m < 4; ++m)
#pragma unroll
                    for (int n = 0; n < 2; ++n) acc[a][b][m][n] = (f32x4){0.f, 0.f, 0.f, 0.f};
        cur = nxt; cA = nA; cB = nB; ++ui;
        if constexpr (ALIGN_EPI) { if (wr == 1) PG8_BAR; }
    }
    PG8_WAIT_V(0);
    if constexpr (!ALIGN_EPI) { if (wr == 0) PG8_BAR; }
    PG8_BAR;
    if constexpr (Epi::AFTER_DRAIN) { E.fused(acc, cur, wr, wc, fr, fq, lds, wid, lane); S.done(cur); }
#undef PG8_SA
#undef PG8_SB
#undef PG8_STAGE
#undef PG8_LDA
#undef PG8_LDB
#undef PG8_MMA
#undef PG8_WAIT_V
#undef PG8_WAIT_L
#undef PG8_BAR
#undef PG8_SCHED
}
template <class Epi, class Sched, bool F8 = false, int SCA = 127, int SCB = 127>
__device__ __forceinline__ void gemm_phase_gather(PG8_LAS unsigned char* lds, const Gemm g, const Sched& S, const Epi& E) {
    const int tid = threadIdx.x, wid = __builtin_amdgcn_readfirstlane(tid >> 6), lane = tid & 63, wr = wid >> 2, wc = wid & 3, fr = lane & 15, fq = lane >> 4;
    constexpr bool ALIGN_EPI = true, SP2 = true;
    const int K = g.K, nt = K / BK;
    unsigned voffA[2], voffB[2]; int rowA[2];
#pragma unroll
    for (int i = 0; i < 2; ++i) { int R, C; stage_rc(tid, i, R, C); const int Rb = Epi::PERM ? ((R & ~31) + perm32(R & 31)) : R;
        voffA[i] = (unsigned)C * 2u; rowA[i] = R; voffB[i] = (unsigned)(Rb * K + C) * 2u; }
    const size_t kstep = (size_t)(BK * 2);
    const size_t hstep = (size_t)HALF * K * 2;
    const size_t tstep = 2 * hstep;
    const unsigned ldsw = (unsigned)wid * (unsigned)KBP;
    const int aoff = lds_byte(wr * 64 + fr, fq * 8), boff = lds_byte(wc * 32 + fr, fq * 8);
#define PG8_SA(b, h) (((b) * 2 + (h)) * HTB)
#define PG8_SB(b, h) ((4 + (b) * 2 + (h)) * HTB)
#define PG8_STAGE(bufoff, gbase, voff) do { _Pragma("unroll") for (int _i = 0; _i < 2; ++_i) \
        __builtin_amdgcn_global_load_lds((const unsigned*)((const char*)(gbase) + (voff)[_i]), (PG8_LAS unsigned*)(lds + (bufoff) + ldsw + _i * (8 * KBP)), 16, 0, 0); } while (0)
#define PG8_STAGE_A(bufoff, gbase, o0, o1) do { \
        __builtin_amdgcn_global_load_lds((const unsigned*)((const char*)(gbase) + (o0)), (PG8_LAS unsigned*)(lds + (bufoff) + ldsw), 16, 0, 0); \
        __builtin_amdgcn_global_load_lds((const unsigned*)((const char*)(gbase) + (o1)), (PG8_LAS unsigned*)(lds + (bufoff) + ldsw + 8 * KBP), 16, 0, 0); } while (0)
#define PG8_GOFF(dst, u) do { int ix_[2][2], tv_[2][2]; bool ok_[2][2];   \
        _Pragma("unroll") for (int h_ = 0; h_ < 2; ++h_) _Pragma("unroll") for (int i_ = 0; i_ < 2; ++i_) ix_[h_][i_] = S.a_idx(u, 128 * h_ + rowA[i_], ok_[h_][i_]); \
        __builtin_amdgcn_sched_barrier(0); \
        _Pragma("unroll") for (int h_ = 0; h_ < 2; ++h_) _Pragma("unroll") for (int i_ = 0; i_ < 2; ++i_) tv_[h_][i_] = S.a_tab()[ix_[h_][i_]]; \
        __builtin_amdgcn_sched_barrier(0); \
        _Pragma("unroll") for (int h_ = 0; h_ < 2; ++h_) _Pragma("unroll") for (int i_ = 0; i_ < 2; ++i_) dst[h_][i_] = (unsigned)S.a_fix(tv_[h_][i_], ok_[h_][i_]) * (unsigned)(K * 2) + voffA[i_]; } while (0)
#define PG8_LDA(dst, b, h) do { if constexpr (F8) { _Pragma("unroll") for (int m = 0; m < 4; ++m) dst##8[m] = cat8(*(const PG8_LAS i32x4*)(lds + PG8_SA(b, h) + aoff + m * (2 * KBP)), *(const PG8_LAS i32x4*)(lds + PG8_SA(b, h) + aoff + m * (2 * KBP) + 64)); } \
        else { _Pragma("unroll") for (int m = 0; m < 4; ++m) _Pragma("unroll") for (int k = 0; k < 2; ++k) dst[m][k] = *(const PG8_LAS bf16x8*)(lds + PG8_SA(b, h) + aoff + m * (2 * KBP) + k * 64); } } while (0)
#define PG8_LDB(dst, b, h) do { if constexpr (F8) { _Pragma("unroll") for (int n = 0; n < 2; ++n) dst##8[n] = cat8(*(const PG8_LAS i32x4*)(lds + PG8_SB(b, h) + boff + n * (2 * KBP)), *(const PG8_LAS i32x4*)(lds + PG8_SB(b, h) + boff + n * (2 * KBP) + 64)); } \
        else { _Pragma("unroll") for (int n = 0; n < 2; ++n) _Pragma("unroll") for (int k = 0; k < 2; ++k) dst[n][k] = *(const PG8_LAS bf16x8*)(lds + PG8_SB(b, h) + boff + n * (2 * KBP) + k * 64); } } while (0)
#define PG8_MMA(ai, bj, At, Bt) do { __builtin_amdgcn_s_setprio(1); _Pragma("unroll") for (int m = 0; m < 4; ++m) _Pragma("unroll") for (int n = 0; n < 2; ++n) { \
        if constexpr (F8) { mfma_scale_f8(acc[ai][bj][m][n], Bt##8[n], At##8[m], sc1); } \
        else { _Pragma("unroll") for (int k = 0; k < 2; ++k) acc[ai][bj][m][n] = __builtin_amdgcn_mfma_f32_16x16x32_bf16(Bt[n][k], At[m][k], acc[ai][bj][m][n], 0, 0, 0); } } \
        __builtin_amdgcn_s_setprio(0); } while (0)
#define PG8_WAIT_V(n) asm volatile("s_waitcnt vmcnt(" #n ")" ::: "memory")
#define PG8_WAIT_L(n) asm volatile("s_waitcnt lgkmcnt(" #n ")" ::: "memory")
#define PG8_BAR __builtin_amdgcn_s_barrier()
#define PG8_SCHED __builtin_amdgcn_sched_barrier(0)
    Unit cur, nxt; int ui = 0;
    if (!S.next(0, cur)) return;
    f32x4 acc[2][2][4][2];
#pragma unroll
    for (int a = 0; a < 2; ++a)
#pragma unroll
        for (int b = 0; b < 2; ++b)
#pragma unroll
            for (int m = 0; m < 4; ++m)
#pragma unroll
                for (int n = 0; n < 2; ++n) acc[a][b][m][n] = (f32x4){0.f, 0.f, 0.f, 0.f};
    bf16x8 At[4][2], B0[2][2], B1[2][2]; i32x8 At8[4], B08[2], B18[2]; int sc1 = 0x7f7f7f7f; asm volatile("" : "+v"(sc1));
    const char* const cA = (const char*)g.A; const char* cB = (const char*)g.Bt + (size_t)cur.pn * tstep;
    unsigned gc[2][2], gn[2][2];
    S.a_ready(cur); PG8_GOFF(gc, cur);
    if constexpr (SP2) {
        PG8_STAGE(PG8_SB(0, 0), cB, voffB); PG8_STAGE(PG8_SB(0, 1), cB + hstep, voffB); PG8_STAGE_A(PG8_SA(0, 0), cA, gc[0][0], gc[0][1]); PG8_STAGE_A(PG8_SA(0, 1), cA, gc[1][0], gc[1][1]);
        if (wr == 1) PG8_BAR;
        PG8_WAIT_V(2); PG8_BAR;
        PG8_STAGE(PG8_SB(1, 0), cB + kstep, voffB); PG8_STAGE_A(PG8_SA(1, 0), cA + kstep, gc[0][0], gc[0][1]); PG8_STAGE(PG8_SB(1, 1), cB + hstep + kstep, voffB);
        PG8_WAIT_V(6); PG8_BAR;
    }
    for (;;) {
        const bool has_next = S.next(ui + 1, nxt);
        const char* nB = has_next ? (const char*)g.Bt + (size_t)nxt.pn * tstep : cB;
        if (has_next) { PG8_GOFF(gn, nxt); } else { _Pragma("unroll") for (int h_ = 0; h_ < 2; ++h_) _Pragma("unroll") for (int i_ = 0; i_ < 2; ++i_) gn[h_][i_] = gc[h_][i_]; }
#pragma nounroll
        for (int t = 0; t < nt; t += 2) {
            const bool last = (t == nt - 2);
            const char* a1 = cA + (size_t)(t + 1) * kstep;
            const char* a2 = last ? cA : cA + (size_t)(t + 2) * kstep; const char* b2 = last ? nB : cB + (size_t)(t + 2) * kstep;
            const unsigned g200 = last ? gn[0][0] : gc[0][0], g201 = last ? gn[0][1] : gc[0][1], g210 = last ? gn[1][0] : gc[1][0], g211 = last ? gn[1][1] : gc[1][1];
            const char* a3 = a2 + kstep; const char* b3 = b2 + kstep;
            if (last && has_next) S.a_ready(nxt);
            if constexpr (SP2) {
            PG8_LDB(B0, 0, 0); PG8_LDB(B1, 0, 1); PG8_SCHED; PG8_LDA(At, 0, 0); PG8_STAGE_A(PG8_SA(1, 1), a1, gc[1][0], gc[1][1]);
            PG8_WAIT_V(8); PG8_WAIT_L(0); PG8_BAR; PG8_MMA(0, 0, At, B0); PG8_MMA(0, 1, At, B1); PG8_BAR; PG8_SCHED;
            PG8_LDA(At, 0, 1); PG8_STAGE(PG8_SB(0, 0), b2, voffB); PG8_STAGE(PG8_SB(0, 1), b2 + hstep, voffB); PG8_STAGE_A(PG8_SA(0, 0), a2, g200, g201);
            PG8_WAIT_V(8); PG8_WAIT_L(0); PG8_BAR; PG8_MMA(1, 0, At, B0); PG8_MMA(1, 1, At, B1); PG8_BAR; PG8_SCHED;
            PG8_LDB(B0, 1, 0); PG8_LDB(B1, 1, 1); PG8_SCHED; PG8_LDA(At, 1, 0); PG8_STAGE_A(PG8_SA(0, 1), a2, g210, g211);
            PG8_WAIT_V(8); PG8_WAIT_L(0); PG8_BAR; PG8_MMA(0, 0, At, B0); PG8_MMA(0, 1, At, B1); PG8_BAR; PG8_SCHED;
            PG8_LDA(At, 1, 1); PG8_STAGE(PG8_SB(1, 0), b3, voffB); PG8_STAGE(PG8_SB(1, 1), b3 + hstep, voffB); PG8_STAGE_A(PG8_SA(1, 0), a3, g200, g201);
            PG8_WAIT_V(8); PG8_WAIT_L(0); PG8_BAR; PG8_MMA(1, 0, At, B0); PG8_MMA(1, 1, At, B1); PG8_BAR; PG8_SCHED;
            }
        }
        if constexpr (F8) {
            asm volatile("s_nop 15\n\ts_nop 15" ::: "memory");
            _Pragma("unroll") for (int a = 0; a < 2; ++a) _Pragma("unroll") for (int b = 0; b < 2; ++b) _Pragma("unroll") for (int m = 0; m < 4; ++m) _Pragma("unroll") for (int n = 0; n < 2; ++n) asm volatile("" : "+v"(acc[a][b][m][n]));
        }
        if constexpr (ALIGN_EPI) { if (wr == 0) PG8_BAR; }
        if constexpr (!Epi::AFTER_DRAIN) { E(acc, cur, wr, wc, fr, fq); S.done(cur); }
        if (!has_next) break;
#pragma unroll
        for (int a = 0; a < 2; ++a)
#pragma unroll
            for (int b = 0; b < 2; ++b)
#pragma unroll
                for (int m = 0; m < 4; ++m)
#pragma unroll
                    for (int n = 0; n < 2; ++n) acc[a][b][m][n] = (f32x4){0.f, 0.f, 0.f, 0.f};
        cur = nxt; cB = nB; ++ui;
#pragma unroll
        for (int h_ = 0; h_ < 2; ++h_)
#pragma unroll
            for (int i_ = 0; i_ < 2; ++i_) gc[h_][i_] = gn[h_][i_];
        if constexpr (ALIGN_EPI) { if (wr == 1) PG8_BAR; }
    }
    PG8_WAIT_V(0);
    if constexpr (!ALIGN_EPI) { if (wr == 0) PG8_BAR; }
    PG8_BAR;
    if constexpr (Epi::AFTER_DRAIN) { E.fused(acc, cur, wr, wc, fr, fq, lds, wid, lane); S.done(cur); }
#undef PG8_SA
#undef PG8_SB
#undef PG8_STAGE
#undef PG8_STAGE_A
#undef PG8_GOFF
#undef PG8_LDA
#undef PG8_LDB
#undef PG8_MMA
#undef PG8_WAIT_V
#undef PG8_WAIT_L
#undef PG8_BAR
#undef PG8_SCHED
}
}

namespace att {
constexpr int D = 128;
constexpr float THR = 8.f;
constexpr bool WSKIP = false;
constexpr float SCALE = 0.08838834764831845f;
constexpr int NW = 8, QBLK = 32, KVBLK = 64, QB = NW * QBLK;
constexpr int SHM_V = KVBLK * D * 2, SHM_K = KVBLK * D * 2;
constexpr int ATT_LDS_BYTES = 2 * SHM_V + 2 * SHM_K + NW * 64 * 4;
typedef short bf16x8 __attribute__((ext_vector_type(8)));
typedef short s16x4 __attribute__((ext_vector_type(4)));
typedef float f32x16 __attribute__((ext_vector_type(16)));
typedef float f32x4 __attribute__((ext_vector_type(4)));
typedef unsigned u32x4 __attribute__((ext_vector_type(4)));
template <class A, class Bt> struct same_t { static constexpr bool v = false; };
template <class A> struct same_t<A, A> { static constexpr bool v = true; };

#define KSWZ(row, colB) ((row) * 256 + ((colB) ^ (((row) & 7) << 4)))
#define SBAR() __builtin_amdgcn_sched_barrier(0)
__device__ __forceinline__ int v_st(int k, int c) { const int kk = (k & ~0xC) | ((k & 4) << 1) | ((k & 8) >> 1); return ((kk >> 3) * 4 + (c >> 5)) * 512 + ((kk & 7) * 32 + (c & 31)) * 2; }
__device__ __forceinline__ int v_rd_base(int lane) { return ((lane & 3) << 3) | (((lane >> 2) & 3) << 6) | (((lane >> 4) & 1) << 5) | (((lane >> 5) & 1) << 8); }
constexpr int v_rd_off(int d0, int ks, int half) { return d0 * 512 + ks * 4096 + half * 2048; }
__device__ __forceinline__ int crow(int r, int hi) { return (r & 3) + 8 * (r >> 2) + 4 * hi; }
__device__ __forceinline__ unsigned cvtpk(float lo, float hi) {
    unsigned r; asm volatile("v_cvt_pk_bf16_f32 %0, %1, %2" : "=v"(r) : "v"(lo), "v"(hi)); return r;
}
__device__ __forceinline__ bf16x8 pack8(f32x4 a, f32x4 b) {
    u32x4 w = {cvtpk(a[0], a[1]), cvtpk(a[2], a[3]), cvtpk(b[0], b[1]), cvtpk(b[2], b[3])};
    return *reinterpret_cast<bf16x8*>(&w);
}
template <class T> __device__ __forceinline__ bf16x8 load8(const T* p) {
    if constexpr (same_t<T, float>::v) { return pack8(*(const f32x4*)p, *(const f32x4*)(p + 4)); }
    else { return *reinterpret_cast<const bf16x8*>(p); }
}
__device__ __forceinline__ void mask_tile(f32x16& p0, f32x16& p1, int dq, unsigned W) {
    const float NEG = -__builtin_inff();
#pragma unroll
    for (int r = 0; r < 16; ++r) {
        const int c = (r & 3) + 8 * (r >> 2);
        if ((unsigned)(dq - c) >= W) p0[r] = NEG;
        if ((unsigned)(dq - c - 32) >= W) p1[r] = NEG;
    }
}
__device__ __forceinline__ void partialSM(f32x16& p0, f32x16& p1, float& m_reg, float& mn, float& alpha) {
    float pmax = p0[0]; for (int r = 1; r < 16; ++r) pmax = fmaxf(pmax, p0[r]); for (int r = 0; r < 16; ++r) pmax = fmaxf(pmax, p1[r]);
    { auto rr = __builtin_amdgcn_permlane32_swap(__float_as_uint(pmax), __float_as_uint(pmax), false, false);
      pmax = fmaxf(__uint_as_float(rr[0]), __uint_as_float(rr[1])); }
    constexpr float C2 = 1.4426950408889634f * SCALE;
    if (__builtin_expect(__all((pmax - m_reg) * SCALE <= THR), 1)) { mn = m_reg; alpha = 1.f; }
    else { mn = fmaxf(m_reg, pmax); alpha = __builtin_amdgcn_exp2f((m_reg - mn) * C2); m_reg = mn; }
    const float mnL = -mn * C2;
    for (int r = 0; r < 16; ++r) p0[r] = fmaf(p0[r], C2, mnL); for (int r = 0; r < 16; ++r) p1[r] = fmaf(p1[r], C2, mnL);
    for (int r = 0; r < 16; ++r) p0[r] = __builtin_amdgcn_exp2f(p0[r]);
}
__device__ __forceinline__ void finishSM(f32x16& p0, f32x16& p1, float alpha, float& l_reg, bf16x8& pa0, bf16x8& pa1, bf16x8& pa2, bf16x8& pa3) {
    for (int r = 0; r < 16; ++r) p1[r] = __builtin_amdgcn_exp2f(p1[r]);
    float ps = 0; for (int r = 0; r < 16; ++r) ps += p0[r]; for (int r = 0; r < 16; ++r) ps += p1[r];
    { auto rr = __builtin_amdgcn_permlane32_swap(__float_as_uint(ps), __float_as_uint(ps), false, false);
      ps = __uint_as_float(rr[0]) + __uint_as_float(rr[1]); }
    l_reg = l_reg * alpha + ps;
#define PK4(P, B_, OUT) do { unsigned a0 = cvtpk(P[B_+0], P[B_+1]), a1 = cvtpk(P[B_+2], P[B_+3]);                          \
        unsigned b0 = cvtpk(P[B_+4], P[B_+5]), b1 = cvtpk(P[B_+6], P[B_+7]);                                             \
        auto r0 = __builtin_amdgcn_permlane32_swap(a0, b0, false, false); auto r1 = __builtin_amdgcn_permlane32_swap(a1, b1, false, false); \
        u32x4 w = {r0[0], r1[0], r0[1], r1[1]}; OUT = *reinterpret_cast<bf16x8*>(&w); } while (0)
    PK4(p0, 0, pa0); PK4(p0, 8, pa1); PK4(p1, 0, pa2); PK4(p1, 8, pa3);
#undef PK4
}
template <int KB, bool SK>
__device__ __forceinline__ void qkt(f32x16& p0, f32x16& p1, const char* K_lds, int r32, int hi, const bf16x8* qr, bool act) {
    if (SK && !act) { const float NEG = -__builtin_inff();
#pragma unroll
        for (int r = 0; r < 16; ++r) { p0[r] = NEG; p1[r] = NEG; } return; }
    p0 = f32x16{}; p1 = f32x16{};
    const char* kb[4];
#pragma unroll
    for (int dd = 0; dd < 4; ++dd) kb[dd] = K_lds + KB * SHM_K + KSWZ(r32, (dd * 16 + hi * 8) * 2);
#pragma unroll
    for (int d0 = 0; d0 < 8; ++d0) { const char* a = kb[d0 & 3] + (d0 >> 2) * 128;
        bf16x8 b0 = *reinterpret_cast<const bf16x8*>(a);
        bf16x8 b1 = *reinterpret_cast<const bf16x8*>(a + 32 * 256);
        p0 = __builtin_amdgcn_mfma_f32_32x32x16_bf16(b0, qr[d0], p0, 0, 0, 0);
        p1 = __builtin_amdgcn_mfma_f32_32x32x16_bf16(b1, qr[d0], p1, 0, 0, 0); }
}
template <int VB, bool SK>
__device__ __forceinline__ void pv_tile(f32x16* o, int vb0, bf16x8 pa0, bf16x8 pa1, bf16x8 pa2, bf16x8 pa3, bool act) {
    if (SK && !act) return;
#define TRRD(dst, off) asm volatile("ds_read_b64_tr_b16 %0, %1 offset:%2" : "=&v"(dst) : "v"(vb0), "i"(off) : "memory")
#define PV_D0(d0) do { s16x4 l0, l1, l2, l3, h0, h1, h2, h3; constexpr int b_ = VB * SHM_V + v_rd_off(d0, 0, 0);     \
        TRRD(l0, b_); TRRD(h0, b_ + 2048); TRRD(l1, b_ + 4096); TRRD(h1, b_ + 6144); TRRD(l2, b_ + 8192); TRRD(h2, b_ + 10240); TRRD(l3, b_ + 12288); TRRD(h3, b_ + 14336); \
        asm volatile("s_waitcnt lgkmcnt(0)" ::: "memory"); SBAR();                 \
        o[d0] = __builtin_amdgcn_mfma_f32_32x32x16_bf16(pa0, (bf16x8){l0[0], l0[1], l0[2], l0[3], h0[0], h0[1], h0[2], h0[3]}, o[d0], 0, 0, 0);   \
        o[d0] = __builtin_amdgcn_mfma_f32_32x32x16_bf16(pa1, (bf16x8){l1[0], l1[1], l1[2], l1[3], h1[0], h1[1], h1[2], h1[3]}, o[d0], 0, 0, 0);   \
        o[d0] = __builtin_amdgcn_mfma_f32_32x32x16_bf16(pa2, (bf16x8){l2[0], l2[1], l2[2], l2[3], h2[0], h2[1], h2[2], h2[3]}, o[d0], 0, 0, 0);   \
        o[d0] = __builtin_amdgcn_mfma_f32_32x32x16_bf16(pa3, (bf16x8){l3[0], l3[1], l3[2], l3[3], h3[0], h3[1], h3[2], h3[3]}, o[d0], 0, 0, 0); } while (0)
    PV_D0(0); PV_D0(1); PV_D0(2); PV_D0(3);
#undef PV_D0
#undef TRRD
}

template <class TIn, class TOut> struct BlockRef { const TIn* Q; const TIn* K; const TIn* V; TOut* O; int P0; };
template <class TIn> struct Seam {
    bf16x8 qr[8];
    bf16x8 st_v0, st_v1, st_k0, st_k1; f32x4 sf0, sf1, sf2, sf3;
    f32x4 tq[16];
};
__device__ __forceinline__ int swa_jlo(int P0, int W) { const int lowk = P0 - W + 1; return lowk > 0 ? lowk / KVBLK : 0; }
#define ROW(p, k0, rr) ((p) + (size_t)((k0) + (rr)) * D + sc)
#define VMW() asm volatile("s_waitcnt vmcnt(0)" ::: "memory")
#define VMWN(n) asm volatile("s_waitcnt vmcnt(%0)" :: "i"(n) : "memory")
#define SLOAD_H(Kp, Vp, k0) do { S.st_v0 = load8<TIn>(ROW(Vp, k0, sr)); S.st_v1 = load8<TIn>(ROW(Vp, k0, 32 + sr));              \
                         S.st_k0 = load8<TIn>(ROW(Kp, k0, sr)); S.st_k1 = load8<TIn>(ROW(Kp, k0, 32 + sr)); } while (0)
#define SWRITE_HK(bf) do { *(bf16x8*)(K_lds + (bf) * SHM_K + kws) = S.st_k0; *(bf16x8*)(K_lds + (bf) * SHM_K + kws + 32 * 256) = S.st_k1; } while (0)
#define SWRITE_HV(bf) do { *(bf16x8*)(V_lds + (bf) * SHM_V + vst0) = S.st_v0; *(bf16x8*)(V_lds + (bf) * SHM_V + vst1) = S.st_v1; } while (0)
#define SWRITE_H(bf) do { SWRITE_HV(bf); SWRITE_HK(bf); } while (0)
#define SLOAD_F(p, k0) do { S.sf0 = *(const f32x4*)ROW(p, k0, sr); S.sf1 = *(const f32x4*)(ROW(p, k0, sr) + 4);                \
                            S.sf2 = *(const f32x4*)ROW(p, k0, 32 + sr); S.sf3 = *(const f32x4*)(ROW(p, k0, 32 + sr) + 4); } while (0)
#define SWRITE_KF(bf) do { *(bf16x8*)(K_lds + (bf) * SHM_K + kws) = pack8(S.sf0, S.sf1); *(bf16x8*)(K_lds + (bf) * SHM_K + kws + 32 * 256) = pack8(S.sf2, S.sf3); } while (0)
#define SWRITE_VF(bf) do { *(bf16x8*)(V_lds + (bf) * SHM_V + vst0) = pack8(S.sf0, S.sf1); *(bf16x8*)(V_lds + (bf) * SHM_V + vst1) = pack8(S.sf2, S.sf3); } while (0)
template <class TIn, class TOut>
__device__ __forceinline__ void causal_swa_prime(const BlockRef<TIn, TOut>& cur, int W, char* lds, Seam<TIn>& S) {
    constexpr bool F32 = same_t<TIn, float>::v;
    const int tid = threadIdx.x, wid = __builtin_amdgcn_readfirstlane(tid >> 6), lane = tid & 63, r32 = lane & 31, hi = lane >> 5;
    const int sr = tid >> 4, sc = (tid & 15) * 8, kws = KSWZ(sr, sc * 2); char* K_lds = lds + 2 * SHM_V;
    const int kb0 = swa_jlo(cur.P0, W) * KVBLK;
    for (int d0 = 0; d0 < 8; ++d0) S.qr[d0] = load8<TIn>(cur.Q + (size_t)(wid * QBLK + r32) * D + d0 * 16 + hi * 8);
    if constexpr (F32) { SLOAD_F((const float*)cur.K, kb0); VMW(); SWRITE_KF(0); SBAR(); SLOAD_F((const float*)cur.V, kb0); }
    else { SLOAD_H(cur.K, cur.V, kb0); VMW(); SWRITE_HK(0); }
    __syncthreads();
}
template <class TIn, class TOut, class CV>
__device__ __forceinline__ void causal_swa_block(const BlockRef<TIn, TOut>& cur, const BlockRef<TIn, TOut>& nxt, int skv, int W, char* lds, Seam<TIn>& S, CV& cv) {
    constexpr bool F32 = same_t<TIn, float>::v;
    const int tid = threadIdx.x, wid = __builtin_amdgcn_readfirstlane(tid >> 6), lane = tid & 63, r32 = lane & 31, hi = lane >> 5;
    const int j_lo = swa_jlo(cur.P0, W);
    int j_hi = (cur.P0 + QB - 1) / KVBLK + 1; if (j_hi > skv / KVBLK) j_hi = skv / KVBLK;
    const int NT = j_hi - j_lo;
    const int kbn = swa_jlo(nxt.P0, W) * KVBLK;
    const int qlo = cur.P0 + wid * QBLK, qm = ((qlo + r32) | 63) - 4 * hi;
    char* V_lds = lds; char* K_lds = lds + 2 * SHM_V;
    float* ws = (float*)(lds + 2 * SHM_V + 2 * SHM_K) + wid * 64; float* li_l = ws, * al_l = ws + 32;
    float m_reg = -1e30f, l_reg = 0; f32x16 o[4] = {};
    const int sr = tid >> 4, sc = (tid & 15) * 8, vst0 = v_st(sr, sc), vst1 = v_st(32 + sr, sc), kws = KSWZ(sr, sc * 2);
    const int vb0 = (int)(uintptr_t)V_lds + v_rd_base(lane);
    const TIn* Kh = cur.K; const TIn* Vh = cur.V;
#define RESC(a) do { if (__any((a) < 1.f)) { if (hi == 0) al_l[r32] = (a); asm volatile("s_waitcnt lgkmcnt(0)" ::: "memory");              \
                     for (int d_ = 0; d_ < 4; ++d_) for (int r = 0; r < 16; ++r) o[d_][r] *= al_l[crow(r, hi)]; } } while (0)
#define KBASE(t) ((j_lo + (t)) * KVBLK)
#define ACT(t) (KBASE(t) <= qlo + QBLK - 1 && KBASE(t) + KVBLK - 1 >= qlo - W + 1)
#define MASKT(P0_, P1_, t) do { const int kb_ = KBASE(t); if ((!SK || ACT(t)) && (kb_ > qlo)) mask_tile(P0_, P1_, qm - kb_, (unsigned)W); } while (0)
    constexpr int NQL = F32 ? 16 : 8;
    constexpr bool SK = WSKIP && !F32;
#define SEAM_K0() do { VMWN(NQL); if constexpr (F32) { SWRITE_KF(0); SBAR(); SLOAD_F((const float*)nxt.V, kbn); } else { SWRITE_HK(0); } SBAR(); } while (0)
    f32x16 pA0, pA1, pB0, pB1; float mnA, mnB, alA, alB; bf16x8 pa0, pa1, pa2, pa3;
    if constexpr (F32) { VMW(); SWRITE_VF(0); SBAR(); } else { SWRITE_HV(0); SBAR(); }
    if (NT > 1) { if constexpr (F32) SLOAD_F((const float*)Kh, KBASE(1)); else SLOAD_H(Kh, Vh, KBASE(1)); }
    SBAR(); qkt<0, SK>(pA0, pA1, K_lds, r32, hi, S.qr, ACT(0));
    if constexpr (F32) { if (NT > 1) { VMW(); SWRITE_KF(1); SBAR(); SLOAD_F((const float*)Vh, KBASE(1)); } }
    MASKT(pA0, pA1, 0); partialSM(pA0, pA1, m_reg, mnA, alA);
    if (NT > 1) { VMW(); if constexpr (F32) { SWRITE_VF(1); SBAR(); if (NT > 2) SLOAD_F((const float*)Kh, KBASE(2)); } else SWRITE_H(1); }
    __syncthreads();
#define LBAR() do { asm volatile("s_waitcnt lgkmcnt(0)" ::: "memory"); __builtin_amdgcn_s_barrier(); asm volatile("" ::: "memory"); } while (0)
#define HALF_STEP(PX0, PX1, mnX, alX, PY0, PY1, alY, t, KB, VB, SB) do {                                                      \
        SBAR(); cv.issue(); SBAR(); qkt<KB, SK>(PX0, PX1, K_lds, r32, hi, S.qr, ACT(t));                                             \
        finishSM(PY0, PY1, alY, l_reg, pa0, pa1, pa2, pa3); SBAR();                                                           \
        if ((t) + 1 < NT) { if constexpr (F32) { VMW(); SWRITE_KF(SB); SBAR(); SLOAD_F((const float*)Vh, KBASE((t) + 1)); }  \
                            else { SLOAD_H(Kh, Vh, KBASE((t) + 1)); } SBAR(); }                                               \
        pv_tile<VB, SK>(o, vb0, pa0, pa1, pa2, pa3, ACT((t) - 1)); MASKT(PX0, PX1, (t)); partialSM(PX0, PX1, m_reg, mnX, alX);                                        \
        LBAR();                                                                                                               \
        if ((t) + 1 < NT) { VMW(); if constexpr (F32) { SWRITE_VF(SB); SBAR(); if ((t) + 2 < NT) SLOAD_F((const float*)Kh, KBASE((t) + 2)); } \
                            else { SWRITE_H(SB); } }                                                                          \
        RESC(alX); SBAR(); cv.consume(); SBAR(); LBAR(); } while (0)
    __builtin_amdgcn_s_waitcnt(0x0F70);
    for (int t = 1; t + 1 < NT; t += 2) {
        HALF_STEP(pB0, pB1, mnB, alB, pA0, pA1, alA, t, 1, 0, 0);
        HALF_STEP(pA0, pA1, mnA, alA, pB0, pB1, alB, t + 1, 0, 1, 1);
    }
    const bool even = (NT & 1) == 0;
    if (even) { SBAR(); qkt<1, SK>(pB0, pB1, K_lds, r32, hi, S.qr, ACT(NT - 1)); SBAR(); }
#define QROW(e) (nxt.Q + (size_t)(wid * QBLK + r32) * D + ((e) >> 1) * 16 + hi * 8 + ((e) & 1) * 4)
    if constexpr (F32) { SLOAD_F((const float*)nxt.K, kbn); SBAR();
#pragma unroll
        for (int e = 0; e < 8; ++e) S.tq[e] = *(const f32x4*)QROW(e); }
    else { SLOAD_H(nxt.K, nxt.V, kbn); SBAR();
#pragma unroll
        for (int d0 = 0; d0 < 8; ++d0) S.qr[d0] = load8<TIn>(nxt.Q + (size_t)(wid * QBLK + r32) * D + d0 * 16 + hi * 8); }
    SBAR();
    finishSM(pA0, pA1, alA, l_reg, pa0, pa1, pa2, pa3); SBAR();
    if constexpr (F32) {
#pragma unroll
        for (int e = 8; e < 16; ++e) S.tq[e] = *(const f32x4*)QROW(e); SBAR(); }
#undef QROW
    pv_tile<0, SK>(o, vb0, pa0, pa1, pa2, pa3, ACT(even ? NT - 2 : NT - 1));
    if (even) { MASKT(pB0, pB1, NT - 1); partialSM(pB0, pB1, m_reg, mnB, alB); __syncthreads(); RESC(alB);
        finishSM(pB0, pB1, alB, l_reg, pa0, pa1, pa2, pa3); SBAR(); pv_tile<1, SK>(o, vb0, pa0, pa1, pa2, pa3, ACT(NT - 1)); }
    SBAR(); SEAM_K0();
    if (hi == 0) li_l[r32] = l_reg; asm volatile("s_waitcnt lgkmcnt(0)" ::: "memory");
    float rli[16];
#pragma unroll
    for (int r = 0; r < 16; ++r) rli[r] = __builtin_amdgcn_rcpf(li_l[crow(r, hi)]);
    TOut* Ow = cur.O + (size_t)(wid * QBLK) * D;
#pragma unroll
    for (int r = 0; r < 16; ++r) { const int orow = crow(r, hi);
#pragma unroll
        for (int d0 = 0; d0 < 4; ++d0) { const float v = o[d0][r] * rli[r];
            if constexpr (same_t<TOut, float>::v) { Ow[(size_t)orow * D + d0 * 32 + r32] = v; }
            else { const float vn = __shfl_xor(v, 1);
                   if ((r32 & 1) == 0) *(unsigned*)(Ow + (size_t)orow * D + d0 * 32 + r32) = cvtpk(v, vn); } } }
    if constexpr (F32) {
#pragma unroll
        for (int d0 = 0; d0 < 8; ++d0) S.qr[d0] = pack8(S.tq[2 * d0], S.tq[2 * d0 + 1]); }
    __syncthreads();
#undef RESC
#undef KBASE
#undef ACT
#undef MASKT
#undef SEAM_K0
#undef HALF_STEP
#undef LBAR
}
#undef ROW
#undef VMW
#undef VMWN
#undef SLOAD_H
#undef SWRITE_HK
#undef SWRITE_HV
#undef SWRITE_H
#undef SLOAD_F
#undef SWRITE_KF
#undef SWRITE_VF
}


namespace mk {
using pg8::bf16_t; using pg8::f32x4; using pg8::u32x4; using pg8::Unit;
typedef float f32x2v __attribute__((ext_vector_type(2)));
typedef __bf16 bf16x2v __attribute__((ext_vector_type(2)));
__device__ __forceinline__ unsigned cvt_pk_bf16(float lo, float hi) { const f32x2v v = {lo, hi}; return __builtin_bit_cast(unsigned, __builtin_convertvector(v, bf16x2v)); }
#define LAS __attribute__((address_space(3)))
#define LDS_WAIT() asm volatile("s_waitcnt lgkmcnt(0)" ::: "memory")
#define VM_WAIT() asm volatile("s_waitcnt vmcnt(0)" ::: "memory")
constexpr int D = 2048, NB = 4, S = 4096, NT = NB * S, NE = 32, NA = 2 * NT, MH = 1024;
constexpr int NWAVES = 8, NTHR = 512;
constexpr int LDS_MISC = 147456, LDS_BYTES = 163840;
constexpr int MISC_BAR = 0, MISC_PE = 64, MISC_PS = 64 + 1024, MISC_HIST = 64 + 1024 + 256, MISC_BASE = MISC_HIST + 128, MISC_NP = MISC_BASE + 128, MISC_CNT = MISC_NP + 64;
constexpr int PMAX = NA + NE * 256;
constexpr float EPS = 1e-6f;
typedef unsigned u32x2 __attribute__((ext_vector_type(2)));

struct Args {
    const float *x, *c; const int* pos; const float *ada_w, *ada_b, *nmg, *nfg, *fng, *a_win, *a_wout, *lq1, *lk1, *lq2, *lk2, *a_hg,
        *m_win, *m_cw, *m_cb, *m_gb, *m_hg, *m_wout, *wg, *bg, *we, *be, *wgu, *wdn;
    float* out;
    unsigned* ctl; float* mod; float2* cs;
    bf16_t *Bt_qkv, *Bt_ao, *Bt_min, *Bt_mo, *Bt_rt, *Bt_g, *Bt_gu, *Bt_dn;
    bf16_t* xres; bf16_t* hb; bf16_t* ob; float* proj;
    float* logits; int* eid; float* wts; int* pos_in_e; int* slot; int* counts; int* inv;
    bf16_t *XG, *Hm, *Y;
    bf16_t *Qh, *Kh, *Vh, *Oa;
    unsigned char *hb8, *Hm8, *Bt_gu8, *Bt_dn8;
    unsigned char *Bt_min8, *Bt_mo8, *ob8;
    bf16_t *P3, *Qn, *Kn, *KT, *VT, *HS; float *gates, *GA, *GS;
    int ph_lo, ph_hi;
};

__device__ __forceinline__ unsigned pk4_fp8(float x0, float x1, float x2, float x3) { unsigned w = 0u; w = __builtin_amdgcn_cvt_pk_fp8_f32(x0, x1, w, false); w = __builtin_amdgcn_cvt_pk_fp8_f32(x2, x3, w, true); return w; }
__device__ __forceinline__ float wave_sum(float v) {
#pragma unroll
    for (int o = 1; o < 64; o <<= 1) v += __shfl_xor(v, o);
    return v;
}
__device__ __forceinline__ float silu_f(float v) { return v / (1.f + __expf(-v)); }
__device__ __forceinline__ f32x4 bf4_to_f32(const u32x2 p) { f32x4 r; r[0] = __uint_as_float(p.x << 16); r[1] = __uint_as_float(p.x & 0xffff0000u); r[2] = __uint_as_float(p.y << 16); r[3] = __uint_as_float(p.y & 0xffff0000u); return r; }
__device__ __forceinline__ int opq(int v) { asm volatile("" : "+v"(v)); return v; }

template <bool IN_F32>
struct EpiResid {
    static constexpr bool PERM = true, AFTER_DRAIN = false;
    const void* xin; bf16_t* xout; const float* gt; float sc;
    __device__ __forceinline__ void operator()(const f32x4 (&acc)[2][2][4][2], const Unit& u, int wr, int wc, int fr, int fq) const {
        const int row0 = u.pm * 256 + wr * 64 + fr, col0 = u.pn * 256 + wc * 32 + 8 * fq, b = (u.pm * 256) / S;
        f32x4 gv[2][2];
#pragma unroll
        for (int bj = 0; bj < 2; ++bj)
#pragma unroll
            for (int n = 0; n < 2; ++n) gv[bj][n] = *(const f32x4*)(gt + (size_t)b * 6 * D + col0 + bj * 128 + n * 4) * sc;
#pragma unroll
        for (int ai = 0; ai < 2; ++ai) {
            f32x4 X0[4][2], X1[4][2];
#pragma unroll
            for (int m = 0; m < 4; ++m) { const size_t off = (size_t)(row0 + ai * 128 + m * 16) * D + col0;
#pragma unroll
                for (int bj = 0; bj < 2; ++bj) {
                    if (IN_F32) { X0[m][bj] = *(const f32x4*)((const float*)xin + off + bj * 128); X1[m][bj] = *(const f32x4*)((const float*)xin + off + bj * 128 + 4); }
                    else { const u32x4 p = *(const u32x4*)((const bf16_t*)xin + off + bj * 128); X0[m][bj] = __builtin_bit_cast(f32x4, p); } } }
            __builtin_amdgcn_sched_barrier(0);
#pragma unroll
            for (int m = 0; m < 4; ++m) { const size_t off = (size_t)(row0 + ai * 128 + m * 16) * D + col0;
#pragma unroll
                for (int bj = 0; bj < 2; ++bj) { f32x4 x0, x1;
                    if (IN_F32) { x0 = X0[m][bj]; x1 = X1[m][bj]; }
                    else { const u32x4 p = __builtin_bit_cast(u32x4, X0[m][bj]); x0 = bf4_to_f32((u32x2){p.x, p.y}); x1 = bf4_to_f32((u32x2){p.z, p.w}); }
                    const f32x4 y0 = x0 + gv[bj][0] * acc[ai][bj][m][0], y1 = x1 + gv[bj][1] * acc[ai][bj][m][1];
                    u32x4 w; w.x = cvt_pk_bf16(y0[0], y0[1]); w.y = cvt_pk_bf16(y0[2], y0[3]); w.z = cvt_pk_bf16(y1[0], y1[1]); w.w = cvt_pk_bf16(y1[2], y1[3]);
                    *(u32x4*)(xout + off + bj * 128) = w; } }
            __builtin_amdgcn_sched_barrier(0);
        }
    }
};
struct EpiGU {
    static constexpr bool PERM = true, AFTER_DRAIN = false;
    unsigned char* Hm8;
    __device__ __forceinline__ void operator()(const f32x4 (&acc)[2][2][4][2], const Unit& u, int wr, int wc, int fr, int fq) const {
        const int row0 = u.pm * 256 + wr * 64 + fr, col0 = (u.pn & 7) * 128 + wc * 32 + 8 * fq;
#pragma unroll
        for (int ai = 0; ai < 2; ++ai)
#pragma unroll
            for (int m = 0; m < 4; ++m) { unsigned char* rowp = Hm8 + (size_t)(row0 + ai * 128 + m * 16) * MH + col0;
                float h[8];
#pragma unroll
                for (int n = 0; n < 2; ++n)
#pragma unroll
                    for (int j = 0; j < 4; ++j) { const float g = acc[ai][0][m][n][j] * (1.f / 256.f), up = acc[ai][1][m][n][j] * (1.f / 256.f); h[n * 4 + j] = silu_f(g) * up * 4.f; }
                u32x2 w; w.x = pk4_fp8(h[0], h[1], h[2], h[3]); w.y = pk4_fp8(h[4], h[5], h[6], h[7]);
                *(u32x2*)rowp = w; }
    }
};
struct EpiBf16G {
    static constexpr bool PERM = true, AFTER_DRAIN = false;
    bf16_t* O; int ldc; float sc;
    __device__ __forceinline__ void operator()(const f32x4 (&acc)[2][2][4][2], const Unit& u, int wr, int wc, int fr, int fq) const {
        const int row0 = u.pm * 256 + wr * 64 + fr, col0 = (u.pn & 7) * 256 + wc * 32 + 8 * fq;
#pragma unroll
        for (int ai = 0; ai < 2; ++ai)
#pragma unroll
            for (int m = 0; m < 4; ++m) { bf16_t* rowp = O + (size_t)(row0 + ai * 128 + m * 16) * ldc + col0;
#pragma unroll
                for (int bj = 0; bj < 2; ++bj) { const f32x4 v0 = acc[ai][bj][m][0] * sc, v1 = acc[ai][bj][m][1] * sc;
                    u32x4 w; w.x = cvt_pk_bf16(v0[0], v0[1]); w.y = cvt_pk_bf16(v0[2], v0[3]); w.z = cvt_pk_bf16(v1[0], v1[1]); w.w = cvt_pk_bf16(v1[2], v1[3]);
                    *(u32x4*)(rowp + bj * 128) = w; } }
    }
};
struct GroupedOrder {
    int NP, total, G, c; const LAS int* pe;
    __device__ __forceinline__ bool next(int i, Unit& u) const {
        int p, j;
        if (G == 256) { const int x = c >> 5, l = c & 31, gidx = i * 8 + x; p = gidx * 4 + (l >> 3); j = l & 7; if (p >= NP) return false; }
        else { const long L = (long)i * G + c; if (L >= total) return false; p = (int)(L % NP); j = (int)(L / NP); }
        u.pm = p; u.pn = __builtin_amdgcn_readfirstlane(pe[p]) * 8 + j; return true; }
    __device__ __forceinline__ void a_ready(const Unit&) const {}
    __device__ __forceinline__ void done(const Unit&) const {}
};
struct GroupedOrderG : GroupedOrder {
    const LAS int* ps; const LAS int* cn; const int* inv;
    __device__ __forceinline__ int a_idx(const Unit& u, int r, bool& ok) const { const int e = u.pn >> 3, local = u.pm * 256 + r - ps[e]; ok = local < cn[e]; return e * 32768 + (ok ? local : 0); }
    __device__ __forceinline__ const int* a_tab() const { return inv; }
    __device__ __forceinline__ int a_fix(int t, bool ok) const { return ok ? t : NT; }
};
struct CvItem { const float* W; bf16_t* WT; int ldw, K, n0, s0, k0; };
__device__ __forceinline__ void tr_load(const CvItem& d, int lane, f32x4 (&v)[8]) {
    const int kp = lane >> 3, c4 = lane & 7;
#pragma unroll
    for (int i = 0; i < 8; ++i) v[i] = *(const f32x4*)(d.W + (size_t)(d.k0 + 2 * kp + 16 * (i >> 1) + (i & 1)) * d.ldw + d.s0 + 4 * c4);
}
__device__ __forceinline__ void tr_finish(const CvItem& d, const f32x4 (&v)[8], LAS float* scr, int lane) {
    const int kp = lane >> 3, c4 = lane & 7; LAS unsigned* sp = (LAS unsigned*)scr;
#pragma unroll
    for (int i = 0; i < 4; ++i) { u32x4 o; o.x = cvt_pk_bf16(v[2 * i][0], v[2 * i + 1][0]); o.y = cvt_pk_bf16(v[2 * i][1], v[2 * i + 1][1]); o.z = cvt_pk_bf16(v[2 * i][2], v[2 * i + 1][2]); o.w = cvt_pk_bf16(v[2 * i][3], v[2 * i + 1][3]);
        *(LAS u32x4*)(sp + (kp + 8 * i) * 36 + 4 * c4) = o; }
    LDS_WAIT(); asm volatile("" ::: "memory");
    const int c = lane & 7;
#pragma unroll
    for (int j = 0; j < 4; ++j) { const int n = (lane >> 3) + 8 * j; const LAS unsigned* q = sp + (4 * c) * 36 + n;
        u32x4 o; o.x = q[0]; o.y = q[36]; o.z = q[72]; o.w = q[108];
        *(u32x4*)(d.WT + (size_t)(d.n0 + n) * d.K + d.k0 + 8 * c) = o; }
    LDS_WAIT(); asm volatile("" ::: "memory");
}
__device__ __forceinline__ int gu_src(int n) { const int t = n >> 8, r = n & 255; return r < 128 ? t * 128 + r : 1024 + t * 128 + (r - 128); }

constexpr int CV_I1 = 32 * 192, CV_I2 = 32 * 64, CV_ALL = CV_I1 + CV_I2;
__device__ __forceinline__ CvItem cv_decode(const Args& a, int r) {
    CvItem d;
    if (r < CV_I1) { const int kb = r / 192, nb = r % 192; d.W = a.a_win; d.ldw = 6144; d.WT = a.Bt_qkv; d.K = D; d.n0 = nb * 32; d.s0 = nb * 32; d.k0 = kb * 64; return d; } r -= CV_I1;
    { const int kb = r / 64, nb = r % 64; d.W = a.a_wout; d.ldw = D; d.WT = a.Bt_ao; d.K = D; d.n0 = nb * 32; d.s0 = nb * 32; d.k0 = kb * 64; return d; }
}
__device__ __forceinline__ void conv_items(const Args& a, LAS unsigned char* lds, int w, int nw, int lo, int hi, int wave, int lane) {
    LAS float* scr = (LAS float*)(lds + wave * 16384);
    const int it = lo + w; if (it >= hi) return;
    CvItem d0 = cv_decode(a, it), d1 = d0, d2 = d0; f32x4 v0[8], v1[8], v2[8];
    bool h1 = it + nw < hi, h2 = it + 2 * nw < hi, h0;
    tr_load(d0, lane, v0);
    if (h1) { d1 = cv_decode(a, it + nw); tr_load(d1, lane, v1); }
    if (h2) { d2 = cv_decode(a, it + 2 * nw); tr_load(d2, lane, v2); }
    int nx = it + 3 * nw;
    for (;;) {
        tr_finish(d0, v0, scr, lane); h0 = nx < hi; if (h0) { d0 = cv_decode(a, nx); tr_load(d0, lane, v0); nx += nw; }
        if (!h1) break;
        tr_finish(d1, v1, scr, lane); h1 = nx < hi; if (h1) { d1 = cv_decode(a, nx); tr_load(d1, lane, v1); nx += nw; }
        if (!h2) break;
        tr_finish(d2, v2, scr, lane); h2 = nx < hi; if (h2) { d2 = cv_decode(a, nx); tr_load(d2, lane, v2); nx += nw; }
        if (!h0) break;
    }
}
__device__ __forceinline__ void p0_prologue(const Args& a, LAS unsigned char* lds, int vcu, int G, int tid, int wave, int lane) {
    {
        LAS float* sc = (LAS float*)lds;
        LAS float* red = (LAS float*)(lds + 32768);
        for (int i = tid; i < NB * D; i += NTHR) sc[i] = silu_f(a.c[i]);
        __syncthreads();
        for (int it = vcu; it < 2 * 384; it += G) {
            const int l = it / 384, col = (it % 384) * 32 + (lane & 31), kh = lane >> 5;
            const float* w = a.ada_w + (size_t)l * D * 6 * D + (size_t)(wave * 256 + kh * 128) * 6 * D + col;
            float a0 = 0.f, a1 = 0.f, a2 = 0.f, a3 = 0.f;
#pragma unroll 8
            for (int k = 0; k < 128; ++k) { const float wv = w[(size_t)k * 6 * D]; const int kk = wave * 256 + kh * 128 + k;
                a0 += sc[kk] * wv; a1 += sc[D + kk] * wv; a2 += sc[2 * D + kk] * wv; a3 += sc[3 * D + kk] * wv; }
            a0 += __shfl_xor(a0, 32); a1 += __shfl_xor(a1, 32); a2 += __shfl_xor(a2, 32); a3 += __shfl_xor(a3, 32);
            if (lane < 32) { red[(wave * 4 + 0) * 32 + lane] = a0; red[(wave * 4 + 1) * 32 + lane] = a1; red[(wave * 4 + 2) * 32 + lane] = a2; red[(wave * 4 + 3) * 32 + lane] = a3; }
            __syncthreads();
            if (tid < 128) { const int bb = tid >> 5, cl = tid & 31; float sacc = 0.f;
#pragma unroll
                for (int w8 = 0; w8 < 8; ++w8) sacc += red[(w8 * 4 + bb) * 32 + cl];
                const int cg = (it % 384) * 32 + cl;
                a.mod[((size_t)l * NB + bb) * 6 * D + cg] = sacc + a.ada_b[l * 6 * D + cg]; }
            __syncthreads();
        }
    }
    for (int i = vcu * NTHR + tid; i < NT * 16; i += G * NTHR) {
        const int row = i >> 4, j = i & 15;
        const double ang = (double)a.pos[row] * pow(500000.0, -(double)j / 16.0);
        a.cs[i] = make_float2((float)cos(ang), (float)sin(ang));
    }
    for (int i0 = vcu * NTHR + tid; i0 < 2 * 256 * D; i0 += 8 * G * NTHR) {
        float v[8];
#pragma unroll
        for (int j = 0; j < 8; ++j) { const int i = i0 + j * G * NTHR, ic = i < 2 * 256 * D ? i : 0, k = ic % D, n = (ic / D) % 256, l = ic / (256 * D);
            const float* p = n < 4 ? a.wg + ((size_t)l * D + k) * 4 + n : a.we + ((size_t)l * D + k) * 32 + (n < 36 ? n - 4 : 0);
            const float t = *p; v[j] = n < 36 ? t : 0.f; }
        __builtin_amdgcn_sched_barrier(0);
#pragma unroll
        for (int j = 0; j < 8; ++j) { const int i = i0 + j * G * NTHR; if (i < 2 * 256 * D) a.Bt_rt[i] = (bf16_t)(cvt_pk_bf16(v[j], 0.f) & 0xffffu); }
    }
    if (vcu == 0) for (int i = tid; i < D / 4; i += NTHR) ((unsigned*)(a.hb8 + (size_t)NT * D))[i] = 0u;
    for (int i = vcu * NTHR + tid; i < 16 * D; i += G * NTHR) { const int k = i % D, n = i / D; a.Bt_g[i] = (bf16_t)(cvt_pk_bf16(a.m_win[(size_t)k * 6160 + 6144 + n], 0.f) & 0xffffu); }
    __syncthreads();
    conv_items(a, lds, vcu * NWAVES + wave, G * NWAVES, 0, CV_I1 + CV_I2, wave, lane);
}
template <bool TOLDS>
__device__ __forceinline__ void norm_store(const f32x4 (&v)[8], float ss, const float* g, const float* scv, const float* shv, bf16_t* orow, int lane, LAS unsigned char* yrow) {
    const float rstd = rsqrtf(wave_sum(ss) * (1.f / D) + EPS);
#pragma unroll
    for (int j = 0; j < 8; ++j) { const int c = 4 * lane + 256 * j;
        const f32x4 gg = *(const f32x4*)(g + c), sc = *(const f32x4*)(scv + c), sh = *(const f32x4*)(shv + c);
        const f32x4 y = v[j] * rstd * gg * (sc + 1.f) + sh;
        u32x2 w; w.x = cvt_pk_bf16(y[0], y[1]); w.y = cvt_pk_bf16(y[2], y[3]);
        *(u32x2*)(orow + c) = w;
        if (TOLDS) *(LAS u32x2*)(yrow + c * 2) = w; }
}
constexpr int YT_PITCH = 4112, NR_YT = 0, NR_RED = 16 * YT_PITCH, NR_LG = NR_RED + 24576, NR_TOK = NR_LG + 3072, CG_AN = 100352, CG_SH = CG_AN + 8192;
typedef short bf16x8r __attribute__((ext_vector_type(8)));
template <int NTL>
__device__ __forceinline__ void rows16_logits(const bf16_t* Bt, LAS unsigned char* lds, int wave, int lane, int tid) {
    const int r16 = lane & 15, q4 = lane >> 4;
    f32x4 acc[NTL];
#pragma unroll
    for (int nt = 0; nt < NTL; ++nt) acc[nt] = (f32x4){0.f, 0.f, 0.f, 0.f};
#pragma unroll
    for (int h = 0; h < 2; ++h) { bf16x8r wf[4][NTL];
#pragma unroll
        for (int kk = 0; kk < 4; ++kk)
#pragma unroll
            for (int nt = 0; nt < NTL; ++nt) wf[kk][nt] = *(const bf16x8r*)(Bt + (size_t)(16 * nt + r16) * D + 256 * wave + 32 * (4 * h + kk) + 8 * q4);
        __builtin_amdgcn_sched_barrier(0);
#pragma unroll
        for (int kk = 0; kk < 4; ++kk) { const int k0 = 256 * wave + 32 * (4 * h + kk) + 8 * q4;
            const bf16x8r yf = *(const LAS bf16x8r*)(lds + NR_YT + r16 * YT_PITCH + k0 * 2);
#pragma unroll
            for (int nt = 0; nt < NTL; ++nt) acc[nt] = __builtin_amdgcn_mfma_f32_16x16x32_bf16(wf[kk][nt], yf, acc[nt], 0, 0, 0); }
        __builtin_amdgcn_sched_barrier(0); }
#pragma unroll
    for (int nt = 0; nt < NTL; ++nt) *(LAS f32x4*)(lds + NR_RED + ((wave * NTL + nt) * 64 + lane) * 16) = acc[nt];
    __syncthreads();
    if (tid < NTL * 64) { const int nt = tid >> 6, ln = tid & 63; f32x4 sum = {0.f, 0.f, 0.f, 0.f};
#pragma unroll
        for (int w = 0; w < 8; ++w) sum += *(const LAS f32x4*)(lds + NR_RED + ((w * NTL + nt) * 64 + ln) * 16);
        LAS float* lg = (LAS float*)(lds + NR_LG) + (ln & 15) * 48 + 16 * nt + 4 * (ln >> 4);
        lg[0] = sum[0]; lg[1] = sum[1]; lg[2] = sum[2]; lg[3] = sum[3]; }
    __syncthreads();
}
__device__ __forceinline__ void phase_norm(const float* xin, const float* g, const float* modl, int sh_idx, int sc_idx, bf16_t* hb, int gw, int NGW, int lane) {
    const int RPW = (NT + NGW - 1) / NGW; int m = gw * RPW; const int mend = (m + RPW < NT) ? m + RPW : NT;
    if (m >= mend) return;
    f32x4 A[8], Bv[8], v[8], vn[8]; int bcur = -1;
#pragma unroll
    for (int j = 0; j < 8; ++j) v[j] = *(const f32x4*)(xin + (size_t)m * D + 4 * lane + 256 * j);
    for (;;) {
        const bool more = m + 1 < mend;
        if (more) {
#pragma unroll
            for (int j = 0; j < 8; ++j) vn[j] = *(const f32x4*)(xin + (size_t)(m + 1) * D + 4 * lane + 256 * j); }
        const int b = m / S;
        if (b != bcur) { bcur = b; const float* scv = modl + (size_t)b * 6 * D + sc_idx * D; const float* shv = modl + (size_t)b * 6 * D + sh_idx * D;
#pragma unroll
            for (int j = 0; j < 8; ++j) { const int c = 4 * lane + 256 * j; A[j] = *(const f32x4*)(g + c) * (*(const f32x4*)(scv + c) + 1.f); Bv[j] = *(const f32x4*)(shv + c); } }
        float ss = 0.f;
#pragma unroll
        for (int j = 0; j < 8; ++j) ss += (v[j][0] * v[j][0] + v[j][1] * v[j][1]) + (v[j][2] * v[j][2] + v[j][3] * v[j][3]);
        const float rstd = rsqrtf(wave_sum(ss) * (1.f / D) + EPS);
        bf16_t* orow = hb + (size_t)m * D;
#pragma unroll
        for (int j = 0; j < 8; ++j) { const f32x4 y = v[j] * rstd * A[j] + Bv[j]; u32x2 w; w.x = cvt_pk_bf16(y[0], y[1]); w.y = cvt_pk_bf16(y[2], y[3]); *(u32x2*)(orow + 4 * lane + 256 * j) = w; }
        if (!more) break;
        ++m;
#pragma unroll
        for (int j = 0; j < 8; ++j) v[j] = vn[j];
    }
}
__device__ __forceinline__ void phase_combine_final(const Args& a, const float* modl, const LAS int* ps, int gw, int NGW, int lane) {
    const int RPW = (NT + NGW - 1) / NGW; const int m0 = gw * RPW; const int mend = (m0 + RPW < NT) ? m0 + RPW : NT;
    if (m0 >= mend) return;
    int slot_l = 0; float w_l = 0.f;
    if (lane < 2 * (mend - m0) && lane < 64) { const int as = 2 * m0 + lane; slot_l = ps[a.eid[as]] + a.pos_in_e[as]; w_l = a.wts[as]; }
    f32x4 G4[8], F4[8];
    { const float* gt = modl + (size_t)(m0 / S) * 6 * D + 5 * D;
#pragma unroll
      for (int j = 0; j < 8; ++j) { G4[j] = *(const f32x4*)(gt + 4 * lane + 256 * j); F4[j] = *(const f32x4*)(a.fng + 4 * lane + 256 * j); } }
    for (int m = m0; m < mend; ++m) {
        const int r = m - m0; const int s0 = __shfl(slot_l, 2 * r), s1 = __shfl(slot_l, 2 * r + 1); const float w0 = __shfl(w_l, 2 * r), w1 = __shfl(w_l, 2 * r + 1);
        const bf16_t* xr = a.xres + (size_t)m * D; const bf16_t* y0 = a.Y + (size_t)s0 * D; const bf16_t* y1 = a.Y + (size_t)s1 * D;
        f32x4 v[8]; float ss = 0.f;
#pragma unroll
        for (int j = 0; j < 8; ++j) { const int c = 4 * lane + 256 * j;
            const f32x4 x1 = bf4_to_f32(*(const u32x2*)(xr + c)); const u32x2 p0 = *(const u32x2*)(y0 + c), p1 = *(const u32x2*)(y1 + c);
            f32x4 ya, yb;
            ya[0] = __uint_as_float(p0.x << 16); ya[1] = __uint_as_float(p0.x & 0xffff0000u); ya[2] = __uint_as_float(p0.y << 16); ya[3] = __uint_as_float(p0.y & 0xffff0000u);
            yb[0] = __uint_as_float(p1.x << 16); yb[1] = __uint_as_float(p1.x & 0xffff0000u); yb[2] = __uint_as_float(p1.y << 16); yb[3] = __uint_as_float(p1.y & 0xffff0000u);
            v[j] = x1 + G4[j] * (ya * w0 + yb * w1);
            ss += (v[j][0] * v[j][0] + v[j][1] * v[j][1]) + (v[j][2] * v[j][2] + v[j][3] * v[j][3]); }
        const float rstd = rsqrtf(wave_sum(ss) * (1.f / D) + EPS);
#pragma unroll
        for (int j = 0; j < 8; ++j) *(f32x4*)(a.out + (size_t)m * D + 4 * lane + 256 * j) = v[j] * rstd * F4[j];
    }
}
__device__ __forceinline__ void phase_combine_gates(const Args& a, const float* modl, const float* modn, const float* gnext, const LAS int* ps, LAS unsigned char* lds, int vcu, int G, int tid, int wave, int lane) {
    const int NGRP = NT / 16, GPW = (NGRP + G - 1) / G, g0 = vcu * GPW, gend = (g0 + GPW < NGRP) ? g0 + GPW : NGRP;
    if (g0 >= gend) return;
    int slot_l = 0; float w_l = 0.f;
    if (lane < 4 * (gend - g0)) { const int m = (g0 + (lane >> 2)) * 16 + 2 * wave + ((lane >> 1) & 1), as = 2 * m + (lane & 1); slot_l = ps[a.eid[as]] + a.pos_in_e[as]; w_l = a.wts[as]; }
    const int b = (g0 * 16) / S;
    const float* gt = modl + (size_t)b * 6 * D + 5 * D; const float* scv = modn + (size_t)b * 6 * D + 1 * D; const float* shv = modn + (size_t)b * 6 * D;
    LAS float* anl = (LAS float*)(lds + CG_AN); LAS float* shl = (LAS float*)(lds + CG_SH);
    for (int i = tid; i < D / 4; i += NTHR) { *(LAS f32x4*)(anl + 4 * i) = *(const f32x4*)(gnext + 4 * i) * (*(const f32x4*)(scv + 4 * i) + 1.f); *(LAS f32x4*)(shl + 4 * i) = *(const f32x4*)(shv + 4 * i); }
    __syncthreads();
    u32x2 xc[8], xn[8]; u32x2 pc0[8], pc1[8], pn0[8], pn1[8];
#define CG_LOAD(s_, X, P0, P1) do { const int m_ = (g0 + ((s_) >> 1)) * 16 + 2 * wave + ((s_) & 1), li_ = 2 * (s_); \
        const bf16_t* y0_ = a.Y + (size_t)__shfl(slot_l, li_) * D; const bf16_t* y1_ = a.Y + (size_t)__shfl(slot_l, li_ + 1) * D; \
        _Pragma("unroll") for (int j_ = 0; j_ < 8; ++j_) { const int c_ = 4 * lane + 256 * j_; X[j_] = *(const u32x2*)(a.xres + (size_t)m_ * D + c_); P0[j_] = *(const u32x2*)(y0_ + c_); P1[j_] = *(const u32x2*)(y1_ + c_); } } while (0)
    const int nrow = 2 * (gend - g0);
    CG_LOAD(0, xc, pc0, pc1);
    for (int sq = 0; sq < nrow; ++sq) {
        const int grp = g0 + (sq >> 1), rr = sq & 1, m = grp * 16 + 2 * wave + rr;
        if (sq + 1 < nrow) CG_LOAD(sq + 1, xn, pn0, pn1);
        const float w0 = __shfl(w_l, 2 * sq), w1 = __shfl(w_l, 2 * sq + 1);
        f32x4 v[8]; float ss = 0.f;
#pragma unroll
        for (int jg = 0; jg < 2; ++jg) { f32x4 Gt[4];
#pragma unroll
            for (int jj = 0; jj < 4; ++jj) Gt[jj] = *(const f32x4*)(gt + 4 * lane + 256 * (4 * jg + jj));
            __builtin_amdgcn_sched_barrier(0);
#pragma unroll
            for (int jj = 0; jj < 4; ++jj) { const int j = 4 * jg + jj; const u32x2 p0 = pc0[j], p1 = pc1[j]; f32x4 ya, yb;
                ya[0] = __uint_as_float(p0.x << 16); ya[1] = __uint_as_float(p0.x & 0xffff0000u); ya[2] = __uint_as_float(p0.y << 16); ya[3] = __uint_as_float(p0.y & 0xffff0000u);
                yb[0] = __uint_as_float(p1.x << 16); yb[1] = __uint_as_float(p1.x & 0xffff0000u); yb[2] = __uint_as_float(p1.y << 16); yb[3] = __uint_as_float(p1.y & 0xffff0000u);
                v[j] = bf4_to_f32(xc[j]) + Gt[jj] * (ya * w0 + yb * w1);
                ss += (v[j][0] * v[j][0] + v[j][1] * v[j][1]) + (v[j][2] * v[j][2] + v[j][3] * v[j][3]); } }
        const float rstd = rsqrtf(wave_sum(ss) * (1.f / D) + EPS);
        LAS unsigned char* yrow = lds + NR_YT + (2 * wave + rr) * YT_PITCH;
#pragma unroll
        for (int j = 0; j < 8; ++j) { const int c = 4 * lane + 256 * j; { u32x2 xw; xw.x = cvt_pk_bf16(v[j][0], v[j][1]); xw.y = cvt_pk_bf16(v[j][2], v[j][3]); *(u32x2*)(a.xres + (size_t)m * D + c) = xw; }
            const f32x4 y = v[j] * rstd * (*(const LAS f32x4*)(anl + c)) + *(const LAS f32x4*)(shl + c); u32x2 w; w.x = cvt_pk_bf16(y[0], y[1]); w.y = cvt_pk_bf16(y[2], y[3]);
            *(unsigned*)(a.hb8 + (size_t)m * D + c) = pk4_fp8(y[0] * 4.f, y[1] * 4.f, y[2] * 4.f, y[3] * 4.f); *(LAS u32x2*)(yrow + c * 2) = w; }
#pragma unroll
        for (int j = 0; j < 8; ++j) { xc[j] = xn[j]; pc0[j] = pn0[j]; pc1[j] = pn1[j]; }
        if (rr == 1) {
            __syncthreads();
            rows16_logits<1>(a.Bt_g, lds, wave, lane, tid);
            if (tid < 256) a.gates[(size_t)(grp * 16 + (tid >> 4)) * 16 + (tid & 15)] = ((const LAS float*)(lds + NR_LG))[(tid >> 4) * 48 + (tid & 15)];
        }
    }
#undef CG_LOAD
}
__device__ __forceinline__ void phase_norm_route(const Args& a, int layer, const float* modl, LAS unsigned char* lds, LAS unsigned char* misc, int vcu, int G, int tid, int wave, int lane) {
    LAS int* hist = (LAS int*)(misc + MISC_HIST); LAS int* base = (LAS int*)(misc + MISC_BASE);
    LAS int* tk = (LAS int*)(lds + NR_TOK);
    LAS float* tw = (LAS float*)(lds + NR_TOK + 2048);
    int* counts = a.counts + layer * 64;
    const float* bg = a.bg + layer * 4; const float* be = a.be + layer * 32; const float* g = a.nfg + layer * D;
    if (tid < 32) hist[tid] = 0;
    LAS float* bl = (LAS float*)(lds + NR_TOK + 3072);
    if (tid < 36) bl[tid] = tid < 4 ? bg[tid] : be[tid - 4];
    __syncthreads();
    const int NGRP = NT / 16, GPW = (NGRP + G - 1) / G, g0 = vcu * GPW, gend = (g0 + GPW < NGRP) ? g0 + GPW : NGRP;
    const int ng = gend > g0 ? gend - g0 : 0;
    if (ng > 0) {
        const int b = (g0 * 16) / S;
        f32x4 A[8]; const float* shv = modl + (size_t)b * 6 * D + 3 * D;
        { const float* scv = modl + (size_t)b * 6 * D + 4 * D;
#pragma unroll
          for (int j = 0; j < 8; ++j) { const int c = 4 * lane + 256 * j; A[j] = *(const f32x4*)(g + c) * (*(const f32x4*)(scv + c) + 1.f); } }
        u32x2 x1[2][8];
#define NR_LOAD(grp_) do { _Pragma("unroll") for (int rr_ = 0; rr_ < 2; ++rr_) { const bf16_t* xr_ = a.xres + (size_t)((grp_) * 16 + 2 * wave + rr_) * D; \
        _Pragma("unroll") for (int j_ = 0; j_ < 8; ++j_) x1[rr_][j_] = *(const u32x2*)(xr_ + 4 * lane + 256 * j_); } } while (0)
        NR_LOAD(g0);
        for (int grp = g0; grp < gend; ++grp) {
            const int gi = grp - g0;
#pragma unroll
            for (int rr = 0; rr < 2; ++rr) { const int m = grp * 16 + 2 * wave + rr; float ss = 0.f;
#pragma unroll
                for (int j = 0; j < 8; ++j) { const f32x4 v = bf4_to_f32(x1[rr][j]); ss += (v[0] * v[0] + v[1] * v[1]) + (v[2] * v[2] + v[3] * v[3]); }
                const float rstd = rsqrtf(wave_sum(ss) * (1.f / D) + EPS);
                LAS unsigned char* yrow = lds + NR_YT + (2 * wave + rr) * YT_PITCH;
                f32x4 Bs[8];
#pragma unroll
                for (int j = 0; j < 8; ++j) Bs[j] = *(const f32x4*)(shv + 4 * lane + 256 * j);
                __builtin_amdgcn_sched_barrier(0);
#pragma unroll
                for (int j = 0; j < 8; ++j) { const int c = 4 * lane + 256 * j; const f32x4 y = bf4_to_f32(x1[rr][j]) * rstd * A[j] + Bs[j];
                    u32x2 w; w.x = cvt_pk_bf16(y[0], y[1]); w.y = cvt_pk_bf16(y[2], y[3]); *(LAS u32x2*)(yrow + c * 2) = w;
                    *(unsigned*)(a.hb8 + (size_t)m * D + c) = pk4_fp8(y[0] * 4.f, y[1] * 4.f, y[2] * 4.f, y[3] * 4.f); } }
            if (grp + 1 < gend) NR_LOAD(grp + 1);
            __syncthreads();
            rows16_logits<3>(a.Bt_rt + (size_t)layer * 256 * D, lds, wave, lane, tid);
            if (tid < 16 && gi < 8) {
                const LAS float* lg = (const LAS float*)(lds + NR_LG) + tid * 48;
                float gmax = -INFINITY; int grpi = 0;
#pragma unroll
                for (int i = 0; i < 4; ++i) { const float v = lg[i] + bl[i]; if (v > gmax) { gmax = v; grpi = i; } }
                float gs = 0.f;
#pragma unroll
                for (int i = 0; i < 4; ++i) gs += expf(lg[i] + bl[i] - gmax);
                const float pg = 1.f / gs;
                float v1 = -INFINITY, v2 = -INFINITY; int i1 = 0, i2 = 0;
                for (int i = 0; i < 8; ++i) { const float v = lg[4 + grpi * 8 + i] + bl[4 + grpi * 8 + i];
                    if (v > v1) { v2 = v1; i2 = i1; v1 = v; i1 = i; } else if (v > v2) { v2 = v; i2 = i; } }
                const float ex = expf(v2 - v1); const int e1 = grpi * 8 + i1, e2 = grpi * 8 + i2, sl = gi * 16 + tid;
                tk[sl] = e1; tk[128 + sl] = e2; tk[256 + sl] = atomicAdd((int*)&hist[e1], 1); tk[384 + sl] = atomicAdd((int*)&hist[e2], 1);
                tw[sl] = pg / (1.f + ex); tw[128 + sl] = pg * ex / (1.f + ex);
            }
        }
#undef NR_LOAD
    }
    __syncthreads();
    if (tid < 32) { const int h = hist[tid]; base[tid] = h ? atomicAdd(&counts[tid], h) : 0; }
    __syncthreads();
    if (tid < ng * 16 && tid < 128) { const int t = (g0 + (tid >> 4)) * 16 + (tid & 15), e1 = tk[tid], e2 = tk[128 + tid];
        a.eid[2 * t] = e1; a.eid[2 * t + 1] = e2; a.wts[2 * t] = tw[tid]; a.wts[2 * t + 1] = tw[128 + tid];
        const int p1 = base[e1] + tk[256 + tid], p2 = base[e2] + tk[384 + tid];
        a.pos_in_e[2 * t] = p1; a.pos_in_e[2 * t + 1] = p2; a.inv[e1 * 32768 + p1] = t; a.inv[e2 * 32768 + p2] = t; }
    __syncthreads();
}
__device__ __forceinline__ int moe_tables(const int* counts, LAS unsigned char* misc, int tid) {
    LAS int* ps = (LAS int*)(misc + MISC_PS); LAS int* pe = (LAS int*)(misc + MISC_PE); LAS int* npw = (LAS int*)(misc + MISC_NP);
    __syncthreads();
    if (tid < 64) {
        LAS int* cn = (LAS int*)(misc + MISC_CNT); const int e = tid & 31;
        const int c = __hip_atomic_load(&counts[e], __ATOMIC_RELAXED, __HIP_MEMORY_SCOPE_AGENT), np = (c + 255) >> 8;
        int incl = np;
#pragma unroll
        for (int d = 1; d < 32; d <<= 1) { const int t = __shfl_up(incl, d); if (tid >= d) incl += t; }
        if (tid < 32) { const int start = incl - np; ps[e] = start << 8; cn[e] = c;
            for (int p = 0; p < np; ++p) pe[start + p] = e;
            if (e == NE - 1) { ps[NE] = incl << 8; npw[0] = incl; } }
    }
    __syncthreads();
    return npw[0];
}
struct EpiQKV {
    static constexpr bool PERM = true, AFTER_DRAIN = false;
    bf16_t *Qh, *Kh, *Vh; const float2* cs;
    __device__ __forceinline__ void operator()(const f32x4 (&acc)[2][2][4][2], const Unit& u, int wr, int wc, int fr, int fq) const {
        const int t = u.pn >> 3, hh = u.pn & 7;
        bf16_t* base = Qh + (size_t)t * ((size_t)NT * 2048);
        const int row0 = u.pm * 256 + wr * 64 + fr;
        const bool rope = (t < 2) && (wc == 0);
#pragma unroll
        for (int am = 0; am < 4; ++am) { const int ai = am >> 1;
            f32x4 C[2][4];
            if (rope) {
#pragma unroll
                for (int mm = 0; mm < 2; ++mm) { const f32x4* cp = (const f32x4*)(cs + (size_t)(row0 + ai * 128 + (2 * (am & 1) + mm) * 16) * 16 + 8 * (fq & 1)); C[mm][0] = cp[0]; C[mm][1] = cp[1]; C[mm][2] = cp[2]; C[mm][3] = cp[3]; }
            } else {
#pragma unroll
                for (int mm = 0; mm < 2; ++mm) { C[mm][0] = (f32x4){0.f, 0.f, 0.f, 0.f}; C[mm][1] = C[mm][0]; C[mm][2] = C[mm][0]; C[mm][3] = C[mm][0]; }
            }
            __builtin_amdgcn_sched_barrier(0);
#pragma unroll
            for (int mm = 0; mm < 2; ++mm) { const int m = 2 * (am & 1) + mm, row = row0 + ai * 128 + m * 16;
                const f32x4 c0 = C[mm][0], c1 = C[mm][1], c2 = C[mm][2], c3 = C[mm][3];
#pragma unroll
                for (int bj = 0; bj < 2; ++bj) { f32x4 v0 = acc[ai][bj][m][0], v1 = acc[ai][bj][m][1];
                    if (rope) {
                        const float sg = (fq < 2) ? -1.f : 1.f;
                        float v[8] = {v0[0], v0[1], v0[2], v0[3], v1[0], v1[1], v1[2], v1[3]};
                        const float cc[8] = {c0[0], c0[2], c1[0], c1[2], c2[0], c2[2], c3[0], c3[2]}, sn[8] = {c0[1], c0[3], c1[1], c1[3], c2[1], c2[3], c3[1], c3[3]};
#pragma unroll
                        for (int i = 0; i < 8; ++i) { const float pv = __shfl_xor(v[i], 32); v[i] = v[i] * cc[i] + sg * pv * sn[i]; }
                        v0 = (f32x4){v[0], v[1], v[2], v[3]}; v1 = (f32x4){v[4], v[5], v[6], v[7]};
                    }
                    u32x4 w; w.x = cvt_pk_bf16(v0[0], v0[1]); w.y = cvt_pk_bf16(v0[2], v0[3]); w.z = cvt_pk_bf16(v1[0], v1[1]); w.w = cvt_pk_bf16(v1[2], v1[3]);
                    *(u32x4*)(base + ((size_t)(hh * 2 + bj) * NT + row) * 128 + wc * 32 + 8 * fq) = w; } }
            __builtin_amdgcn_sched_barrier(0);
        }
    }
};
typedef att::BlockRef<bf16_t, bf16_t> ARef;
__device__ __forceinline__ ARef att_ref(const Args& a, int hd, int qb) {
    const int b = hd >> 5, vh = hd & 31, h = vh >> 2, m = (vh >> 1) & 1, half = vh & 1;
    ARef r;
    r.Q = a.Qh + ((size_t)(h * 2 + m) * NT + (size_t)b * S + (size_t)qb * 256) * 128;
    r.K = a.Kh + ((size_t)(h * 2 + m) * NT + (size_t)b * S) * 128;
    r.V = a.Vh + ((size_t)(h * 2 + half) * NT + (size_t)b * S) * 128;
    r.O = a.Oa + ((size_t)((h * 2 + m) * 2 + half) * NT + (size_t)b * S + (size_t)qb * 256) * 128;
    r.P0 = qb * 256;
    return r;
}
__device__ __forceinline__ bool att_pos(int w, int N, int r, int& hd, int& qb) {
    const int p = r * N + ((r & 1) ? (N - 1 - w) : w); if (p >= 2048) return false;
    const int c = p >> 9, pl = p & 511; hd = pl >> 2; qb = 15 - 4 * c - (pl & 3); return true;
}
constexpr int CVA_MIN = 16 * 96, CVA_MO = 16 * 32, CVA_GU = 64 * 512, CVA_DN = 64 * 256, CVA_ITEMS = CVA_MIN + CVA_MO + CVA_GU + CVA_DN, CVA_BUF = 4224;
struct CvaItem { const float* W; unsigned char* WT; int ldw, K, k0, n0, s0; float sc; };
__device__ __forceinline__ CvaItem cva_decode(const Args& a, int r) {
    CvaItem d; d.ldw = 2048; d.K = D; d.sc = 64.f;
    if (r < CVA_MIN) { const int kb = r / 96, nb = r - kb * 96; d.W = a.m_win; d.ldw = 6160; d.WT = a.Bt_min8; d.k0 = kb * 128; d.n0 = nb * 64; d.s0 = d.n0; return d; } r -= CVA_MIN;
    if (r < CVA_MO) { d.W = a.m_wout; d.WT = a.Bt_mo8; d.k0 = (r >> 5) * 128; d.n0 = (r & 31) * 64; d.s0 = d.n0; return d; } r -= CVA_MO;
    if (r < CVA_GU) { const int ex = r >> 9, q = r & 511; d.W = a.wgu + (size_t)ex * D * 2048; d.WT = a.Bt_gu8 + (size_t)ex * 2048 * D; d.k0 = (q >> 5) * 128; d.n0 = (q & 31) * 64; d.s0 = gu_src(d.n0); return d; } r -= CVA_GU;
    { const int ex = r >> 8, q = r & 255; d.W = a.wdn + (size_t)ex * MH * D; d.WT = a.Bt_dn8 + (size_t)ex * D * MH; d.K = MH; d.k0 = (q >> 5) * 128; d.n0 = (q & 31) * 64; d.s0 = d.n0; d.sc = 32.f; return d; }
}
struct AttConv {
    const Args* a; LAS unsigned char* buf;
    int nxt, stride, cur, wave; unsigned bufa;
    __device__ __forceinline__ void issue() {
        if (nxt >= CVA_ITEMS) return;
        const CvaItem d = cva_decode(*a, nxt);
        const int l = opq((int)threadIdx.x) & 63, kq = wave & 3, nh = wave >> 2;
        cur = nxt; nxt += stride;
        const char* base = (const char*)(d.W + (size_t)(d.k0 + 32 * kq) * d.ldw + d.s0 + 32 * nh);
        const unsigned voff = (unsigned)(((l >> 3) * d.ldw + 4 * (l & 7)) * 4);
#pragma unroll
        for (int j = 0; j < 4; ++j) asm volatile("s_mov_b32 m0, %2\n\ts_nop 0\n\tglobal_load_lds_dwordx4 %0, %1" :: "v"(voff), "s"(base + (size_t)(8 * j) * d.ldw * 4), "s"(bufa + j * 1024 + (j >= 2 ? 128 : 0)) : "memory", "m0");
    }
    __device__ __forceinline__ void consume() {
        if (cur < 0) return;
        asm volatile("s_waitcnt vmcnt(0)" ::: "memory");
        const CvaItem d = cva_decode(*a, cur);
        const int l = opq((int)threadIdx.x) & 63, n = l & 31, kh = l >> 5, kq = wave & 3, nh = wave >> 2;
        const LAS float* p = (const LAS float*)(buf + kh * (17 * 128) + n * 4);
        float v[16];
#pragma unroll
        for (int i = 0; i < 16; ++i) v[i] = p[i * 32] * d.sc;
        u32x4 o; o.x = pk4_fp8(v[0], v[1], v[2], v[3]); o.y = pk4_fp8(v[4], v[5], v[6], v[7]); o.z = pk4_fp8(v[8], v[9], v[10], v[11]); o.w = pk4_fp8(v[12], v[13], v[14], v[15]);
        *(u32x4*)(d.WT + (size_t)(d.n0 + 32 * nh + n) * d.K + d.k0 + 32 * kq + 16 * kh) = o;
        asm volatile("s_waitcnt lgkmcnt(0)" ::: "memory");
        cur = -1;
    }
    __device__ __forceinline__ void finish() {
        consume();
        while (nxt < CVA_ITEMS) { issue(); consume(); }
    }
};
__device__ __forceinline__ void phase_attn(const Args& a, char* lds, int w, int N  ) {
    AttConv cv; cv.a = &a; cv.wave = __builtin_amdgcn_readfirstlane((int)threadIdx.x >> 6); cv.buf = (LAS unsigned char*)lds + att::ATT_LDS_BYTES + cv.wave * CVA_BUF; cv.bufa = __builtin_amdgcn_readfirstlane((unsigned)(uintptr_t)lds + att::ATT_LDS_BYTES + cv.wave * CVA_BUF);
    cv.nxt = w; cv.stride = N; cv.cur = -1;
    int hd, qb, r = 0;
    if (att_pos(w, N, 0, hd, qb)) {
        ARef cur = att_ref(a, hd, qb);
        att::Seam<bf16_t> Sm;
        att::causal_swa_prime<bf16_t, bf16_t>(cur, 1 << 30, lds, Sm);
        for (;;) {
            int hn, qn; const bool more = att_pos(w, N, r + 1, hn, qn);
            const ARef nxt = more ? att_ref(a, hn, qn) : cur;
            att::causal_swa_block<bf16_t, bf16_t, AttConv>(cur, nxt, S, 1 << 30, lds, Sm, cv);
            if (!more) break;
            cur = nxt; ++r;
        }
    }
    cv.finish();
}
__device__ __forceinline__ float bf_lo(unsigned u) { return __uint_as_float(u << 16); }
__device__ __forceinline__ float bf_hi(unsigned u) { return __uint_as_float(u & 0xffff0000u); }
typedef unsigned short u16x8 __attribute__((ext_vector_type(8)));
__device__ __forceinline__ void bf8_to_f32(const u32x4 p, float (&f)[8]) {
    f[0] = bf_lo(p.x); f[1] = bf_hi(p.x); f[2] = bf_lo(p.y); f[3] = bf_hi(p.y); f[4] = bf_lo(p.z); f[5] = bf_hi(p.z); f[6] = bf_lo(p.w); f[7] = bf_hi(p.w); }
__device__ __forceinline__ void phase_attn_combine(const Args& a, int gw, int NGW, int lane) {
    float d1 = a.lq1[lane] * a.lk1[lane] + a.lq1[lane + 64] * a.lk1[lane + 64], d2 = a.lq2[lane] * a.lk2[lane] + a.lq2[lane + 64] * a.lk2[lane + 64];
    const float lam = __expf(wave_sum(d1)) - __expf(wave_sum(d2)) + 0.2f;
    const int hh = lane >> 3, e0 = (lane & 7) * 32, half = e0 >> 7, d0 = e0 & 127;
    float gv[32];
#pragma unroll
    for (int i = 0; i < 8; ++i) { const f32x4 t = *(const f32x4*)(a.a_hg + e0 + 4 * i); gv[4 * i] = t[0]; gv[4 * i + 1] = t[1]; gv[4 * i + 2] = t[2]; gv[4 * i + 3] = t[3]; }
    const bf16_t* O0 = a.Oa + ((size_t)((hh * 2 + 0) * 2 + half) * NT) * 128 + d0;
    const bf16_t* O1 = a.Oa + ((size_t)((hh * 2 + 1) * 2 + half) * NT) * 128 + d0;
    const int RPW = (NT + NGW - 1) / NGW; int m = gw * RPW; const int mend = (m + RPW < NT) ? m + RPW : NT;
    if (m >= mend) return;
    u32x4 p0[4], p1[4], n0[4], n1[4];
#pragma unroll
    for (int i = 0; i < 4; ++i) { p0[i] = *(const u32x4*)(O0 + (size_t)m * 128 + 8 * i); p1[i] = *(const u32x4*)(O1 + (size_t)m * 128 + 8 * i); }
    for (;;) {
        const bool more = m + 1 < mend;
        if (more) {
#pragma unroll
            for (int i = 0; i < 4; ++i) { n0[i] = *(const u32x4*)(O0 + (size_t)(m + 1) * 128 + 8 * i); n1[i] = *(const u32x4*)(O1 + (size_t)(m + 1) * 128 + 8 * i); } }
        float o[32]; float ss = 0.f;
#pragma unroll
        for (int i = 0; i < 4; ++i) { float f0[8], f1[8]; bf8_to_f32(p0[i], f0); bf8_to_f32(p1[i], f1);
#pragma unroll
            for (int j = 0; j < 8; ++j) { o[8 * i + j] = f0[j] - lam * f1[j]; ss += o[8 * i + j] * o[8 * i + j]; } }
        ss += __shfl_xor(ss, 1); ss += __shfl_xor(ss, 2); ss += __shfl_xor(ss, 4);
        const float r = rsqrtf(ss * (1.f / 256.f) + EPS) * 0.8f;
        bf16_t* orow = a.ob + (size_t)m * D + hh * 256 + e0;
#pragma unroll
        for (int i = 0; i < 4; ++i) { u32x4 w; w.x = cvt_pk_bf16(o[8 * i] * r * gv[8 * i], o[8 * i + 1] * r * gv[8 * i + 1]); w.y = cvt_pk_bf16(o[8 * i + 2] * r * gv[8 * i + 2], o[8 * i + 3] * r * gv[8 * i + 3]);
            w.z = cvt_pk_bf16(o[8 * i + 4] * r * gv[8 * i + 4], o[8 * i + 5] * r * gv[8 * i + 5]); w.w = cvt_pk_bf16(o[8 * i + 6] * r * gv[8 * i + 6], o[8 * i + 7] * r * gv[8 * i + 7]);
            *(u32x4*)(orow + 8 * i) = w; }
        if (!more) break;
        ++m;
#pragma unroll
        for (int i = 0; i < 4; ++i) { p0[i] = n0[i]; p1[i] = n1[i]; }
    }
}

struct EpiMin {
    static constexpr bool PERM = true, AFTER_DRAIN = false;
    bf16_t* P3;
    __device__ __forceinline__ void operator()(const f32x4 (&acc)[2][2][4][2], const Unit& u, int wr, int wc, int fr, int fq) const {
        const int t = u.pn >> 3; const int row0 = u.pm * 256 + wr * 64 + fr;
        bf16_t* base = P3 + (size_t)t * ((size_t)NT * 2048); const int col0 = (u.pn & 7) * 256 + wc * 32 + 8 * fq;
#pragma unroll
        for (int ai = 0; ai < 2; ++ai)
#pragma unroll
            for (int m = 0; m < 4; ++m) { bf16_t* rowp = base + (size_t)(row0 + ai * 128 + m * 16) * 2048 + col0;
#pragma unroll
                for (int bj = 0; bj < 2; ++bj) { f32x4 v0 = acc[ai][bj][m][0] * (1.f / 256.f), v1 = acc[ai][bj][m][1] * (1.f / 256.f);
                    if (t == 2) {
#pragma unroll
                        for (int j = 0; j < 4; ++j) { v0[j] = 1.f / (1.f + __expf(-v0[j])); v1[j] = 1.f / (1.f + __expf(-v1[j])); } }
                    u32x4 w; w.x = cvt_pk_bf16(v0[0], v0[1]); w.y = cvt_pk_bf16(v0[2], v0[3]); w.z = cvt_pk_bf16(v1[0], v1[1]); w.w = cvt_pk_bf16(v1[2], v1[3]);
                    *(u32x4*)(rowp + bj * 128) = w; } }
    }
};
constexpr int MP_XS = 0, MP_VT = 35840, MP_QS = 69632, MP_KS = 87040, MP_GT = 104448;
__device__ __forceinline__ unsigned pk_lo(unsigned a, unsigned b) { return (a & 0xffffu) | (b << 16); }
__device__ __forceinline__ unsigned pk_hi(unsigned a, unsigned b) { return (a >> 16) | (b & 0xffff0000u); }
__device__ __forceinline__ void phase_mprep(const Args& a, LAS unsigned char* lds, int vcu, int G, int tid) {
    const bf16_t* QKP = a.P3; const bf16_t* VB = a.P3 + (size_t)NT * 2048;
    for (int it = vcu; it < NB * 64; it += G) {
        const int b = it >> 6, ck = it & 63; const size_t row0 = (size_t)b * S + (size_t)ck * 64;
        __syncthreads();
        {
            const int t = tid >> 3, h = tid & 7; LAS float* gt = (LAS float*)(lds + MP_GT);
            const float gi = a.gates[(row0 + t) * 16 + h] + a.m_gb[h], z = a.gates[(row0 + t) * 16 + 8 + h] + a.m_gb[8 + h];
            gt[t * 8 + h] = gi; gt[512 + t * 8 + h] = fminf(z, 0.f) - log1pf(expf(-fabsf(z)));
        }
        __syncthreads();
        if (tid < 8) {
            const int h = tid; float bc = 0.f, cm = -INFINITY; const LAS float* gt = (const LAS float*)(lds + MP_GT);
            float* ga = a.GA + (size_t)((b * 8 + h) * 64 + ck) * 192;
            for (int t = 0; t < 64; ++t) { bc += gt[512 + t * 8 + h]; const float av = gt[t * 8 + h] - bc; cm = fmaxf(cm, av); ga[t] = av; ga[64 + t] = cm; ga[128 + t] = bc; }
            a.GS[(size_t)((b * 8 + h) * 64 + ck) * 2 + 0] = cm; a.GS[(size_t)((b * 8 + h) * 64 + ck) * 2 + 1] = bc;
        }
        for (int h = 0; h < 8; ++h) {
            {
                const int tq = opq(tid); u32x4 xs[5];
#pragma unroll
                for (int i = 0; i < 5; ++i) { const int c0 = tq + 512 * i, c = c0 < 67 * 32 ? c0 : 67 * 32 - 1, r = c >> 5, cc = c & 31; long gr = (long)row0 + r - 3; if (gr < 0) gr = 0;
                    xs[i] = *(const u32x4*)(QKP + (size_t)gr * 2048 + (cc < 16 ? h * 128 + cc * 8 : 1024 + h * 128 + (cc - 16) * 8)); }
                __builtin_amdgcn_sched_barrier(0);
#pragma unroll
                for (int i = 0; i < 5; ++i) { const int c = tq + 512 * i, r = c >> 5, cc = c & 31;
                    if (c < 67 * 32) *(LAS u32x4*)(lds + MP_XS + r * 528 + cc * 16) = (ck * 64 + r - 3 >= 0) ? xs[i] : (u32x4){0u, 0u, 0u, 0u}; }
                __builtin_amdgcn_sched_barrier(0);
            }
            {   const int tq = opq(tid); u32x4 vv[4];
#pragma unroll
                for (int i = 0; i < 4; ++i) { const int c = tq + 512 * i, sr = c >> 5, e16 = c & 31; vv[i] = *(const u32x4*)(VB + (row0 + sr) * 2048 + h * 256 + e16 * 8); }
                __builtin_amdgcn_sched_barrier(0);
#pragma unroll
                for (int i = 0; i < 4; ++i) { const int c = tq + 512 * i, sr = c >> 5, e16 = c & 31; *(LAS u32x4*)(lds + MP_VT + sr * 528 + e16 * 16) = vv[i]; }
            }
            __syncthreads();
            {
                const int cp = tid & 127, rq = tid >> 7; const bool isk = cp >= 64;
                const int col = isk ? 1024 + h * 128 + 2 * (cp - 64) : h * 128 + 2 * cp;
                float w0[4], w1[4];
#pragma unroll
                for (int j = 0; j < 4; ++j) { w0[j] = a.m_cw[j * 2048 + col]; w1[j] = a.m_cw[j * 2048 + col + 1]; }
                const float b0 = a.m_cb[col], b1 = a.m_cb[col + 1];
                const LAS unsigned char* xp = lds + MP_XS + (16 * rq) * 528 + cp * 4;
                float xa[4], xb[4];
#pragma unroll
                for (int j = 0; j < 3; ++j) { const unsigned v = *(const LAS unsigned*)(xp + j * 528); xa[j] = bf_lo(v); xb[j] = bf_hi(v); }
                const float sc = isk ? 0.08838834764831845f : 1.f;
                LAS unsigned char* dst = lds + (isk ? MP_KS : MP_QS) + (isk ? cp - 64 : cp) * 4;
#pragma unroll
                for (int i = 0; i < 16; ++i) { const int t = 16 * rq + i;
                    const unsigned v = *(const LAS unsigned*)(xp + (i + 3) * 528); xa[3] = bf_lo(v); xb[3] = bf_hi(v);
                    float ya = b0 + w0[0] * xa[0] + w0[1] * xa[1] + w0[2] * xa[2] + w0[3] * xa[3];
                    float yb = b1 + w1[0] * xb[0] + w1[1] * xb[1] + w1[2] * xb[2] + w1[3] * xb[3];
                    ya = ya / (1.f + __expf(-ya)) * sc; yb = yb / (1.f + __expf(-yb)) * sc;
                    *(LAS unsigned*)(dst + t * 272) = cvt_pk_bf16(ya, yb);
                    xa[0] = xa[1]; xa[1] = xa[2]; xa[2] = xa[3]; xb[0] = xb[1]; xb[1] = xb[2]; xb[2] = xb[3]; }
            }
            __syncthreads();
            {
#pragma unroll
                for (int i = 0; i < 4; ++i) { const int c = tid + 512 * i, isk = c >> 10, r = (c >> 4) & 63, cc = c & 15;
                    *(u32x4*)(a.Qn + (isk ? (size_t)NT * 1024 : (size_t)0) + (row0 + r) * 1024 + h * 128 + cc * 8) = *(const LAS u32x4*)(lds + (isk ? MP_KS : MP_QS) + r * 272 + cc * 16); }
            }
            if (tid < 256) {
                const int dp = tid & 63, sq = tid >> 6; unsigned w[16];
#pragma unroll
                for (int i = 0; i < 16; ++i) w[i] = *(const LAS unsigned*)(lds + MP_KS + (16 * sq + i) * 272 + dp * 4);
                u32x4* d0p = (u32x4*)(a.KT + ((size_t)((b * 8 + h) * 64 + ck) * 128 + 2 * dp) * 64 + 16 * sq);
                d0p[0] = (u32x4){pk_lo(w[0], w[1]), pk_lo(w[2], w[3]), pk_lo(w[4], w[5]), pk_lo(w[6], w[7])};
                d0p[1] = (u32x4){pk_lo(w[8], w[9]), pk_lo(w[10], w[11]), pk_lo(w[12], w[13]), pk_lo(w[14], w[15])};
                d0p[8] = (u32x4){pk_hi(w[0], w[1]), pk_hi(w[2], w[3]), pk_hi(w[4], w[5]), pk_hi(w[6], w[7])};
                d0p[9] = (u32x4){pk_hi(w[8], w[9]), pk_hi(w[10], w[11]), pk_hi(w[12], w[13]), pk_hi(w[14], w[15])};
            }
            {
                const int ep = tid & 127, sq = tid >> 7; unsigned w[16];
#pragma unroll
                for (int i = 0; i < 16; ++i) w[i] = *(const LAS unsigned*)(lds + MP_VT + (16 * sq + i) * 528 + ep * 4);
                u32x4* d0p = (u32x4*)(a.VT + ((size_t)((b * 8 + h) * 64 + ck) * 256 + 2 * ep) * 64 + 16 * sq);
                d0p[0] = (u32x4){pk_lo(w[0], w[1]), pk_lo(w[2], w[3]), pk_lo(w[4], w[5]), pk_lo(w[6], w[7])};
                d0p[1] = (u32x4){pk_lo(w[8], w[9]), pk_lo(w[10], w[11]), pk_lo(w[12], w[13]), pk_lo(w[14], w[15])};
                d0p[8] = (u32x4){pk_hi(w[0], w[1]), pk_hi(w[2], w[3]), pk_hi(w[4], w[5]), pk_hi(w[6], w[7])};
                d0p[9] = (u32x4){pk_hi(w[8], w[9]), pk_hi(w[10], w[11]), pk_hi(w[12], w[13]), pk_hi(w[14], w[15])};
            }
            __syncthreads();
        }
    }
}

constexpr int ML_QS = 0, ML_KS = 17408, ML_KTS = 34816, ML_VTS = 53248, ML_GL = 60160, ML_PL = 60928, ML_QD = 70144, ML_CL = 87552, ML_MP = 113664, ML_END = 113920;
typedef short bf16x8s __attribute__((ext_vector_type(8)));
__device__ __forceinline__ void phase_mlstm(const Args& a, LAS unsigned char* lds, int vcu, int G, int tid, int wave, int lane) {
    const int r16 = lane & 15, q4 = lane >> 4;
    for (int unit = vcu; unit < 256; unit += G) {
        const int bh = unit >> 3, es = unit & 7, b = bh >> 3, h = bh & 7;
        __syncthreads();
        for (int i = tid; i < 16 * 36; i += NTHR) { const int r = i / 36, c = i % 36; *(LAS unsigned*)(lds + ML_VTS + (32 + r) * 144 + c * 4) = (r == 0) ? 0x3F803F80u : 0u; }
        for (int i = tid; i < 48 * 68; i += NTHR) *(LAS unsigned*)(lds + ML_CL + i * 4) = 0u;
        if (tid < 64) { ((LAS float*)(lds + ML_END))[2 * tid] = a.GS[(size_t)(bh * 64 + tid) * 2]; ((LAS float*)(lds + ML_END))[2 * tid + 1] = a.GS[(size_t)(bh * 64 + tid) * 2 + 1]; }
        __syncthreads();
        if (tid == 0) { float m = 0.f; LAS float* mp = (LAS float*)(lds + ML_MP); const LAS float* gs = (const LAS float*)(lds + ML_END);
            for (int k = 0; k < 64; ++k) { mp[k] = m; m = gs[2 * k + 1] + fmaxf(m, gs[2 * k]); } }
        f32x4 accC[2][3];
#pragma unroll
        for (int i = 0; i < 2; ++i)
#pragma unroll
            for (int j = 0; j < 3; ++j) accC[i][j] = (f32x4){0.f, 0.f, 0.f, 0.f};
        u32x4 rq[2], rk[2], rkt[2], rv, rg, sq[2], sk[2], skt[2], sv, sg;
        rv = (u32x4){0u, 0u, 0u, 0u}; rg = rv; sv = rv; sg = rv;
#define ML_LOAD(k, Q_, K_, KT_, V_, G_) do { const int kc_ = (k) < 64 ? (k) : 63; const size_t row0_ = (size_t)b * S + (size_t)kc_ * 64; const size_t cb_ = (size_t)(bh * 64 + kc_); \
        _Pragma("unroll") for (int i_ = 0; i_ < 2; ++i_) { const int c_ = tid + 512 * i_; \
            Q_[i_] = *(const u32x4*)(a.Qn + (row0_ + (c_ >> 4)) * 1024 + h * 128 + (c_ & 15) * 8); \
            K_[i_] = *(const u32x4*)(a.Kn + (row0_ + (c_ >> 4)) * 1024 + h * 128 + (c_ & 15) * 8); \
            KT_[i_] = *(const u32x4*)(a.KT + cb_ * 8192 + (size_t)c_ * 8); } \
        V_ = *(const u32x4*)(a.VT + cb_ * 16384 + (size_t)es * 2048 + (size_t)(tid & 255) * 8); \
        G_ = *(const u32x4*)(a.GA + cb_ * 192 + (tid & 31) * 4); } while (0)
#define ML_STORE(Q_, K_, KT_, V_, G_) do { \
        _Pragma("unroll") for (int i_ = 0; i_ < 2; ++i_) { const int c_ = tid + 512 * i_; \
            *(LAS u32x4*)(lds + ML_QS + (c_ >> 4) * 272 + (c_ & 15) * 16) = Q_[i_]; \
            *(LAS u32x4*)(lds + ML_KS + (c_ >> 4) * 272 + (c_ & 15) * 16) = K_[i_]; \
            *(LAS u32x4*)(lds + ML_KTS + (c_ >> 3) * 144 + (c_ & 7) * 16) = KT_[i_]; } \
        if (tid < 256) *(LAS u32x4*)(lds + ML_VTS + (tid >> 3) * 144 + (tid & 7) * 16) = V_; \
        if (tid < 48) *(LAS u32x4*)(lds + ML_GL + tid * 16) = G_; } while (0)
        ML_LOAD(0, rq, rk, rkt, rv, rg);
        ML_STORE(rq, rk, rkt, rv, rg);
        __syncthreads();
        ML_LOAD(1, rq, rk, rkt, rv, rg); ML_LOAD(2, sq, sk, skt, sv, sg);
        auto chunk = [&](const int k) __attribute__((always_inline)) {
            const LAS float* ga = (const LAS float*)(lds + ML_GL);
            const float m = ((const LAS float*)(lds + ML_MP))[k];
            const int cur = k & 1;
            if (wave < 4) {
                const int tr = wave, t = 16 * tr + r16;
                const float Mt = fmaxf(m, ga[64 + t]);
                bf16x8s qf[4];
#pragma unroll
                for (int kk = 0; kk < 4; ++kk) qf[kk] = *(const LAS bf16x8s*)(lds + ML_QS + t * 272 + kk * 64 + q4 * 16);
#pragma unroll
                for (int sc = 0; sc < 4; ++sc) {
                    u32x2 w0 = {0u, 0u};
                    if (sc <= tr) {
                        f32x4 s0 = {0.f, 0.f, 0.f, 0.f};
#pragma unroll
                        for (int kk = 0; kk < 4; ++kk) { const bf16x8s kf = *(const LAS bf16x8s*)(lds + ML_KS + (16 * sc + r16) * 272 + kk * 64 + q4 * 16);
                            s0 = __builtin_amdgcn_mfma_f32_16x16x32_bf16(kf, qf[kk], s0, 0, 0, 0); }
                        const f32x4 a0 = *(const LAS f32x4*)(lds + ML_GL + (16 * sc + 4 * q4) * 4);
                        float p[4];
#pragma unroll
                        for (int j = 0; j < 4; ++j) { const int sA = 16 * sc + 4 * q4 + j; p[j] = (sA <= t) ? s0[j] * __expf(a0[j] - Mt) : 0.f; }
                        w0.x = cvt_pk_bf16(p[0], p[1]); w0.y = cvt_pk_bf16(p[2], p[3]);
                    }
                    *(LAS u32x2*)(lds + ML_PL + t * 144 + (16 * sc + 4 * q4) * 2) = w0;
                }
                {
                    const int tq = 16 * tr + (lane >> 2), c0 = (lane & 3) * 32;
                    const float dec = __expf(m - fmaxf(m, ga[64 + tq]));
#pragma unroll
                    for (int i = 0; i < 4; ++i) { const u32x4 v = *(const LAS u32x4*)(lds + ML_QS + tq * 272 + (c0 + 8 * i) * 2); u32x4 o;
                        o.x = cvt_pk_bf16(bf_lo(v.x) * dec, bf_hi(v.x) * dec); o.y = cvt_pk_bf16(bf_lo(v.y) * dec, bf_hi(v.y) * dec);
                        o.z = cvt_pk_bf16(bf_lo(v.z) * dec, bf_hi(v.z) * dec); o.w = cvt_pk_bf16(bf_lo(v.w) * dec, bf_hi(v.w) * dec);
                        *(LAS u32x4*)(lds + ML_QD + tq * 272 + (c0 + 8 * i) * 2) = o; }
                }
                asm volatile("s_waitcnt lgkmcnt(0)" ::: "memory");
                f32x4 o0 = {0.f, 0.f, 0.f, 0.f}, o1 = o0, o2 = o0;
#pragma unroll
                for (int kk = 0; kk < 2; ++kk) {
                    if (kk * 2 <= tr) {
                    const bf16x8s pf = *(const LAS bf16x8s*)(lds + ML_PL + t * 144 + kk * 64 + q4 * 16);
                    const bf16x8s v0 = *(const LAS bf16x8s*)(lds + ML_VTS + (r16) * 144 + kk * 64 + q4 * 16);
                    const bf16x8s v1 = *(const LAS bf16x8s*)(lds + ML_VTS + (16 + r16) * 144 + kk * 64 + q4 * 16);
                    const bf16x8s v2 = *(const LAS bf16x8s*)(lds + ML_VTS + (32 + r16) * 144 + kk * 64 + q4 * 16);
                    o0 = __builtin_amdgcn_mfma_f32_16x16x32_bf16(v0, pf, o0, 0, 0, 0);
                    o1 = __builtin_amdgcn_mfma_f32_16x16x32_bf16(v1, pf, o1, 0, 0, 0);
                    o2 = __builtin_amdgcn_mfma_f32_16x16x32_bf16(v2, pf, o2, 0, 0, 0); }
                }
#pragma unroll
                for (int kk = 0; kk < 4; ++kk) {
                    const bf16x8s qd = *(const LAS bf16x8s*)(lds + ML_QD + t * 272 + kk * 64 + q4 * 16);
                    const bf16x8s c0 = *(const LAS bf16x8s*)(lds + ML_CL + cur * 13056 + (r16) * 272 + kk * 64 + q4 * 16);
                    const bf16x8s c1 = *(const LAS bf16x8s*)(lds + ML_CL + cur * 13056 + (16 + r16) * 272 + kk * 64 + q4 * 16);
                    const bf16x8s c2 = *(const LAS bf16x8s*)(lds + ML_CL + cur * 13056 + (32 + r16) * 272 + kk * 64 + q4 * 16);
                    o0 = __builtin_amdgcn_mfma_f32_16x16x32_bf16(c0, qd, o0, 0, 0, 0);
                    o1 = __builtin_amdgcn_mfma_f32_16x16x32_bf16(c1, qd, o1, 0, 0, 0);
                    o2 = __builtin_amdgcn_mfma_f32_16x16x32_bf16(c2, qd, o2, 0, 0, 0);
                }
                const float den = __shfl(o2[0], r16);
                const float mt = ga[128 + t] + Mt;
                const float inv = 1.f / fmaxf(fabsf(den), __expf(-mt));
                bf16_t* hp = a.HS + ((size_t)b * S + (size_t)k * 64 + t) * 2048 + h * 256 + es * 32 + 4 * q4;
                u32x2 w0, w1; w0.x = cvt_pk_bf16(o0[0] * inv, o0[1] * inv); w0.y = cvt_pk_bf16(o0[2] * inv, o0[3] * inv);
                w1.x = cvt_pk_bf16(o1[0] * inv, o1[1] * inv); w1.y = cvt_pk_bf16(o1[2] * inv, o1[3] * inv);
                *(u32x2*)hp = w0; *(u32x2*)(hp + 16) = w1;
            } else {
                const int dj = wave - 4;
                const float Ml = fmaxf(m, ga[64 + 63]), cd = __expf(m - Ml);
#pragma unroll
                for (int i = 0; i < 2; ++i)
#pragma unroll
                    for (int et = 0; et < 3; ++et) accC[i][et] = accC[i][et] * cd;
#pragma unroll
                for (int kk = 0; kk < 2; ++kk) {
                    const f32x4 aA = *(const LAS f32x4*)(lds + ML_GL + (32 * kk + 8 * q4) * 4), aB = *(const LAS f32x4*)(lds + ML_GL + (32 * kk + 8 * q4 + 4) * 4);
                    float wg[8];
#pragma unroll
                    for (int j = 0; j < 4; ++j) { wg[j] = __expf(aA[j] - Ml); wg[4 + j] = __expf(aB[j] - Ml); }
                    bf16x8s vw[3];
#pragma unroll
                    for (int et = 0; et < 3; ++et) { const u32x4 v = *(const LAS u32x4*)(lds + ML_VTS + (16 * et + r16) * 144 + kk * 64 + q4 * 16); u32x4 o;
                        o.x = cvt_pk_bf16(bf_lo(v.x) * wg[0], bf_hi(v.x) * wg[1]); o.y = cvt_pk_bf16(bf_lo(v.y) * wg[2], bf_hi(v.y) * wg[3]);
                        o.z = cvt_pk_bf16(bf_lo(v.z) * wg[4], bf_hi(v.z) * wg[5]); o.w = cvt_pk_bf16(bf_lo(v.w) * wg[6], bf_hi(v.w) * wg[7]);
                        vw[et] = __builtin_bit_cast(bf16x8s, o); }
#pragma unroll
                    for (int i = 0; i < 2; ++i) { const bf16x8s kf = *(const LAS bf16x8s*)(lds + ML_KTS + (16 * (2 * dj + i) + r16) * 144 + kk * 64 + q4 * 16);
#pragma unroll
                        for (int et = 0; et < 3; ++et) accC[i][et] = __builtin_amdgcn_mfma_f32_16x16x32_bf16(kf, vw[et], accC[i][et], 0, 0, 0); }
                }
#pragma unroll
                for (int i = 0; i < 2; ++i)
#pragma unroll
                    for (int et = 0; et < 3; ++et) { u32x2 w; w.x = cvt_pk_bf16(accC[i][et][0], accC[i][et][1]); w.y = cvt_pk_bf16(accC[i][et][2], accC[i][et][3]);
                        *(LAS u32x2*)(lds + ML_CL + (cur ^ 1) * 13056 + (16 * et + r16) * 272 + (16 * (2 * dj + i) + 4 * q4) * 2) = w; }
            }
        };
        for (int k = 0; k < 64; k += 2) {
            chunk(k);
            __syncthreads();
            ML_STORE(rq, rk, rkt, rv, rg);
            __syncthreads();
            ML_LOAD(k + 3, rq, rk, rkt, rv, rg);
            chunk(k + 1);
            __syncthreads();
            ML_STORE(sq, sk, skt, sv, sg);
            __syncthreads();
            ML_LOAD(k + 4, sq, sk, skt, sv, sg);
        }
#undef ML_LOAD
#undef ML_STORE
    }
}
__device__ __forceinline__ void phase_mnorm(const Args& a, int gw, int NGW, int lane) {
    const bf16_t* SG = a.P3 + (size_t)2 * NT * 2048;
    float gv[32];
#pragma unroll
    for (int i = 0; i < 8; ++i) { const f32x4 t = *(const f32x4*)(a.m_hg + 32 * lane + 4 * i); gv[4 * i] = t[0]; gv[4 * i + 1] = t[1]; gv[4 * i + 2] = t[2]; gv[4 * i + 3] = t[3]; }
    const int RPW = (NT + NGW - 1) / NGW; int m = gw * RPW; const int mend = (m + RPW < NT) ? m + RPW : NT;
    if (m >= mend) return;
    u32x4 p0[4], p1[4], n0[4], n1[4];
#pragma unroll
    for (int i = 0; i < 4; ++i) { p0[i] = *(const u32x4*)(a.HS + (size_t)m * D + 32 * lane + 8 * i); p1[i] = *(const u32x4*)(SG + (size_t)m * D + 32 * lane + 8 * i); }
    for (;;) {
        const bool more = m + 1 < mend;
        if (more) {
#pragma unroll
            for (int i = 0; i < 4; ++i) { n0[i] = *(const u32x4*)(a.HS + (size_t)(m + 1) * D + 32 * lane + 8 * i); n1[i] = *(const u32x4*)(SG + (size_t)(m + 1) * D + 32 * lane + 8 * i); } }
        float o[32], sg[32]; float ss = 0.f;
#pragma unroll
        for (int i = 0; i < 4; ++i) { float f0[8], f1[8]; bf8_to_f32(p0[i], f0); bf8_to_f32(p1[i], f1);
#pragma unroll
            for (int j = 0; j < 8; ++j) { o[8 * i + j] = f0[j]; sg[8 * i + j] = f1[j]; ss += f0[j] * f0[j]; } }
        ss += __shfl_xor(ss, 1); ss += __shfl_xor(ss, 2); ss += __shfl_xor(ss, 4);
        const float r = rsqrtf(ss * (1.f / 256.f) + EPS);
        unsigned char* orow = a.ob8 + (size_t)m * D + 32 * lane;
#pragma unroll
        for (int i = 0; i < 4; ++i) { float y[8];
#pragma unroll
            for (int j = 0; j < 8; ++j) y[j] = o[8 * i + j] * r * gv[8 * i + j] * sg[8 * i + j];
            u32x2 w; w.x = pk4_fp8(y[0] * 8.f, y[1] * 8.f, y[2] * 8.f, y[3] * 8.f); w.y = pk4_fp8(y[4] * 8.f, y[5] * 8.f, y[6] * 8.f, y[7] * 8.f);
            *(u32x2*)(orow + 8 * i) = w; }
        if (!more) break;
        ++m;
#pragma unroll
        for (int i = 0; i < 4; ++i) { p0[i] = n0[i]; p1[i] = n1[i]; }
    }
}

#define XB_TMO      128
#define XB_XCNT(j)  (256  + 64 * (j))
#define XB_XSUB(j)  (1280 + 64 * (j))
#define XB_XGEN(j)  (2304 + 64 * (j))
#define XB_TOP      3328
#define XB_TOPGEN   3392
#define XCD_BAR_WORDS 3456
#define XB_SPIN_CAP (1u << 18)

__device__ __forceinline__ unsigned xb_ld(unsigned* p)              { return __hip_atomic_load(p, __ATOMIC_RELAXED, __HIP_MEMORY_SCOPE_AGENT); }
__device__ __forceinline__ unsigned xb_add(unsigned* p, unsigned v) { return __hip_atomic_fetch_add(p, v, __ATOMIC_RELAXED, __HIP_MEMORY_SCOPE_AGENT); }
__device__ __forceinline__ unsigned xb_xcc_id() { return (unsigned)__builtin_amdgcn_s_getreg((3 << 11) | 20) & 0xFu; }
#define XB_SPIN(cond, bar) do { unsigned _sp = 0; while (cond) { __builtin_amdgcn_s_sleep(1); \
    if ((++_sp & 255u) == 0u) { if (xb_ld(&(bar)[XB_TMO])) break; if (_sp > XB_SPIN_CAP) { atomicAdd(&(bar)[XB_TMO], 1u); break; } } } } while (0)

struct XcdBarrier {
    unsigned* bar; unsigned x;
    volatile LAS unsigned* st;
};

__device__ __forceinline__ XcdBarrier xcd_barrier_post(unsigned* bar, volatile LAS unsigned* st) {
    XcdBarrier b; b.bar = bar; b.x = xb_xcc_id(); b.st = st;
    if (threadIdx.x == 0) (void)xb_add(&bar[XB_XCNT(b.x)], 1u);
    return b;
}
__device__ __forceinline__ void xcd_barrier_complete(unsigned* bar, unsigned x, unsigned& nloc, unsigned& nx) {
    const unsigned G = gridDim.x * gridDim.y * gridDim.z;
    unsigned sum, cnt, mine, sp = 0u;
    for (;;) {
        sum = 0u; cnt = 0u; mine = 0u;
#pragma unroll
        for (unsigned j = 0; j < 16; ++j) { const unsigned c = xb_ld(&bar[XB_XCNT(j)]); sum += c; cnt += (c > 0u) ? 1u : 0u; mine = (j == x) ? c : mine; }
        if (sum == G) break;
        __builtin_amdgcn_s_sleep(1);
        if ((++sp & 255u) == 0u) { if (xb_ld(&bar[XB_TMO])) break; if (sp > XB_SPIN_CAP) { atomicAdd(&bar[XB_TMO], 1u); break; } }
    }
    nloc = mine > 0u ? mine : 1u; nx = cnt > 0u ? cnt : 1u;
}

__device__ __forceinline__ void xcd_barrier(const XcdBarrier& b) {
    asm volatile("s_waitcnt vmcnt(0)" ::: "memory");
    __syncthreads();
    if (threadIdx.x == 0) {
        unsigned* bar = b.bar;
        __builtin_amdgcn_s_waitcnt(0);
        unsigned nloc = b.st[0], nx = b.st[1];
        if (nloc == 0u) { xcd_barrier_complete(bar, b.x, nloc, nx); b.st[0] = nloc; b.st[1] = nx; }
        const unsigned old = xb_add(&bar[XB_XSUB(b.x)], 1u);
        const unsigned gen = old / nloc;
        if (old + 1u == (gen + 1u) * nloc) {
            __builtin_amdgcn_fence(__ATOMIC_RELEASE, "agent");
            asm volatile("s_waitcnt vmcnt(0)" ::: "memory");
            const unsigned og = xb_add(&bar[XB_TOP], 1u);
            const unsigned tg = og / nx;
            if (og + 1u == (tg + 1u) * nx) xb_add(&bar[XB_TOPGEN], 1u);
            else XB_SPIN(xb_ld(&bar[XB_TOPGEN]) == tg, bar);
            __builtin_amdgcn_fence(__ATOMIC_ACQUIRE, "agent");
            xb_add(&bar[XB_XGEN(b.x)], 1u);
            asm volatile("s_waitcnt vmcnt(0)" ::: "memory");
        } else {
            XB_SPIN(xb_ld(&bar[XB_XGEN(b.x)]) == gen, bar);
            __builtin_amdgcn_fence(__ATOMIC_ACQUIRE, "agent");
            asm volatile("s_waitcnt vmcnt(0)" ::: "memory");
        }
    }
    __syncthreads();
}


#ifndef MK_REP_MASK
#define MK_REP_MASK 0u
#endif
__device__ __forceinline__ constexpr int REPS(int k) { return ((MK_REP_MASK >> k) & 1u) ? 2 : 1; }
__global__ void __launch_bounds__(NTHR, 2) mk_fwd(Args a) {
    extern __shared__ __attribute__((aligned(16))) unsigned char lds_raw[];
    LAS unsigned char* lds = (LAS unsigned char*)lds_raw;
    LAS unsigned char* misc = lds + LDS_MISC;
    const int tid = threadIdx.x, lane = tid & 63, wave = __builtin_amdgcn_readfirstlane(tid >> 6);
    const int G = gridDim.x; const int bx = blockIdx.x; const int vcu = (G % 8 == 0) ? (bx % 8) * (G / 8) + bx / 8 : bx;
    const int gw = vcu * NWAVES + wave, NGW = G * NWAVES;
    if (tid < 16) ((LAS unsigned*)(misc + MISC_BAR))[tid] = 0u;
    __syncthreads();
    const int lo = a.ph_lo, hi = a.ph_hi;
    XcdBarrier bar; bar.bar = a.ctl + 4096; bar.x = 0; bar.st = nullptr;
    if (hi - lo > 1) bar = xcd_barrier_post(a.ctl + 4096, (volatile LAS unsigned*)(misc + MISC_BAR));
#define IN(k) (lo <= (k) && (k) < hi)
#define SEAM(k) do { if (IN(k) && IN((k) + 1)) xcd_barrier(bar); } while (0)
    const float* mod0 = a.mod; const float* mod1 = a.mod + (size_t)NB * 6 * D;

#define PH(k) if (IN(k)) _Pragma("unroll") for (int rep_ = 0; rep_ < REPS(k); (REPS(k) > 1 ? __syncthreads() : (void)0, ++rep_))
    PH(0) { p0_prologue(a, lds, vcu, G, opq(tid), wave, opq(lane)); } SEAM(0);
    PH(1) { phase_norm(a.x, a.nmg, mod0, 0, 1, a.hb, gw, NGW, opq(lane)); } SEAM(1);
    PH(2) {
        pg8::Gemm g{a.hb, a.Bt_qkv, NT, 6144, D}; pg8::StaticOrder So; So.init(NT, 6144, G, bx);
        EpiQKV E{a.Qh, a.Kh, a.Vh, a.cs};
        pg8::gemm_phase<EpiQKV, pg8::StaticOrder, true, true>(lds, g, So, E);
    } SEAM(2);
    PH(3) { phase_attn(a, (char*)lds_raw, vcu, G); } SEAM(3);
    PH(4) { phase_attn_combine(a, gw, NGW, opq(lane)); } SEAM(4);
    PH(5) {
        pg8::Gemm g{a.ob, a.Bt_ao, NT, D, D}; pg8::StaticOrder So; So.init(NT, D, G, bx);
        EpiResid<true> E{a.x, a.xres, mod0 + 2 * D, 1.f};
        pg8::gemm_phase<EpiResid<true>, pg8::StaticOrder, true, true>(lds, g, So, E);
    } SEAM(5);
#define MOE_PHASES(P, layer, modl)                                                                                                   \
    PH(P) { phase_norm_route(a, layer, modl, lds, misc, vcu, G, opq(tid), wave, opq(lane)); } SEAM(P);                            \
    PH(P + 1) { const int NP = moe_tables(a.counts + (layer) * 64, misc, tid);                                                    \
        pg8::Gemm g{(const bf16_t*)a.hb8, (const bf16_t*)(a.Bt_gu8 + (size_t)(layer) * NE * 2048 * D), NP * 256, NE * 2048, D / 2};     \
        GroupedOrderG So; So.NP = NP; So.total = NP * 8; So.G = G; So.c = vcu; So.pe = (const LAS int*)(misc + MISC_PE);          \
        So.ps = (const LAS int*)(misc + MISC_PS); So.cn = (const LAS int*)(misc + MISC_CNT); So.inv = a.inv; EpiGU E{a.Hm8};      \
        pg8::gemm_phase_gather<EpiGU, GroupedOrderG, true, 125, 121>(lds, g, So, E); } SEAM(P + 1);                                               \
    PH(P + 2) { const int NP = moe_tables(a.counts + (layer) * 64, misc, tid);                                                    \
        pg8::Gemm g{(const bf16_t*)a.Hm8, (const bf16_t*)(a.Bt_dn8 + (size_t)(layer) * NE * D * MH), NP * 256, NE * 2048, MH / 2};   \
        GroupedOrder So{NP, NP * 8, G, vcu, (const LAS int*)(misc + MISC_PE)}; EpiBf16G E{a.Y, D, 1.f / 128.f};                                \
        pg8::gemm_phase<EpiBf16G, GroupedOrder, true, true, true, 125, 122>(lds, g, So, E); } SEAM(P + 2);
    MOE_PHASES(6, 0, mod0)
    PH(9) { moe_tables(a.counts, misc, tid); phase_combine_gates(a, mod0, mod1, a.nmg + D, (const LAS int*)(misc + MISC_PS), lds, vcu, G, opq(tid), wave, opq(lane)); } SEAM(9);
    PH(10) {
        pg8::Gemm g{(const bf16_t*)a.hb8, (const bf16_t*)a.Bt_min8, NT, 6144, D / 2}; pg8::StaticOrder So; So.init(NT, 6144, G, bx);
        EpiMin E{a.P3};
        pg8::gemm_phase<EpiMin, pg8::StaticOrder, true, true, true>(lds, g, So, E);
    } SEAM(10);
    PH(11) { phase_mprep(a, lds, vcu, G, opq(tid)); } SEAM(11);
    PH(12) { phase_mlstm(a, lds, vcu, G, opq(tid), wave, opq(lane)); } SEAM(12);
    PH(13) { phase_mnorm(a, gw, NGW, opq(lane)); } SEAM(13);
    PH(14) {
        pg8::Gemm g{(const bf16_t*)a.ob8, (const bf16_t*)a.Bt_mo8, NT, D, D / 2}; pg8::StaticOrder So; So.init(NT, D, G, bx);
        EpiResid<false> E{a.xres, a.xres, mod1 + 2 * D, 1.f / 512.f};
        pg8::gemm_phase<EpiResid<false>, pg8::StaticOrder, true, true, true>(lds, g, So, E);
    } SEAM(14);
    MOE_PHASES(15, 1, mod1)
    PH(18) { moe_tables(a.counts + 64, misc, tid); phase_combine_final(a, mod1, (const LAS int*)(misc + MISC_PS), gw, NGW, opq(lane)); }
#undef PH
#undef IN
#undef SEAM
}
}

extern "C" void kernel_launch(void* const* d_in, const int* in_sizes, int n_in, void* d_out, int out_size, void* d_ws, size_t ws_size, hipStream_t st) {
    using namespace mk;
    static int grid = 0;
    if (grid == 0) {
        int dev = 0, cus = 0;
        if (hipGetDevice(&dev) != hipSuccess || hipDeviceGetAttribute(&cus, hipDeviceAttributeMultiprocessorCount, dev) != hipSuccess || cus <= 0) cus = 256;
        (void)hipFuncSetAttribute((const void*)mk_fwd, hipFuncAttributeMaxDynamicSharedMemorySize, LDS_BYTES);
        int per_cu = 0; (void)hipOccupancyMaxActiveBlocksPerMultiprocessor(&per_cu, (const void*)mk_fwd, NTHR, LDS_BYTES);
        (void)hipGetLastError();
        grid = cus;
    }
    Args a{};
    a.x = (const float*)d_in[0]; a.c = (const float*)d_in[1]; a.pos = (const int*)d_in[2];
    a.ada_w = (const float*)d_in[3]; a.ada_b = (const float*)d_in[4]; a.nmg = (const float*)d_in[5]; a.nfg = (const float*)d_in[6]; a.fng = (const float*)d_in[7];
    a.a_win = (const float*)d_in[8]; a.a_wout = (const float*)d_in[9];
    a.lq1 = (const float*)d_in[10]; a.lk1 = (const float*)d_in[11]; a.lq2 = (const float*)d_in[12]; a.lk2 = (const float*)d_in[13]; a.a_hg = (const float*)d_in[14];
    a.m_win = (const float*)d_in[15]; a.m_cw = (const float*)d_in[16]; a.m_cb = (const float*)d_in[17]; a.m_gb = (const float*)d_in[18]; a.m_hg = (const float*)d_in[19]; a.m_wout = (const float*)d_in[20];
    a.wg = (const float*)d_in[21]; a.bg = (const float*)d_in[22]; a.we = (const float*)d_in[23]; a.be = (const float*)d_in[24]; a.wgu = (const float*)d_in[25]; a.wdn = (const float*)d_in[26];
    a.out = (float*)d_out;
    char* w = (char*)d_ws; size_t off = 0;
    auto alloc = [&](size_t bytes) { void* p = w + off; off += (bytes + 4095) & ~(size_t)4095; return p; };
    a.ctl = (unsigned*)alloc(1 << 20);
    a.counts = (int*)(a.ctl + 65536);
    a.mod = (float*)alloc((size_t)2 * NB * 6 * D * 4);
    a.cs = (float2*)alloc((size_t)NT * 16 * 8);
    a.Bt_qkv = (bf16_t*)alloc((size_t)6144 * D * 2); a.Bt_ao = (bf16_t*)alloc((size_t)D * D * 2); a.Bt_min = nullptr; a.Bt_mo = nullptr; a.Bt_min8 = (unsigned char*)alloc((size_t)6144 * D); a.Bt_mo8 = (unsigned char*)alloc((size_t)D * D);
    a.Bt_rt = (bf16_t*)alloc((size_t)2 * 256 * D * 2); a.Bt_g = (bf16_t*)alloc((size_t)16 * D * 2); a.Bt_gu = nullptr; a.Bt_dn = nullptr;
    a.Bt_gu8 = (unsigned char*)alloc((size_t)2 * NE * 2048 * D); a.Bt_dn8 = (unsigned char*)alloc((size_t)2 * NE * D * MH); a.hb8 = (unsigned char*)alloc((size_t)(NT + 1) * D);
    a.xres = (bf16_t*)alloc((size_t)NT * D * 2); a.hb = (bf16_t*)alloc((size_t)(NT + 1) * D * 2); a.ob = (bf16_t*)alloc((size_t)NT * D * 2); a.ob8 = (unsigned char*)a.ob;

    a.logits = nullptr; a.eid = (int*)alloc((size_t)NA * 4); a.wts = (float*)alloc((size_t)NA * 4); a.pos_in_e = (int*)alloc((size_t)NA * 4); a.slot = nullptr; a.inv = (int*)alloc((size_t)NE * 32768 * 4);
    a.Qh = (bf16_t*)alloc((size_t)3 * NT * 2048 * 2); a.Kh = a.Qh + (size_t)NT * 2048; a.Vh = a.Kh + (size_t)NT * 2048; a.Oa = (bf16_t*)alloc((size_t)NT * 4096 * 2);
    a.P3 = (bf16_t*)alloc((size_t)3 * NT * 2048 * 2); a.Qn = (bf16_t*)alloc((size_t)2 * NT * 1024 * 2); a.Kn = a.Qn + (size_t)NT * 1024;
    a.KT = (bf16_t*)alloc((size_t)NT * 1024 * 2); a.VT = (bf16_t*)alloc((size_t)NT * 2048 * 2); a.HS = (bf16_t*)alloc((size_t)NT * 2048 * 2);
    a.gates = (float*)alloc((size_t)NT * 16 * 4); a.GA = (float*)alloc((size_t)32 * 64 * 192 * 4); a.GS = (float*)alloc((size_t)32 * 64 * 2 * 4);
    a.XG = nullptr; a.Hm = nullptr; a.Hm8 = (unsigned char*)alloc((size_t)PMAX * MH); a.Y = (bf16_t*)alloc((size_t)PMAX * D * 2);
    if (off > ws_size) return;

    (void)hipMemsetAsync(a.ctl, 0, 1 << 20, st);
    auto run = [&](int lo, int hi) { a.ph_lo = lo; a.ph_hi = hi; hipLaunchKernelGGL(mk_fwd, dim3(grid), dim3(NTHR), LDS_BYTES, st, a); };
#ifndef MK_N_LAUNCHES
#define MK_N_LAUNCHES 1
#endif
#if MK_N_LAUNCHES == 1
    run(0, 19);
#else
    for (int p = 0; p <= 18; ++p) run(p, p + 1);
#endif
}
```

```cpp
#include <hip/hip_runtime.h>
#include <math.h>
#include <stdint.h>


namespace pg8 {
#define PG8_LAS __attribute__((address_space(3)))
typedef unsigned short bf16_t;
typedef short bf16x8 __attribute__((ext_vector_type(8)));
typedef float f32x4 __attribute__((ext_vector_type(4)));
typedef unsigned u32x4 __attribute__((ext_vector_type(4)));
constexpr int BM = 256, BK = 64, HALF = 128, KBP = 1088  , HTB = 16 * KBP  , STAGE_BYTES = 8 * HTB, NXCD = 8, WGM = 8;

__host__ __device__ __forceinline__ int lds_byte(int r, int c) { const int ch = c >> 3, p = (ch & 4) | ((ch & 3) ^ ((r >> 1) & 3)); return (r >> 3) * KBP + (r & 7) * 128 + p * 16 + (c & 7) * 2; }
__host__ __device__ __forceinline__ void stage_rc(int tid, int i, int& R, int& C) { const int g = (tid >> 6) + 8 * i, l = tid & 63, rr = l >> 3, p = l & 7, ch = (p & 4) | ((p & 3) ^ ((rr >> 1) & 3)); R = 8 * g + rr; C = ch * 8; }
__host__ __device__ __forceinline__ int perm32(int rho) { const int n = rho >> 4, i = rho & 15; return 8 * (i >> 2) + 4 * n + (i & 3); }

typedef int i32x4 __attribute__((ext_vector_type(4)));
typedef int i32x8 __attribute__((ext_vector_type(8)));
typedef int i32x2 __attribute__((ext_vector_type(2)));
__device__ __forceinline__ i32x8 cat8(i32x4 l, i32x4 h) { return __builtin_shufflevector(l, h, 0, 1, 2, 3, 4, 5, 6, 7); }
__device__ __forceinline__ void mfma_scale_f8(f32x4& acc, i32x8 b, i32x8 a, int sc) {
    asm volatile("v_mfma_scale_f32_16x16x128_f8f6f4 %0, %1, %2, %0, %3, %3 op_sel_hi:[0,0,0]" : "+v"(acc) : "v"(b), "v"(a), "v"(sc));
}
struct Unit { int pm, pn; };
struct Gemm { const bf16_t* A; const bf16_t* Bt; int M, N, K; };

struct StaticOrder {
    int nM, nN, nwg, G, c;
    __host__ __device__ void init(int M, int N, int G_, int c_) { nM = M / BM; nN = N / BM; nwg = nM * nN; G = G_; c = c_; }
    __host__ __device__ bool next(int i, Unit& u) const {
        const long L = (long)i * G + c; if (L >= nwg) return false;
        int wgid = (int)L; { const int q = nwg / NXCD, r = nwg % NXCD, xcd = wgid % NXCD, off = wgid / NXCD; wgid = (xcd < r ? xcd * (q + 1) : r * (q + 1) + (xcd - r) * q) + off; }
        const int nig = WGM * nN, gid = wgid / nig, fm = gid * WGM, gsz = (nM - fm) < WGM ? (nM - fm) : WGM;
        u.pm = fm + ((wgid % nig) % gsz); u.pn = (wgid % nig) / gsz; return true;
    }
    __device__ __forceinline__ void a_ready(const Unit&) const {}
    __device__ __forceinline__ void done(const Unit&) const {}
};

__device__ __forceinline__ unsigned cvt_pk_bf16(float lo, float hi) { unsigned r; asm volatile("v_cvt_pk_bf16_f32 %0, %1, %2" : "=v"(r) : "v"(lo), "v"(hi)); return r; }
typedef float f32x2 __attribute__((ext_vector_type(2)));
__device__ __forceinline__ f32x2 gelu_pk(f32x2 v) {
    const f32x2 av = __builtin_elementwise_abs(v), d = av * 0.2316418882f + 1.0f;
    f32x2 t; t.x = __builtin_amdgcn_rcpf(d.x); t.y = __builtin_amdgcn_rcpf(d.y);
    f32x2 q = t * 0.5307027145f + (-0.7265760135f); q = q * t + 0.7107068705f; q = q * t + (-0.142248368f); q = q * t + 0.127414796f; q = q * t;
    const f32x2 s = (v * v) * (-0.72134752044f);
    f32x2 e; e.x = __builtin_amdgcn_exp2f(s.x); e.y = __builtin_amdgcn_exp2f(s.y);
    const f32x2 m = v * (q * e), r = v - m;
    f32x2 o; o.x = v.x < 0.f ? m.x : r.x; o.y = v.y < 0.f ? m.y : r.y; return o;
}


template <class Epi, class Sched, bool ALIGN_EPI = false, bool SP2 = false, bool F8 = false, int SCA = 127, int SCB = 127>
__device__ __forceinline__ void gemm_phase(PG8_LAS unsigned char* lds, const Gemm g, const Sched& S, const Epi& E) {
    const int tid = threadIdx.x, wid = __builtin_amdgcn_readfirstlane(tid >> 6), lane = tid & 63, wr = wid >> 2, wc = wid & 3, fr = lane & 15, fq = lane >> 4;
    const int K = g.K, nt = K / BK;
    unsigned voffA[2], voffB[2];
#pragma unroll
    for (int i = 0; i < 2; ++i) { int R, C; stage_rc(tid, i, R, C); const int Rb = Epi::PERM ? ((R & ~31) + perm32(R & 31)) : R;
        voffA[i] = (unsigned)(R * K + C) * 2u; voffB[i] = (unsigned)(Rb * K + C) * 2u; }
    const size_t kstep = (size_t)(BK * 2);
    const size_t hstep = (size_t)HALF * K * 2;
    const size_t tstep = 2 * hstep;
    const unsigned ldsw = (unsigned)wid * (unsigned)KBP;
    const int aoff = lds_byte(wr * 64 + fr, fq * 8), boff = lds_byte(wc * 32 + fr, fq * 8);
#define PG8_SA(b, h) (((b) * 2 + (h)) * HTB)
#define PG8_SB(b, h) ((4 + (b) * 2 + (h)) * HTB)
#define PG8_STAGE(bufoff, gbase, voff) do { _Pragma("unroll") for (int _i = 0; _i < 2; ++_i) \
        __builtin_amdgcn_global_load_lds((const unsigned*)((const char*)(gbase) + (voff)[_i]), (PG8_LAS unsigned*)(lds + (bufoff) + ldsw + _i * (8 * KBP)), 16, 0, 0); } while (0)
#define PG8_LDA(dst, b, h) do { if constexpr (F8) { _Pragma("unroll") for (int m = 0; m < 4; ++m) dst##8[m] = cat8(*(const PG8_LAS i32x4*)(lds + PG8_SA(b, h) + aoff + m * (2 * KBP)), *(const PG8_LAS i32x4*)(lds + PG8_SA(b, h) + aoff + m * (2 * KBP) + 64)); } \
        else { _Pragma("unroll") for (int m = 0; m < 4; ++m) _Pragma("unroll") for (int k = 0; k < 2; ++k) dst[m][k] = *(const PG8_LAS bf16x8*)(lds + PG8_SA(b, h) + aoff + m * (2 * KBP) + k * 64); } } while (0)
#define PG8_LDB(dst, b, h) do { if constexpr (F8) { _Pragma("unroll") for (int n = 0; n < 2; ++n) dst##8[n] = cat8(*(const PG8_LAS i32x4*)(lds + PG8_SB(b, h) + boff + n * (2 * KBP)), *(const PG8_LAS i32x4*)(lds + PG8_SB(b, h) + boff + n * (2 * KBP) + 64)); } \
        else { _Pragma("unroll") for (int n = 0; n < 2; ++n) _Pragma("unroll") for (int k = 0; k < 2; ++k) dst[n][k] = *(const PG8_LAS bf16x8*)(lds + PG8_SB(b, h) + boff + n * (2 * KBP) + k * 64); } } while (0)
#define PG8_MMA(ai, bj, At, Bt) do { __builtin_amdgcn_s_setprio(1); _Pragma("unroll") for (int m = 0; m < 4; ++m) _Pragma("unroll") for (int n = 0; n < 2; ++n) { \
        if constexpr (F8) { mfma_scale_f8(acc[ai][bj][m][n], Bt##8[n], At##8[m], sc1); } \
        else { _Pragma("unroll") for (int k = 0; k < 2; ++k) acc[ai][bj][m][n] = __builtin_amdgcn_mfma_f32_16x16x32_bf16(Bt[n][k], At[m][k], acc[ai][bj][m][n], 0, 0, 0); } } \
        __builtin_amdgcn_s_setprio(0); } while (0)
#define PG8_WAIT_V(n) asm volatile("s_waitcnt vmcnt(" #n ")" ::: "memory")
#define PG8_WAIT_L(n) asm volatile("s_waitcnt lgkmcnt(" #n ")" ::: "memory")
#define PG8_BAR __builtin_amdgcn_s_barrier()
#define PG8_SCHED __builtin_amdgcn_sched_barrier(0)
    Unit cur, nxt; int ui = 0;
    if (!S.next(0, cur)) return;
    f32x4 acc[2][2][4][2];
#pragma unroll
    for (int a = 0; a < 2; ++a)
#pragma unroll
        for (int b = 0; b < 2; ++b)
#pragma unroll
            for (int m = 0; m < 4; ++m)
#pragma unroll
                for (int n = 0; n < 2; ++n) acc[a][b][m][n] = (f32x4){0.f, 0.f, 0.f, 0.f};
    bf16x8 At[4][2], B0[2][2], B1[2][2]; i32x8 At8[4], B08[2], B18[2]; int sc1 = 0x7f7f7f7f; asm volatile("" : "+v"(sc1));
    const char* cA = (const char*)g.A + (size_t)cur.pm * tstep; const char* cB = (const char*)g.Bt + (size_t)cur.pn * tstep;
    S.a_ready(cur);
    if constexpr (SP2) {
        PG8_STAGE(PG8_SB(0, 0), cB, voffB); PG8_STAGE(PG8_SB(0, 1), cB + hstep, voffB); PG8_STAGE(PG8_SA(0, 0), cA, voffA); PG8_STAGE(PG8_SA(0, 1), cA + hstep, voffA);
        if (wr == 1) PG8_BAR;
        PG8_WAIT_V(2); PG8_BAR;
        PG8_STAGE(PG8_SB(1, 0), cB + kstep, voffB); PG8_STAGE(PG8_SA(1, 0), cA + kstep, voffA); PG8_STAGE(PG8_SB(1, 1), cB + hstep + kstep, voffB);
        PG8_WAIT_V(6); PG8_BAR;
    } else {
        PG8_STAGE(PG8_SB(0, 0), cB, voffB); PG8_STAGE(PG8_SA(0, 0), cA, voffA); PG8_STAGE(PG8_SB(0, 1), cB + hstep, voffB); PG8_STAGE(PG8_SA(0, 1), cA + hstep, voffA);
        if (wr == 1) PG8_BAR;
        PG8_WAIT_V(4); PG8_BAR;
        PG8_STAGE(PG8_SB(1, 0), cB + kstep, voffB); PG8_STAGE(PG8_SA(1, 0), cA + kstep, voffA); PG8_STAGE(PG8_SB(1, 1), cB + hstep + kstep, voffB);
        PG8_WAIT_V(6); PG8_BAR;
    }
    for (;;) {
        const bool has_next = S.next(ui + 1, nxt);
        const char* nA = has_next ? (const char*)g.A + (size_t)nxt.pm * tstep : cA; const char* nB = has_next ? (const char*)g.Bt + (size_t)nxt.pn * tstep : cB;
#pragma nounroll
        for (int t = 0; t < nt; t += 2) {
            const bool last = (t == nt - 2);
            const char* a1 = cA + (size_t)(t + 1) * kstep;
            const char* a2 = last ? nA : cA + (size_t)(t + 2) * kstep; const char* b2 = last ? nB : cB + (size_t)(t + 2) * kstep;
            const char* a3 = a2 + kstep; const char* b3 = b2 + kstep;
            if (last && has_next) S.a_ready(nxt);
            if constexpr (SP2) {
            PG8_LDB(B0, 0, 0); PG8_LDB(B1, 0, 1); PG8_SCHED; PG8_LDA(At, 0, 0); PG8_STAGE(PG8_SA(1, 1), a1 + hstep, voffA);
            PG8_WAIT_V(8); PG8_WAIT_L(0); PG8_BAR; PG8_MMA(0, 0, At, B0); PG8_MMA(0, 1, At, B1); PG8_BAR; PG8_SCHED;
            PG8_LDA(At, 0, 1); PG8_STAGE(PG8_SB(0, 0), b2, voffB); PG8_STAGE(PG8_SB(0, 1), b2 + hstep, voffB); PG8_STAGE(PG8_SA(0, 0), a2, voffA);
            PG8_WAIT_V(8); PG8_WAIT_L(0); PG8_BAR; PG8_MMA(1, 0, At, B0); PG8_MMA(1, 1, At, B1); PG8_BAR; PG8_SCHED;
            PG8_LDB(B0, 1, 0); PG8_LDB(B1, 1, 1); PG8_SCHED; PG8_LDA(At, 1, 0); PG8_STAGE(PG8_SA(0, 1), a2 + hstep, voffA);
            PG8_WAIT_V(8); PG8_WAIT_L(0); PG8_BAR; PG8_MMA(0, 0, At, B0); PG8_MMA(0, 1, At, B1); PG8_BAR; PG8_SCHED;
            PG8_LDA(At, 1, 1); PG8_STAGE(PG8_SB(1, 0), b3, voffB); PG8_STAGE(PG8_SB(1, 1), b3 + hstep, voffB); PG8_STAGE(PG8_SA(1, 0), a3, voffA);
            PG8_WAIT_V(8); PG8_WAIT_L(0); PG8_BAR; PG8_MMA(1, 0, At, B0); PG8_MMA(1, 1, At, B1); PG8_BAR; PG8_SCHED;
            } else {
            PG8_LDB(B0, 0, 0); PG8_SCHED; PG8_LDA(At, 0, 0); PG8_STAGE(PG8_SA(1, 1), a1 + hstep, voffA);
            PG8_WAIT_L(8); PG8_BAR; PG8_WAIT_L(0); PG8_MMA(0, 0, At, B0); PG8_BAR; PG8_SCHED;
            PG8_LDB(B1, 0, 1); PG8_STAGE(PG8_SB(0, 0), b2, voffB);
            PG8_BAR; PG8_WAIT_L(0); PG8_MMA(0, 1, At, B1); PG8_BAR;
            PG8_LDA(At, 0, 1); PG8_STAGE(PG8_SA(0, 0), a2, voffA);
            PG8_BAR; PG8_WAIT_L(0); PG8_MMA(1, 0, At, B0); PG8_BAR; PG8_SCHED;
            PG8_STAGE(PG8_SB(0, 1), b2 + hstep, voffB);
            PG8_WAIT_V(6); PG8_BAR; PG8_MMA(1, 1, At, B1); PG8_BAR;
            PG8_LDB(B0, 1, 0); PG8_SCHED; PG8_LDA(At, 1, 0); PG8_STAGE(PG8_SA(0, 1), a2 + hstep, voffA);
            PG8_WAIT_L(8); PG8_BAR; PG8_WAIT_L(0); PG8_MMA(0, 0, At, B0); PG8_BAR; PG8_SCHED;
            PG8_LDB(B1, 1, 1); PG8_STAGE(PG8_SB(1, 0), b3, voffB);
            PG8_BAR; PG8_WAIT_L(0); PG8_MMA(0, 1, At, B1); PG8_BAR;
            PG8_LDA(At, 1, 1); PG8_STAGE(PG8_SA(1, 0), a3, voffA);
            PG8_BAR; PG8_WAIT_L(0); PG8_MMA(1, 0, At, B0); PG8_BAR; PG8_SCHED;
            PG8_STAGE(PG8_SB(1, 1), b3 + hstep, voffB);
            PG8_WAIT_V(6); PG8_BAR; PG8_MMA(1, 1, At, B1); PG8_BAR;
            }
        }
        if constexpr (F8) {
            asm volatile("s_nop 15\n\ts_nop 15" ::: "memory");
            _Pragma("unroll") for (int a = 0; a < 2; ++a) _Pragma("unroll") for (int b = 0; b < 2; ++b) _Pragma("unroll") for (int m = 0; m < 4; ++m) _Pragma("unroll") for (int n = 0; n < 2; ++n) asm volatile("" : "+v"(acc[a][b][m][n]));
        }
        if constexpr (ALIGN_EPI) { if (wr == 0) PG8_BAR; }
        if constexpr (!Epi::AFTER_DRAIN) { E(acc, cur, wr, wc, fr, fq); S.done(cur); }
        if (!has_next) break;
#pragma unroll
        for (int a = 0; a < 2; ++a)
#pragma unroll
            for (int b = 0; b < 2; ++b)
#pragma unroll
                for (int m = 0; m < 4; ++m)
#pragma unroll
                    for (int n = 0; n < 2; ++n) acc[a][b][m][n] = (f32x4){0.f, 0.f, 0.f, 0.f};
        cur = nxt; cA = nA; cB = nB; ++ui;
        if constexpr (ALIGN_EPI) { if (wr == 1) PG8_BAR; }
    }
    PG8_WAIT_V(0);
    if constexpr (!ALIGN_EPI) { if (wr == 0) PG8_BAR; }
    PG8_BAR;
    if constexpr (Epi::AFTER_DRAIN) { E.fused(acc, cur, wr, wc, fr, fq, lds, wid, lane); S.done(cur); }
#undef PG8_SA
#undef PG8_SB
#undef PG8_STAGE
#undef PG8_LDA
#undef PG8_LDB
#undef PG8_MMA
#undef PG8_WAIT_V
#undef PG8_WAIT_L
#undef PG8_BAR
#undef PG8_SCHED
}
template <class Epi, class Sched, bool F8 = false, int SCA = 127, int SCB = 127>
__device__ __forceinline__ void gemm_phase_gather(PG8_LAS unsigned char* lds, const Gemm g, const Sched& S, const Epi& E) {
    const int tid = threadIdx.x, wid = __builtin_amdgcn_readfirstlane(tid >> 6), lane = tid & 63, wr = wid >> 2, wc = wid & 3, fr = lane & 15, fq = lane >> 4;
    constexpr bool ALIGN_EPI = true, SP2 = true;
    const int K = g.K, nt = K / BK;
    unsigned voffA[2], voffB[2]; int rowA[2];
#pragma unroll
    for (int i = 0; i < 2; ++i) { int R, C; stage_rc(tid, i, R, C); const int Rb = Epi::PERM ? ((R & ~31) + perm32(R & 31)) : R;
        voffA[i] = (unsigned)C * 2u; rowA[i] = R; voffB[i] = (unsigned)(Rb * K + C) * 2u; }
    const size_t kstep = (size_t)(BK * 2);
    const size_t hstep = (size_t)HALF * K * 2;
    const size_t tstep = 2 * hstep;
    const unsigned ldsw = (unsigned)wid * (unsigned)KBP;
    const int aoff = lds_byte(wr * 64 + fr, fq * 8), boff = lds_byte(wc * 32 + fr, fq * 8);
#define PG8_SA(b, h) (((b) * 2 + (h)) * HTB)
#define PG8_SB(b, h) ((4 + (b) * 2 + (h)) * HTB)
#define PG8_STAGE(bufoff, gbase, voff) do { _Pragma("unroll") for (int _i = 0; _i < 2; ++_i) \
        __builtin_amdgcn_global_load_lds((const unsigned*)((const char*)(gbase) + (voff)[_i]), (PG8_LAS unsigned*)(lds + (bufoff) + ldsw + _i * (8 * KBP)), 16, 0, 0); } while (0)
#define PG8_STAGE_A(bufoff, gbase, o0, o1) do { \
        __builtin_amdgcn_global_load_lds((const unsigned*)((const char*)(gbase) + (o0)), (PG8_LAS unsigned*)(lds + (bufoff) + ldsw), 16, 0, 0); \
        __builtin_amdgcn_global_load_lds((const unsigned*)((const char*)(gbase) + (o1)), (PG8_LAS unsigned*)(lds + (bufoff) + ldsw + 8 * KBP), 16, 0, 0); } while (0)
#define PG8_GOFF(dst, u) do { int ix_[2][2], tv_[2][2]; bool ok_[2][2];   \
        _Pragma("unroll") for (int h_ = 0; h_ < 2; ++h_) _Pragma("unroll") for (int i_ = 0; i_ < 2; ++i_) ix_[h_][i_] = S.a_idx(u, 128 * h_ + rowA[i_], ok_[h_][i_]); \
        __builtin_amdgcn_sched_barrier(0); \
        _Pragma("unroll") for (int h_ = 0; h_ < 2; ++h_) _Pragma("unroll") for (int i_ = 0; i_ < 2; ++i_) tv_[h_][i_] = S.a_tab()[ix_[h_][i_]]; \
        __builtin_amdgcn_sched_barrier(0); \
        _Pragma("unroll") for (int h_ = 0; h_ < 2; ++h_) _Pragma("unroll") for (int i_ = 0; i_ < 2; ++i_) dst[h_][i_] = (unsigned)S.a_fix(tv_[h_][i_], ok_[h_][i_]) * (unsigned)(K * 2) + voffA[i_]; } while (0)
#define PG8_LDA(dst, b, h) do { if constexpr (F8) { _Pragma("unroll") for (int m = 0; m < 4; ++m) dst##8[m] = cat8(*(const PG8_LAS i32x4*)(lds + PG8_SA(b, h) + aoff + m * (2 * KBP)), *(const PG8_LAS i32x4*)(lds + PG8_SA(b, h) + aoff + m * (2 * KBP) + 64)); } \
        else { _Pragma("unroll") for (int m = 0; m < 4; ++m) _Pragma("unroll") for (int k = 0; k < 2; ++k) dst[m][k] = *(const PG8_LAS bf16x8*)(lds + PG8_SA(b, h) + aoff + m * (2 * KBP) + k * 64); } } while (0)
#define PG8_LDB(dst, b, h) do { if constexpr (F8) { _Pragma("unroll") for (int n = 0; n < 2; ++n) dst##8[n] = cat8(*(const PG8_LAS i32x4*)(lds + PG8_SB(b, h) + boff + n * (2 * KBP)), *(const PG8_LAS i32x4*)(lds + PG8_SB(b, h) + boff + n * (2 * KBP) + 64)); } \
        else { _Pragma("unroll") for (int n = 0; n < 2; ++n) _Pragma("unroll") for (int k = 0; k < 2; ++k) dst[n][k] = *(const PG8_LAS bf16x8*)(lds + PG8_SB(b, h) + boff + n * (2 * KBP) + k * 64); } } while (0)
#define PG8_MMA(ai, bj, At, Bt) do { __builtin_amdgcn_s_setprio(1); _Pragma("unroll") for (int m = 0; m < 4; ++m) _Pragma("unroll") for (int n = 0; n < 2; ++n) { \
        if constexpr (F8) { mfma_scale_f8(acc[ai][bj][m][n], Bt##8[n], At##8[m], sc1); } \
        else { _Pragma("unroll") for (int k = 0; k < 2; ++k) acc[ai][bj][m][n] = __builtin_amdgcn_mfma_f32_16x16x32_bf16(Bt[n][k], At[m][k], acc[ai][bj][m][n], 0, 0, 0); } } \
        __builtin_amdgcn_s_setprio(0); } while (0)
#define PG8_WAIT_V(n) asm volatile("s_waitcnt vmcnt(" #n ")" ::: "memory")
#define PG8_WAIT_L(n) asm volatile("s_waitcnt lgkmcnt(" #n ")" ::: "memory")
#define PG8_BAR __builtin_amdgcn_s_barrier()
#define PG8_SCHED __builtin_amdgcn_sched_barrier(0)
    Unit cur, nxt; int ui = 0;
    if (!S.next(0, cur)) return;
    f32x4 acc[2][2][4][2];
#pragma unroll
    for (int a = 0; a < 2; ++a)
#pragma unroll
        for (int b = 0; b < 2; ++b)
#pragma unroll
            for (int m = 0; m < 4; ++m)
#pragma unroll
                for (int n = 0; n < 2; ++n) acc[a][b][m][n] = (f32x4){0.f, 0.f, 0.f, 0.f};
    bf16x8 At[4][2], B0[2][2], B1[2][2]; i32x8 At8[4], B08[2], B18[2]; int sc1 = 0x7f7f7f7f; asm volatile("" : "+v"(sc1));
    const char* const cA = (const char*)g.A; const char* cB = (const char*)g.Bt + (size_t)cur.pn * tstep;
    unsigned gc[2][2], gn[2][2];
    S.a_ready(cur); PG8_GOFF(gc, cur);
    if constexpr (SP2) {
        PG8_STAGE(PG8_SB(0, 0), cB, voffB); PG8_STAGE(PG8_SB(0, 1), cB + hstep, voffB); PG8_STAGE_A(PG8_SA(0, 0), cA, gc[0][0], gc[0][1]); PG8_STAGE_A(PG8_SA(0, 1), cA, gc[1][0], gc[1][1]);
        if (wr == 1) PG8_BAR;
        PG8_WAIT_V(2); PG8_BAR;
        PG8_STAGE(PG8_SB(1, 0), cB + kstep, voffB); PG8_STAGE_A(PG8_SA(1, 0), cA + kstep, gc[0][0], gc[0][1]); PG8_STAGE(PG8_SB(1, 1), cB + hstep + kstep, voffB);
        PG8_WAIT_V(6); PG8_BAR;
    }
    for (;;) {
        const bool has_next = S.next(ui + 1, nxt);
        const char* nB = has_next ? (const char*)g.Bt + (size_t)nxt.pn * tstep : cB;
        if (has_next) { PG8_GOFF(gn, nxt); } else { _Pragma("unroll") for (int h_ = 0; h_ < 2; ++h_) _Pragma("unroll") for (int i_ = 0; i_ < 2; ++i_) gn[h_][i_] = gc[h_][i_]; }
#pragma nounroll
        for (int t = 0; t < nt; t += 2) {
            const bool last = (t == nt - 2);
            const char* a1 = cA + (size_t)(t + 1) * kstep;
            const char* a2 = last ? cA : cA + (size_t)(t + 2) * kstep; const char* b2 = last ? nB : cB + (size_t)(t + 2) * kstep;
            const unsigned g200 = last ? gn[0][0] : gc[0][0], g201 = last ? gn[0][1] : gc[0][1], g210 = last ? gn[1][0] : gc[1][0], g211 = last ? gn[1][1] : gc[1][1];
            const char* a3 = a2 + kstep; const char* b3 = b2 + kstep;
            if (last && has_next) S.a_ready(nxt);
            if constexpr (SP2) {
            PG8_LDB(B0, 0, 0); PG8_LDB(B1, 0, 1); PG8_SCHED; PG8_LDA(At, 0, 0); PG8_STAGE_A(PG8_SA(1, 1), a1, gc[1][0], gc[1][1]);
            PG8_WAIT_V(8); PG8_WAIT_L(0); PG8_BAR; PG8_MMA(0, 0, At, B0); PG8_MMA(0, 1, At, B1); PG8_BAR; PG8_SCHED;
            PG8_LDA(At, 0, 1); PG8_STAGE(PG8_SB(0, 0), b2, voffB); PG8_STAGE(PG8_SB(0, 1), b2 + hstep, voffB); PG8_STAGE_A(PG8_SA(0, 0), a2, g200, g201);
            PG8_WAIT_V(8); PG8_WAIT_L(0); PG8_BAR; PG8_MMA(1, 0, At, B0); PG8_MMA(1, 1, At, B1); PG8_BAR; PG8_SCHED;
            PG8_LDB(B0, 1, 0); PG8_LDB(B1, 1, 1); PG8_SCHED; PG8_LDA(At, 1, 0); PG8_STAGE_A(PG8_SA(0, 1), a2, g210, g211);
            PG8_WAIT_V(8); PG8_WAIT_L(0); PG8_BAR; PG8_MMA(0, 0, At, B0); PG8_MMA(0, 1, At, B1); PG8_BAR; PG8_SCHED;
            PG8_LDA(At, 1, 1); PG8_STAGE(PG8_SB(1, 0), b3, voffB); PG8_STAGE(PG8_SB(1, 1), b3 + hstep, voffB); PG8_STAGE_A(PG8_SA(1, 0), a3, g200, g201);
            PG8_WAIT_V(8); PG8_WAIT_L(0); PG8_BAR; PG8_MMA(1, 0, At, B0); PG8_MMA(1, 1, At, B1); PG8_BAR; PG8_SCHED;
            }
        }
        if constexpr (F8) {
            asm volatile("s_nop 15\n\ts_nop 15" ::: "memory");
            _Pragma("unroll") for (int a = 0; a < 2; ++a) _Pragma("unroll") for (int b = 0; b < 2; ++b) _Pragma("unroll") for (int m = 0; m < 4; ++m) _Pragma("unroll") for (int n = 0; n < 2; ++n) asm volatile("" : "+v"(acc[a][b][m][n]));
        }
        if constexpr (ALIGN_EPI) { if (wr == 0) PG8_BAR; }
        if constexpr (!Epi::AFTER_DRAIN) { E(acc, cur, wr, wc, fr, fq); S.done(cur); }
        if (!has_next) break;
#pragma unroll
        for (int a = 0; a < 2; ++a)
#pragma unroll
            for (int b = 0; b < 2; ++b)
#pragma unroll
                for (int m = 0; m < 4; ++m)
#pragma unroll
                    for (int n = 0; n < 2; ++n) acc[a][b][m][n] = (f32x4){0.f, 0.f, 0.f, 0.f};
        cur = nxt; cB = nB; ++ui;
#pragma unroll
        for (int h_ = 0; h_ < 2; ++h_)
#pragma unroll
            for (int i_ = 0; i_ < 2; ++i_) gc[h_][i_] = gn[h_][i_];
        if constexpr (ALIGN_EPI) { if (wr == 1) PG8_BAR; }
    }
    PG8_WAIT_V(0);
    if constexpr (!ALIGN_EPI) { if (wr == 0) PG8_BAR; }
    PG8_BAR;
    if constexpr (Epi::AFTER_DRAIN) { E.fused(acc, cur, wr, wc, fr, fq, lds, wid, lane); S.done(cur); }
#undef PG8_SA
#undef PG8_SB
#undef PG8_STAGE
#undef PG8_STAGE_A
#undef PG8_GOFF
#undef PG8_LDA
#undef PG8_LDB
#undef PG8_MMA
#undef PG8_WAIT_V
#undef PG8_WAIT_L
#undef PG8_BAR
#undef PG8_SCHED
}
}

namespace att {
constexpr int D = 128;
constexpr float THR = 8.f;
constexpr bool WSKIP = false;
constexpr float SCALE = 0.08838834764831845f;
constexpr int NW = 8, QBLK = 32, KVBLK = 64, QB = NW * QBLK;
constexpr int SHM_V = KVBLK * D * 2, SHM_K = KVBLK * D * 2;
constexpr int ATT_LDS_BYTES = 2 * SHM_V + 2 * SHM_K + NW * 64 * 4;
typedef short bf16x8 __attribute__((ext_vector_type(8)));
typedef short s16x4 __attribute__((ext_vector_type(4)));
typedef float f32x16 __attribute__((ext_vector_type(16)));
typedef float f32x4 __attribute__((ext_vector_type(4)));
typedef unsigned u32x4 __attribute__((ext_vector_type(4)));
template <class A, class Bt> struct same_t { static constexpr bool v = false; };
template <class A> struct same_t<A, A> { static constexpr bool v = true; };

#define KSWZ(row, colB) ((row) * 256 + ((colB) ^ (((row) & 7) << 4)))
#define SBAR() __builtin_amdgcn_sched_barrier(0)
__device__ __forceinline__ int v_st(int k, int c) { const int kk = (k & ~0xC) | ((k & 4) << 1) | ((k & 8) >> 1); return ((kk >> 3) * 4 + (c >> 5)) * 512 + ((kk & 7) * 32 + (c & 31)) * 2; }
__device__ __forceinline__ int v_rd_base(int lane) { return ((lane & 3) << 3) | (((lane >> 2) & 3) << 6) | (((lane >> 4) & 1) << 5) | (((lane >> 5) & 1) << 8); }
constexpr int v_rd_off(int d0, int ks, int half) { return d0 * 512 + ks * 4096 + half * 2048; }
__device__ __forceinline__ int crow(int r, int hi) { return (r & 3) + 8 * (r >> 2) + 4 * hi; }
__device__ __forceinline__ unsigned cvtpk(float lo, float hi) {
    unsigned r; asm volatile("v_cvt_pk_bf16_f32 %0, %1, %2" : "=v"(r) : "v"(lo), "v"(hi)); return r;
}
__device__ __forceinline__ bf16x8 pack8(f32x4 a, f32x4 b) {
    u32x4 w = {cvtpk(a[0], a[1]), cvtpk(a[2], a[3]), cvtpk(b[0], b[1]), cvtpk(b[2], b[3])};
    return *reinterpret_cast<bf16x8*>(&w);
}
template <class T> __device__ __forceinline__ bf16x8 load8(const T* p) {
    if constexpr (same_t<T, float>::v) { return pack8(*(const f32x4*)p, *(const f32x4*)(p + 4)); }
    else { return *reinterpret_cast<const bf16x8*>(p); }
}
__device__ __forceinline__ void mask_tile(f32x16& p0, f32x16& p1, int dq, unsigned W) {
    const float NEG = -__builtin_inff();
#pragma unroll
    for (int r = 0; r < 16; ++r) {
        const int c = (r & 3) + 8 * (r >> 2);
        if ((unsigned)(dq - c) >= W) p0[r] = NEG;
        if ((unsigned)(dq - c - 32) >= W) p1[r] = NEG;
    }
}
__device__ __forceinline__ void partialSM(f32x16& p0, f32x16& p1, float& m_reg, float& mn, float& alpha) {
    float pmax = p0[0]; for (int r = 1; r < 16; ++r) pmax = fmaxf(pmax, p0[r]); for (int r = 0; r < 16; ++r) pmax = fmaxf(pmax, p1[r]);
    { auto rr = __builtin_amdgcn_permlane32_swap(__float_as_uint(pmax), __float_as_uint(pmax), false, false);
      pmax = fmaxf(__uint_as_float(rr[0]), __uint_as_float(rr[1])); }
    constexpr float C2 = 1.4426950408889634f * SCALE;
    if (__builtin_expect(__all((pmax - m_reg) * SCALE <= THR), 1)) { mn = m_reg; alpha = 1.f; }
    else { mn = fmaxf(m_reg, pmax); alpha = __builtin_amdgcn_exp2f((m_reg - mn) * C2); m_reg = mn; }
    const float mnL = -mn * C2;
    for (int r = 0; r < 16; ++r) p0[r] = fmaf(p0[r], C2, mnL); for (int r = 0; r < 16; ++r) p1[r] = fmaf(p1[r], C2, mnL);
    for (int r = 0; r < 16; ++r) p0[r] = __builtin_amdgcn_exp2f(p0[r]);
}
__device__ __forceinline__ void finishSM(f32x16& p0, f32x16& p1, float alpha, float& l_reg, bf16x8& pa0, bf16x8& pa1, bf16x8& pa2, bf16x8& pa3) {
    for (int r = 0; r < 16; ++r) p1[r] = __builtin_amdgcn_exp2f(p1[r]);
    float ps = 0; for (int r = 0; r < 16; ++r) ps += p0[r]; for (int r = 0; r < 16; ++r) ps += p1[r];
    { auto rr = __builtin_amdgcn_permlane32_swap(__float_as_uint(ps), __float_as_uint(ps), false, false);
      ps = __uint_as_float(rr[0]) + __uint_as_float(rr[1]); }
    l_reg = l_reg * alpha + ps;
#define PK4(P, B_, OUT) do { unsigned a0 = cvtpk(P[B_+0], P[B_+1]), a1 = cvtpk(P[B_+2], P[B_+3]);                          \
        unsigned b0 = cvtpk(P[B_+4], P[B_+5]), b1 = cvtpk(P[B_+6], P[B_+7]);                                             \
        auto r0 = __builtin_amdgcn_permlane32_swap(a0, b0, false, false); auto r1 = __builtin_amdgcn_permlane32_swap(a1, b1, false, false); \
        u32x4 w = {r0[0], r1[0], r0[1], r1[1]}; OUT = *reinterpret_cast<bf16x8*>(&w); } while (0)
    PK4(p0, 0, pa0); PK4(p0, 8, pa1); PK4(p1, 0, pa2); PK4(p1, 8, pa3);
#undef PK4
}
template <int KB, bool SK>
__device__ __forceinline__ void qkt(f32x16& p0, f32x16& p1, const char* K_lds, int r32, int hi, const bf16x8* qr, bool act) {
    if (SK && !act) { const float NEG = -__builtin_inff();
#pragma unroll
        for (int r = 0; r < 16; ++r) { p0[r] = NEG; p1[r] = NEG; } return; }
    p0 = f32x16{}; p1 = f32x16{};
    const char* kb[4];
#pragma unroll
    for (int dd = 0; dd < 4; ++dd) kb[dd] = K_lds + KB * SHM_K + KSWZ(r32, (dd * 16 + hi * 8) * 2);
#pragma unroll
    for (int d0 = 0; d0 < 8; ++d0) { const char* a = kb[d0 & 3] + (d0 >> 2) * 128;
        bf16x8 b0 = *reinterpret_cast<const bf16x8*>(a);
        bf16x8 b1 = *reinterpret_cast<const bf16x8*>(a + 32 * 256);
        p0 = __builtin_amdgcn_mfma_f32_32x32x16_bf16(b0, qr[d0], p0, 0, 0, 0);
        p1 = __builtin_amdgcn_mfma_f32_32x32x16_bf16(b1, qr[d0], p1, 0, 0, 0); }
}
template <int VB, bool SK>
__device__ __forceinline__ void pv_tile(f32x16* o, int vb0, bf16x8 pa0, bf16x8 pa1, bf16x8 pa2, bf16x8 pa3, bool act) {
    if (SK && !act) return;
#define TRRD(dst, off) asm volatile("ds_read_b64_tr_b16 %0, %1 offset:%2" : "=&v"(dst) : "v"(vb0), "i"(off) : "memory")
#define PV_D0(d0) do { s16x4 l0, l1, l2, l3, h0, h1, h2, h3; constexpr int b_ = VB * SHM_V + v_rd_off(d0, 0, 0);     \
        TRRD(l0, b_); TRRD(h0, b_ + 2048); TRRD(l1, b_ + 4096); TRRD(h1, b_ + 6144); TRRD(l2, b_ + 8192); TRRD(h2, b_ + 10240); TRRD(l3, b_ + 12288); TRRD(h3, b_ + 14336); \
        asm volatile("s_waitcnt lgkmcnt(0)" ::: "memory"); SBAR();                 \
        o[d0] = __builtin_amdgcn_mfma_f32_32x32x16_bf16(pa0, (bf16x8){l0[0], l0[1], l0[2], l0[3], h0[0], h0[1], h0[2], h0[3]}, o[d0], 0, 0, 0);   \
        o[d0] = __builtin_amdgcn_mfma_f32_32x32x16_bf16(pa1, (bf16x8){l1[0], l1[1], l1[2], l1[3], h1[0], h1[1], h1[2], h1[3]}, o[d0], 0, 0, 0);   \
        o[d0] = __builtin_amdgcn_mfma_f32_32x32x16_bf16(pa2, (bf16x8){l2[0], l2[1], l2[2], l2[3], h2[0], h2[1], h2[2], h2[3]}, o[d0], 0, 0, 0);   \
        o[d0] = __builtin_amdgcn_mfma_f32_32x32x16_bf16(pa3, (bf16x8){l3[0], l3[1], l3[2], l3[3], h3[0], h3[1], h3[2], h3[3]}, o[d0], 0, 0, 0); } while (0)
    PV_D0(0); PV_D0(1); PV_D0(2); PV_D0(3);
#undef PV_D0
#undef TRRD
}

template <class TIn, class TOut> struct BlockRef { const TIn* Q; const TIn* K; const TIn* V; TOut* O; int P0; };
template <class TIn> struct Seam {
    bf16x8 qr[8];
    bf16x8 st_v0, st_v1, st_k0, st_k1; f32x4 sf0, sf1, sf2, sf3;
    f32x4 tq[16];
};
__device__ __forceinline__ int swa_jlo(int P0, int W) { const int lowk = P0 - W + 1; return lowk > 0 ? lowk / KVBLK : 0; }
#define ROW(p, k0, rr) ((p) + (size_t)((k0) + (rr)) * D + sc)
#define VMW() asm volatile("s_waitcnt vmcnt(0)" ::: "memory")
#define VMWN(n) asm volatile("s_waitcnt vmcnt(%0)" :: "i"(n) : "memory")
#define SLOAD_H(Kp, Vp, k0) do { S.st_v0 = load8<TIn>(ROW(Vp, k0, sr)); S.st_v1 = load8<TIn>(ROW(Vp, k0, 32 + sr));              \
                         S.st_k0 = load8<TIn>(ROW(Kp, k0, sr)); S.st_k1 = load8<TIn>(ROW(Kp, k0, 32 + sr)); } while (0)
#define SWRITE_HK(bf) do { *(bf16x8*)(K_lds + (bf) * SHM_K + kws) = S.st_k0; *(bf16x8*)(K_lds + (bf) * SHM_K + kws + 32 * 256) = S.st_k1; } while (0)
#define SWRITE_HV(bf) do { *(bf16x8*)(V_lds + (bf) * SHM_V + vst0) = S.st_v0; *(bf16x8*)(V_lds + (bf) * SHM_V + vst1) = S.st_v1; } while (0)
#define SWRITE_H(bf) do { SWRITE_HV(bf); SWRITE_HK(bf); } while (0)
#define SLOAD_F(p, k0) do { S.sf0 = *(const f32x4*)ROW(p, k0, sr); S.sf1 = *(const f32x4*)(ROW(p, k0, sr) + 4);                \
                            S.sf2 = *(const f32x4*)ROW(p, k0, 32 + sr); S.sf3 = *(const f32x4*)(ROW(p, k0, 32 + sr) + 4); } while (0)
#define SWRITE_KF(bf) do { *(bf16x8*)(K_lds + (bf) * SHM_K + kws) = pack8(S.sf0, S.sf1); *(bf16x8*)(K_lds + (bf) * SHM_K + kws + 32 * 256) = pack8(S.sf2, S.sf3); } while (0)
#define SWRITE_VF(bf) do { *(bf16x8*)(V_lds + (bf) * SHM_V + vst0) = pack8(S.sf0, S.sf1); *(bf16x8*)(V_lds + (bf) * SHM_V + vst1) = pack8(S.sf2, S.sf3); } while (0)
template <class TIn, class TOut>
__device__ __forceinline__ void causal_swa_prime(const BlockRef<TIn, TOut>& cur, int W, char* lds, Seam<TIn>& S) {
    constexpr bool F32 = same_t<TIn, float>::v;
    const int tid = threadIdx.x, wid = __builtin_amdgcn_readfirstlane(tid >> 6), lane = tid & 63, r32 = lane & 31, hi = lane >> 5;
    const int sr = tid >> 4, sc = (tid & 15) * 8, kws = KSWZ(sr, sc * 2); char* K_lds = lds + 2 * SHM_V;
    const int kb0 = swa_jlo(cur.P0, W) * KVBLK;
    for (int d0 = 0; d0 < 8; ++d0) S.qr[d0] = load8<TIn>(cur.Q + (size_t)(wid * QBLK + r32) * D + d0 * 16 + hi * 8);
    if constexpr (F32) { SLOAD_F((const float*)cur.K, kb0); VMW(); SWRITE_KF(0); SBAR(); SLOAD_F((const float*)cur.V, kb0); }
    else { SLOAD_H(cur.K, cur.V, kb0); VMW(); SWRITE_HK(0); }
    __syncthreads();
}
template <class TIn, class TOut, class CV>
__device__ __forceinline__ void causal_swa_block(const BlockRef<TIn, TOut>& cur, const BlockRef<TIn, TOut>& nxt, int skv, int W, char* lds, Seam<TIn>& S, CV& cv) {
    constexpr bool F32 = same_t<TIn, float>::v;
    const int tid = threadIdx.x, wid = __builtin_amdgcn_readfirstlane(tid >> 6), lane = tid & 63, r32 = lane & 31, hi = lane >> 5;
    const int j_lo = swa_jlo(cur.P0, W);
    int j_hi = (cur.P0 + QB - 1) / KVBLK + 1; if (j_hi > skv / KVBLK) j_hi = skv / KVBLK;
    const int NT = j_hi - j_lo;
    const int kbn = swa_jlo(nxt.P0, W) * KVBLK;
    const int qlo = cur.P0 + wid * QBLK, qm = ((qlo + r32) | 63) - 4 * hi;
    char* V_lds = lds; char* K_lds = lds + 2 * SHM_V;
    float* ws = (float*)(lds + 2 * SHM_V + 2 * SHM_K) + wid * 64; float* li_l = ws, * al_l = ws + 32;
    float m_reg = -1e30f, l_reg = 0; f32x16 o[4] = {};
    const int sr = tid >> 4, sc = (tid & 15) * 8, vst0 = v_st(sr, sc), vst1 = v_st(32 + sr, sc), kws = KSWZ(sr, sc * 2);
    const int vb0 = (int)(uintptr_t)V_lds + v_rd_base(lane);
    const TIn* Kh = cur.K; const TIn* Vh = cur.V;
#define RESC(a) do { if (__any((a) < 1.f)) { if (hi == 0) al_l[r32] = (a); asm volatile("s_waitcnt lgkmcnt(0)" ::: "memory");              \
                     for (int d_ = 0; d_ < 4; ++d_) for (int r = 0; r < 16; ++r) o[d_][r] *= al_l[crow(r, hi)]; } } while (0)
#define KBASE(t) ((j_lo + (t)) * KVBLK)
#define ACT(t) (KBASE(t) <= qlo + QBLK - 1 && KBASE(t) + KVBLK - 1 >= qlo - W + 1)
#define MASKT(P0_, P1_, t) do { const int kb_ = KBASE(t); if ((!SK || ACT(t)) && (kb_ > qlo)) mask_tile(P0_, P1_, qm - kb_, (unsigned)W); } while (0)
    constexpr int NQL = F32 ? 16 : 8;
    constexpr bool SK = WSKIP && !F32;
#define SEAM_K0() do { VMWN(NQL); if constexpr (F32) { SWRITE_KF(0); SBAR(); SLOAD_F((const float*)nxt.V, kbn); } else { SWRITE_HK(0); } SBAR(); } while (0)
    f32x16 pA0, pA1, pB0, pB1; float mnA, mnB, alA, alB; bf16x8 pa0, pa1, pa2, pa3;
    if constexpr (F32) { VMW(); SWRITE_VF(0); SBAR(); } else { SWRITE_HV(0); SBAR(); }
    if (NT > 1) { if constexpr (F32) SLOAD_F((const float*)Kh, KBASE(1)); else SLOAD_H(Kh, Vh, KBASE(1)); }
    SBAR(); qkt<0, SK>(pA0, pA1, K_lds, r32, hi, S.qr, ACT(0));
    if constexpr (F32) { if (NT > 1) { VMW(); SWRITE_KF(1); SBAR(); SLOAD_F((const float*)Vh, KBASE(1)); } }
    MASKT(pA0, pA1, 0); partialSM(pA0, pA1, m_reg, mnA, alA);
    if (NT > 1) { VMW(); if constexpr (F32) { SWRITE_VF(1); SBAR(); if (NT > 2) SLOAD_F((const float*)Kh, KBASE(2)); } else SWRITE_H(1); }
    __syncthreads();
#define LBAR() do { asm volatile("s_waitcnt lgkmcnt(0)" ::: "memory"); __builtin_amdgcn_s_barrier(); asm volatile("" ::: "memory"); } while (0)
#define HALF_STEP(PX0, PX1, mnX, alX, PY0, PY1, alY, t, KB, VB, SB) do {                                                      \
        SBAR(); cv.issue(); SBAR(); qkt<KB, SK>(PX0, PX1, K_lds, r32, hi, S.qr, ACT(t));                                             \
        finishSM(PY0, PY1, alY, l_reg, pa0, pa1, pa2, pa3); SBAR();                                                           \
        if ((t) + 1 < NT) { if constexpr (F32) { VMW(); SWRITE_KF(SB); SBAR(); SLOAD_F((const float*)Vh, KBASE((t) + 1)); }  \
                            else { SLOAD_H(Kh, Vh, KBASE((t) + 1)); } SBAR(); }                                               \
        pv_tile<VB, SK>(o, vb0, pa0, pa1, pa2, pa3, ACT((t) - 1)); MASKT(PX0, PX1, (t)); partialSM(PX0, PX1, m_reg, mnX, alX);                                        \
        LBAR();                                                                                                               \
        if ((t) + 1 < NT) { VMW(); if constexpr (F32) { SWRITE_VF(SB); SBAR(); if ((t) + 2 < NT) SLOAD_F((const float*)Kh, KBASE((t) + 2)); } \
                            else { SWRITE_H(SB); } }                                                                          \
        RESC(alX); SBAR(); cv.consume(); SBAR(); LBAR(); } while (0)
    __builtin_amdgcn_s_waitcnt(0x0F70);
    for (int t = 1; t + 1 < NT; t += 2) {
        HALF_STEP(pB0, pB1, mnB, alB, pA0, pA1, alA, t, 1, 0, 0);
        HALF_STEP(pA0, pA1, mnA, alA, pB0, pB1, alB, t + 1, 0, 1, 1);
    }
    const bool even = (NT & 1) == 0;
    if (even) { SBAR(); qkt<1, SK>(pB0, pB1, K_lds, r32, hi, S.qr, ACT(NT - 1)); SBAR(); }
#define QROW(e) (nxt.Q + (size_t)(wid * QBLK + r32) * D + ((e) >> 1) * 16 + hi * 8 + ((e) & 1) * 4)
    if constexpr (F32) { SLOAD_F((const float*)nxt.K, kbn); SBAR();
#pragma unroll
        for (int e = 0; e < 8; ++e) S.tq[e] = *(const f32x4*)QROW(e); }
    else { SLOAD_H(nxt.K, nxt.V, kbn); SBAR();
#pragma unroll
        for (int d0 = 0; d0 < 8; ++d0) S.qr[d0] = load8<TIn>(nxt.Q + (size_t)(wid * QBLK + r32) * D + d0 * 16 + hi * 8); }
    SBAR();
    finishSM(pA0, pA1, alA, l_reg, pa0, pa1, pa2, pa3); SBAR();
    if constexpr (F32) {
#pragma unroll
        for (int e = 8; e < 16; ++e) S.tq[e] = *(const f32x4*)QROW(e); SBAR(); }
#undef QROW
    pv_tile<0, SK>(o, vb0, pa0, pa1, pa2, pa3, ACT(even ? NT - 2 : NT - 1));
    if (even) { MASKT(pB0, pB1, NT - 1); partialSM(pB0, pB1, m_reg, mnB, alB); __syncthreads(); RESC(alB);
        finishSM(pB0, pB1, alB, l_reg, pa0, pa1, pa2, pa3); SBAR(); pv_tile<1, SK>(o, vb0, pa0, pa1, pa2, pa3, ACT(NT - 1)); }
    SBAR(); SEAM_K0();
    if (hi == 0) li_l[r32] = l_reg; asm volatile("s_waitcnt lgkmcnt(0)" ::: "memory");
    float rli[16];
#pragma unroll
    for (int r = 0; r < 16; ++r) rli[r] = __builtin_amdgcn_rcpf(li_l[crow(r, hi)]);
    TOut* Ow = cur.O + (size_t)(wid * QBLK) * D;
#pragma unroll
    for (int r = 0; r < 16; ++r) { const int orow = crow(r, hi);
#pragma unroll
        for (int d0 = 0; d0 < 4; ++d0) { const float v = o[d0][r] * rli[r];
            if constexpr (same_t<TOut, float>::v) { Ow[(size_t)orow * D + d0 * 32 + r32] = v; }
            else { const float vn = __shfl_xor(v, 1);
                   if ((r32 & 1) == 0) *(unsigned*)(Ow + (size_t)orow * D + d0 * 32 + r32) = cvtpk(v, vn); } } }
    if constexpr (F32) {
#pragma unroll
        for (int d0 = 0; d0 < 8; ++d0) S.qr[d0] = pack8(S.tq[2 * d0], S.tq[2 * d0 + 1]); }
    __syncthreads();
#undef RESC
#undef KBASE
#undef ACT
#undef MASKT
#undef SEAM_K0
#undef HALF_STEP
#undef LBAR
}
#undef ROW
#undef VMW
#undef VMWN
#undef SLOAD_H
#undef SWRITE_HK
#undef SWRITE_HV
#undef SWRITE_H
#undef SLOAD_F
#undef SWRITE_KF
#undef SWRITE_VF
}


namespace mk {
using pg8::bf16_t; using pg8::f32x4; using pg8::u32x4; using pg8::Unit;
typedef float f32x2v __attribute__((ext_vector_type(2)));
typedef __bf16 bf16x2v __attribute__((ext_vector_type(2)));
__device__ __forceinline__ unsigned cvt_pk_bf16(float lo, float hi) { const f32x2v v = {lo, hi}; return __builtin_bit_cast(unsigned, __builtin_convertvector(v, bf16x2v)); }
#define LAS __attribute__((address_space(3)))
#define LDS_WAIT() asm volatile("s_waitcnt lgkmcnt(0)" ::: "memory")
#define VM_WAIT() asm volatile("s_waitcnt vmcnt(0)" ::: "memory")
constexpr int D = 2048, NB = 4, S = 4096, NT = NB * S, NE = 32, NA = 2 * NT, MH = 1024;
constexpr int NWAVES = 8, NTHR = 512;
constexpr int LDS_MISC = 147456, LDS_BYTES = 163840;
constexpr int MISC_BAR = 0, MISC_PE = 64, MISC_PS = 64 + 1024, MISC_HIST = 64 + 1024 + 256, MISC_BASE = MISC_HIST + 128, MISC_NP = MISC_BASE + 128, MISC_CNT = MISC_NP + 64;
constexpr int PMAX = NA + NE * 256;
constexpr float EPS = 1e-6f;
typedef unsigned u32x2 __attribute__((ext_vector_type(2)));

struct Args {
    const float *x, *c; const int* pos; const float *ada_w, *ada_b, *nmg, *nfg, *fng, *a_win, *a_wout, *lq1, *lk1, *lq2, *lk2, *a_hg,
        *m_win, *m_cw, *m_cb, *m_gb, *m_hg, *m_wout, *wg, *bg, *we, *be, *wgu, *wdn;
    float* out;
    unsigned* ctl; float* mod; float2* cs;
    bf16_t *Bt_qkv, *Bt_ao, *Bt_min, *Bt_mo, *Bt_rt, *Bt_g, *Bt_gu, *Bt_dn;
    bf16_t* xres; bf16_t* hb; bf16_t* ob; float* proj;
    float* logits; int* eid; float* wts; int* pos_in_e; int* slot; int* counts; int* inv;
    bf16_t *XG, *Hm, *Y;
    bf16_t *Qh, *Kh, *Vh, *Oa;
    unsigned char *hb8, *Hm8, *Bt_gu8, *Bt_dn8;
    unsigned char *Bt_min8, *Bt_mo8, *ob8;
    bf16_t *P3, *Qn, *Kn, *KT, *VT, *HS; float *gates, *GA, *GS;
    int ph_lo, ph_hi;
};

__device__ __forceinline__ unsigned pk4_fp8(float x0, float x1, float x2, float x3) { unsigned w = 0u; w = __builtin_amdgcn_cvt_pk_fp8_f32(x0, x1, w, false); w = __builtin_amdgcn_cvt_pk_fp8_f32(x2, x3, w, true); return w; }
__device__ __forceinline__ float wave_sum(float v) {
#pragma unroll
    for (int o = 1; o < 64; o <<= 1) v += __shfl_xor(v, o);
    return v;
}
__device__ __forceinline__ float silu_f(float v) { return v / (1.f + __expf(-v)); }
__device__ __forceinline__ f32x4 bf4_to_f32(const u32x2 p) { f32x4 r; r[0] = __uint_as_float(p.x << 16); r[1] = __uint_as_float(p.x & 0xffff0000u); r[2] = __uint_as_float(p.y << 16); r[3] = __uint_as_float(p.y & 0xffff0000u); return r; }
__device__ __forceinline__ int opq(int v) { asm volatile("" : "+v"(v)); return v; }

template <bool IN_F32>
struct EpiResid {
    static constexpr bool PERM = true, AFTER_DRAIN = false;
    const void* xin; bf16_t* xout; const float* gt; float sc;
    __device__ __forceinline__ void operator()(const f32x4 (&acc)[2][2][4][2], const Unit& u, int wr, int wc, int fr, int fq) const {
        const int row0 = u.pm * 256 + wr * 64 + fr, col0 = u.pn * 256 + wc * 32 + 8 * fq, b = (u.pm * 256) / S;
        f32x4 gv[2][2];
#pragma unroll
        for (int bj = 0; bj < 2; ++bj)
#pragma unroll
            for (int n = 0; n < 2; ++n) gv[bj][n] = *(const f32x4*)(gt + (size_t)b * 6 * D + col0 + bj * 128 + n * 4) * sc;
#pragma unroll
        for (int ai = 0; ai < 2; ++ai) {
            f32x4 X0[4][2], X1[4][2];
#pragma unroll
            for (int m = 0; m < 4; ++m) { const size_t off = (size_t)(row0 + ai * 128 + m * 16) * D + col0;
#pragma unroll
                for (int bj = 0; bj < 2; ++bj) {
                    if (IN_F32) { X0[m][bj] = *(const f32x4*)((const float*)xin + off + bj * 128); X1[m][bj] = *(const f32x4*)((const float*)xin + off + bj * 128 + 4); }
                    else { const u32x4 p = *(const u32x4*)((const bf16_t*)xin + off + bj * 128); X0[m][bj] = __builtin_bit_cast(f32x4, p); } } }
            __builtin_amdgcn_sched_barrier(0);
#pragma unroll
            for (int m = 0; m < 4; ++m) { const size_t off = (size_t)(row0 + ai * 128 + m * 16) * D + col0;
#pragma unroll
                for (int bj = 0; bj < 2; ++bj) { f32x4 x0, x1;
                    if (IN_F32) { x0 = X0[m][bj]; x1 = X1[m][bj]; }
                    else { const u32x4 p = __builtin_bit_cast(u32x4, X0[m][bj]); x0 = bf4_to_f32((u32x2){p.x, p.y}); x1 = bf4_to_f32((u32x2){p.z, p.w}); }
                    const f32x4 y0 = x0 + gv[bj][0] * acc[ai][bj][m][0], y1 = x1 + gv[bj][1] * acc[ai][bj][m][1];
                    u32x4 w; w.x = cvt_pk_bf16(y0[0], y0[1]); w.y = cvt_pk_bf16(y0[2], y0[3]); w.z = cvt_pk_bf16(y1[0], y1[1]); w.w = cvt_pk_bf16(y1[2], y1[3]);
                    *(u32x4*)(xout + off + bj * 128) = w; } }
            __builtin_amdgcn_sched_barrier(0);
        }
    }
};
struct EpiGU {
    static constexpr bool PERM = true, AFTER_DRAIN = false;
    unsigned char* Hm8;
    __device__ __forceinline__ void operator()(const f32x4 (&acc)[2][2][4][2], const Unit& u, int wr, int wc, int fr, int fq) const {
        const int row0 = u.pm * 256 + wr * 64 + fr, col0 = (u.pn & 7) * 128 + wc * 32 + 8 * fq;
#pragma unroll
        for (int ai = 0; ai < 2; ++ai)
#pragma unroll
            for (int m = 0; m < 4; ++m) { unsigned char* rowp = Hm8 + (size_t)(row0 + ai * 128 + m * 16) * MH + col0;
                float h[8];
#pragma unroll
                for (int n = 0; n < 2; ++n)
#pragma unroll
                    for (int j = 0; j < 4; ++j) { const float g = acc[ai][0][m][n][j] * (1.f / 256.f), up = acc[ai][1][m][n][j] * (1.f / 256.f); h[n * 4 + j] = silu_f(g) * up * 4.f; }
                u32x2 w; w.x = pk4_fp8(h[0], h[1], h[2], h[3]); w.y = pk4_fp8(h[4], h[5], h[6], h[7]);
                *(u32x2*)rowp = w; }
    }
};
struct EpiBf16G {
    static constexpr bool PERM = true, AFTER_DRAIN = false;
    bf16_t* O; int ldc; float sc;
    __device__ __forceinline__ void operator()(const f32x4 (&acc)[2][2][4][2], const Unit& u, int wr, int wc, int fr, int fq) const {
        const int row0 = u.pm * 256 + wr * 64 + fr, col0 = (u.pn & 7) * 256 + wc * 32 + 8 * fq;
#pragma unroll
        for (int ai = 0; ai < 2; ++ai)
#pragma unroll
            for (int m = 0; m < 4; ++m) { bf16_t* rowp = O + (size_t)(row0 + ai * 128 + m * 16) * ldc + col0;
#pragma unroll
                for (int bj = 0; bj < 2; ++bj) { const f32x4 v0 = acc[ai][bj][m][0] * sc, v1 = acc[ai][bj][m][1] * sc;
                    u32x4 w; w.x = cvt_pk_bf16(v0[0], v0[1]); w.y = cvt_pk_bf16(v0[2], v0[3]); w.z = cvt_pk_bf16(v1[0], v1[1]); w.w = cvt_pk_bf16(v1[2], v1[3]);
                    *(u32x4*)(rowp + bj * 128) = w; } }
    }
};
struct GroupedOrder {
    int NP, total, G, c; const LAS int* pe;
    __device__ __forceinline__ bool next(int i, Unit& u) const {
        int p, j;
        if (G == 256) { const int x = c >> 5, l = c & 31, gidx = i * 8 + x; p = gidx * 4 + (l >> 3); j = l & 7; if (p >= NP) return false; }
        else { const long L = (long)i * G + c; if (L >= total) return false; p = (int)(L % NP); j = (int)(L / NP); }
        u.pm = p; u.pn = __builtin_amdgcn_readfirstlane(pe[p]) * 8 + j; return true; }
    __device__ __forceinline__ void a_ready(const Unit&) const {}
    __device__ __forceinline__ void done(const Unit&) const {}
};
struct GroupedOrderG : GroupedOrder {
    const LAS int* ps; const LAS int* cn; const int* inv;
    __device__ __forceinline__ int a_idx(const Unit& u, int r, bool& ok) const { const int e = u.pn >> 3, local = u.pm * 256 + r - ps[e]; ok = local < cn[e]; return e * 32768 + (ok ? local : 0); }
    __device__ __forceinline__ const int* a_tab() const { return inv; }
    __device__ __forceinline__ int a_fix(int t, bool ok) const { return ok ? t : NT; }
};
struct CvItem { const float* W; bf16_t* WT; int ldw, K, n0, s0, k0; };
__device__ __forceinline__ void tr_load(const CvItem& d, int lane, f32x4 (&v)[8]) {
    const int kp = lane >> 3, c4 = lane & 7;
#pragma unroll
    for (int i = 0; i < 8; ++i) v[i] = *(const f32x4*)(d.W + (size_t)(d.k0 + 2 * kp + 16 * (i >> 1) + (i & 1)) * d.ldw + d.s0 + 4 * c4);
}
__device__ __forceinline__ void tr_finish(const CvItem& d, const f32x4 (&v)[8], LAS float* scr, int lane) {
    const int kp = lane >> 3, c4 = lane & 7; LAS unsigned* sp = (LAS unsigned*)scr;
#pragma unroll
    for (int i = 0; i < 4; ++i) { u32x4 o; o.x = cvt_pk_bf16(v[2 * i][0], v[2 * i + 1][0]); o.y = cvt_pk_bf16(v[2 * i][1], v[2 * i + 1][1]); o.z = cvt_pk_bf16(v[2 * i][2], v[2 * i + 1][2]); o.w = cvt_pk_bf16(v[2 * i][3], v[2 * i + 1][3]);
        *(LAS u32x4*)(sp + (kp + 8 * i) * 36 + 4 * c4) = o; }
    LDS_WAIT(); asm volatile("" ::: "memory");
    const int c = lane & 7;
#pragma unroll
    for (int j = 0; j < 4; ++j) { const int n = (lane >> 3) + 8 * j; const LAS unsigned* q = sp + (4 * c) * 36 + n;
        u32x4 o; o.x = q[0]; o.y = q[36]; o.z = q[72]; o.w = q[108];
        *(u32x4*)(d.WT + (size_t)(d.n0 + n) * d.K + d.k0 + 8 * c) = o; }
    LDS_WAIT(); asm volatile("" ::: "memory");
}
__device__ __forceinline__ int gu_src(int n) { const int t = n >> 8, r = n & 255; return r < 128 ? t * 128 + r : 1024 + t * 128 + (r - 128); }

constexpr int CV_I1 = 32 * 192, CV_I2 = 32 * 64, CV_ALL = CV_I1 + CV_I2;
__device__ __forceinline__ CvItem cv_decode(const Args& a, int r) {
    CvItem d;
    if (r < CV_I1) { const int kb = r / 192, nb = r % 192; d.W = a.a_win; d.ldw = 6144; d.WT = a.Bt_qkv; d.K = D; d.n0 = nb * 32; d.s0 = nb * 32; d.k0 = kb * 64; return d; } r -= CV_I1;
    { const int kb = r / 64, nb = r % 64; d.W = a.a_wout; d.ldw = D; d.WT = a.Bt_ao; d.K = D; d.n0 = nb * 32; d.s0 = nb * 32; d.k0 = kb * 64; return d; }
}
__device__ __forceinline__ void conv_items(const Args& a, LAS unsigned char* lds, int w, int nw, int lo, int hi, int wave, int lane) {
    LAS float* scr = (LAS float*)(lds + wave * 16384);
    const int it = lo + w; if (it >= hi) return;
    CvItem d0 = cv_decode(a, it), d1 = d0, d2 = d0; f32x4 v0[8], v1[8], v2[8];
    bool h1 = it + nw < hi, h2 = it + 2 * nw < hi, h0;
    tr_load(d0, lane, v0);
    if (h1) { d1 = cv_decode(a, it + nw); tr_load(d1, lane, v1); }
    if (h2) { d2 = cv_decode(a, it + 2 * nw); tr_load(d2, lane, v2); }
    int nx = it + 3 * nw;
    for (;;) {
        tr_finish(d0, v0, scr, lane); h0 = nx < hi; if (h0) { d0 = cv_decode(a, nx); tr_load(d0, lane, v0); nx += nw; }
        if (!h1) break;
        tr_finish(d1, v1, scr, lane); h1 = nx < hi; if (h1) { d1 = cv_decode(a, nx); tr_load(d1, lane, v1); nx += nw; }
        if (!h2) break;
        tr_finish(d2, v2, scr, lane); h2 = nx < hi; if (h2) { d2 = cv_decode(a, nx); tr_load(d2, lane, v2); nx += nw; }
        if (!h0) break;
    }
}
__device__ __forceinline__ void p0_prologue(const Args& a, LAS unsigned char* lds, int vcu, int G, int tid, int wave, int lane) {
    {
        LAS float* sc = (LAS float*)lds;
        LAS float* red = (LAS float*)(lds + 32768);
        for (int i = tid; i < NB * D; i += NTHR) sc[i] = silu_f(a.c[i]);
        __syncthreads();
        for (int it = vcu; it < 2 * 384; it += G) {
            const int l = it / 384, col = (it % 384) * 32 + (lane & 31), kh = lane >> 5;
            const float* w = a.ada_w + (size_t)l * D * 6 * D + (size_t)(wave * 256 + kh * 128) * 6 * D + col;
            float a0 = 0.f, a1 = 0.f, a2 = 0.f, a3 = 0.f;
#pragma unroll 8
            for (int k = 0; k < 128; ++k) { const float wv = w[(size_t)k * 6 * D]; const int kk = wave * 256 + kh * 128 + k;
                a0 += sc[kk] * wv; a1 += sc[D + kk] * wv; a2 += sc[2 * D + kk] * wv; a3 += sc[3 * D + kk] * wv; }
            a0 += __shfl_xor(a0, 32); a1 += __shfl_xor(a1, 32); a2 += __shfl_xor(a2, 32); a3 += __shfl_xor(a3, 32);
            if (lane < 32) { red[(wave * 4 + 0) * 32 + lane] = a0; red[(wave * 4 + 1) * 32 + lane] = a1; red[(wave * 4 + 2) * 32 + lane] = a2; red[(wave * 4 + 3) * 32 + lane] = a3; }
            __syncthreads();
            if (tid < 128) { const int bb = tid >> 5, cl = tid & 31; float sacc = 0.f;
#pragma unroll
                for (int w8 = 0; w8 < 8; ++w8) sacc += red[(w8 * 4 + bb) * 32 + cl];
                const int cg = (it % 384) * 32 + cl;
                a.mod[((size_t)l * NB + bb) * 6 * D + cg] = sacc + a.ada_b[l * 6 * D + cg]; }
            __syncthreads();
        }
    }
    for (int i = vcu * NTHR + tid; i < NT * 16; i += G * NTHR) {
        const int row = i >> 4, j = i & 15;
        const double ang = (double)a.pos[row] * pow(500000.0, -(double)j / 16.0);
        a.cs[i] = make_float2((float)cos(ang), (float)sin(ang));
    }
    for (int i0 = vcu * NTHR + tid; i0 < 2 * 256 * D; i0 += 8 * G * NTHR) {
        float v[8];
#pragma unroll
        for (int j = 0; j < 8; ++j) { const int i = i0 + j * G * NTHR, ic = i < 2 * 256 * D ? i : 0, k = ic % D, n = (ic / D) % 256, l = ic / (256 * D);
            const float* p = n < 4 ? a.wg + ((size_t)l * D + k) * 4 + n : a.we + ((size_t)l * D + k) * 32 + (n < 36 ? n - 4 : 0);
            const float t = *p; v[j] = n < 36 ? t : 0.f; }
        __builtin_amdgcn_sched_barrier(0);
#pragma unroll
        for (int j = 0; j < 8; ++j) { const int i = i0 + j * G * NTHR; if (i < 2 * 256 * D) a.Bt_rt[i] = (bf16_t)(cvt_pk_bf16(v[j], 0.f) & 0xffffu); }
    }
    if (vcu == 0) for (int i = tid; i < D / 4; i += NTHR) ((unsigned*)(a.hb8 + (size_t)NT * D))[i] = 0u;
    for (int i = vcu * NTHR + tid; i < 16 * D; i += G * NTHR) { const int k = i % D, n = i / D; a.Bt_g[i] = (bf16_t)(cvt_pk_bf16(a.m_win[(size_t)k * 6160 + 6144 + n], 0.f) & 0xffffu); }
    __syncthreads();
    conv_items(a, lds, vcu * NWAVES + wave, G * NWAVES, 0, CV_I1 + CV_I2, wave, lane);
}
template <bool TOLDS>
__device__ __forceinline__ void norm_store(const f32x4 (&v)[8], float ss, const float* g, const float* scv, const float* shv, bf16_t* orow, int lane, LAS unsigned char* yrow) {
    const float rstd = rsqrtf(wave_sum(ss) * (1.f / D) + EPS);
#pragma unroll
    for (int j = 0; j < 8; ++j) { const int c = 4 * lane + 256 * j;
        const f32x4 gg = *(const f32x4*)(g + c), sc = *(const f32x4*)(scv + c), sh = *(const f32x4*)(shv + c);
        const f32x4 y = v[j] * rstd * gg * (sc + 1.f) + sh;
        u32x2 w; w.x = cvt_pk_bf16(y[0], y[1]); w.y = cvt_pk_bf16(y[2], y[3]);
        *(u32x2*)(orow + c) = w;
        if (TOLDS) *(LAS u32x2*)(yrow + c * 2) = w; }
}
constexpr int YT_PITCH = 4112, NR_YT = 0, NR_RED = 16 * YT_PITCH, NR_LG = NR_RED + 24576, NR_TOK = NR_LG + 3072, CG_AN = 100352, CG_SH = CG_AN + 8192;
typedef short bf16x8r __attribute__((ext_vector_type(8)));
template <int NTL>
__device__ __forceinline__ void rows16_logits(const bf16_t* Bt, LAS unsigned char* lds, int wave, int lane, int tid) {
    const int r16 = lane & 15, q4 = lane >> 4;
    f32x4 acc[NTL];
#pragma unroll
    for (int nt = 0; nt < NTL; ++nt) acc[nt] = (f32x4){0.f, 0.f, 0.f, 0.f};
#pragma unroll
    for (int h = 0; h < 2; ++h) { bf16x8r wf[4][NTL];
#pragma unroll
        for (int kk = 0; kk < 4; ++kk)
#pragma unroll
            for (int nt = 0; nt < NTL; ++nt) wf[kk][nt] = *(const bf16x8r*)(Bt + (size_t)(16 * nt + r16) * D + 256 * wave + 32 * (4 * h + kk) + 8 * q4);
        __builtin_amdgcn_sched_barrier(0);
#pragma unroll
        for (int kk = 0; kk < 4; ++kk) { const int k0 = 256 * wave + 32 * (4 * h + kk) + 8 * q4;
            const bf16x8r yf = *(const LAS bf16x8r*)(lds + NR_YT + r16 * YT_PITCH + k0 * 2);
#pragma unroll
            for (int nt = 0; nt < NTL; ++nt) acc[nt] = __builtin_amdgcn_mfma_f32_16x16x32_bf16(wf[kk][nt], yf, acc[nt], 0, 0, 0); }
        __builtin_amdgcn_sched_barrier(0); }
#pragma unroll
    for (int nt = 0; nt < NTL; ++nt) *(LAS f32x4*)(lds + NR_RED + ((wave * NTL + nt) * 64 + lane) * 16) = acc[nt];
    __syncthreads();
    if (tid < NTL * 64) { const int nt = tid >> 6, ln = tid & 63; f32x4 sum = {0.f, 0.f, 0.f, 0.f};
#pragma unroll
        for (int w = 0; w < 8; ++w) sum += *(const LAS f32x4*)(lds + NR_RED + ((w * NTL + nt) * 64 + ln) * 16);
        LAS float* lg = (LAS float*)(lds + NR_LG) + (ln & 15) * 48 + 16 * nt + 4 * (ln >> 4);
        lg[0] = sum[0]; lg[1] = sum[1]; lg[2] = sum[2]; lg[3] = sum[3]; }
    __syncthreads();
}
__device__ __forceinline__ void phase_norm(const float* xin, const float* g, const float* modl, int sh_idx, int sc_idx, bf16_t* hb, int gw, int NGW, int lane) {
    const int RPW = (NT + NGW - 1) / NGW; int m = gw * RPW; const int mend = (m + RPW < NT) ? m + RPW : NT;
    if (m >= mend) return;
    f32x4 A[8], Bv[8], v[8], vn[8]; int bcur = -1;
#pragma unroll
    for (int j = 0; j < 8; ++j) v[j] = *(const f32x4*)(xin + (size_t)m * D + 4 * lane + 256 * j);
    for (;;) {
        const bool more = m + 1 < mend;
        if (more) {
#pragma unroll
            for (int j = 0; j < 8; ++j) vn[j] = *(const f32x4*)(xin + (size_t)(m + 1) * D + 4 * lane + 256 * j); }
        const int b = m / S;
        if (b != bcur) { bcur = b; const float* scv = modl + (size_t)b * 6 * D + sc_idx * D; const float* shv = modl + (size_t)b * 6 * D + sh_idx * D;
#pragma unroll
            for (int j = 0; j < 8; ++j) { const int c = 4 * lane + 256 * j; A[j] = *(const f32x4*)(g + c) * (*(const f32x4*)(scv + c) + 1.f); Bv[j] = *(const f32x4*)(shv + c); } }
        float ss = 0.f;
#pragma unroll
        for (int j = 0; j < 8; ++j) ss += (v[j][0] * v[j][0] + v[j][1] * v[j][1]) + (v[j][2] * v[j][2] + v[j][3] * v[j][3]);
        const float rstd = rsqrtf(wave_sum(ss) * (1.f / D) + EPS);
        bf16_t* orow = hb + (size_t)m * D;
#pragma unroll
        for (int j = 0; j < 8; ++j) { const f32x4 y = v[j] * rstd * A[j] + Bv[j]; u32x2 w; w.x = cvt_pk_bf16(y[0], y[1]); w.y = cvt_pk_bf16(y[2], y[3]); *(u32x2*)(orow + 4 * lane + 256 * j) = w; }
        if (!more) break;
        ++m;
#pragma unroll
        for (int j = 0; j < 8; ++j) v[j] = vn[j];
    }
}
__device__ __forceinline__ void phase_combine_final(const Args& a, const float* modl, const LAS int* ps, int gw, int NGW, int lane) {
    const int RPW = (NT + NGW - 1) / NGW; const int m0 = gw * RPW; const int mend = (m0 + RPW < NT) ? m0 + RPW : NT;
    if (m0 >= mend) return;
    int slot_l = 0; float w_l = 0.f;
    if (lane < 2 * (mend - m0) && lane < 64) { const int as = 2 * m0 + lane; slot_l = ps[a.eid[as]] + a.pos_in_e[as]; w_l = a.wts[as]; }
    f32x4 G4[8], F4[8];
    { const float* gt = modl + (size_t)(m0 / S) * 6 * D + 5 * D;
#pragma unroll
      for (int j = 0; j < 8; ++j) { G4[j] = *(const f32x4*)(gt + 4 * lane + 256 * j); F4[j] = *(const f32x4*)(a.fng + 4 * lane + 256 * j); } }
    for (int m = m0; m < mend; ++m) {
        const int r = m - m0; const int s0 = __shfl(slot_l, 2 * r), s1 = __shfl(slot_l, 2 * r + 1); const float w0 = __shfl(w_l, 2 * r), w1 = __shfl(w_l, 2 * r + 1);
        const bf16_t* xr = a.xres + (size_t)m * D; const bf16_t* y0 = a.Y + (size_t)s0 * D; const bf16_t* y1 = a.Y + (size_t)s1 * D;
        f32x4 v[8]; float ss = 0.f;
#pragma unroll
        for (int j = 0; j < 8; ++j) { const int c = 4 * lane + 256 * j;
            const f32x4 x1 = bf4_to_f32(*(const u32x2*)(xr + c)); const u32x2 p0 = *(const u32x2*)(y0 + c), p1 = *(const u32x2*)(y1 + c);
            f32x4 ya, yb;
            ya[0] = __uint_as_float(p0.x << 16); ya[1] = __uint_as_float(p0.x & 0xffff0000u); ya[2] = __uint_as_float(p0.y << 16); ya[3] = __uint_as_float(p0.y & 0xffff0000u);
            yb[0] = __uint_as_float(p1.x << 16); yb[1] = __uint_as_float(p1.x & 0xffff0000u); yb[2] = __uint_as_float(p1.y << 16); yb[3] = __uint_as_float(p1.y & 0xffff0000u);
            v[j] = x1 + G4[j] * (ya * w0 + yb * w1);
            ss += (v[j][0] * v[j][0] + v[j][1] * v[j][1]) + (v[j][2] * v[j][2] + v[j][3] * v[j][3]); }
        const float rstd = rsqrtf(wave_sum(ss) * (1.f / D) + EPS);
#pragma unroll
        for (int j = 0; j < 8; ++j) *(f32x4*)(a.out + (size_t)m * D + 4 * lane + 256 * j) = v[j] * rstd * F4[j];
    }
}
__device__ __forceinline__ void phase_combine_gates(const Args& a, const float* modl, const float* modn, const float* gnext, const LAS int* ps, LAS unsigned char* lds, int vcu, int G, int tid, int wave, int lane) {
    const int NGRP = NT / 16, GPW = (NGRP + G - 1) / G, g0 = vcu * GPW, gend = (g0 + GPW < NGRP) ? g0 + GPW : NGRP;
    if (g0 >= gend) return;
    int slot_l = 0; float w_l = 0.f;
    if (lane < 4 * (gend - g0)) { const int m = (g0 + (lane >> 2)) * 16 + 2 * wave + ((lane >> 1) & 1), as = 2 * m + (lane & 1); slot_l = ps[a.eid[as]] + a.pos_in_e[as]; w_l = a.wts[as]; }
    const int b = (g0 * 16) / S;
    const float* gt = modl + (size_t)b * 6 * D + 5 * D; const float* scv = modn + (size_t)b * 6 * D + 1 * D; const float* shv = modn + (size_t)b * 6 * D;
    LAS float* anl = (LAS float*)(lds + CG_AN); LAS float* shl = (LAS float*)(lds + CG_SH);
    for (int i = tid; i < D / 4; i += NTHR) { *(LAS f32x4*)(anl + 4 * i) = *(const f32x4*)(gnext + 4 * i) * (*(const f32x4*)(scv + 4 * i) + 1.f); *(LAS f32x4*)(shl + 4 * i) = *(const f32x4*)(shv + 4 * i); }
    __syncthreads();
    u32x2 xc[8], xn[8]; u32x2 pc0[8], pc1[8], pn0[8], pn1[8];
#define CG_LOAD(s_, X, P0, P1) do { const int m_ = (g0 + ((s_) >> 1)) * 16 + 2 * wave + ((s_) & 1), li_ = 2 * (s_); \
        const bf16_t* y0_ = a.Y + (size_t)__shfl(slot_l, li_) * D; const bf16_t* y1_ = a.Y + (size_t)__shfl(slot_l, li_ + 1) * D; \
        _Pragma("unroll") for (int j_ = 0; j_ < 8; ++j_) { const int c_ = 4 * lane + 256 * j_; X[j_] = *(const u32x2*)(a.xres + (size_t)m_ * D + c_); P0[j_] = *(const u32x2*)(y0_ + c_); P1[j_] = *(const u32x2*)(y1_ + c_); } } while (0)
    const int nrow = 2 * (gend - g0);
    CG_LOAD(0, xc, pc0, pc1);
    for (int sq = 0; sq < nrow; ++sq) {
        const int grp = g0 + (sq >> 1), rr = sq & 1, m = grp * 16 + 2 * wave + rr;
        if (sq + 1 < nrow) CG_LOAD(sq + 1, xn, pn0, pn1);
        const float w0 = __shfl(w_l, 2 * sq), w1 = __shfl(w_l, 2 * sq + 1);
        f32x4 v[8]; float ss = 0.f;
#pragma unroll
        for (int jg = 0; jg < 2; ++jg) { f32x4 Gt[4];
#pragma unroll
            for (int jj = 0; jj < 4; ++jj) Gt[jj] = *(const f32x4*)(gt + 4 * lane + 256 * (4 * jg + jj));
            __builtin_amdgcn_sched_barrier(0);
#pragma unroll
            for (int jj = 0; jj < 4; ++jj) { const int j = 4 * jg + jj; const u32x2 p0 = pc0[j], p1 = pc1[j]; f32x4 ya, yb;
                ya[0] = __uint_as_float(p0.x << 16); ya[1] = __uint_as_float(p0.x & 0xffff0000u); ya[2] = __uint_as_float(p0.y << 16); ya[3] = __uint_as_float(p0.y & 0xffff0000u);
                yb[0] = __uint_as_float(p1.x << 16); yb[1] = __uint_as_float(p1.x & 0xffff0000u); yb[2] = __uint_as_float(p1.y << 16); yb[3] = __uint_as_float(p1.y & 0xffff0000u);
                v[j] = bf4_to_f32(xc[j]) + Gt[jj] * (ya * w0 + yb * w1);
                ss += (v[j][0] * v[j][0] + v[j][1] * v[j][1]) + (v[j][2] * v[j][2] + v[j][3] * v[j][3]); } }
        const float rstd = rsqrtf(wave_sum(ss) * (1.f / D) + EPS);
        LAS unsigned char* yrow = lds + NR_YT + (2 * wave + rr) * YT_PITCH;
#pragma unroll
        for (int j = 0; j < 8; ++j) { const int c = 4 * lane + 256 * j; { u32x2 xw; xw.x = cvt_pk_bf16(v[j][0], v[j][1]); xw.y = cvt_pk_bf16(v[j][2], v[j][3]); *(u32x2*)(a.xres + (size_t)m * D + c) = xw; }
            const f32x4 y = v[j] * rstd * (*(const LAS f32x4*)(anl + c)) + *(const LAS f32x4*)(shl + c); u32x2 w; w.x = cvt_pk_bf16(y[0], y[1]); w.y = cvt_pk_bf16(y[2], y[3]);
            *(unsigned*)(a.hb8 + (size_t)m * D + c) = pk4_fp8(y[0] * 4.f, y[1] * 4.f, y[2] * 4.f, y[3] * 4.f); *(LAS u32x2*)(yrow + c * 2) = w; }
#pragma unroll
        for (int j = 0; j < 8; ++j) { xc[j] = xn[j]; pc0[j] = pn0[j]; pc1[j] = pn1[j]; }
        if (rr == 1) {
            __syncthreads();
            rows16_logits<1>(a.Bt_g, lds, wave, lane, tid);
            if (tid < 256) a.gates[(size_t)(grp * 16 + (tid >> 4)) * 16 + (tid & 15)] = ((const LAS float*)(lds + NR_LG))[(tid >> 4) * 48 + (tid & 15)];
        }
    }
#undef CG_LOAD
}
__device__ __forceinline__ void phase_norm_route(const Args& a, int layer, const float* modl, LAS unsigned char* lds, LAS unsigned char* misc, int vcu, int G, int tid, int wave, int lane) {
    LAS int* hist = (LAS int*)(misc + MISC_HIST); LAS int* base = (LAS int*)(misc + MISC_BASE);
    LAS int* tk = (LAS int*)(lds + NR_TOK);
    LAS float* tw = (LAS float*)(lds + NR_TOK + 2048);
    int* counts = a.counts + layer * 64;
    const float* bg = a.bg + layer * 4; const float* be = a.be + layer * 32; const float* g = a.nfg + layer * D;
    if (tid < 32) hist[tid] = 0;
    LAS float* bl = (LAS float*)(lds + NR_TOK + 3072);
    if (tid < 36) bl[tid] = tid < 4 ? bg[tid] : be[tid - 4];
    __syncthreads();
    const int NGRP = NT / 16, GPW = (NGRP + G - 1) / G, g0 = vcu * GPW, gend = (g0 + GPW < NGRP) ? g0 + GPW : NGRP;
    const int ng = gend > g0 ? gend - g0 : 0;
    if (ng > 0) {
        const int b = (g0 * 16) / S;
        f32x4 A[8]; const float* shv = modl + (size_t)b * 6 * D + 3 * D;
        { const float* scv = modl + (size_t)b * 6 * D + 4 * D;
#pragma unroll
          for (int j = 0; j < 8; ++j) { const int c = 4 * lane + 256 * j; A[j] = *(const f32x4*)(g + c) * (*(const f32x4*)(scv + c) + 1.f); } }
        u32x2 x1[2][8];
#define NR_LOAD(grp_) do { _Pragma("unroll") for (int rr_ = 0; rr_ < 2; ++rr_) { const bf16_t* xr_ = a.xres + (size_t)((grp_) * 16 + 2 * wave + rr_) * D; \
        _Pragma("unroll") for (int j_ = 0; j_ < 8; ++j_) x1[rr_][j_] = *(const u32x2*)(xr_ + 4 * lane + 256 * j_); } } while (0)
        NR_LOAD(g0);
        for (int grp = g0; grp < gend; ++grp) {
            const int gi = grp - g0;
#pragma unroll
            for (int rr = 0; rr < 2; ++rr) { const int m = grp * 16 + 2 * wave + rr; float ss = 0.f;
#pragma unroll
                for (int j = 0; j < 8; ++j) { const f32x4 v = bf4_to_f32(x1[rr][j]); ss += (v[0] * v[0] + v[1] * v[1]) + (v[2] * v[2] + v[3] * v[3]); }
                const float rstd = rsqrtf(wave_sum(ss) * (1.f / D) + EPS);
                LAS unsigned char* yrow = lds + NR_YT + (2 * wave + rr) * YT_PITCH;
                f32x4 Bs[8];
#pragma unroll
                for (int j = 0; j < 8; ++j) Bs[j] = *(const f32x4*)(shv + 4 * lane + 256 * j);
                __builtin_amdgcn_sched_barrier(0);
#pragma unroll
                for (int j = 0; j < 8; ++j) { const int c = 4 * lane + 256 * j; const f32x4 y = bf4_to_f32(x1[rr][j]) * rstd * A[j] + Bs[j];
                    u32x2 w; w.x = cvt_pk_bf16(y[0], y[1]); w.y = cvt_pk_bf16(y[2], y[3]); *(LAS u32x2*)(yrow + c * 2) = w;
                    *(unsigned*)(a.hb8 + (size_t)m * D + c) = pk4_fp8(y[0] * 4.f, y[1] * 4.f, y[2] * 4.f, y[3] * 4.f); } }
            if (grp + 1 < gend) NR_LOAD(grp + 1);
            __syncthreads();
            rows16_logits<3>(a.Bt_rt + (size_t)layer * 256 * D, lds, wave, lane, tid);
            if (tid < 16 && gi < 8) {
                const LAS float* lg = (const LAS float*)(lds + NR_LG) + tid * 48;
                float gmax = -INFINITY; int grpi = 0;
#pragma unroll
                for (int i = 0; i < 4; ++i) { const float v = lg[i] + bl[i]; if (v > gmax) { gmax = v; grpi = i; } }
                float gs = 0.f;
#pragma unroll
                for (int i = 0; i < 4; ++i) gs += expf(lg[i] + bl[i] - gmax);
                const float pg = 1.f / gs;
                float v1 = -INFINITY, v2 = -INFINITY; int i1 = 0, i2 = 0;
                for (int i = 0; i < 8; ++i) { const float v = lg[4 + grpi * 8 + i] + bl[4 + grpi * 8 + i];
                    if (v > v1) { v2 = v1; i2 = i1; v1 = v; i1 = i; } else if (v > v2) { v2 = v; i2 = i; } }
                const float ex = expf(v2 - v1); const int e1 = grpi * 8 + i1, e2 = grpi * 8 + i2, sl = gi * 16 + tid;
                tk[sl] = e1; tk[128 + sl] = e2; tk[256 + sl] = atomicAdd((int*)&hist[e1], 1); tk[384 + sl] = atomicAdd((int*)&hist[e2], 1);
                tw[sl] = pg / (1.f + ex); tw[128 + sl] = pg * ex / (1.f + ex);
            }
        }
#undef NR_LOAD
    }
    __syncthreads();
    if (tid < 32) { const int h = hist[tid]; base[tid] = h ? atomicAdd(&counts[tid], h) : 0; }
    __syncthreads();
    if (tid < ng * 16 && tid < 128) { const int t = (g0 + (tid >> 4)) * 16 + (tid & 15), e1 = tk[tid], e2 = tk[128 + tid];
        a.eid[2 * t] = e1; a.eid[2 * t + 1] = e2; a.wts[2 * t] = tw[tid]; a.wts[2 * t + 1] = tw[128 + tid];
        const int p1 = base[e1] + tk[256 + tid], p2 = base[e2] + tk[384 + tid];
        a.pos_in_e[2 * t] = p1; a.pos_in_e[2 * t + 1] = p2; a.inv[e1 * 32768 + p1] = t; a.inv[e2 * 32768 + p2] = t; }
    __syncthreads();
}
__device__ __forceinline__ int moe_tables(const int* counts, LAS unsigned char* misc, int tid) {
    LAS int* ps = (LAS int*)(misc + MISC_PS); LAS int* pe = (LAS int*)(misc + MISC_PE); LAS int* npw = (LAS int*)(misc + MISC_NP);
    __syncthreads();
    if (tid < 64) {
        LAS int* cn = (LAS int*)(misc + MISC_CNT); const int e = tid & 31;
        const int c = __hip_atomic_load(&counts[e], __ATOMIC_RELAXED, __HIP_MEMORY_SCOPE_AGENT), np = (c + 255) >> 8;
        int incl = np;
#pragma unroll
        for (int d = 1; d < 32; d <<= 1) { const int t = __shfl_up(incl, d); if (tid >= d) incl += t; }
        if (tid < 32) { const int start = incl - np; ps[e] = start << 8; cn[e] = c;
            for (int p = 0; p < np; ++p) pe[start + p] = e;
            if (e == NE - 1) { ps[NE] = incl << 8; npw[0] = incl; } }
    }
    __syncthreads();
    return npw[0];
}
struct EpiQKV {
    static constexpr bool PERM = true, AFTER_DRAIN = false;
    bf16_t *Qh, *Kh, *Vh; const float2* cs;
    __device__ __forceinline__ void operator()(const f32x4 (&acc)[2][2][4][2], const Unit& u, int wr, int wc, int fr, int fq) const {
        const int t = u.pn >> 3, hh = u.pn & 7;
        bf16_t* base = Qh + (size_t)t * ((size_t)NT * 2048);
        const int row0 = u.pm * 256 + wr * 64 + fr;
        const bool rope = (t < 2) && (wc == 0);
#pragma unroll
        for (int ai = 0; ai < 2; ++ai) {
            f32x4 C[4][4];
            if (rope) {
#pragma unroll
                for (int mm = 0; mm < 4; ++mm) { const f32x4* cp = (const f32x4*)(cs + (size_t)(row0 + ai * 128 + mm * 16) * 16 + 8 * (fq & 1)); C[mm][0] = cp[0]; C[mm][1] = cp[1]; C[mm][2] = cp[2]; C[mm][3] = cp[3]; }
            } else {
#pragma unroll
                for (int mm = 0; mm < 4; ++mm) { C[mm][0] = (f32x4){0.f, 0.f, 0.f, 0.f}; C[mm][1] = C[mm][0]; C[mm][2] = C[mm][0]; C[mm][3] = C[mm][0]; }
            }
            __builtin_amdgcn_sched_barrier(0);
#pragma unroll
            for (int mm = 0; mm < 4; ++mm) { const int m = mm, row = row0 + ai * 128 + m * 16;
                const f32x4 c0 = C[mm][0], c1 = C[mm][1], c2 = C[mm][2], c3 = C[mm][3];
#pragma unroll
                for (int bj = 0; bj < 2; ++bj) { f32x4 v0 = acc[ai][bj][m][0], v1 = acc[ai][bj][m][1];
                    if (rope) {
                        const float sg = (fq < 2) ? -1.f : 1.f;
                        float v[8] = {v0[0], v0[1], v0[2], v0[3], v1[0], v1[1], v1[2], v1[3]};
                        const float cc[8] = {c0[0], c0[2], c1[0], c1[2], c2[0], c2[2], c3[0], c3[2]}, sn[8] = {c0[1], c0[3], c1[1], c1[3], c2[1], c2[3], c3[1], c3[3]};
#pragma unroll
                        for (int i = 0; i < 8; ++i) { const float pv = __shfl_xor(v[i], 32); v[i] = v[i] * cc[i] + sg * pv * sn[i]; }
                        v0 = (f32x4){v[0], v[1], v[2], v[3]}; v1 = (f32x4){v[4], v[5], v[6], v[7]};
                    }
                    u32x4 w; w.x = cvt_pk_bf16(v0[0], v0[1]); w.y = cvt_pk_bf16(v0[2], v0[3]); w.z = cvt_pk_bf16(v1[0], v1[1]); w.w = cvt_pk_bf16(v1[2], v1[3]);
                    *(u32x4*)(base + ((size_t)(hh * 2 + bj) * NT + row) * 128 + wc * 32 + 8 * fq) = w; } }
            __builtin_amdgcn_sched_barrier(0);
        }
    }
};
typedef att::BlockRef<bf16_t, bf16_t> ARef;
__device__ __forceinline__ ARef att_ref(const Args& a, int hd, int qb) {
    const int b = hd >> 5, vh = hd & 31, h = vh >> 2, m = (vh >> 1) & 1, half = vh & 1;
    ARef r;
    r.Q = a.Qh + ((size_t)(h * 2 + m) * NT + (size_t)b * S + (size_t)qb * 256) * 128;
    r.K = a.Kh + ((size_t)(h * 2 + m) * NT + (size_t)b * S) * 128;
    r.V = a.Vh + ((size_t)(h * 2 + half) * NT + (size_t)b * S) * 128;
    r.O = a.Oa + ((size_t)((h * 2 + m) * 2 + half) * NT + (size_t)b * S + (size_t)qb * 256) * 128;
    r.P0 = qb * 256;
    return r;
}
__device__ __forceinline__ bool att_pos(int w, int N, int r, int& hd, int& qb) {
    const int p = r * N + ((r & 1) ? (N - 1 - w) : w); if (p >= 2048) return false;
    const int c = p >> 9, pl = p & 511; hd = pl >> 2; qb = 15 - 4 * c - (pl & 3); return true;
}
constexpr int CVA_MIN = 16 * 96, CVA_MO = 16 * 32, CVA_GU = 64 * 512, CVA_DN = 64 * 256, CVA_ITEMS = CVA_MIN + CVA_MO + CVA_GU + CVA_DN, CVA_BUF = 4224;
struct CvaItem { const float* W; unsigned char* WT; int ldw, K, k0, n0, s0; float sc; };
__device__ __forceinline__ CvaItem cva_decode(const Args& a, int r) {
    CvaItem d; d.ldw = 2048; d.K = D; d.sc = 64.f;
    if (r < CVA_MIN) { const int kb = r / 96, nb = r - kb * 96; d.W = a.m_win; d.ldw = 6160; d.WT = a.Bt_min8; d.k0 = kb * 128; d.n0 = nb * 64; d.s0 = d.n0; return d; } r -= CVA_MIN;
    if (r < CVA_MO) { d.W = a.m_wout; d.WT = a.Bt_mo8; d.k0 = (r >> 5) * 128; d.n0 = (r & 31) * 64; d.s0 = d.n0; return d; } r -= CVA_MO;
    if (r < CVA_GU) { const int ex = r >> 9, q = r & 511; d.W = a.wgu + (size_t)ex * D * 2048; d.WT = a.Bt_gu8 + (size_t)ex * 2048 * D; d.k0 = (q >> 5) * 128; d.n0 = (q & 31) * 64; d.s0 = gu_src(d.n0); return d; } r -= CVA_GU;
    { const int ex = r >> 8, q = r & 255; d.W = a.wdn + (size_t)ex * MH * D; d.WT = a.Bt_dn8 + (size_t)ex * D * MH; d.K = MH; d.k0 = (q >> 5) * 128; d.n0 = (q & 31) * 64; d.s0 = d.n0; d.sc = 32.f; return d; }
}
struct AttConv {
    const Args* a; LAS unsigned char* buf;
    int nxt, stride, cur, wave; unsigned bufa;
    __device__ __forceinline__ void issue() {
        if (nxt >= CVA_ITEMS) return;
        const CvaItem d = cva_decode(*a, nxt);
        const int l = opq((int)threadIdx.x) & 63, kq = wave & 3, nh = wave >> 2;
        cur = nxt; nxt += stride;
        const char* base = (const char*)(d.W + (size_t)(d.k0 + 32 * kq) * d.ldw + d.s0 + 32 * nh);
        const unsigned voff = (unsigned)(((l >> 3) * d.ldw + 4 * (l & 7)) * 4);
#pragma unroll
        for (int j = 0; j < 4; ++j) asm volatile("s_mov_b32 m0, %2\n\ts_nop 0\n\tglobal_load_lds_dwordx4 %0, %1" :: "v"(voff), "s"(base + (size_t)(8 * j) * d.ldw * 4), "s"(bufa + j * 1024 + (j >= 2 ? 128 : 0)) : "memory", "m0");
    }
    __device__ __forceinline__ void consume() {
        if (cur < 0) return;
        asm volatile("s_waitcnt vmcnt(0)" ::: "memory");
        const CvaItem d = cva_decode(*a, cur);
        const int l = opq((int)threadIdx.x) & 63, n = l & 31, kh = l >> 5, kq = wave & 3, nh = wave >> 2;
        const LAS float* p = (const LAS float*)(buf + kh * (17 * 128) + n * 4);
        float v[16];
#pragma unroll
        for (int i = 0; i < 16; ++i) v[i] = p[i * 32] * d.sc;
        u32x4 o; o.x = pk4_fp8(v[0], v[1], v[2], v[3]); o.y = pk4_fp8(v[4], v[5], v[6], v[7]); o.z = pk4_fp8(v[8], v[9], v[10], v[11]); o.w = pk4_fp8(v[12], v[13], v[14], v[15]);
        *(u32x4*)(d.WT + (size_t)(d.n0 + 32 * nh + n) * d.K + d.k0 + 32 * kq + 16 * kh) = o;
        asm volatile("s_waitcnt lgkmcnt(0)" ::: "memory");
        cur = -1;
    }
    __device__ __forceinline__ void finish() {
        consume();
        while (nxt < CVA_ITEMS) { issue(); consume(); }
    }
};
__device__ __forceinline__ void phase_attn(const Args& a, char* lds, int w, int N  ) {
    AttConv cv; cv.a = &a; cv.wave = __builtin_amdgcn_readfirstlane((int)threadIdx.x >> 6); cv.buf = (LAS unsigned char*)lds + att::ATT_LDS_BYTES + cv.wave * CVA_BUF; cv.bufa = __builtin_amdgcn_readfirstlane((unsigned)(uintptr_t)lds + att::ATT_LDS_BYTES + cv.wave * CVA_BUF);
    cv.nxt = w; cv.stride = N; cv.cur = -1;
    int hd, qb, r = 0;
    if (att_pos(w, N, 0, hd, qb)) {
        ARef cur = att_ref(a, hd, qb);
        att::Seam<bf16_t> Sm;
        att::causal_swa_prime<bf16_t, bf16_t>(cur, 1 << 30, lds, Sm);
        for (;;) {
            int hn, qn; const bool more = att_pos(w, N, r + 1, hn, qn);
            const ARef nxt = more ? att_ref(a, hn, qn) : cur;
            att::causal_swa_block<bf16_t, bf16_t, AttConv>(cur, nxt, S, 1 << 30, lds, Sm, cv);
            if (!more) break;
            cur = nxt; ++r;
        }
    }
    cv.finish();
}
__device__ __forceinline__ float bf_lo(unsigned u) { return __uint_as_float(u << 16); }
__device__ __forceinline__ float bf_hi(unsigned u) { return __uint_as_float(u & 0xffff0000u); }
typedef unsigned short u16x8 __attribute__((ext_vector_type(8)));
__device__ __forceinline__ void bf8_to_f32(const u32x4 p, float (&f)[8]) {
    f[0] = bf_lo(p.x); f[1] = bf_hi(p.x); f[2] = bf_lo(p.y); f[3] = bf_hi(p.y); f[4] = bf_lo(p.z); f[5] = bf_hi(p.z); f[6] = bf_lo(p.w); f[7] = bf_hi(p.w); }
__device__ __forceinline__ void phase_attn_combine(const Args& a, int gw, int NGW, int lane) {
    float d1 = a.lq1[lane] * a.lk1[lane] + a.lq1[lane + 64] * a.lk1[lane + 64], d2 = a.lq2[lane] * a.lk2[lane] + a.lq2[lane + 64] * a.lk2[lane + 64];
    const float lam = __expf(wave_sum(d1)) - __expf(wave_sum(d2)) + 0.2f;
    const int hh = lane >> 3, e0 = (lane & 7) * 32, half = e0 >> 7, d0 = e0 & 127;
    float gv[32];
#pragma unroll
    for (int i = 0; i < 8; ++i) { const f32x4 t = *(const f32x4*)(a.a_hg + e0 + 4 * i); gv[4 * i] = t[0]; gv[4 * i + 1] = t[1]; gv[4 * i + 2] = t[2]; gv[4 * i + 3] = t[3]; }
    const bf16_t* O0 = a.Oa + ((size_t)((hh * 2 + 0) * 2 + half) * NT) * 128 + d0;
    const bf16_t* O1 = a.Oa + ((size_t)((hh * 2 + 1) * 2 + half) * NT) * 128 + d0;
    const int RPW = (NT + NGW - 1) / NGW; int m = gw * RPW; const int mend = (m + RPW < NT) ? m + RPW : NT;
    if (m >= mend) return;
    u32x4 p0[4], p1[4], n0[4], n1[4];
#pragma unroll
    for (int i = 0; i < 4; ++i) { p0[i] = *(const u32x4*)(O0 + (size_t)m * 128 + 8 * i); p1[i] = *(const u32x4*)(O1 + (size_t)m * 128 + 8 * i); }
    for (;;) {
        const bool more = m + 1 < mend;
        if (more) {
#pragma unroll
            for (int i = 0; i < 4; ++i) { n0[i] = *(const u32x4*)(O0 + (size_t)(m + 1) * 128 + 8 * i); n1[i] = *(const u32x4*)(O1 + (size_t)(m + 1) * 128 + 8 * i); } }
        float o[32]; float ss = 0.f;
#pragma unroll
        for (int i = 0; i < 4; ++i) { float f0[8], f1[8]; bf8_to_f32(p0[i], f0); bf8_to_f32(p1[i], f1);
#pragma unroll
            for (int j = 0; j < 8; ++j) { o[8 * i + j] = f0[j] - lam * f1[j]; ss += o[8 * i + j] * o[8 * i + j]; } }
        ss += __shfl_xor(ss, 1); ss += __shfl_xor(ss, 2); ss += __shfl_xor(ss, 4);
        const float r = rsqrtf(ss * (1.f / 256.f) + EPS) * 0.8f;
        bf16_t* orow = a.ob + (size_t)m * D + hh * 256 + e0;
#pragma unroll
        for (int i = 0; i < 4; ++i) { u32x4 w; w.x = cvt_pk_bf16(o[8 * i] * r * gv[8 * i], o[8 * i + 1] * r * gv[8 * i + 1]); w.y = cvt_pk_bf16(o[8 * i + 2] * r * gv[8 * i + 2], o[8 * i + 3] * r * gv[8 * i + 3]);
            w.z = cvt_pk_bf16(o[8 * i + 4] * r * gv[8 * i + 4], o[8 * i + 5] * r * gv[8 * i + 5]); w.w = cvt_pk_bf16(o[8 * i + 6] * r * gv[8 * i + 6], o[8 * i + 7] * r * gv[8 * i + 7]);
            *(u32x4*)(orow + 8 * i) = w; }
        if (!more) break;
        ++m;
#pragma unroll
        for (int i = 0; i < 4; ++i) { p0[i] = n0[i]; p1[i] = n1[i]; }
    }
}

struct EpiMin {
    static constexpr bool PERM = true, AFTER_DRAIN = false;
    bf16_t* P3;
    __device__ __forceinline__ void operator()(const f32x4 (&acc)[2][2][4][2], const Unit& u, int wr, int wc, int fr, int fq) const {
        const int t = u.pn >> 3; const int row0 = u.pm * 256 + wr * 64 + fr;
        bf16_t* base = P3 + (size_t)t * ((size_t)NT * 2048); const int col0 = (u.pn & 7) * 256 + wc * 32 + 8 * fq;
#pragma unroll
        for (int ai = 0; ai < 2; ++ai)
#pragma unroll
            for (int m = 0; m < 4; ++m) { bf16_t* rowp = base + (size_t)(row0 + ai * 128 + m * 16) * 2048 + col0;
#pragma unroll
                for (int bj = 0; bj < 2; ++bj) { f32x4 v0 = acc[ai][bj][m][0] * (1.f / 256.f), v1 = acc[ai][bj][m][1] * (1.f / 256.f);
                    if (t == 2) {
#pragma unroll
                        for (int j = 0; j < 4; ++j) { v0[j] = 1.f / (1.f + __expf(-v0[j])); v1[j] = 1.f / (1.f + __expf(-v1[j])); } }
                    u32x4 w; w.x = cvt_pk_bf16(v0[0], v0[1]); w.y = cvt_pk_bf16(v0[2], v0[3]); w.z = cvt_pk_bf16(v1[0], v1[1]); w.w = cvt_pk_bf16(v1[2], v1[3]);
                    *(u32x4*)(rowp + bj * 128) = w; } }
    }
};
constexpr int MP_XS = 0, MP_VT = 35840, MP_QS = 69632, MP_KS = 87040, MP_GT = 104448;
__device__ __forceinline__ unsigned pk_lo(unsigned a, unsigned b) { return (a & 0xffffu) | (b << 16); }
__device__ __forceinline__ unsigned pk_hi(unsigned a, unsigned b) { return (a >> 16) | (b & 0xffff0000u); }
__device__ __forceinline__ void phase_mprep(const Args& a, LAS unsigned char* lds, int vcu, int G, int tid) {
    const bf16_t* QKP = a.P3; const bf16_t* VB = a.P3 + (size_t)NT * 2048;
    for (int it = vcu; it < NB * 64; it += G) {
        const int b = it >> 6, ck = it & 63; const size_t row0 = (size_t)b * S + (size_t)ck * 64;
        __syncthreads();
        {
            const int t = tid >> 3, h = tid & 7; LAS float* gt = (LAS float*)(lds + MP_GT);
            const float gi = a.gates[(row0 + t) * 16 + h] + a.m_gb[h], z = a.gates[(row0 + t) * 16 + 8 + h] + a.m_gb[8 + h];
            gt[t * 8 + h] = gi; gt[512 + t * 8 + h] = fminf(z, 0.f) - log1pf(expf(-fabsf(z)));
        }
        __syncthreads();
        if (tid < 8) {
            const int h = tid; float bc = 0.f, cm = -INFINITY; const LAS float* gt = (const LAS float*)(lds + MP_GT);
            float* ga = a.GA + (size_t)((b * 8 + h) * 64 + ck) * 192;
            for (int t = 0; t < 64; ++t) { bc += gt[512 + t * 8 + h]; const float av = gt[t * 8 + h] - bc; cm = fmaxf(cm, av); ga[t] = av; ga[64 + t] = cm; ga[128 + t] = bc; }
            a.GS[(size_t)((b * 8 + h) * 64 + ck) * 2 + 0] = cm; a.GS[(size_t)((b * 8 + h) * 64 + ck) * 2 + 1] = bc;
        }
        for (int h = 0; h < 8; ++h) {
            {
                const int tq = opq(tid); u32x4 xs[5];
#pragma unroll
                for (int i = 0; i < 5; ++i) { const int c0 = tq + 512 * i, c = c0 < 67 * 32 ? c0 : 67 * 32 - 1, r = c >> 5, cc = c & 31; long gr = (long)row0 + r - 3; if (gr < 0) gr = 0;
                    xs[i] = *(const u32x4*)(QKP + (size_t)gr * 2048 + (cc < 16 ? h * 128 + cc * 8 : 1024 + h * 128 + (cc - 16) * 8)); }
                __builtin_amdgcn_sched_barrier(0);
#pragma unroll
                for (int i = 0; i < 5; ++i) { const int c = tq + 512 * i, r = c >> 5, cc = c & 31;
                    if (c < 67 * 32) *(LAS u32x4*)(lds + MP_XS + r * 528 + cc * 16) = (ck * 64 + r - 3 >= 0) ? xs[i] : (u32x4){0u, 0u, 0u, 0u}; }
                __builtin_amdgcn_sched_barrier(0);
            }
            {   const int tq = opq(tid); u32x4 vv[4];
#pragma unroll
                for (int i = 0; i < 4; ++i) { const int c = tq + 512 * i, sr = c >> 5, e16 = c & 31; vv[i] = *(const u32x4*)(VB + (row0 + sr) * 2048 + h * 256 + e16 * 8); }
                __builtin_amdgcn_sched_barrier(0);
#pragma unroll
                for (int i = 0; i < 4; ++i) { const int c = tq + 512 * i, sr = c >> 5, e16 = c & 31; *(LAS u32x4*)(lds + MP_VT + sr * 528 + e16 * 16) = vv[i]; }
            }
            __syncthreads();
            {
                const int cp = tid & 127, rq = tid >> 7; const bool isk = cp >= 64;
                const int col = isk ? 1024 + h * 128 + 2 * (cp - 64) : h * 128 + 2 * cp;
                float w0[4], w1[4];
#pragma unroll
                for (int j = 0; j < 4; ++j) { w0[j] = a.m_cw[j * 2048 + col]; w1[j] = a.m_cw[j * 2048 + col + 1]; }
                const float b0 = a.m_cb[col], b1 = a.m_cb[col + 1];
                const LAS unsigned char* xp = lds + MP_XS + (16 * rq) * 528 + cp * 4;
                float xa[4], xb[4];
#pragma unroll
                for (int j = 0; j < 3; ++j) { const unsigned v = *(const LAS unsigned*)(xp + j * 528); xa[j] = bf_lo(v); xb[j] = bf_hi(v); }
                const float sc = isk ? 0.08838834764831845f : 1.f;
                LAS unsigned char* dst = lds + (isk ? MP_KS : MP_QS) + (isk ? cp - 64 : cp) * 4;
#pragma unroll
                for (int i = 0; i < 16; ++i) { const int t = 16 * rq + i;
                    const unsigned v = *(const LAS unsigned*)(xp + (i + 3) * 528); xa[3] = bf_lo(v); xb[3] = bf_hi(v);
                    float ya = b0 + w0[0] * xa[0] + w0[1] * xa[1] + w0[2] * xa[2] + w0[3] * xa[3];
                    float yb = b1 + w1[0] * xb[0] + w1[1] * xb[1] + w1[2] * xb[2] + w1[3] * xb[3];
                    ya = ya / (1.f + __expf(-ya)) * sc; yb = yb / (1.f + __expf(-yb)) * sc;
                    *(LAS unsigned*)(dst + t * 272) = cvt_pk_bf16(ya, yb);
                    xa[0] = xa[1]; xa[1] = xa[2]; xa[2] = xa[3]; xb[0] = xb[1]; xb[1] = xb[2]; xb[2] = xb[3]; }
            }
            __syncthreads();
            {
#pragma unroll
                for (int i = 0; i < 4; ++i) { const int c = tid + 512 * i, isk = c >> 10, r = (c >> 4) & 63, cc = c & 15;
                    *(u32x4*)(a.Qn + (isk ? (size_t)NT * 1024 : (size_t)0) + (row0 + r) * 1024 + h * 128 + cc * 8) = *(const LAS u32x4*)(lds + (isk ? MP_KS : MP_QS) + r * 272 + cc * 16); }
            }
            if (tid < 256) {
                const int dp = tid & 63, sq = tid >> 6; unsigned w[16];
#pragma unroll
                for (int i = 0; i < 16; ++i) w[i] = *(const LAS unsigned*)(lds + MP_KS + (16 * sq + i) * 272 + dp * 4);
                u32x4* d0p = (u32x4*)(a.KT + ((size_t)((b * 8 + h) * 64 + ck) * 128 + 2 * dp) * 64 + 16 * sq);
                d0p[0] = (u32x4){pk_lo(w[0], w[1]), pk_lo(w[2], w[3]), pk_lo(w[4], w[5]), pk_lo(w[6], w[7])};
                d0p[1] = (u32x4){pk_lo(w[8], w[9]), pk_lo(w[10], w[11]), pk_lo(w[12], w[13]), pk_lo(w[14], w[15])};
                d0p[8] = (u32x4){pk_hi(w[0], w[1]), pk_hi(w[2], w[3]), pk_hi(w[4], w[5]), pk_hi(w[6], w[7])};
                d0p[9] = (u32x4){pk_hi(w[8], w[9]), pk_hi(w[10], w[11]), pk_hi(w[12], w[13]), pk_hi(w[14], w[15])};
            }
            {
                const int ep = tid & 127, sq = tid >> 7; unsigned w[16];
#pragma unroll
                for (int i = 0; i < 16; ++i) w[i] = *(const LAS unsigned*)(lds + MP_VT + (16 * sq + i) * 528 + ep * 4);
                u32x4* d0p = (u32x4*)(a.VT + ((size_t)((b * 8 + h) * 64 + ck) * 256 + 2 * ep) * 64 + 16 * sq);
                d0p[0] = (u32x4){pk_lo(w[0], w[1]), pk_lo(w[2], w[3]), pk_lo(w[4], w[5]), pk_lo(w[6], w[7])};
                d0p[1] = (u32x4){pk_lo(w[8], w[9]), pk_lo(w[10], w[11]), pk_lo(w[12], w[13]), pk_lo(w[14], w[15])};
                d0p[8] = (u32x4){pk_hi(w[0], w[1]), pk_hi(w[2], w[3]), pk_hi(w[4], w[5]), pk_hi(w[6], w[7])};
                d0p[9] = (u32x4){pk_hi(w[8], w[9]), pk_hi(w[10], w[11]), pk_hi(w[12], w[13]), pk_hi(w[14], w[15])};
            }
            __syncthreads();
        }
    }
}

constexpr int ML_QS = 0, ML_KS = 17408, ML_KTS = 34816, ML_VTS = 53248, ML_GL = 60160, ML_PL = 60928, ML_QD = 70144, ML_CL = 87552, ML_MP = 113664, ML_END = 113920;
typedef short bf16x8s __attribute__((ext_vector_type(8)));
__device__ __forceinline__ void phase_mlstm(const Args& a, LAS unsigned char* lds, int vcu, int G, int tid, int wave, int lane) {
    const int r16 = lane & 15, q4 = lane >> 4;
    for (int unit = vcu; unit < 256; unit += G) {
        const int bh = unit >> 3, es = unit & 7, b = bh >> 3, h = bh & 7;
        __syncthreads();
        for (int i = tid; i < 16 * 36; i += NTHR) { const int r = i / 36, c = i % 36; *(LAS unsigned*)(lds + ML_VTS + (32 + r) * 144 + c * 4) = (r == 0) ? 0x3F803F80u : 0u; }
        for (int i = tid; i < 48 * 68; i += NTHR) *(LAS unsigned*)(lds + ML_CL + i * 4) = 0u;
        if (tid < 64) { ((LAS float*)(lds + ML_END))[2 * tid] = a.GS[(size_t)(bh * 64 + tid) * 2]; ((LAS float*)(lds + ML_END))[2 * tid + 1] = a.GS[(size_t)(bh * 64 + tid) * 2 + 1]; }
        __syncthreads();
        if (tid == 0) { float m = 0.f; LAS float* mp = (LAS float*)(lds + ML_MP); const LAS float* gs = (const LAS float*)(lds + ML_END);
            for (int k = 0; k < 64; ++k) { mp[k] = m; m = gs[2 * k + 1] + fmaxf(m, gs[2 * k]); } }
        f32x4 accC[2][3];
#pragma unroll
        for (int i = 0; i < 2; ++i)
#pragma unroll
            for (int j = 0; j < 3; ++j) accC[i][j] = (f32x4){0.f, 0.f, 0.f, 0.f};
        u32x4 rq[2], rk[2], rkt[2], rv, rg, sq[2], sk[2], skt[2], sv, sg;
        rv = (u32x4){0u, 0u, 0u, 0u}; rg = rv; sv = rv; sg = rv;
#define ML_LOAD(k, Q_, K_, KT_, V_, G_) do { const int kc_ = (k) < 64 ? (k) : 63; const size_t row0_ = (size_t)b * S + (size_t)kc_ * 64; const size_t cb_ = (size_t)(bh * 64 + kc_); \
        _Pragma("unroll") for (int i_ = 0; i_ < 2; ++i_) { const int c_ = tid + 512 * i_; \
            Q_[i_] = *(const u32x4*)(a.Qn + (row0_ + (c_ >> 4)) * 1024 + h * 128 + (c_ & 15) * 8); \
            K_[i_] = *(const u32x4*)(a.Kn + (row0_ + (c_ >> 4)) * 1024 + h * 128 + (c_ & 15) * 8); \
            KT_[i_] = *(const u32x4*)(a.KT + cb_ * 8192 + (size_t)c_ * 8); } \
        V_ = *(const u32x4*)(a.VT + cb_ * 16384 + (size_t)es * 2048 + (size_t)(tid & 255) * 8); \
        G_ = *(const u32x4*)(a.GA + cb_ * 192 + (tid & 31) * 4); } while (0)
#define ML_STORE(Q_, K_, KT_, V_, G_) do { \
        _Pragma("unroll") for (int i_ = 0; i_ < 2; ++i_) { const int c_ = tid + 512 * i_; \
            *(LAS u32x4*)(lds + ML_QS + (c_ >> 4) * 272 + (c_ & 15) * 16) = Q_[i_]; \
            *(LAS u32x4*)(lds + ML_KS + (c_ >> 4) * 272 + (c_ & 15) * 16) = K_[i_]; \
            *(LAS u32x4*)(lds + ML_KTS + (c_ >> 3) * 144 + (c_ & 7) * 16) = KT_[i_]; } \
        if (tid < 256) *(LAS u32x4*)(lds + ML_VTS + (tid >> 3) * 144 + (tid & 7) * 16) = V_; \
        if (tid < 48) *(LAS u32x4*)(lds + ML_GL + tid * 16) = G_; } while (0)
        ML_LOAD(0, rq, rk, rkt, rv, rg);
        ML_STORE(rq, rk, rkt, rv, rg);
        __syncthreads();
        ML_LOAD(1, rq, rk, rkt, rv, rg); ML_LOAD(2, sq, sk, skt, sv, sg);
        auto chunk = [&](const int k) __attribute__((always_inline)) {
            const LAS float* ga = (const LAS float*)(lds + ML_GL);
            const float m = ((const LAS float*)(lds + ML_MP))[k];
            const int cur = k & 1;
            if (wave < 4) {
                const int tr = wave, t = 16 * tr + r16;
                const float Mt = fmaxf(m, ga[64 + t]);
                bf16x8s qf[4];
#pragma unroll
                for (int kk = 0; kk < 4; ++kk) qf[kk] = *(const LAS bf16x8s*)(lds + ML_QS + t * 272 + kk * 64 + q4 * 16);
#pragma unroll
                for (int sh = 0; sh < 2; ++sh) {
                    bf16x8s kf[2][4]; f32x4 a0v[2];
#pragma unroll
                    for (int s2 = 0; s2 < 2; ++s2) { const int sc = 2 * sh + s2;
#pragma unroll
                        for (int kk = 0; kk < 4; ++kk) kf[s2][kk] = *(const LAS bf16x8s*)(lds + ML_KS + (16 * sc + r16) * 272 + kk * 64 + q4 * 16);
                        a0v[s2] = *(const LAS f32x4*)(lds + ML_GL + (16 * sc + 4 * q4) * 4); }
                    __builtin_amdgcn_sched_barrier(0);
#pragma unroll
                    for (int s2 = 0; s2 < 2; ++s2) { const int sc = 2 * sh + s2;
                        u32x2 w0 = {0u, 0u};
                        if (sc <= tr) {
                            f32x4 s0 = {0.f, 0.f, 0.f, 0.f};
#pragma unroll
                            for (int kk = 0; kk < 4; ++kk) s0 = __builtin_amdgcn_mfma_f32_16x16x32_bf16(kf[s2][kk], qf[kk], s0, 0, 0, 0);
                            const f32x4 a0 = a0v[s2];
                            float p[4];
#pragma unroll
                            for (int j = 0; j < 4; ++j) { const int sA = 16 * sc + 4 * q4 + j; p[j] = (sA <= t) ? s0[j] * __expf(a0[j] - Mt) : 0.f; }
                            w0.x = cvt_pk_bf16(p[0], p[1]); w0.y = cvt_pk_bf16(p[2], p[3]);
                        }
                        *(LAS u32x2*)(lds + ML_PL + t * 144 + (16 * sc + 4 * q4) * 2) = w0;
                    }
                    __builtin_amdgcn_sched_barrier(0);
                }
                {
                    const int tq = 16 * tr + (lane >> 2), c0 = (lane & 3) * 32;
                    const float dec = __expf(m - fmaxf(m, ga[64 + tq]));
#pragma unroll
                    for (int i = 0; i < 4; ++i) { const u32x4 v = *(const LAS u32x4*)(lds + ML_QS + tq * 272 + (c0 + 8 * i) * 2); u32x4 o;
                        o.x = cvt_pk_bf16(bf_lo(v.x) * dec, bf_hi(v.x) * dec); o.y = cvt_pk_bf16(bf_lo(v.y) * dec, bf_hi(v.y) * dec);
                        o.z = cvt_pk_bf16(bf_lo(v.z) * dec, bf_hi(v.z) * dec); o.w = cvt_pk_bf16(bf_lo(v.w) * dec, bf_hi(v.w) * dec);
                        *(LAS u32x4*)(lds + ML_QD + tq * 272 + (c0 + 8 * i) * 2) = o; }
                }
                asm volatile("s_waitcnt lgkmcnt(0)" ::: "memory");
                f32x4 o0 = {0.f, 0.f, 0.f, 0.f}, o1 = o0, o2 = o0;
                {
                    bf16x8s pf[2], vv[2][3];
#pragma unroll
                    for (int kk = 0; kk < 2; ++kk) { pf[kk] = *(const LAS bf16x8s*)(lds + ML_PL + t * 144 + kk * 64 + q4 * 16);
#pragma unroll
                        for (int et = 0; et < 3; ++et) vv[kk][et] = *(const LAS bf16x8s*)(lds + ML_VTS + (16 * et + r16) * 144 + kk * 64 + q4 * 16); }
                    __builtin_amdgcn_sched_barrier(0);
#pragma unroll
                    for (int kk = 0; kk < 2; ++kk) {
                        o0 = __builtin_amdgcn_mfma_f32_16x16x32_bf16(vv[kk][0], pf[kk], o0, 0, 0, 0);
                        o1 = __builtin_amdgcn_mfma_f32_16x16x32_bf16(vv[kk][1], pf[kk], o1, 0, 0, 0);
                        o2 = __builtin_amdgcn_mfma_f32_16x16x32_bf16(vv[kk][2], pf[kk], o2, 0, 0, 0); }
                }
#pragma unroll
                for (int kh = 0; kh < 2; ++kh) {
                    bf16x8s qd[2], cc[2][3];
#pragma unroll
                    for (int k2 = 0; k2 < 2; ++k2) { const int kk = 2 * kh + k2; qd[k2] = *(const LAS bf16x8s*)(lds + ML_QD + t * 272 + kk * 64 + q4 * 16);
#pragma unroll
                        for (int et = 0; et < 3; ++et) cc[k2][et] = *(const LAS bf16x8s*)(lds + ML_CL + cur * 13056 + (16 * et + r16) * 272 + kk * 64 + q4 * 16); }
                    __builtin_amdgcn_sched_barrier(0);
#pragma unroll
                    for (int k2 = 0; k2 < 2; ++k2) {
                        o0 = __builtin_amdgcn_mfma_f32_16x16x32_bf16(cc[k2][0], qd[k2], o0, 0, 0, 0);
                        o1 = __builtin_amdgcn_mfma_f32_16x16x32_bf16(cc[k2][1], qd[k2], o1, 0, 0, 0);
                        o2 = __builtin_amdgcn_mfma_f32_16x16x32_bf16(cc[k2][2], qd[k2], o2, 0, 0, 0); }
                    __builtin_amdgcn_sched_barrier(0);
                }
                const float den = __shfl(o2[0], r16);
                const float mt = ga[128 + t] + Mt;
                const float inv = 1.f / fmaxf(fabsf(den), __expf(-mt));
                bf16_t* hp = a.HS + ((size_t)b * S + (size_t)k * 64 + t) * 2048 + h * 256 + es * 32 + 4 * q4;
                u32x2 w0, w1; w0.x = cvt_pk_bf16(o0[0] * inv, o0[1] * inv); w0.y = cvt_pk_bf16(o0[2] * inv, o0[3] * inv);
                w1.x = cvt_pk_bf16(o1[0] * inv, o1[1] * inv); w1.y = cvt_pk_bf16(o1[2] * inv, o1[3] * inv);
                *(u32x2*)hp = w0; *(u32x2*)(hp + 16) = w1;
            } else {
                const int dj = wave - 4;
                const float Ml = fmaxf(m, ga[64 + 63]), cd = __expf(m - Ml);
#pragma unroll
                for (int i = 0; i < 2; ++i)
#pragma unroll
                    for (int et = 0; et < 3; ++et) accC[i][et] = accC[i][et] * cd;
#pragma unroll
                for (int kk = 0; kk < 2; ++kk) {
                    const f32x4 aA = *(const LAS f32x4*)(lds + ML_GL + (32 * kk + 8 * q4) * 4), aB = *(const LAS f32x4*)(lds + ML_GL + (32 * kk + 8 * q4 + 4) * 4);
                    float wg[8];
#pragma unroll
                    for (int j = 0; j < 4; ++j) { wg[j] = __expf(aA[j] - Ml); wg[4 + j] = __expf(aB[j] - Ml); }
                    bf16x8s vw[3];
#pragma unroll
                    for (int et = 0; et < 3; ++et) { const u32x4 v = *(const LAS u32x4*)(lds + ML_VTS + (16 * et + r16) * 144 + kk * 64 + q4 * 16); u32x4 o;
                        o.x = cvt_pk_bf16(bf_lo(v.x) * wg[0], bf_hi(v.x) * wg[1]); o.y = cvt_pk_bf16(bf_lo(v.y) * wg[2], bf_hi(v.y) * wg[3]);
                        o.z = cvt_pk_bf16(bf_lo(v.z) * wg[4], bf_hi(v.z) * wg[5]); o.w = cvt_pk_bf16(bf_lo(v.w) * wg[6], bf_hi(v.w) * wg[7]);
                        vw[et] = __builtin_bit_cast(bf16x8s, o); }
#pragma unroll
                    for (int i = 0; i < 2; ++i) { const bf16x8s kf = *(const LAS bf16x8s*)(lds + ML_KTS + (16 * (2 * dj + i) + r16) * 144 + kk * 64 + q4 * 16);
#pragma unroll
                        for (int et = 0; et < 3; ++et) accC[i][et] = __builtin_amdgcn_mfma_f32_16x16x32_bf16(kf, vw[et], accC[i][et], 0, 0, 0); }
                }
#pragma unroll
                for (int i = 0; i < 2; ++i)
#pragma unroll
                    for (int et = 0; et < 3; ++et) { u32x2 w; w.x = cvt_pk_bf16(accC[i][et][0], accC[i][et][1]); w.y = cvt_pk_bf16(accC[i][et][2], accC[i][et][3]);
                        *(LAS u32x2*)(lds + ML_CL + (cur ^ 1) * 13056 + (16 * et + r16) * 272 + (16 * (2 * dj + i) + 4 * q4) * 2) = w; }
            }
        };
        for (int k = 0; k < 64; k += 2) {
            chunk(k);
            __syncthreads();
            ML_STORE(rq, rk, rkt, rv, rg);
            __syncthreads();
            ML_LOAD(k + 3, rq, rk, rkt, rv, rg);
            chunk(k + 1);
            __syncthreads();
            ML_STORE(sq, sk, skt, sv, sg);
            __syncthreads();
            ML_LOAD(k + 4, sq, sk, skt, sv, sg);
        }
#undef ML_LOAD
#undef ML_STORE
    }
}
__device__ __forceinline__ void phase_mnorm(const Args& a, int gw, int NGW, int lane) {
    const bf16_t* SG = a.P3 + (size_t)2 * NT * 2048;
    float gv[32];
#pragma unroll
    for (int i = 0; i < 8; ++i) { const f32x4 t = *(const f32x4*)(a.m_hg + 32 * lane + 4 * i); gv[4 * i] = t[0]; gv[4 * i + 1] = t[1]; gv[4 * i + 2] = t[2]; gv[4 * i + 3] = t[3]; }
    const int RPW = (NT + NGW - 1) / NGW; int m = gw * RPW; const int mend = (m + RPW < NT) ? m + RPW : NT;
    if (m >= mend) return;
    u32x4 p0[4], p1[4], n0[4], n1[4];
#pragma unroll
    for (int i = 0; i < 4; ++i) { p0[i] = *(const u32x4*)(a.HS + (size_t)m * D + 32 * lane + 8 * i); p1[i] = *(const u32x4*)(SG + (size_t)m * D + 32 * lane + 8 * i); }
    for (;;) {
        const bool more = m + 1 < mend;
        if (more) {
#pragma unroll
            for (int i = 0; i < 4; ++i) { n0[i] = *(const u32x4*)(a.HS + (size_t)(m + 1) * D + 32 * lane + 8 * i); n1[i] = *(const u32x4*)(SG + (size_t)(m + 1) * D + 32 * lane + 8 * i); } }
        float o[32], sg[32]; float ss = 0.f;
#pragma unroll
        for (int i = 0; i < 4; ++i) { float f0[8], f1[8]; bf8_to_f32(p0[i], f0); bf8_to_f32(p1[i], f1);
#pragma unroll
            for (int j = 0; j < 8; ++j) { o[8 * i + j] = f0[j]; sg[8 * i + j] = f1[j]; ss += f0[j] * f0[j]; } }
        ss += __shfl_xor(ss, 1); ss += __shfl_xor(ss, 2); ss += __shfl_xor(ss, 4);
        const float r = rsqrtf(ss * (1.f / 256.f) + EPS);
        unsigned char* orow = a.ob8 + (size_t)m * D + 32 * lane;
#pragma unroll
        for (int i = 0; i < 4; ++i) { float y[8];
#pragma unroll
            for (int j = 0; j < 8; ++j) y[j] = o[8 * i + j] * r * gv[8 * i + j] * sg[8 * i + j];
            u32x2 w; w.x = pk4_fp8(y[0] * 8.f, y[1] * 8.f, y[2] * 8.f, y[3] * 8.f); w.y = pk4_fp8(y[4] * 8.f, y[5] * 8.f, y[6] * 8.f, y[7] * 8.f);
            *(u32x2*)(orow + 8 * i) = w; }
        if (!more) break;
        ++m;
#pragma unroll
        for (int i = 0; i < 4; ++i) { p0[i] = n0[i]; p1[i] = n1[i]; }
    }
}

#define XB_TMO      128
#define XB_XCNT(j)  (256  + 64 * (j))
#define XB_XSUB(j)  (1280 + 64 * (j))
#define XB_XGEN(j)  (2304 + 64 * (j))
#define XB_TOP      3328
#define XB_TOPGEN   3392
#define XCD_BAR_WORDS 3456
#define XB_SPIN_CAP (1u << 18)

__device__ __forceinline__ unsigned xb_ld(unsigned* p)              { return __hip_atomic_load(p, __ATOMIC_RELAXED, __HIP_MEMORY_SCOPE_AGENT); }
__device__ __forceinline__ unsigned xb_add(unsigned* p, unsigned v) { return __hip_atomic_fetch_add(p, v, __ATOMIC_RELAXED, __HIP_MEMORY_SCOPE_AGENT); }
__device__ __forceinline__ unsigned xb_xcc_id() { return (unsigned)__builtin_amdgcn_s_getreg((3 << 11) | 20) & 0xFu; }
#define XB_SPIN(cond, bar) do { unsigned _sp = 0; while (cond) { __builtin_amdgcn_s_sleep(1); \
    if ((++_sp & 255u) == 0u) { if (xb_ld(&(bar)[XB_TMO])) break; if (_sp > XB_SPIN_CAP) { atomicAdd(&(bar)[XB_TMO], 1u); break; } } } } while (0)

struct XcdBarrier {
    unsigned* bar; unsigned x;
    volatile LAS unsigned* st;
};

__device__ __forceinline__ XcdBarrier xcd_barrier_post(unsigned* bar, volatile LAS unsigned* st) {
    XcdBarrier b; b.bar = bar; b.x = xb_xcc_id(); b.st = st;
    if (threadIdx.x == 0) (void)xb_add(&bar[XB_XCNT(b.x)], 1u);
    return b;
}
__device__ __forceinline__ void xcd_barrier_complete(unsigned* bar, unsigned x, unsigned& nloc, unsigned& nx) {
    const unsigned G = gridDim.x * gridDim.y * gridDim.z;
    unsigned sum, cnt, mine, sp = 0u;
    for (;;) {
        sum = 0u; cnt = 0u; mine = 0u;
#pragma unroll
        for (unsigned j = 0; j < 16; ++j) { const unsigned c = xb_ld(&bar[XB_XCNT(j)]); sum += c; cnt += (c > 0u) ? 1u : 0u; mine = (j == x) ? c : mine; }
        if (sum == G) break;
        __builtin_amdgcn_s_sleep(1);
        if ((++sp & 255u) == 0u) { if (xb_ld(&bar[XB_TMO])) break; if (sp > XB_SPIN_CAP) { atomicAdd(&bar[XB_TMO], 1u); break; } }
    }
    nloc = mine > 0u ? mine : 1u; nx = cnt > 0u ? cnt : 1u;
}

__device__ __forceinline__ void xcd_barrier(const XcdBarrier& b) {
    asm volatile("s_waitcnt vmcnt(0)" ::: "memory");
    __syncthreads();
    if (threadIdx.x == 0) {
        unsigned* bar = b.bar;
        __builtin_amdgcn_s_waitcnt(0);
        unsigned nloc = b.st[0], nx = b.st[1];
        if (nloc == 0u) { xcd_barrier_complete(bar, b.x, nloc, nx); b.st[0] = nloc; b.st[1] = nx; }
        const unsigned old = xb_add(&bar[XB_XSUB(b.x)], 1u);
        const unsigned gen = old / nloc;
        if (old + 1u == (gen + 1u) * nloc) {
            __builtin_amdgcn_fence(__ATOMIC_RELEASE, "agent");
            asm volatile("s_waitcnt vmcnt(0)" ::: "memory");
            const unsigned og = xb_add(&bar[XB_TOP], 1u);
            const unsigned tg = og / nx;
            if (og + 1u == (tg + 1u) * nx) xb_add(&bar[XB_TOPGEN], 1u);
            else XB_SPIN(xb_ld(&bar[XB_TOPGEN]) == tg, bar);
            __builtin_amdgcn_fence(__ATOMIC_ACQUIRE, "agent");
            xb_add(&bar[XB_XGEN(b.x)], 1u);
            asm volatile("s_waitcnt vmcnt(0)" ::: "memory");
        } else {
            XB_SPIN(xb_ld(&bar[XB_XGEN(b.x)]) == gen, bar);
            __builtin_amdgcn_fence(__ATOMIC_ACQUIRE, "agent");
            asm volatile("s_waitcnt vmcnt(0)" ::: "memory");
        }
    }
    __syncthreads();
}


#ifndef MK_REP_MASK
#define MK_REP_MASK 0u
#endif
__device__ __forceinline__ constexpr int REPS(int k) { return ((MK_REP_MASK >> k) & 1u) ? 2 : 1; }
__global__ void __launch_bounds__(NTHR, 2) mk_fwd(Args a) {
    extern __shared__ __attribute__((aligned(16))) unsigned char lds_raw[];
    LAS unsigned char* lds = (LAS unsigned char*)lds_raw;
    LAS unsigned char* misc = lds + LDS_MISC;
    const int tid = threadIdx.x, lane = tid & 63, wave = __builtin_amdgcn_readfirstlane(tid >> 6);
    const int G = gridDim.x; const int bx = blockIdx.x; const int vcu = (G % 8 == 0) ? (bx % 8) * (G / 8) + bx / 8 : bx;
    const int gw = vcu * NWAVES + wave, NGW = G * NWAVES;
    if (tid < 16) ((LAS unsigned*)(misc + MISC_BAR))[tid] = 0u;
    __syncthreads();
    const int lo = a.ph_lo, hi = a.ph_hi;
    XcdBarrier bar; bar.bar = a.ctl + 4096; bar.x = 0; bar.st = nullptr;
    if (hi - lo > 1) bar = xcd_barrier_post(a.ctl + 4096, (volatile LAS unsigned*)(misc + MISC_BAR));
#define IN(k) (lo <= (k) && (k) < hi)
#define SEAM(k) do { if (IN(k) && IN((k) + 1)) xcd_barrier(bar); } while (0)
    const float* mod0 = a.mod; const float* mod1 = a.mod + (size_t)NB * 6 * D;

#define PH(k) if (IN(k)) _Pragma("unroll") for (int rep_ = 0; rep_ < REPS(k); (REPS(k) > 1 ? __syncthreads() : (void)0, ++rep_))
    PH(0) { p0_prologue(a, lds, vcu, G, opq(tid), wave, opq(lane)); } SEAM(0);
    PH(1) { phase_norm(a.x, a.nmg, mod0, 0, 1, a.hb, gw, NGW, opq(lane)); } SEAM(1);
    PH(2) {
        pg8::Gemm g{a.hb, a.Bt_qkv, NT, 6144, D}; pg8::StaticOrder So; So.init(NT, 6144, G, bx);
        EpiQKV E{a.Qh, a.Kh, a.Vh, a.cs};
        pg8::gemm_phase<EpiQKV, pg8::StaticOrder, true, true>(lds, g, So, E);
    } SEAM(2);
    PH(3) { phase_attn(a, (char*)lds_raw, vcu, G); } SEAM(3);
    PH(4) { phase_attn_combine(a, gw, NGW, opq(lane)); } SEAM(4);
    PH(5) {
        pg8::Gemm g{a.ob, a.Bt_ao, NT, D, D}; pg8::StaticOrder So; So.init(NT, D, G, bx);
        EpiResid<true> E{a.x, a.xres, mod0 + 2 * D, 1.f};
        pg8::gemm_phase<EpiResid<true>, pg8::StaticOrder, true, true>(lds, g, So, E);
    } SEAM(5);
#define MOE_PHASES(P, layer, modl)                                                                                                   \
    PH(P) { phase_norm_route(a, layer, modl, lds, misc, vcu, G, opq(tid), wave, opq(lane)); } SEAM(P);                            \
    PH(P + 1) { const int NP = moe_tables(a.counts + (layer) * 64, misc, tid);                                                    \
        pg8::Gemm g{(const bf16_t*)a.hb8, (const bf16_t*)(a.Bt_gu8 + (size_t)(layer) * NE * 2048 * D), NP * 256, NE * 2048, D / 2};     \
        GroupedOrderG So; So.NP = NP; So.total = NP * 8; So.G = G; So.c = vcu; So.pe = (const LAS int*)(misc + MISC_PE);          \
        So.ps = (const LAS int*)(misc + MISC_PS); So.cn = (const LAS int*)(misc + MISC_CNT); So.inv = a.inv; EpiGU E{a.Hm8};      \
        pg8::gemm_phase_gather<EpiGU, GroupedOrderG, true, 125, 121>(lds, g, So, E); } SEAM(P + 1);                                               \
    PH(P + 2) { const int NP = moe_tables(a.counts + (layer) * 64, misc, tid);                                                    \
        pg8::Gemm g{(const bf16_t*)a.Hm8, (const bf16_t*)(a.Bt_dn8 + (size_t)(layer) * NE * D * MH), NP * 256, NE * 2048, MH / 2};   \
        GroupedOrder So{NP, NP * 8, G, vcu, (const LAS int*)(misc + MISC_PE)}; EpiBf16G E{a.Y, D, 1.f / 128.f};                                \
        pg8::gemm_phase<EpiBf16G, GroupedOrder, true, true, true, 125, 122>(lds, g, So, E); } SEAM(P + 2);
    MOE_PHASES(6, 0, mod0)
    PH(9) { moe_tables(a.counts, misc, tid); phase_combine_gates(a, mod0, mod1, a.nmg + D, (const LAS int*)(misc + MISC_PS), lds, vcu, G, opq(tid), wave, opq(lane)); } SEAM(9);
    PH(10) {
        pg8::Gemm g{(const bf16_t*)a.hb8, (const bf16_t*)a.Bt_min8, NT, 6144, D / 2}; pg8::StaticOrder So; So.init(NT, 6144, G, bx);
        EpiMin E{a.P3};
        pg8::gemm_phase<EpiMin, pg8::StaticOrder, true, true, true>(lds, g, So, E);
    } SEAM(10);
    PH(11) { phase_mprep(a, lds, vcu, G, opq(tid)); } SEAM(11);
    PH(12) { phase_mlstm(a, lds, vcu, G, opq(tid), wave, opq(lane)); } SEAM(12);
    PH(13) { phase_mnorm(a, gw, NGW, opq(lane)); } SEAM(13);
    PH(14) {
        pg8::Gemm g{(const bf16_t*)a.ob8, (const bf16_t*)a.Bt_mo8, NT, D, D / 2}; pg8::StaticOrder So; So.init(NT, D, G, bx);
        EpiResid<false> E{a.xres, a.xres, mod1 + 2 * D, 1.f / 512.f};
        pg8::gemm_phase<EpiResid<false>, pg8::StaticOrder, true, true, true>(lds, g, So, E);
    } SEAM(14);
    MOE_PHASES(15, 1, mod1)
    PH(18) { moe_tables(a.counts + 64, misc, tid); phase_combine_final(a, mod1, (const LAS int*)(misc + MISC_PS), gw, NGW, opq(lane)); }
#undef PH
#undef IN
#undef SEAM
}
}

extern "C" void kernel_launch(void* const* d_in, const int* in_sizes, int n_in, void* d_out, int out_size, void* d_ws, size_t ws_size, hipStream_t st) {
    using namespace mk;
    static int grid = 0;
    if (grid == 0) {
        int dev = 0, cus = 0;
        if (hipGetDevice(&dev) != hipSuccess || hipDeviceGetAttribute(&cus, hipDeviceAttributeMultiprocessorCount, dev) != hipSuccess || cus <= 0) cus = 256;
        (void)hipFuncSetAttribute((const void*)mk_fwd, hipFuncAttributeMaxDynamicSharedMemorySize, LDS_BYTES);
        int per_cu = 0; (void)hipOccupancyMaxActiveBlocksPerMultiprocessor(&per_cu, (const void*)mk_fwd, NTHR, LDS_BYTES);
        (void)hipGetLastError();
        grid = cus;
    }
    Args a{};
    a.x = (const float*)d_in[0]; a.c = (const float*)d_in[1]; a.pos = (const int*)d_in[2];
    a.ada_w = (const float*)d_in[3]; a.ada_b = (const float*)d_in[4]; a.nmg = (const float*)d_in[5]; a.nfg = (const float*)d_in[6]; a.fng = (const float*)d_in[7];
    a.a_win = (const float*)d_in[8]; a.a_wout = (const float*)d_in[9];
    a.lq1 = (const float*)d_in[10]; a.lk1 = (const float*)d_in[11]; a.lq2 = (const float*)d_in[12]; a.lk2 = (const float*)d_in[13]; a.a_hg = (const float*)d_in[14];
    a.m_win = (const float*)d_in[15]; a.m_cw = (const float*)d_in[16]; a.m_cb = (const float*)d_in[17]; a.m_gb = (const float*)d_in[18]; a.m_hg = (const float*)d_in[19]; a.m_wout = (const float*)d_in[20];
    a.wg = (const float*)d_in[21]; a.bg = (const float*)d_in[22]; a.we = (const float*)d_in[23]; a.be = (const float*)d_in[24]; a.wgu = (const float*)d_in[25]; a.wdn = (const float*)d_in[26];
    a.out = (float*)d_out;
    char* w = (char*)d_ws; size_t off = 0;
    auto alloc = [&](size_t bytes) { void* p = w + off; off += (bytes + 4095) & ~(size_t)4095; return p; };
    a.ctl = (unsigned*)alloc(1 << 20);
    a.counts = (int*)(a.ctl + 65536);
    a.mod = (float*)alloc((size_t)2 * NB * 6 * D * 4);
    a.cs = (float2*)alloc((size_t)NT * 16 * 8);
    a.Bt_qkv = (bf16_t*)alloc((size_t)6144 * D * 2); a.Bt_ao = (bf16_t*)alloc((size_t)D * D * 2); a.Bt_min = nullptr; a.Bt_mo = nullptr; a.Bt_min8 = (unsigned char*)alloc((size_t)6144 * D); a.Bt_mo8 = (unsigned char*)alloc((size_t)D * D);
    a.Bt_rt = (bf16_t*)alloc((size_t)2 * 256 * D * 2); a.Bt_g = (bf16_t*)alloc((size_t)16 * D * 2); a.Bt_gu = nullptr; a.Bt_dn = nullptr;
    a.Bt_gu8 = (unsigned char*)alloc((size_t)2 * NE * 2048 * D); a.Bt_dn8 = (unsigned char*)alloc((size_t)2 * NE * D * MH); a.hb8 = (unsigned char*)alloc((size_t)(NT + 1) * D);
    a.xres = (bf16_t*)alloc((size_t)NT * D * 2); a.hb = (bf16_t*)alloc((size_t)(NT + 1) * D * 2); a.ob = (bf16_t*)alloc((size_t)NT * D * 2); a.ob8 = (unsigned char*)a.ob;

    a.logits = nullptr; a.eid = (int*)alloc((size_t)NA * 4); a.wts = (float*)alloc((size_t)NA * 4); a.pos_in_e = (int*)alloc((size_t)NA * 4); a.slot = nullptr; a.inv = (int*)alloc((size_t)NE * 32768 * 4);
    a.Qh = (bf16_t*)alloc((size_t)3 * NT * 2048 * 2); a.Kh = a.Qh + (size_t)NT * 2048; a.Vh = a.Kh + (size_t)NT * 2048; a.Oa = (bf16_t*)alloc((size_t)NT * 4096 * 2);
    a.P3 = (bf16_t*)alloc((size_t)3 * NT * 2048 * 2); a.Qn = (bf16_t*)alloc((size_t)2 * NT * 1024 * 2); a.Kn = a.Qn + (size_t)NT * 1024;
    a.KT = (bf16_t*)alloc((size_t)NT * 1024 * 2); a.VT = (bf16_t*)alloc((size_t)NT * 2048 * 2); a.HS = (bf16_t*)alloc((size_t)NT * 2048 * 2);
    a.gates = (float*)alloc((size_t)NT * 16 * 4); a.GA = (float*)alloc((size_t)32 * 64 * 192 * 4); a.GS = (float*)alloc((size_t)32 * 64 * 2 * 4);
    a.XG = nullptr; a.Hm = nullptr; a.Hm8 = (unsigned char*)alloc((size_t)PMAX * MH); a.Y = (bf16_t*)alloc((size_t)PMAX * D * 2);
    if (off > ws_size) return;

    (void)hipMemsetAsync(a.ctl, 0, 1 << 20, st);
    auto run = [&](int lo, int hi) { a.ph_lo = lo; a.ph_hi = hi; hipLaunchKernelGGL(mk_fwd, dim3(grid), dim3(NTHR), LDS_BYTES, st, a); };
#ifndef MK_N_LAUNCHES
#define MK_N_LAUNCHES 1
#endif
#if MK_N_LAUNCHES == 1
    run(0, 19);
#else
    for (int p = 0; p <= 18; ++p) run(p, p + 1);
#endif
}
```
